# Optimizing an MI355X kernel written in HIP

```python
import jax, jax.numpy as jnp
from jax import lax
import numpy as np

D_MODEL = 4096
BATCH = 4
SEQ = 2048
DEPTH = 1

HEAD_DIM = 128
SWA_Q_HEADS = 16
SWA_KV_HEADS = 4
SWA_WINDOW = 128
SWA_BLOCK = 128
ROPE_THETA = 10000.0
NAT_HEADS = 16
NAT_KR_MAX = 8
NAT_KC = 16
GRID_W = 64
NAT_QROWS = 2
SWA_Q_W = SWA_Q_HEADS * HEAD_DIM
SWA_KV_W = SWA_KV_HEADS * HEAD_DIM
NAT_W = NAT_HEADS * HEAD_DIM
MIX_W = SWA_Q_W + NAT_W
IN_W = SWA_Q_W + 2 * SWA_KV_W + 3 * NAT_W
MEM_LEN = 256
MEM_HEADS = 4
MEM_HEAD_DIM = 256
MEM_W = MEM_HEADS * MEM_HEAD_DIM
PEER_HEADS = 8
PEER_NKEYS = 128
PEER_EXPERTS = PEER_NKEYS * PEER_NKEYS
PEER_QDIM = 256
PEER_TOPK = 16
PEER_CHUNK = 64
RMS_EPS = 1e-6
NEG_INF = -1e30

kernel_name = 'hymba_swa_nat_peer_encoder_layer'


def rms_norm(x, g):
    xf = x.astype(jnp.float32)
    y = xf * lax.rsqrt(jnp.mean(xf * xf, axis=-1, keepdims=True) + RMS_EPS)
    return (y * g.astype(jnp.float32)).astype(x.dtype)


def rope(x, pos):
    half = HEAD_DIM // 2
    inv = ROPE_THETA ** (-jnp.arange(half, dtype=jnp.float32) / half)
    ang = pos.astype(jnp.float32)[:, None] * inv[None, :]
    cos = jnp.cos(ang)[None, :, None, :]
    sin = jnp.sin(ang)[None, :, None, :]
    xf = x.astype(jnp.float32)
    x1, x2 = xf[..., :half], xf[..., half:]
    return jnp.concatenate([x1 * cos - x2 * sin, x2 * cos + x1 * sin], axis=-1).astype(x.dtype)


def swa_sink_attention(q, k, v, sink):
    B, S = q.shape[0], q.shape[1]
    nb = S // SWA_BLOCK
    G = SWA_Q_HEADS // SWA_KV_HEADS
    qb = q.reshape(B, nb, SWA_BLOCK, SWA_KV_HEADS, G, HEAD_DIM)
    pad = ((0, 0), (SWA_BLOCK, SWA_BLOCK), (0, 0), (0, 0))

    def band(t):
        tp = jnp.pad(t, pad).reshape(B, nb + 2, SWA_BLOCK, SWA_KV_HEADS, HEAD_DIM)
        return jnp.concatenate([tp[:, :-2], tp[:, 1:-1], tp[:, 2:]], axis=2)

    kb, vb = band(k), band(v)
    s = jnp.einsum('bnqhgd,bnkhd->bnhgqk', qb, kb, preferred_element_type=jnp.float32) * (HEAD_DIM ** -0.5)
    qpos = np.arange(nb)[:, None] * SWA_BLOCK + np.arange(SWA_BLOCK)[None, :]
    kpos = np.arange(nb)[:, None] * SWA_BLOCK - SWA_BLOCK + np.arange(3 * SWA_BLOCK)[None, :]
    valid = ((np.abs(qpos[:, :, None] - kpos[:, None, :]) <= SWA_WINDOW)
             & (kpos[:, None, :] >= 0) & (kpos[:, None, :] < S))
    s = jnp.where(valid[None, :, None, None], s, NEG_INF)
    sink_l = sink.astype(jnp.float32).reshape(SWA_KV_HEADS, G)[None, None, :, :, None, None]
    m = jnp.maximum(jnp.max(s, axis=-1, keepdims=True), sink_l)
    p = jnp.exp(s - m)
    p = p / (jnp.sum(p, axis=-1, keepdims=True) + jnp.exp(sink_l - m))
    o = jnp.einsum('bnhgqk,bnkhd->bnqhgd', p.astype(v.dtype), vb)
    return o.reshape(B, S, SWA_Q_W)


def neighborhood_attention(q, k, v, rel_bias):
    B, S = q.shape[0], q.shape[1]
    rows = S // GRID_W
    kr = min(NAT_KR_MAX, rows)
    span = min(rows, NAT_QROWS + kr - 1)
    nb = rows // NAT_QROWS
    qbl = NAT_QROWS * GRID_W
    r0 = np.arange(nb) * NAT_QROWS
    kstart = np.clip(r0 - kr // 2, 0, rows - span)
    key_rows = kstart[:, None] + np.arange(span)[None, :]
    kg = k.reshape(B, rows, GRID_W, NAT_HEADS, HEAD_DIM)[:, key_rows].reshape(B, nb, span * GRID_W, NAT_HEADS, HEAD_DIM)
    vg = v.reshape(B, rows, GRID_W, NAT_HEADS, HEAD_DIM)[:, key_rows].reshape(B, nb, span * GRID_W, NAT_HEADS, HEAD_DIM)
    qb = q.reshape(B, nb, qbl, NAT_HEADS, HEAD_DIM)
    q_row = r0[:, None] + (np.arange(qbl) // GRID_W)[None, :]
    q_col = np.broadcast_to((np.arange(qbl) % GRID_W)[None, :], q_row.shape)
    k_row = np.repeat(key_rows, GRID_W, axis=1)
    k_col = np.broadcast_to(np.tile(np.arange(GRID_W), span)[None, :], k_row.shape)
    rs = np.clip(q_row - kr // 2, 0, rows - kr)[:, :, None]
    cs = np.clip(q_col - NAT_KC // 2, 0, GRID_W - NAT_KC)[:, :, None]
    kr3, kc3 = k_row[:, None, :], k_col[:, None, :]
    valid = (kr3 >= rs) & (kr3 < rs + kr) & (kc3 >= cs) & (kc3 < cs + NAT_KC)
    dr = np.clip(kr3 - q_row[:, :, None] + NAT_KR_MAX - 1, 0, 2 * NAT_KR_MAX - 2)
    dc = np.clip(kc3 - q_col[:, :, None] + NAT_KC - 1, 0, 2 * NAT_KC - 2)
    bias = jnp.transpose(rel_bias[:, dr, dc], (1, 0, 2, 3)).astype(jnp.float32)
    s = jnp.einsum('bnqhd,bnkhd->bnhqk', qb, kg, preferred_element_type=jnp.float32) * (HEAD_DIM ** -0.5)
    s = jnp.where(valid[None, :, None], s + bias[None], NEG_INF)
    p = jax.nn.softmax(s, axis=-1)
    o = jnp.einsum('bnhqk,bnkhd->bnqhd', p.astype(v.dtype), vg)
    return o.reshape(B, S, NAT_W)


def memory_cross_attention(hn, memn, w_q, w_k, w_v, w_o):
    B, S = hn.shape[0], hn.shape[1]
    M = memn.shape[1]
    q = (hn @ w_q).reshape(B, S, MEM_HEADS, MEM_HEAD_DIM)
    k = (memn @ w_k).reshape(B, M, MEM_HEADS, MEM_HEAD_DIM)
    v = (memn @ w_v).reshape(B, M, MEM_HEADS, MEM_HEAD_DIM)
    s = jnp.einsum('bqhd,bkhd->bhqk', q, k, preferred_element_type=jnp.float32) * (MEM_HEAD_DIM ** -0.5)
    p = jax.nn.softmax(s, axis=-1)
    o = jnp.einsum('bhqk,bkhd->bqhd', p.astype(v.dtype), v).reshape(B, S, MEM_W)
    return o @ w_o


def peer_ffn(hn, w_q, sub_keys, u, v):
    B, S, D = hn.shape
    T = B * S
    x2 = hn.reshape(T, D)
    q = (x2 @ w_q).reshape(T, PEER_HEADS, 2, PEER_QDIM // 2)
    s = jnp.einsum('thcd,hckd->thck', q, sub_keys, preferred_element_type=jnp.float32)
    s1, i1 = lax.top_k(s[:, :, 0], PEER_TOPK)
    s2, i2 = lax.top_k(s[:, :, 1], PEER_TOPK)
    cand_s = (s1[..., :, None] + s2[..., None, :]).reshape(T, PEER_HEADS, PEER_TOPK * PEER_TOPK)
    cand_i = (i1[..., :, None] * PEER_NKEYS + i2[..., None, :]).reshape(T, PEER_HEADS, PEER_TOPK * PEER_TOPK)
    top_s, pos = lax.top_k(cand_s, PEER_TOPK)
    idx = jnp.take_along_axis(cand_i, pos, axis=-1).reshape(T, PEER_HEADS * PEER_TOPK)
    g = jax.nn.softmax(top_s, axis=-1).reshape(T, PEER_HEADS * PEER_TOPK)
    nc = T // PEER_CHUNK

    def chunk(args):
        xc, ic, gc = args
        a = jnp.einsum('cd,ced->ce', xc, u[ic], preferred_element_type=jnp.float32)
        w = (jax.nn.gelu(a, approximate=False) * gc).astype(v.dtype)
        return jnp.einsum('ce,ced->cd', w, v[ic])

    out = lax.map(chunk, (x2.reshape(nc, PEER_CHUNK, D),
                          idx.reshape(nc, PEER_CHUNK, -1),
                          g.reshape(nc, PEER_CHUNK, -1)))
    return out.reshape(B, S, D).astype(hn.dtype)


def setup_inputs(seed: int = 0) -> dict:
    key = jax.random.key(seed)
    ks = jax.random.split(key, 24)
    f32 = jnp.float32

    def nrm(k, shape, scale):
        return jax.random.normal(k, shape, f32) * scale

    def gain(k, shape):
        return 1.0 + 0.1 * jax.random.normal(k, shape, f32)

    return {
        'x': nrm(ks[0], (BATCH, SEQ, D_MODEL), 1.0),
        'mem': nrm(ks[1], (BATCH, MEM_LEN, D_MODEL), 1.0),
        'norm_mix': gain(ks[2], (DEPTH, D_MODEL)),
        'w_in': nrm(ks[3], (DEPTH, D_MODEL, IN_W), D_MODEL ** -0.5),
        'swa_sink': nrm(ks[4], (DEPTH, SWA_Q_HEADS), 1.0),
        'nat_rel_bias': nrm(ks[5], (DEPTH, NAT_HEADS, 2 * NAT_KR_MAX - 1, 2 * NAT_KC - 1), 0.5),
        'out_norm_swa': gain(ks[6], (DEPTH, SWA_Q_W)),
        'out_norm_nat': gain(ks[7], (DEPTH, NAT_W)),
        'w_out': nrm(ks[8], (DEPTH, MIX_W, D_MODEL), MIX_W ** -0.5),
        'norm_mem_q': gain(ks[9], (DEPTH, D_MODEL)),
        'norm_mem_kv': gain(ks[10], (DEPTH, D_MODEL)),
        'w_mem_q': nrm(ks[11], (DEPTH, D_MODEL, MEM_W), D_MODEL ** -0.5),
        'w_mem_k': nrm(ks[12], (DEPTH, D_MODEL, MEM_W), D_MODEL ** -0.5),
        'w_mem_v': nrm(ks[13], (DEPTH, D_MODEL, MEM_W), D_MODEL ** -0.5),
        'w_mem_o': nrm(ks[14], (DEPTH, MEM_W, D_MODEL), MEM_W ** -0.5),
        'norm_ffn': gain(ks[15], (DEPTH, D_MODEL)),
        'w_peer_q': nrm(ks[16], (DEPTH, D_MODEL, PEER_HEADS * PEER_QDIM), D_MODEL ** -0.5),
        'peer_sub_keys': nrm(ks[17], (DEPTH, PEER_HEADS, 2, PEER_NKEYS, PEER_QDIM // 2), (PEER_QDIM // 2) ** -0.5),
        'peer_u': nrm(ks[18], (DEPTH, PEER_EXPERTS, D_MODEL), D_MODEL ** -0.5),
        'peer_v': nrm(ks[19], (DEPTH, PEER_EXPERTS, D_MODEL), PEER_TOPK ** -0.5),
        'norm_final': gain(ks[20], (D_MODEL,)),
    }


def reference(x, mem, norm_mix, w_in, swa_sink, nat_rel_bias, out_norm_swa, out_norm_nat, w_out,
              norm_mem_q, norm_mem_kv, w_mem_q, w_mem_k, w_mem_v, w_mem_o,
              norm_ffn, w_peer_q, peer_sub_keys, peer_u, peer_v, norm_final):
    B, S = x.shape[0], x.shape[1]
    pos = jnp.arange(S, dtype=jnp.int32)
    splits = [SWA_Q_W, SWA_Q_W + SWA_KV_W, SWA_Q_W + 2 * SWA_KV_W,
              SWA_Q_W + 2 * SWA_KV_W + NAT_W, SWA_Q_W + 2 * SWA_KV_W + 2 * NAT_W]
    h = x
    for l in range(DEPTH):
        xn = rms_norm(h, norm_mix[l])
        qa, ka, va, qb, kb, vb = jnp.split(xn @ w_in[l], splits, axis=-1)
        qa = rope(qa.reshape(B, S, SWA_Q_HEADS, HEAD_DIM), pos)
        ka = rope(ka.reshape(B, S, SWA_KV_HEADS, HEAD_DIM), pos)
        va = va.reshape(B, S, SWA_KV_HEADS, HEAD_DIM)
        oa = swa_sink_attention(qa, ka, va, swa_sink[l])
        ob = neighborhood_attention(qb.reshape(B, S, NAT_HEADS, HEAD_DIM),
                                    kb.reshape(B, S, NAT_HEADS, HEAD_DIM),
                                    vb.reshape(B, S, NAT_HEADS, HEAD_DIM), nat_rel_bias[l])
        mixed = jnp.concatenate([rms_norm(oa, out_norm_swa[l]), rms_norm(ob, out_norm_nat[l])], axis=-1)
        h = h + mixed @ w_out[l]
        h = h + memory_cross_attention(rms_norm(h, norm_mem_q[l]), rms_norm(mem, norm_mem_kv[l]),
                                       w_mem_q[l], w_mem_k[l], w_mem_v[l], w_mem_o[l])
        h = h + peer_ffn(rms_norm(h, norm_ffn[l]), w_peer_q[l], peer_sub_keys[l], peer_u[l], peer_v[l])
    return rms_norm(h, norm_final)
```

```cpp
#include <hip/hip_runtime.h>
#include <cstdio>
#include <cstdint>
namespace pg8 {
#define PG8_LAS __attribute__((address_space(3)))
typedef unsigned short bf16_t;
typedef short bf16x8 __attribute__((ext_vector_type(8)));
typedef float f32x4 __attribute__((ext_vector_type(4)));
typedef unsigned u32x4 __attribute__((ext_vector_type(4)));
constexpr int BM = 256, BK = 64, HALF = 128, HTB = HALF * BK * 2  , STAGE_BYTES = 8 * HTB, NXCD = 8, WGM = 8;

__host__ __device__ __forceinline__ int lds_byte(int r, int c) { const int st = (r >> 4) * 2 + (c >> 5), rr = r & 15, cc = c & 31, ob = rr * 64 + cc * 2; return st * 1024 + (ob ^ (((ob >> 9) & 1) << 5)); }
__host__ __device__ __forceinline__ void stage_rc(int b, int& R, int& C) { const int st = b / 1024, sb = b % 1024, swz = sb ^ (((sb >> 9) & 1) << 5); R = (st >> 1) * 16 + swz / 64; C = (st & 1) * 32 + (swz % 64) / 2; }
__host__ __device__ __forceinline__ int perm32(int rho) { const int n = rho >> 4, i = rho & 15; return 8 * (i >> 2) + 4 * n + (i & 3); }

struct Unit { int pm, pn; };
struct Gemm { const bf16_t* A; const bf16_t* Bt; int M, N, K; };

struct StaticOrder {
    int nM, nN, nwg, G, c;
    __host__ __device__ void init(int M, int N, int G_, int c_) { nM = M / BM; nN = N / BM; nwg = nM * nN; G = G_; c = c_; }
    __host__ __device__ bool next(int i, Unit& u) const {
        const long L = (long)i * G + c; if (L >= nwg) return false;
        int wgid = (int)L; { const int q = nwg / NXCD, r = nwg % NXCD, xcd = wgid % NXCD, off = wgid / NXCD; wgid = (xcd < r ? xcd * (q + 1) : r * (q + 1) + (xcd - r) * q) + off; }
        const int nig = WGM * nN, gid = wgid / nig, fm = gid * WGM, gsz = (nM - fm) < WGM ? (nM - fm) : WGM;
        u.pm = fm + ((wgid % nig) % gsz); u.pn = (wgid % nig) / gsz; return true;
    }
    __device__ __forceinline__ void a_ready(const Unit&) const {}
    __device__ __forceinline__ void done(const Unit&) const {}
};

__device__ __forceinline__ unsigned cvt_pk_bf16(float lo, float hi) { unsigned r; asm volatile("v_cvt_pk_bf16_f32 %0, %1, %2" : "=v"(r) : "v"(lo), "v"(hi)); return r; }
typedef float f32x2 __attribute__((ext_vector_type(2)));
__device__ __forceinline__ f32x2 gelu_pk(f32x2 v) {
    const f32x2 av = __builtin_elementwise_abs(v), d = av * 0.2316418882f + 1.0f;
    f32x2 t; t.x = __builtin_amdgcn_rcpf(d.x); t.y = __builtin_amdgcn_rcpf(d.y);
    f32x2 q = t * 0.5307027145f + (-0.7265760135f); q = q * t + 0.7107068705f; q = q * t + (-0.142248368f); q = q * t + 0.127414796f; q = q * t;
    const f32x2 s = (v * v) * (-0.72134752044f);
    f32x2 e; e.x = __builtin_amdgcn_exp2f(s.x); e.y = __builtin_amdgcn_exp2f(s.y);
    const f32x2 m = v * (q * e), r = v - m;
    f32x2 o; o.x = v.x < 0.f ? m.x : r.x; o.y = v.y < 0.f ? m.y : r.y; return o;
}

template <int ACT  > struct EpiBf16 {
    static constexpr bool PERM = true, AFTER_DRAIN = false; static_assert(ACT == 0 || ACT == 1, "EpiBf16: ACT is 0 (none) or 1 (gelu_pk)");
    bf16_t* O; int ldc; const float* bias; int split_cols; size_t split_stride; float scale0;
    __device__ __forceinline__ void operator()(const f32x4 (&acc)[2][2][4][2], const Unit& u, int wr, int wc, int fr, int fq) const {
        const int row0 = u.pm * BM + wr * 64 + fr; int colt = u.pn * BM; bf16_t* base = O;
        float sc = 1.f; if (split_cols) { const int t = colt / split_cols; base += (size_t)t * split_stride; colt -= t * split_cols; if (t == 0) sc = scale0; }
        const int col0 = colt + wc * 32 + 8 * fq, bcol0 = u.pn * BM + wc * 32 + 8 * fq;
        f32x4 bv[2][2];
#pragma unroll
        for (int bj = 0; bj < 2; ++bj)
#pragma unroll
            for (int n = 0; n < 2; ++n) bv[bj][n] = bias ? *(const f32x4*)(bias + bcol0 + bj * HALF + 4 * n) : (f32x4){0.f, 0.f, 0.f, 0.f};
#pragma unroll
        for (int ai = 0; ai < 2; ++ai)
#pragma unroll
            for (int m = 0; m < 4; ++m) { bf16_t* rowp = base + (size_t)(row0 + ai * HALF + m * 16) * ldc + col0;
#pragma unroll
                for (int bj = 0; bj < 2; ++bj) { f32x4 v0 = acc[ai][bj][m][0] + bv[bj][0], v1 = acc[ai][bj][m][1] + bv[bj][1];
                    if (ACT == 1) { f32x2 a = gelu_pk((f32x2){v0[0], v0[1]}), b = gelu_pk((f32x2){v0[2], v0[3]}), c = gelu_pk((f32x2){v1[0], v1[1]}), d = gelu_pk((f32x2){v1[2], v1[3]});
                        v0 = (f32x4){a.x, a.y, b.x, b.y}; v1 = (f32x4){c.x, c.y, d.x, d.y}; }
                    v0 = v0 * sc; v1 = v1 * sc; u32x4 w; w.x = cvt_pk_bf16(v0[0], v0[1]); w.y = cvt_pk_bf16(v0[2], v0[3]); w.z = cvt_pk_bf16(v1[0], v1[1]); w.w = cvt_pk_bf16(v1[2], v1[3]);
                    *(u32x4*)(rowp + bj * HALF) = w; } }
    }
};

struct PanelStats {
    unsigned* xbuf;
    unsigned* cnt;
    unsigned* tmo;
    int ntn; float eps;
    unsigned code;
    __device__ __forceinline__ bool run(const f32x4 (&v)[2][2][4][2], const Unit& u, int wr, int wc, int fr, int fq, PG8_LAS unsigned char* lds, int wid, int lane) const {
        typedef float f32x2v __attribute__((ext_vector_type(2)));
        PG8_LAS f32x2v* P = (PG8_LAS f32x2v*)lds;
        PG8_LAS f32x2v* S = (PG8_LAS f32x2v*)(lds + 8192);
        PG8_LAS unsigned* flag = (PG8_LAS unsigned*)(lds + 8192 + 2048);
#pragma unroll
        for (int ai = 0; ai < 2; ++ai)
#pragma unroll
            for (int m = 0; m < 4; ++m) {
                float s = 0.f;
#pragma unroll
                for (int bj = 0; bj < 2; ++bj)
#pragma unroll
                    for (int n = 0; n < 2; ++n) { const f32x4 x = v[ai][bj][m][n]; s += (x[0] + x[1]) + (x[2] + x[3]); }
                s += __shfl_xor(s, 16); s += __shfl_xor(s, 32);
                const float mw = s * (1.0f / 64.0f); float q = 0.f;
#pragma unroll
                for (int bj = 0; bj < 2; ++bj)
#pragma unroll
                    for (int n = 0; n < 2; ++n) { const f32x4 d = v[ai][bj][m][n] - mw; q += (d[0] * d[0] + d[1] * d[1]) + (d[2] * d[2] + d[3] * d[3]); }
                q += __shfl_xor(q, 16); q += __shfl_xor(q, 32);
                if (fq == 0) P[(ai * HALF + wr * 64 + m * 16 + fr) * 4 + wc] = (f32x2v){mw, q};
            }
        asm volatile("s_waitcnt lgkmcnt(0)" ::: "memory"); __builtin_amdgcn_s_barrier(); asm volatile("" ::: "memory");
#if defined(BROKEN_EXCHANGE_NO_WAIT)
#warning BROKEN CONTROL BUILD: the row-statistics exchange does not wait; results are wrong by design
        if (blockIdx.x >= 64) { const long long t0_ = clock64(); while (clock64() - t0_ < 60000) __builtin_amdgcn_s_sleep(8); }
#endif
        const int row = wid * 32 + (lane & 31);
        if (lane < 32) {
            const f32x2v a = P[row * 4 + 0], b = P[row * 4 + 1], c = P[row * 4 + 2], d = P[row * 4 + 3];
            const float mt = (a.x + b.x + c.x + d.x) * 0.25f;
            const float da = a.x - mt, db = b.x - mt, dc = c.x - mt, dd = d.x - mt;
            const float m2 = (a.y + b.y) + (c.y + d.y) + 64.0f * ((da * da + db * db) + (dc * dc + dd * dd));
            unsigned long long* slot = (unsigned long long*)xbuf + ((size_t)(u.pm * BM + row) * 4 + u.pn);
            __hip_atomic_store(slot, ((unsigned long long)__float_as_uint(m2) << 32) | __float_as_uint(mt), __ATOMIC_RELAXED, __HIP_MEMORY_SCOPE_AGENT);
        }
        asm volatile("s_waitcnt vmcnt(0)" ::: "memory");
        if (lane == 0) __hip_atomic_fetch_add(cnt + 64 * u.pm, 1u, __ATOMIC_RELAXED, __HIP_MEMORY_SCOPE_AGENT);
        if (wid == 0) {
            bool dead = false; const unsigned long long t0 = __builtin_amdgcn_s_memrealtime(); const unsigned want = 8u * (unsigned)ntn;
            for (;;) {
#if defined(BROKEN_EXCHANGE_NO_WAIT)
                break;
#endif
                if ((unsigned)__builtin_amdgcn_readfirstlane(__hip_atomic_load(cnt + 64 * u.pm, __ATOMIC_RELAXED, __HIP_MEMORY_SCOPE_AGENT)) >= want) break;
                if (__builtin_amdgcn_s_memrealtime() - t0 > 2000000ull) {
                    if (lane == 0) { unsigned expect = 0u; __hip_atomic_compare_exchange_strong(tmo + 1, &expect, code | (unsigned)(u.pm & 0xff), __ATOMIC_RELAXED, __ATOMIC_RELAXED, __HIP_MEMORY_SCOPE_AGENT);
                                     __hip_atomic_store(tmo, 1u, __ATOMIC_RELAXED, __HIP_MEMORY_SCOPE_AGENT); }
                    dead = true; break; }
                __builtin_amdgcn_s_sleep(2);
            }
            __builtin_amdgcn_fence(__ATOMIC_ACQUIRE, "agent");
            if (lane == 0) flag[0] = dead ? 1u : 0u;
        }
        asm volatile("s_waitcnt vmcnt(0) lgkmcnt(0)" ::: "memory"); __builtin_amdgcn_s_barrier(); asm volatile("" ::: "memory");
        const bool bad = flag[0] != 0u;
        if (lane < 32) {
            const unsigned long long* slot = (const unsigned long long*)xbuf + (size_t)(u.pm * BM + row) * 4; float mt[4], m2[4]; float ms = 0.f;
#pragma unroll
            for (int t = 0; t < 4; ++t) { if (t < ntn) { const unsigned long long w = __hip_atomic_load(slot + t, __ATOMIC_RELAXED, __HIP_MEMORY_SCOPE_AGENT); mt[t] = __uint_as_float((unsigned)w); m2[t] = __uint_as_float((unsigned)(w >> 32)); } else { mt[t] = 0.f; m2[t] = 0.f; } ms += mt[t]; }
            const float mean = ms / (float)ntn; float q = 0.f;
#pragma unroll
            for (int t = 0; t < 4; ++t) if (t < ntn) { const float dm = mt[t] - mean; q += m2[t] + 256.0f * dm * dm; }
            S[row] = (f32x2v){mean, 1.0f / sqrtf(q / (256.0f * (float)ntn) + eps)};
        }
        asm volatile("s_waitcnt lgkmcnt(0)" ::: "memory"); __builtin_amdgcn_s_barrier(); asm volatile("" ::: "memory");
        return bad;
    }
};
struct EpiLnRes {
    static constexpr bool PERM = false, AFTER_DRAIN = true;
    const float* base; float* out; int ldc; const float* bias; PanelStats st; unsigned poison;
    __device__ __forceinline__ void fused(f32x4 (&acc)[2][2][4][2], const Unit& u, int wr, int wc, int fr, int fq, PG8_LAS unsigned char* lds, int wid, int lane) const {
        typedef float f32x2v __attribute__((ext_vector_type(2)));
        const PG8_LAS f32x2v* S = (const PG8_LAS f32x2v*)(lds + 8192);
        const int col0 = u.pn * BM + wc * 32 + 4 * fq;
#pragma unroll
        for (int bj = 0; bj < 2; ++bj)
#pragma unroll
            for (int n = 0; n < 2; ++n) { const f32x4 bv = bias ? *(const f32x4*)(bias + col0 + bj * HALF + n * 16) : (f32x4){0.f, 0.f, 0.f, 0.f};
#pragma unroll
                for (int ai = 0; ai < 2; ++ai)
#pragma unroll
                    for (int m = 0; m < 4; ++m) acc[ai][bj][m][n] += bv; }
        f32x4 pre[4][2][2];
#pragma unroll
        for (int m = 0; m < 4; ++m) { const size_t off = (size_t)(u.pm * BM + wr * 64 + m * 16 + fr) * ldc + col0;
#pragma unroll
            for (int bj = 0; bj < 2; ++bj)
#pragma unroll
                for (int n = 0; n < 2; ++n) pre[m][bj][n] = *(const f32x4*)(base + off + bj * HALF + n * 16); }
        const bool bad = st.run(acc, u, wr, wc, fr, fq, lds, wid, lane) || poison != 0u;
        const float qnan = __builtin_nanf("");
#pragma unroll
        for (int ai = 0; ai < 2; ++ai)
#pragma unroll
            for (int m = 0; m < 4; ++m) { const int r = ai * HALF + wr * 64 + m * 16 + fr; const f32x2v sr = S[r]; const size_t off = (size_t)(u.pm * BM + r) * ldc + col0;
#pragma unroll
                for (int bj = 0; bj < 2; ++bj)
#pragma unroll
                    for (int n = 0; n < 2; ++n) { const f32x4 bs = ai == 0 ? pre[m][bj][n] : *(const f32x4*)(base + off + bj * HALF + n * 16); f32x4 o = bs + (acc[ai][bj][m][n] - sr.x) * sr.y;
                        if (bad) o = (f32x4){qnan, qnan, qnan, qnan}; *(f32x4*)(out + off + bj * HALF + n * 16) = o; }
                if (m & 1) asm volatile("" ::: "memory"); }
    }
};
struct EpiLnResLn {
    static constexpr bool PERM = false, AFTER_DRAIN = true;
    const float* base; float* out; bf16_t* xn; int ldc; const float* bias; PanelStats st1, st2; unsigned poison;
    __device__ __forceinline__ void fused(f32x4 (&acc)[2][2][4][2], const Unit& u, int wr, int wc, int fr, int fq, PG8_LAS unsigned char* lds, int wid, int lane) const {
        typedef float f32x2v __attribute__((ext_vector_type(2))); typedef unsigned u32x2v __attribute__((ext_vector_type(2)));
        const PG8_LAS f32x2v* S = (const PG8_LAS f32x2v*)(lds + 8192);
        const int col0 = u.pn * BM + wc * 32 + 4 * fq;
#pragma unroll
        for (int bj = 0; bj < 2; ++bj)
#pragma unroll
            for (int n = 0; n < 2; ++n) { const f32x4 bv = bias ? *(const f32x4*)(bias + col0 + bj * HALF + n * 16) : (f32x4){0.f, 0.f, 0.f, 0.f};
#pragma unroll
                for (int ai = 0; ai < 2; ++ai)
#pragma unroll
                    for (int m = 0; m < 4; ++m) acc[ai][bj][m][n] += bv; }
        bool bad = st1.run(acc, u, wr, wc, fr, fq, lds, wid, lane) || poison != 0u;
        const float qnan = __builtin_nanf("");
#pragma unroll
        for (int ai = 0; ai < 2; ++ai)
#pragma unroll
            for (int m = 0; m < 4; ++m) { const int r = ai * HALF + wr * 64 + m * 16 + fr; const f32x2v sr = S[r]; const size_t off = (size_t)(u.pm * BM + r) * ldc + col0;
#pragma unroll
                for (int bj = 0; bj < 2; ++bj)
#pragma unroll
                    for (int n = 0; n < 2; ++n) { const f32x4 bs = *(const f32x4*)(base + off + bj * HALF + n * 16); acc[ai][bj][m][n] = bs + (acc[ai][bj][m][n] - sr.x) * sr.y; }
                asm volatile("" : "+v"(acc[ai][0][m][0]), "+v"(acc[ai][0][m][1]), "+v"(acc[ai][1][m][0]), "+v"(acc[ai][1][m][1]));
                if (m & 1) asm volatile("" ::: "memory"); }
        const bool bad1 = bad;
        bad = st2.run(acc, u, wr, wc, fr, fq, lds, wid, lane) || bad;
#pragma unroll
        for (int ai = 0; ai < 2; ++ai)
#pragma unroll
            for (int m = 0; m < 4; ++m) { const int r = ai * HALF + wr * 64 + m * 16 + fr; const f32x2v sr = S[r]; const size_t off = (size_t)(u.pm * BM + r) * ldc + col0;
#pragma unroll
                for (int bj = 0; bj < 2; ++bj)
#pragma unroll
                    for (int n = 0; n < 2; ++n) { const f32x4 x1 = acc[ai][bj][m][n]; *(f32x4*)(out + off + bj * HALF + n * 16) = bad1 ? (f32x4){qnan, qnan, qnan, qnan} : x1;
                        const f32x4 o = (x1 - sr.x) * sr.y; u32x2v w; w.x = cvt_pk_bf16(o[0], o[1]); w.y = cvt_pk_bf16(o[2], o[3]);
                        if (bad) { w.x = 0x7fc07fc0u; w.y = 0x7fc07fc0u; } *(u32x2v*)(xn + off + bj * HALF + n * 16) = w; }
                asm volatile("" ::: "memory"); }
    }
};

template <class Epi, class Sched, bool ALIGN_EPI = false, bool SP2 = false>
__device__ __forceinline__ void gemm_phase(PG8_LAS unsigned char* lds, const Gemm g, const Sched& S, const Epi& E) {
    const int tid = threadIdx.x, wid = __builtin_amdgcn_readfirstlane(tid >> 6), lane = tid & 63, wr = wid >> 2, wc = wid & 3, fr = lane & 15, fq = lane >> 4;
    const int K = g.K, nt = K / BK;
    unsigned voffA[2], voffB[2];
#pragma unroll
    for (int i = 0; i < 2; ++i) { int R, C; stage_rc(tid * 16 + i * 8192, R, C); const int Rb = Epi::PERM ? ((R & ~31) + perm32(R & 31)) : R;
        voffA[i] = (unsigned)(R * K + C) * 2u; voffB[i] = (unsigned)(Rb * K + C) * 2u; }
    const size_t kstep = (size_t)(BK * 2);
    const size_t hstep = (size_t)HALF * K * 2;
    const size_t tstep = 2 * hstep;
    const unsigned ldsw = (unsigned)wid * 1024u;
    const int aoff = lds_byte(wr * 64 + fr, fq * 8), boff = lds_byte(wc * 32 + fr, fq * 8);
#define PG8_SA(b, h) (((b) * 2 + (h)) * HTB)
#define PG8_SB(b, h) ((4 + (b) * 2 + (h)) * HTB)
#define PG8_STAGE(bufoff, gbase, voff) do { _Pragma("unroll") for (int _i = 0; _i < 2; ++_i) \
        __builtin_amdgcn_global_load_lds((const unsigned*)((const char*)(gbase) + (voff)[_i]), (PG8_LAS unsigned*)(lds + (bufoff) + ldsw + _i * 8192), 16, 0, 0); } while (0)
#define PG8_LDA(dst, b, h) do { _Pragma("unroll") for (int m = 0; m < 4; ++m) _Pragma("unroll") for (int k = 0; k < 2; ++k) dst[m][k] = *(const PG8_LAS bf16x8*)(lds + PG8_SA(b, h) + aoff + m * 2048 + k * 1024); } while (0)
#define PG8_LDB(dst, b, h) do { _Pragma("unroll") for (int n = 0; n < 2; ++n) _Pragma("unroll") for (int k = 0; k < 2; ++k) dst[n][k] = *(const PG8_LAS bf16x8*)(lds + PG8_SB(b, h) + boff + n * 2048 + k * 1024); } while (0)
#define PG8_MMA(ai, bj, At, Bt) do { __builtin_amdgcn_s_setprio(1); _Pragma("unroll") for (int m = 0; m < 4; ++m) _Pragma("unroll") for (int n = 0; n < 2; ++n) _Pragma("unroll") for (int k = 0; k < 2; ++k) \
        acc[ai][bj][m][n] = __builtin_amdgcn_mfma_f32_16x16x32_bf16(Bt[n][k], At[m][k], acc[ai][bj][m][n], 0, 0, 0); __builtin_amdgcn_s_setprio(0); } while (0)
#define PG8_WAIT_V(n) asm volatile("s_waitcnt vmcnt(" #n ")" ::: "memory")
#define PG8_WAIT_L(n) asm volatile("s_waitcnt lgkmcnt(" #n ")" ::: "memory")
#define PG8_BAR __builtin_amdgcn_s_barrier()
#define PG8_SCHED __builtin_amdgcn_sched_barrier(0)
    Unit cur, nxt; int ui = 0;
    if (!S.next(0, cur)) return;
    f32x4 acc[2][2][4][2];
#pragma unroll
    for (int a = 0; a < 2; ++a)
#pragma unroll
        for (int b = 0; b < 2; ++b)
#pragma unroll
            for (int m = 0; m < 4; ++m)
#pragma unroll
                for (int n = 0; n < 2; ++n) acc[a][b][m][n] = (f32x4){0.f, 0.f, 0.f, 0.f};
    bf16x8 At[4][2], B0[2][2], B1[2][2];
    const char* cA = (const char*)g.A + (size_t)cur.pm * tstep; const char* cB = (const char*)g.Bt + (size_t)cur.pn * tstep;
    S.a_ready(cur);
    if constexpr (SP2) {
        PG8_STAGE(PG8_SB(0, 0), cB, voffB); PG8_STAGE(PG8_SB(0, 1), cB + hstep, voffB); PG8_STAGE(PG8_SA(0, 0), cA, voffA); PG8_STAGE(PG8_SA(0, 1), cA + hstep, voffA);
        if (wr == 1) PG8_BAR;
        PG8_WAIT_V(2); PG8_BAR;
        PG8_STAGE(PG8_SB(1, 0), cB + kstep, voffB); PG8_STAGE(PG8_SA(1, 0), cA + kstep, voffA); PG8_STAGE(PG8_SB(1, 1), cB + hstep + kstep, voffB);
        PG8_WAIT_V(6); PG8_BAR;
    } else {
        PG8_STAGE(PG8_SB(0, 0), cB, voffB); PG8_STAGE(PG8_SA(0, 0), cA, voffA); PG8_STAGE(PG8_SB(0, 1), cB + hstep, voffB); PG8_STAGE(PG8_SA(0, 1), cA + hstep, voffA);
        if (wr == 1) PG8_BAR;
        PG8_WAIT_V(4); PG8_BAR;
        PG8_STAGE(PG8_SB(1, 0), cB + kstep, voffB); PG8_STAGE(PG8_SA(1, 0), cA + kstep, voffA); PG8_STAGE(PG8_SB(1, 1), cB + hstep + kstep, voffB);
        PG8_WAIT_V(6); PG8_BAR;
    }
    for (;;) {
        const bool has_next = S.next(ui + 1, nxt);
        const char* nA = has_next ? (const char*)g.A + (size_t)nxt.pm * tstep : cA; const char* nB = has_next ? (const char*)g.Bt + (size_t)nxt.pn * tstep : cB;
        for (int t = 0; t < nt; t += 2) {
            const bool last = (t == nt - 2);
            const char* a1 = cA + (size_t)(t + 1) * kstep;
            const char* a2 = last ? nA : cA + (size_t)(t + 2) * kstep; const char* b2 = last ? nB : cB + (size_t)(t + 2) * kstep;
            const char* a3 = a2 + kstep; const char* b3 = b2 + kstep;
            if (last && has_next) S.a_ready(nxt);
            if constexpr (SP2) {
            PG8_LDB(B0, 0, 0); PG8_LDB(B1, 0, 1); PG8_SCHED; PG8_LDA(At, 0, 0); PG8_STAGE(PG8_SA(1, 1), a1 + hstep, voffA);
            PG8_WAIT_V(8); PG8_WAIT_L(0); PG8_BAR; PG8_MMA(0, 0, At, B0); PG8_MMA(0, 1, At, B1); PG8_BAR; PG8_SCHED;
            PG8_LDA(At, 0, 1); PG8_STAGE(PG8_SB(0, 0), b2, voffB); PG8_STAGE(PG8_SB(0, 1), b2 + hstep, voffB); PG8_STAGE(PG8_SA(0, 0), a2, voffA);
            PG8_WAIT_V(8); PG8_WAIT_L(0); PG8_BAR; PG8_MMA(1, 0, At, B0); PG8_MMA(1, 1, At, B1); PG8_BAR; PG8_SCHED;
            PG8_LDB(B0, 1, 0); PG8_LDB(B1, 1, 1); PG8_SCHED; PG8_LDA(At, 1, 0); PG8_STAGE(PG8_SA(0, 1), a2 + hstep, voffA);
            PG8_WAIT_V(8); PG8_WAIT_L(0); PG8_BAR; PG8_MMA(0, 0, At, B0); PG8_MMA(0, 1, At, B1); PG8_BAR; PG8_SCHED;
            PG8_LDA(At, 1, 1); PG8_STAGE(PG8_SB(1, 0), b3, voffB); PG8_STAGE(PG8_SB(1, 1), b3 + hstep, voffB); PG8_STAGE(PG8_SA(1, 0), a3, voffA);
            PG8_WAIT_V(8); PG8_WAIT_L(0); PG8_BAR; PG8_MMA(1, 0, At, B0); PG8_MMA(1, 1, At, B1); PG8_BAR; PG8_SCHED;
            } else {
            PG8_LDB(B0, 0, 0); PG8_SCHED; PG8_LDA(At, 0, 0); PG8_STAGE(PG8_SA(1, 1), a1 + hstep, voffA);
            PG8_WAIT_L(8); PG8_BAR; PG8_WAIT_L(0); PG8_MMA(0, 0, At, B0); PG8_BAR; PG8_SCHED;
            PG8_LDB(B1, 0, 1); PG8_STAGE(PG8_SB(0, 0), b2, voffB);
            PG8_BAR; PG8_WAIT_L(0); PG8_MMA(0, 1, At, B1); PG8_BAR;
            PG8_LDA(At, 0, 1); PG8_STAGE(PG8_SA(0, 0), a2, voffA);
            PG8_BAR; PG8_WAIT_L(0); PG8_MMA(1, 0, At, B0); PG8_BAR; PG8_SCHED;
            PG8_STAGE(PG8_SB(0, 1), b2 + hstep, voffB);
            PG8_WAIT_V(6); PG8_BAR; PG8_MMA(1, 1, At, B1); PG8_BAR;
            PG8_LDB(B0, 1, 0); PG8_SCHED; PG8_LDA(At, 1, 0); PG8_STAGE(PG8_SA(0, 1), a2 + hstep, voffA);
            PG8_WAIT_L(8); PG8_BAR; PG8_WAIT_L(0); PG8_MMA(0, 0, At, B0); PG8_BAR; PG8_SCHED;
            PG8_LDB(B1, 1, 1); PG8_STAGE(PG8_SB(1, 0), b3, voffB);
            PG8_BAR; PG8_WAIT_L(0); PG8_MMA(0, 1, At, B1); PG8_BAR;
            PG8_LDA(At, 1, 1); PG8_STAGE(PG8_SA(1, 0), a3, voffA);
            PG8_BAR; PG8_WAIT_L(0); PG8_MMA(1, 0, At, B0); PG8_BAR; PG8_SCHED;
            PG8_STAGE(PG8_SB(1, 1), b3 + hstep, voffB);
            PG8_WAIT_V(6); PG8_BAR; PG8_MMA(1, 1, At, B1); PG8_BAR;
            }
        }
        if constexpr (ALIGN_EPI) { if (wr == 0) PG8_BAR; }
        if constexpr (!Epi::AFTER_DRAIN) { E(acc, cur, wr, wc, fr, fq); S.done(cur); }
        if (!has_next) break;
#pragma unroll
        for (int a = 0; a < 2; ++a)
#pragma unroll
            for (int b = 0; b < 2; ++b)
#pragma unroll
                for (int m = 0; m < 4; ++m)
#pragma unroll
                    for (int n = 0; n < 2; ++n) acc[a][b][m][n] = (f32x4){0.f, 0.f, 0.f, 0.f};
        cur = nxt; cA = nA; cB = nB; ++ui;
        if constexpr (ALIGN_EPI) { if (wr == 1) PG8_BAR; }
    }
    PG8_WAIT_V(0);
    if constexpr (!ALIGN_EPI) { if (wr == 0) PG8_BAR; }
    PG8_BAR;
    if constexpr (Epi::AFTER_DRAIN) { E.fused(acc, cur, wr, wc, fr, fq, lds, wid, lane); S.done(cur); }
#undef PG8_SA
#undef PG8_SB
#undef PG8_STAGE
#undef PG8_LDA
#undef PG8_LDB
#undef PG8_MMA
#undef PG8_WAIT_V
#undef PG8_WAIT_L
#undef PG8_BAR
#undef PG8_SCHED
}
}
#define GAS __attribute__((address_space(1)))
#define LAS __attribute__((address_space(3)))
typedef unsigned short bf16;
typedef unsigned v4u __attribute__((ext_vector_type(4)));
typedef float f32x4 __attribute__((ext_vector_type(4)));
typedef short bf16x8 __attribute__((ext_vector_type(8)));
typedef GAS unsigned gu32;
typedef GAS unsigned long long gu64;
#define RLX_AGENT __ATOMIC_RELAXED, __HIP_MEMORY_SCOPE_AGENT
#define LDS_WAIT() asm volatile("s_waitcnt lgkmcnt(0)" ::: "memory")
#define VM_WAIT() asm volatile("s_waitcnt vmcnt(0)" ::: "memory")
__device__ __forceinline__ unsigned long long rt() { return __builtin_amdgcn_s_memrealtime(); }
__device__ __forceinline__ unsigned f2bf(float f) { unsigned u = __builtin_bit_cast(unsigned, f); return (u + 0x7fffu + ((u >> 16) & 1u)) >> 16; }
__device__ __forceinline__ unsigned pk2(float lo, float hi) { return f2bf(lo) | (f2bf(hi) << 16); }

#define XB_TMO      128
#define XB_XCNT(j)  (256  + 64 * (j))
#define XB_XSUB(j)  (1280 + 64 * (j))
#define XB_XGEN(j)  (2304 + 64 * (j))
#define XB_TOP      3328
#define XB_TOPGEN   3392
#define XCD_BAR_WORDS 3456
#define XB_SPIN_CAP (1u << 18)

__device__ __forceinline__ unsigned xb_ld(unsigned* p)              { return __hip_atomic_load(p, __ATOMIC_RELAXED, __HIP_MEMORY_SCOPE_AGENT); }
__device__ __forceinline__ unsigned xb_add(unsigned* p, unsigned v) { return __hip_atomic_fetch_add(p, v, __ATOMIC_RELAXED, __HIP_MEMORY_SCOPE_AGENT); }
__device__ __forceinline__ unsigned xb_xcc_id() { return (unsigned)__builtin_amdgcn_s_getreg((3 << 11) | 20) & 0xFu; }
#define XB_SPIN(cond, bar) do { unsigned _sp = 0; while (cond) { __builtin_amdgcn_s_sleep(1); \
    if ((++_sp & 255u) == 0u) { if (xb_ld(&(bar)[XB_TMO])) break; if (_sp > XB_SPIN_CAP) { atomicAdd(&(bar)[XB_TMO], 1u); break; } } } } while (0)

struct XcdBarrier {
    unsigned* bar; unsigned x;
    volatile LAS unsigned* st;
};

__device__ __forceinline__ XcdBarrier xcd_barrier_post(unsigned* bar, volatile LAS unsigned* st) {
    XcdBarrier b; b.bar = bar; b.x = xb_xcc_id(); b.st = st;
    if (threadIdx.x == 0) (void)xb_add(&bar[XB_XCNT(b.x)], 1u);
    return b;
}
__device__ __forceinline__ void xcd_barrier_complete(unsigned* bar, unsigned x, unsigned& nloc, unsigned& nx) {
    const unsigned G = gridDim.x * gridDim.y * gridDim.z;
    unsigned sum, cnt, mine, sp = 0u;
    for (;;) {
        sum = 0u; cnt = 0u; mine = 0u;
#pragma unroll
        for (unsigned j = 0; j < 16; ++j) { const unsigned c = xb_ld(&bar[XB_XCNT(j)]); sum += c; cnt += (c > 0u) ? 1u : 0u; mine = (j == x) ? c : mine; }
        if (sum == G) break;
        __builtin_amdgcn_s_sleep(1);
        if ((++sp & 255u) == 0u) { if (xb_ld(&bar[XB_TMO])) break; if (sp > XB_SPIN_CAP) { atomicAdd(&bar[XB_TMO], 1u); break; } }
    }
    nloc = mine > 0u ? mine : 1u; nx = cnt > 0u ? cnt : 1u;
}

__device__ __forceinline__ void xcd_barrier(const XcdBarrier& b) {
    asm volatile("s_waitcnt vmcnt(0)" ::: "memory");
    __syncthreads();
    if (threadIdx.x == 0) {
        unsigned* bar = b.bar;
        __builtin_amdgcn_s_waitcnt(0);
        unsigned nloc = b.st[0], nx = b.st[1];
        if (nloc == 0u) { xcd_barrier_complete(bar, b.x, nloc, nx); b.st[0] = nloc; b.st[1] = nx; }
        const unsigned old = xb_add(&bar[XB_XSUB(b.x)], 1u);
        const unsigned gen = old / nloc;
        if (old + 1u == (gen + 1u) * nloc) {
            __builtin_amdgcn_fence(__ATOMIC_RELEASE, "agent");
            asm volatile("s_waitcnt vmcnt(0)" ::: "memory");
            const unsigned og = xb_add(&bar[XB_TOP], 1u);
            const unsigned tg = og / nx;
            if (og + 1u == (tg + 1u) * nx) xb_add(&bar[XB_TOPGEN], 1u);
            else XB_SPIN(xb_ld(&bar[XB_TOPGEN]) == tg, bar);
            __builtin_amdgcn_fence(__ATOMIC_ACQUIRE, "agent");
            xb_add(&bar[XB_XGEN(b.x)], 1u);
            asm volatile("s_waitcnt vmcnt(0)" ::: "memory");
        } else {
            XB_SPIN(xb_ld(&bar[XB_XGEN(b.x)]) == gen, bar);
            __builtin_amdgcn_fence(__ATOMIC_ACQUIRE, "agent");
            asm volatile("s_waitcnt vmcnt(0)" ::: "memory");
        }
    }
    __syncthreads();
}

#ifndef XB_SPIN_CAP2
#define XB_SPIN_CAP2 1
#endif
constexpr int NWAVES = 8;
constexpr int T_TOK = 8192, DM = 4096, SEQ = 2048, NBATCH = 4;
constexpr int INW = 9216;
constexpr int C_QA = 0, C_KA = 2048, C_VA = 2560, C_QB = 3072, C_KB = 5120, C_VB = 7168;
constexpr int MEMLEN = 256, MEMW = 1024;
constexpr int NEXP = 16384, PQW = 2048;
constexpr float RMS_EPS = 1e-6f;
constexpr float LOG2E = 1.4426950408889634f;

constexpr size_t MiB = 1u << 20;
constexpr size_t WS_CTL = 0, CTL_ZERO_BYTES = 1 * MiB;
constexpr size_t WS_ROPE = 1 * MiB;
constexpr size_t WS_SKB = 2 * MiB;
constexpr size_t WS_WIN = 4 * MiB;
constexpr size_t WS_WOUT = 76 * MiB;
constexpr size_t WS_WMQ = 108 * MiB;
constexpr size_t WS_WMKV = 116 * MiB;
constexpr size_t WS_WMO = 132 * MiB;
constexpr size_t WS_WPQ = 140 * MiB;
constexpr size_t WS_UB = 156 * MiB;
constexpr size_t WS_VB = 284 * MiB;
constexpr size_t WS_XN = 412 * MiB;
constexpr size_t WS_QKV = 476 * MiB;
constexpr size_t WS_OB = 620 * MiB;
constexpr size_t WS_MEMN = 684 * MiB;
constexpr size_t WS_KVM = 692 * MiB;
constexpr size_t WS_QM = 696 * MiB;
constexpr size_t WS_OM = 712 * MiB;
constexpr size_t WS_QP = 728 * MiB;
constexpr size_t WS_IDX = 760 * MiB;
constexpr size_t WS_GATE = 764 * MiB;
constexpr size_t WS_END = 768 * MiB;
constexpr int CW_BAR = 4096;

constexpr int RING_BYTES = 131072;
constexpr int LDSCTL_OFF = RING_BYTES, MISC_OFF = LDSCTL_OFF + 320;
constexpr int LDS_BYTES = 147456;

typedef float f32x16 __attribute__((ext_vector_type(16)));
typedef float f32x2 __attribute__((ext_vector_type(2)));
typedef short s16x4 __attribute__((ext_vector_type(4)));
typedef __bf16 bf16x2_t __attribute__((ext_vector_type(2)));
typedef unsigned u32x2 __attribute__((ext_vector_type(2)));
#define DI __device__ __forceinline__
#define MFMA32(a, b, c) __builtin_amdgcn_mfma_f32_32x32x16_bf16((a), (b), (c), 0, 0, 0)

DI unsigned cvtpk(float lo, float hi) { f32x2 v = {lo, hi}; bf16x2_t b = __builtin_convertvector(v, bf16x2_t); return __builtin_bit_cast(unsigned, b); }
DI float bflo(unsigned u) { return __uint_as_float(u << 16); }
DI float bfhi(unsigned u) { return __uint_as_float(u & 0xffff0000u); }
DI int crow(int i, int h) { return (i & 3) + 8 * (i >> 2) + 4 * h; }
DI float wave_sum(float v) {
#pragma unroll
    for (int o = 1; o < 64; o <<= 1) v += __shfl_xor(v, o);
    return v;
}
DI float fexp2(float x) { return __builtin_amdgcn_exp2f(x); }
DI bf16x8 pack8(const f32x16& x, int s) {
    v4u p; p.x = cvtpk(x[8 * s + 0], x[8 * s + 1]); p.y = cvtpk(x[8 * s + 2], x[8 * s + 3]); p.z = cvtpk(x[8 * s + 4], x[8 * s + 5]); p.w = cvtpk(x[8 * s + 6], x[8 * s + 7]);
    return __builtin_bit_cast(bf16x8, p);
}
typedef short v4i16_t __attribute__((ext_vector_type(4)));
DI s16x4 vtr(const LAS unsigned char* p) { return __builtin_bit_cast(s16x4, __builtin_amdgcn_ds_read_tr16_b64_v4i16((LAS v4i16_t*)p)); }

DI void p0_transpose_item(const float* W, int K, int N, bf16* WT, int row_off, LAS float* scr, int item, int lane) {
    const int nblk = N / 32, kb = item / nblk, nb = item % nblk, k0 = 64 * kb, n0 = 32 * nb;
#pragma unroll 8
    for (int i = 0; i < 32; ++i) { const int kk = 2 * i + (lane >> 5); scr[kk * 33 + (lane & 31)] = W[(size_t)(k0 + kk) * N + n0 + (lane & 31)]; }
    LDS_WAIT(); asm volatile("" ::: "memory");
    const int c = lane & 7;
#pragma unroll
    for (int j = 0; j < 4; ++j) { const int n = (lane >> 3) + 8 * j; const LAS float* s = scr + (8 * c) * 33 + n;
        v4u o; o.x = cvtpk(s[0 * 33], s[1 * 33]); o.y = cvtpk(s[2 * 33], s[3 * 33]); o.z = cvtpk(s[4 * 33], s[5 * 33]); o.w = cvtpk(s[6 * 33], s[7 * 33]);
        *(GAS v4u*)(WT + (size_t)(row_off + n0 + n) * K + k0 + 8 * c) = o; }
    LDS_WAIT(); asm volatile("" ::: "memory");
}
DI void rms_row_to_bf16(const float* xrow, const float* gain, bf16* orow, int lane) {
    const GAS f32x4* xr = (const GAS f32x4*)xrow + lane;
    f32x4 v[16]; float s = 0.f;
#pragma unroll
    for (int j = 0; j < 16; ++j) { v[j] = xr[64 * j]; s += (v[j].x * v[j].x + v[j].y * v[j].y) + (v[j].z * v[j].z + v[j].w * v[j].w); }
    const float rstd = 1.0f / sqrtf(wave_sum(s) * (1.f / DM) + RMS_EPS);
    const GAS f32x4* gr = (const GAS f32x4*)gain + lane;
    GAS u32x2* o8 = (GAS u32x2*)orow + lane;
#pragma unroll
    for (int j = 0; j < 16; ++j) { const f32x4 g = gr[64 * j]; u32x2 w; w.x = cvtpk(v[j].x * rstd * g.x, v[j].y * rstd * g.y); w.y = cvtpk(v[j].z * rstd * g.z, v[j].w * rstd * g.w); o8[64 * j] = w; }
}
DI void mix_row_norm(bf16* orow, const float* ga, const float* gb, int lane) {
    GAS v4u* p = (GAS v4u*)orow + lane;
    v4u v[8]; float sa = 0.f, sb = 0.f;
#pragma unroll
    for (int j = 0; j < 8; ++j) { v[j] = p[64 * j]; float s = 0.f;
#pragma unroll
        for (int k = 0; k < 4; ++k) { const float a = bflo(v[j][k]), b = bfhi(v[j][k]); s += a * a + b * b; }
        if (j < 4) sa += s; else sb += s; }
    const float ra = 1.0f / sqrtf(wave_sum(sa) * (1.f / 2048.f) + RMS_EPS), rb = 1.0f / sqrtf(wave_sum(sb) * (1.f / 2048.f) + RMS_EPS);
#pragma unroll
    for (int j = 0; j < 8; ++j) { const float rs = j < 4 ? ra : rb; const float* gp = (j < 4 ? ga : gb) + ((lane + 64 * (j & 3)) * 8);
        const f32x4 g0 = *(const GAS f32x4*)gp, g1 = *(const GAS f32x4*)(gp + 4); v4u w;
        w.x = cvtpk(bflo(v[j].x) * rs * g0.x, bfhi(v[j].x) * rs * g0.y); w.y = cvtpk(bflo(v[j].y) * rs * g0.z, bfhi(v[j].y) * rs * g0.w);
        w.z = cvtpk(bflo(v[j].z) * rs * g1.x, bfhi(v[j].z) * rs * g1.y); w.w = cvtpk(bflo(v[j].w) * rs * g1.z, bfhi(v[j].w) * rs * g1.w);
        p[64 * j] = w; }
}

struct EpiResF32 {
    static constexpr bool PERM = false, AFTER_DRAIN = false;
    const float* base; float* out; int ldc; float sc;
    __device__ __forceinline__ void operator()(const pg8::f32x4 (&acc)[2][2][4][2], const pg8::Unit& u, int wr, int wc, int fr, int fq) const {
        const int col0 = u.pn * 256 + wc * 32 + 4 * fq;
#pragma unroll
        for (int ai = 0; ai < 2; ++ai)
#pragma unroll
            for (int m = 0; m < 4; ++m) { const int r = ai * 128 + wr * 64 + m * 16 + fr; const size_t off = (size_t)(u.pm * 256 + r) * ldc + col0;
#pragma unroll
                for (int bj = 0; bj < 2; ++bj)
#pragma unroll
                    for (int n = 0; n < 2; ++n) { const pg8::f32x4 bs = *(const pg8::f32x4*)(base + off + bj * 128 + n * 16); *(pg8::f32x4*)(out + off + bj * 128 + n * 16) = bs + acc[ai][bj][m][n] * sc; } }
    }
};

template <int NSTEP, int KP>
DI f32x16 qk_tile(const LAS unsigned char* Kt, const bf16x8* qf, int r, int h) {
    f32x16 s;
#pragma unroll
    for (int i = 0; i < 16; ++i) s[i] = 0.f;
    const LAS unsigned char* kp = Kt + r * KP + h * 16;
#pragma unroll
    for (int st = 0; st < NSTEP; ++st) { const bf16x8 a = *(const LAS bf16x8*)(kp + st * 32); s = MFMA32(a, qf[st], s); }
    return s;
}
template <int NDB, int VP>
DI void pv_tile(f32x16* o, const LAS unsigned char* Vt, const f32x16& p, int lane) {
    const int h = lane >> 5, q = (lane & 15) >> 2, pp = lane & 3, blk = (lane >> 4) & 1;
    const bf16x8 p0 = pack8(p, 0), p1 = pack8(p, 1);
    const LAS unsigned char* vb = Vt + (4 * h + q) * VP + blk * 32 + pp * 8;
#pragma unroll
    for (int db = 0; db < NDB; ++db) {
        const s16x4 l0 = vtr(vb + db * 64), h0 = vtr(vb + 8 * VP + db * 64), l1 = vtr(vb + 16 * VP + db * 64), h1 = vtr(vb + 24 * VP + db * 64);
        const bf16x8 v0 = __builtin_shufflevector(l0, h0, 0, 1, 2, 3, 4, 5, 6, 7), v1 = __builtin_shufflevector(l1, h1, 0, 1, 2, 3, 4, 5, 6, 7);
        o[db] = MFMA32(v0, p0, o[db]); o[db] = MFMA32(v1, p1, o[db]);
    }
}
DI float softmax_tile(f32x16& s, float& m, float& l) {
    float mx = s[0];
#pragma unroll
    for (int i = 1; i < 16; ++i) mx = fmaxf(mx, s[i]);
    mx = fmaxf(mx, __shfl_xor(mx, 32));
    const float mn = fmaxf(m, mx), alpha = fexp2(m - mn); m = mn;
    float sum = 0.f;
#pragma unroll
    for (int i = 0; i < 16; ++i) { s[i] = fexp2(s[i] - mn); sum += s[i]; }
    l = l * alpha + sum;
    return alpha;
}
template <int NDB> DI void scale_o(f32x16* o, float alpha) {
#pragma unroll
    for (int db = 0; db < NDB; ++db)
#pragma unroll
        for (int i = 0; i < 16; ++i) o[db][i] *= alpha;
}
template <int NDB> DI void store_o(const f32x16* o, float inv, bf16* orow, int h) {
#pragma unroll
    for (int db = 0; db < NDB; ++db)
#pragma unroll
        for (int g = 0; g < 4; ++g) { u32x2 w; w.x = cvtpk(o[db][4 * g] * inv, o[db][4 * g + 1] * inv); w.y = cvtpk(o[db][4 * g + 2] * inv, o[db][4 * g + 3] * inv);
            *(GAS u32x2*)(orow + 32 * db + 8 * g + 4 * h) = w; }
}

constexpr int KP128 = 272, VP128 = 320, KP256 = 528, VP256 = 576;
constexpr int ATT_K_OFF = 0, ATT_V_OFF = 34816, ATT_BIAS_OFF = 72704;

DI void swa_unit(LAS unsigned char* lds, int u, const bf16* QKV, bf16* OB, const float* sink, const float* ropec, const float* ropes) {
    const int tid = threadIdx.x, lane = tid & 63, wid = __builtin_amdgcn_readfirstlane(tid >> 6), r = lane & 31, h = lane >> 5;
    const int qb = u & 31, kvh = (u >> 5) & 3, b = u >> 7;
    const int q0 = qb * 64, g = wid >> 1, sub = wid & 1, head = kvh * 4 + g;
    const int qpos = q0 + 32 * sub + r;
    const size_t tok = (size_t)b * SEQ + qpos;
    const float QS = 0.08838834764831845f * LOG2E;
    bf16x8 qf[8];
    {
        const bf16* qp = QKV + tok * INW + C_QA + head * 128 + 8 * h;
#pragma unroll
        for (int st = 0; st < 4; ++st) {
            const v4u lo = *(const GAS v4u*)(qp + 16 * st), hi = *(const GAS v4u*)(qp + 16 * st + 64);
            const float* cp = ropec + (size_t)qpos * 64 + 16 * st + 8 * h; const float* sp = ropes + (size_t)qpos * 64 + 16 * st + 8 * h;
            const f32x4 c0 = *(const GAS f32x4*)cp, c1 = *(const GAS f32x4*)(cp + 4), s0 = *(const GAS f32x4*)sp, s1 = *(const GAS f32x4*)(sp + 4);
            float x1[8], x2[8], cc[8], ss[8];
#pragma unroll
            for (int k = 0; k < 4; ++k) { x1[2 * k] = bflo(lo[k]); x1[2 * k + 1] = bfhi(lo[k]); x2[2 * k] = bflo(hi[k]); x2[2 * k + 1] = bfhi(hi[k]); cc[k] = c0[k]; cc[4 + k] = c1[k]; ss[k] = s0[k]; ss[4 + k] = s1[k]; }
            v4u a, bq;
#pragma unroll
            for (int k = 0; k < 4; ++k) {
                a[k] = cvtpk((x1[2 * k] * cc[2 * k] - x2[2 * k] * ss[2 * k]) * QS, (x1[2 * k + 1] * cc[2 * k + 1] - x2[2 * k + 1] * ss[2 * k + 1]) * QS);
                bq[k] = cvtpk((x2[2 * k] * cc[2 * k] + x1[2 * k] * ss[2 * k]) * QS, (x2[2 * k + 1] * cc[2 * k + 1] + x1[2 * k + 1] * ss[2 * k + 1]) * QS);
            }
            qf[st] = __builtin_bit_cast(bf16x8, a); qf[st + 4] = __builtin_bit_cast(bf16x8, bq);
        }
    }
    float m = sink[head] * LOG2E, l = (h == 0) ? 1.f : 0.f;
    f32x16 o[4];
#pragma unroll
    for (int db = 0; db < 4; ++db)
#pragma unroll
        for (int i = 0; i < 16; ++i) o[db][i] = 0.f;
    const int t_lo = qb - 2 < 0 ? 0 : qb - 2, t_hi = qb + 2 > 31 ? 31 : qb + 2;
    const int skey = tid >> 3, sc = tid & 7;
    for (int kt = t_lo; kt <= t_hi; ++kt) {
        __syncthreads();
        {
            const int kpos = kt * 64 + skey; const size_t ktok = (size_t)b * SEQ + kpos;
            const bf16* kp = QKV + ktok * INW + C_KA + kvh * 128 + 8 * sc;
            const v4u lo = *(const GAS v4u*)kp, hi = *(const GAS v4u*)(kp + 64);
            const bf16* vp = QKV + ktok * INW + C_VA + kvh * 128 + 8 * sc;
            const v4u v0 = *(const GAS v4u*)vp, v1 = *(const GAS v4u*)(vp + 64);
            const float* cp = ropec + (size_t)kpos * 64 + 8 * sc; const float* sp = ropes + (size_t)kpos * 64 + 8 * sc;
            const f32x4 c0 = *(const GAS f32x4*)cp, c1 = *(const GAS f32x4*)(cp + 4), s0 = *(const GAS f32x4*)sp, s1 = *(const GAS f32x4*)(sp + 4);
            float cc[8], ss[8];
#pragma unroll
            for (int k = 0; k < 4; ++k) { cc[k] = c0[k]; cc[4 + k] = c1[k]; ss[k] = s0[k]; ss[4 + k] = s1[k]; }
            v4u a, bq;
#pragma unroll
            for (int k = 0; k < 4; ++k) {
                const float x1a = bflo(lo[k]), x1b = bfhi(lo[k]), x2a = bflo(hi[k]), x2b = bfhi(hi[k]);
                a[k] = cvtpk(x1a * cc[2 * k] - x2a * ss[2 * k], x1b * cc[2 * k + 1] - x2b * ss[2 * k + 1]);
                bq[k] = cvtpk(x2a * cc[2 * k] + x1a * ss[2 * k], x2b * cc[2 * k + 1] + x1b * ss[2 * k + 1]);
            }
            *(LAS v4u*)(lds + ATT_K_OFF + skey * KP128 + 16 * sc) = a; *(LAS v4u*)(lds + ATT_K_OFF + skey * KP128 + 128 + 16 * sc) = bq;
            *(LAS v4u*)(lds + ATT_V_OFF + skey * VP128 + 16 * sc) = v0; *(LAS v4u*)(lds + ATT_V_OFF + skey * VP128 + 128 + 16 * sc) = v1;
        }
        __syncthreads();
#pragma unroll
        for (int st2 = 0; st2 < 2; ++st2) {
            const int k0 = kt * 64 + 32 * st2, qs = q0 + 32 * sub;
            if (k0 - qs >= 160 || qs - k0 >= 160) continue;
            f32x16 s = qk_tile<8, KP128>(lds + ATT_K_OFF + 32 * st2 * KP128, qf, r, h);
#pragma unroll
            for (int i = 0; i < 16; ++i) { const int d = qpos - (k0 + crow(i, h)); s[i] = (d <= 128 && d >= -128) ? s[i] : -3.0e30f; }
            const float alpha = softmax_tile(s, m, l);
            scale_o<4>(o, alpha);
            pv_tile<4, VP128>(o, lds + ATT_V_OFF + 32 * st2 * VP128, s, lane);
        }
    }
    const float lt = l + __shfl_xor(l, 32);
    store_o<4>(o, 1.0f / lt, OB + tok * DM + head * 128, h);
}

DI void nat_unit(LAS unsigned char* lds, int u, const bf16* QKV, bf16* OB, const float* relb) {
    const int tid = threadIdx.x, lane = tid & 63, wid = __builtin_amdgcn_readfirstlane(tid >> 6), r = lane & 31, h = lane >> 5;
    const int rb = u & 7, head = (u >> 3) & 15, b = u >> 7;
    const int r0 = rb * 4, qrow = r0 + (wid >> 1), qcol = 32 * (wid & 1) + r;
    const size_t tok = (size_t)b * SEQ + qrow * 64 + qcol;
    const float QS = 0.08838834764831845f * LOG2E;
    __syncthreads();
    LAS float* bias = (LAS float*)(lds + ATT_BIAS_OFF) + 64;
    if (tid < 465) bias[tid] = relb[head * 465 + tid] * LOG2E;
    bf16x8 qf[8];
    {
        const bf16* qp = QKV + tok * INW + C_QB + head * 128 + 8 * h;
#pragma unroll
        for (int st = 0; st < 8; ++st) { const v4u x = *(const GAS v4u*)(qp + 16 * st); v4u a;
#pragma unroll
            for (int k = 0; k < 4; ++k) a[k] = cvtpk(bflo(x[k]) * QS, bfhi(x[k]) * QS);
            qf[st] = __builtin_bit_cast(bf16x8, a); }
    }
    float m = -1.0e30f, l = 0.f;
    f32x16 o[4];
#pragma unroll
    for (int db = 0; db < 4; ++db)
#pragma unroll
        for (int i = 0; i < 16; ++i) o[db][i] = 0.f;
    int kr_lo = r0 - 4; kr_lo = kr_lo < 0 ? 0 : (kr_lo > 24 ? 24 : kr_lo);
    int kr_hi = r0 + 3 - 4; kr_hi = (kr_hi < 0 ? 0 : (kr_hi > 24 ? 24 : kr_hi)) + 7;
    int rs = qrow - 4; rs = rs < 0 ? 0 : (rs > 24 ? 24 : rs);
    int cs = qcol - 8; cs = cs < 0 ? 0 : (cs > 48 ? 48 : cs);
    const int skey = tid >> 3, sc = tid & 7;
    for (int kr = kr_lo; kr <= kr_hi; ++kr) {
        __syncthreads();
        {
            const size_t ktok = (size_t)b * SEQ + kr * 64 + skey;
            const bf16* kp = QKV + ktok * INW + C_KB + head * 128 + 8 * sc;
            const v4u k0v = *(const GAS v4u*)kp, k1v = *(const GAS v4u*)(kp + 64);
            const bf16* vp = QKV + ktok * INW + C_VB + head * 128 + 8 * sc;
            const v4u v0 = *(const GAS v4u*)vp, v1 = *(const GAS v4u*)(vp + 64);
            *(LAS v4u*)(lds + ATT_K_OFF + skey * KP128 + 16 * sc) = k0v; *(LAS v4u*)(lds + ATT_K_OFF + skey * KP128 + 128 + 16 * sc) = k1v;
            *(LAS v4u*)(lds + ATT_V_OFF + skey * VP128 + 16 * sc) = v0; *(LAS v4u*)(lds + ATT_V_OFF + skey * VP128 + 128 + 16 * sc) = v1;
        }
        __syncthreads();
        if (kr < rs || kr >= rs + 8) continue;
        int dr = kr - qrow + 7; dr = dr < 0 ? 0 : (dr > 14 ? 14 : dr);
        int boff = 15 - qcol + 4 * h, t0 = 4 * h - cs;
        asm volatile("" : "+v"(boff), "+v"(t0));
        const LAS float* brow = bias + dr * 31 + boff;
#pragma unroll
        for (int st2 = 0; st2 < 2; ++st2) {
            f32x16 s = qk_tile<8, KP128>(lds + ATT_K_OFF + 32 * st2 * KP128, qf, r, h);
#pragma unroll
            for (int i = 0; i < 16; ++i) { const int kc0 = 32 * st2 + (i & 3) + 8 * (i >> 2);
                const float bv = brow[kc0]; s[i] = ((unsigned)(t0 + kc0) < 16u) ? s[i] + bv : -3.0e30f; }
            const float alpha = softmax_tile(s, m, l);
            scale_o<4>(o, alpha);
            pv_tile<4, VP128>(o, lds + ATT_V_OFF + 32 * st2 * VP128, s, lane);
        }
    }
    const float lt = l + __shfl_xor(l, 32);
    store_o<4>(o, 1.0f / lt, OB + tok * DM + 2048 + head * 128, h);
}

DI void mem_unit(LAS unsigned char* lds, int u, const bf16* QM, const bf16* KVM, bf16* OM) {
    const int tid = threadIdx.x, lane = tid & 63, wid = __builtin_amdgcn_readfirstlane(tid >> 6), r = lane & 31, h = lane >> 5;
    const int qblk = u & 15, mh = (u >> 4) & 3, b = u >> 6;
    const int qsub = wid >> 1, dh = wid & 1;
    const size_t tok = (size_t)b * SEQ + qblk * 128 + 32 * qsub + r;
    const float QS = 0.0625f * LOG2E;
    bf16x8 qf[16];
    {
        const bf16* qp = QM + tok * MEMW + mh * 256 + 8 * h;
#pragma unroll
        for (int st = 0; st < 16; ++st) { const v4u x = *(const GAS v4u*)(qp + 16 * st); v4u a;
#pragma unroll
            for (int k = 0; k < 4; ++k) a[k] = cvtpk(bflo(x[k]) * QS, bfhi(x[k]) * QS);
            qf[st] = __builtin_bit_cast(bf16x8, a); }
    }
    float m = -1.0e30f, l = 0.f;
    f32x16 o[4];
#pragma unroll
    for (int db = 0; db < 4; ++db)
#pragma unroll
        for (int i = 0; i < 16; ++i) o[db][i] = 0.f;
    for (int kt = 0; kt < 4; ++kt) {
        __syncthreads();
#pragma unroll
        for (int it = 0; it < 4; ++it) {
            const int ch = tid + 512 * it, key = ch >> 5, c = ch & 31;
            const bf16* kp = KVM + (size_t)(b * MEMLEN + kt * 64 + key) * 2048 + mh * 256 + 8 * c;
            const v4u kv = *(const GAS v4u*)kp, vv = *(const GAS v4u*)(kp + 1024);
            *(LAS v4u*)(lds + ATT_K_OFF + key * KP256 + 16 * c) = kv; *(LAS v4u*)(lds + ATT_V_OFF + key * VP256 + 16 * c) = vv;
        }
        __syncthreads();
#pragma unroll
        for (int st2 = 0; st2 < 2; ++st2) {
            f32x16 s = qk_tile<16, KP256>(lds + ATT_K_OFF + 32 * st2 * KP256, qf, r, h);
            const float alpha = softmax_tile(s, m, l);
            scale_o<4>(o, alpha);
            pv_tile<4, VP256>(o, lds + ATT_V_OFF + 32 * st2 * VP256 + dh * 256, s, lane);
        }
    }
    const float lt = l + __shfl_xor(l, 32);
    store_o<4>(o, 1.0f / lt, OM + tok * MEMW + mh * 256 + dh * 128, h);
}

DI unsigned f2sort(float f) { const unsigned u = __float_as_uint(f); return u ^ ((unsigned)((int)u >> 31) | 0x80000000u); }
DI float sort2f(unsigned k) { const unsigned u = (k & 0x80000000u) ? (k ^ 0x80000000u) : ~k; return __uint_as_float(u); }
constexpr int RT_SK_OFF = 0, RT_A_OFF = 69632;
DI void route_unit(LAS unsigned char* lds, int u, const bf16* QP, const bf16* SKB, int* IDX, float* GATE) {
    const int tid = threadIdx.x, lane = tid & 63, wid = __builtin_amdgcn_readfirstlane(tid >> 6), r = lane & 31, h = lane >> 5;
    const int hd = u & 7, tile = u >> 3;
    const size_t tok = (size_t)tile * 256 + 32 * wid + r;
    __syncthreads();
#pragma unroll
    for (int it = 0; it < 8; ++it) { const int ch = tid + 512 * it, row = ch >> 4, c = ch & 15;
        const v4u x = *(const GAS v4u*)(SKB + ((size_t)hd * 256 + row) * 128 + 8 * c);
        *(LAS v4u*)(lds + RT_SK_OFF + row * 272 + 16 * c) = x; }
    __syncthreads();
    LAS unsigned* A = (LAS unsigned*)(lds + RT_A_OFF);
    const int tslot = wid * 32 + r;
#pragma unroll 1
    for (int c = 0; c < 2; ++c) {
        bf16x8 qf[8];
        const bf16* qp = QP + tok * PQW + hd * 256 + c * 128 + 8 * h;
#pragma unroll
        for (int st = 0; st < 8; ++st) qf[st] = __builtin_bit_cast(bf16x8, *(const GAS v4u*)(qp + 16 * st));
        unsigned pk[64];
#pragma unroll
        for (int kt = 0; kt < 4; ++kt) {
            const f32x16 s = qk_tile<8, 272>(lds + RT_SK_OFF + (c * 128 + 32 * kt) * 272, qf, r, h);
#pragma unroll
            for (int i = 0; i < 16; ++i) pk[kt * 16 + i] = (f2sort(s[i]) & ~0x7Fu) | (unsigned)(127 - (32 * kt + crow(i, h)));
        }
#pragma unroll 1
        for (int t = 0; t < 16; ++t) {
            unsigned mx = pk[0];
#pragma unroll
            for (int i = 1; i < 64; ++i) mx = mx > pk[i] ? mx : pk[i];
            const unsigned ot = (unsigned)__shfl_xor((int)mx, 32);
            mx = mx > ot ? mx : ot;
#pragma unroll
            for (int i = 0; i < 64; ++i) pk[i] = (pk[i] == mx) ? 0u : pk[i];
            if (h == 0) A[(c * 16 + t) * 256 + tslot] = mx;
        }
    }
    LDS_WAIT();
    asm volatile("" ::: "memory");
    float v1[16], v2[16];
#pragma unroll
    for (int a = 0; a < 16; ++a) { v1[a] = sort2f(A[a * 256 + tslot] & ~0x7Fu); v2[a] = sort2f(A[(16 + a) * 256 + tslot] & ~0x7Fu); }
    unsigned cd[50];
    {
        int n = 0;
#pragma unroll
        for (int a = 0; a < 16; ++a)
#pragma unroll
            for (int bb = 0; bb < 16; ++bb)
                if ((a + 1) * (bb + 1) <= 16) { cd[n] = (f2sort(v1[a] + v2[bb]) & ~0xFFu) | (unsigned)(255 - (a * 16 + bb)); ++n; }
    }
    float mx0 = 0.f, esum = 0.f;
#pragma unroll 1
    for (int t = 0; t < 16; ++t) {
        unsigned mx = cd[0];
#pragma unroll
        for (int i = 1; i < 50; ++i) mx = mx > cd[i] ? mx : cd[i];
#pragma unroll
        for (int i = 0; i < 50; ++i) cd[i] = (cd[i] == mx) ? 0u : cd[i];
        const float val = sort2f(mx & ~0xFFu);
        if (t == 0) mx0 = val;
        esum += fexp2((val - mx0) * LOG2E);
        if (h == 0) A[(32 + t) * 256 + tslot] = mx;
    }
    LDS_WAIT();
    asm volatile("" ::: "memory");
    const float inv = 1.0f / esum;
#pragma unroll
    for (int q4 = 0; q4 < 2; ++q4) {
        int iv[4]; float gv[4];
#pragma unroll
        for (int k = 0; k < 4; ++k) {
            const int t = 8 * h + 4 * q4 + k;
            const unsigned cw = A[(32 + t) * 256 + tslot];
            const int code = 255 - (int)(cw & 0xFFu), a = code >> 4, bb = code & 15;
            const int i1 = 127 - (int)(A[a * 256 + tslot] & 0x7Fu), i2 = 127 - (int)(A[(16 + bb) * 256 + tslot] & 0x7Fu);
            iv[k] = i1 * 128 + i2; gv[k] = fexp2((sort2f(cw & ~0xFFu) - mx0) * LOG2E) * inv;
        }
        const size_t o = tok * 128 + hd * 16 + 8 * h + 4 * q4;
        v4u iw; iw.x = (unsigned)iv[0]; iw.y = (unsigned)iv[1]; iw.z = (unsigned)iv[2]; iw.w = (unsigned)iv[3];
        *(GAS v4u*)(IDX + o) = iw;
        f32x4 gw; gw.x = gv[0]; gw.y = gv[1]; gw.z = gv[2]; gw.w = gv[3];
        *(GAS f32x4*)(GATE + o) = gw;
    }
}

DI float dot2bf(unsigned w, unsigned x, float acc) { return __builtin_amdgcn_fdot2_f32_bf16(__builtin_bit_cast(bf16x2_t, w), __builtin_bit_cast(bf16x2_t, x), acc, false); }
DI float readlane_f(float v, int l) { return __uint_as_float((unsigned)__builtin_amdgcn_readlane((int)__float_as_uint(v), l)); }
DI float gelu_erf(float x) { return 0.5f * x * (1.0f + erff(x * 0.70710678118654752f)); }
DI void load_row8(v4u* dst, const bf16* row, int lane) {
    const GAS v4u* p = (const GAS v4u*)row + lane;
#pragma unroll
    for (int j = 0; j < 8; ++j) dst[j] = p[64 * j];
}
DI float dot_row(const v4u* xr, const v4u* w) {
    float a0 = 0.f, a1 = 0.f, a2 = 0.f, a3 = 0.f;
#pragma unroll
    for (int j = 0; j < 8; ++j) { a0 = dot2bf(w[j].x, xr[j].x, a0); a1 = dot2bf(w[j].y, xr[j].y, a1); a2 = dot2bf(w[j].z, xr[j].z, a2); a3 = dot2bf(w[j].w, xr[j].w, a3); }
    return (a0 + a1) + (a2 + a3);
}
DI void axpy_row(float* acc, const v4u* w, float s) {
#pragma unroll
    for (int j = 0; j < 8; ++j)
#pragma unroll
        for (int k = 0; k < 4; ++k) { acc[8 * j + 2 * k] += s * bflo(w[j][k]); acc[8 * j + 2 * k + 1] += s * bfhi(w[j][k]); }
}
DI void peer_token(int tk, const bf16* XN, const int* IDX, const float* GATE, const bf16* UB, const bf16* VB, float* hout, const float* gfin, int lane) {
    v4u xr[8];
    load_row8(xr, XN + (size_t)tk * DM, lane);
    const int ilo = IDX[(size_t)tk * 128 + lane], ihi = IDX[(size_t)tk * 128 + 64 + lane];
    const float glo = GATE[(size_t)tk * 128 + lane], ghi = GATE[(size_t)tk * 128 + 64 + lane];
    float alo = 0.f, ahi = 0.f;
    {
        v4u b0[8], b1[8];
        load_row8(b0, UB + (size_t)__builtin_amdgcn_readlane(ilo, 0) * DM, lane);
#pragma unroll 1
        for (int e = 0; e < 128; e += 2) {
            const int l1 = (e + 1) & 63;
            const int r1 = (e + 1) < 64 ? __builtin_amdgcn_readlane(ilo, l1) : __builtin_amdgcn_readlane(ihi, l1);
            load_row8(b1, UB + (size_t)r1 * DM, lane);
            { const float d = wave_sum(dot_row(xr, b0)); if (e < 64) { if (lane == (e & 63)) alo = d; } else { if (lane == (e & 63)) ahi = d; } }
            const int e2 = e + 2 < 128 ? e + 2 : 127, l2 = e2 & 63;
            const int r2 = e2 < 64 ? __builtin_amdgcn_readlane(ilo, l2) : __builtin_amdgcn_readlane(ihi, l2);
            load_row8(b0, UB + (size_t)r2 * DM, lane);
            { const float d = wave_sum(dot_row(xr, b1)); if (e + 1 < 64) { if (lane == l1) alo = d; } else { if (lane == l1) ahi = d; } }
        }
    }
#ifdef DBG_NO_PEER
    const float wlo = 0.f * alo * glo, whi = 0.f * ahi * ghi;
#else
    const float wlo = gelu_erf(alo) * glo, whi = gelu_erf(ahi) * ghi;
#endif
    float acc[64];
#pragma unroll
    for (int i = 0; i < 64; ++i) acc[i] = 0.f;
    {
        v4u b0[8], b1[8];
        load_row8(b0, VB + (size_t)__builtin_amdgcn_readlane(ilo, 0) * DM, lane);
#pragma unroll 1
        for (int e = 0; e < 128; e += 2) {
            const int l0 = e & 63, l1 = (e + 1) & 63;
            const int r1 = (e + 1) < 64 ? __builtin_amdgcn_readlane(ilo, l1) : __builtin_amdgcn_readlane(ihi, l1);
            load_row8(b1, VB + (size_t)r1 * DM, lane);
            { const float w = e < 64 ? readlane_f(wlo, l0) : readlane_f(whi, l0); axpy_row(acc, b0, w); }
            const int e2 = e + 2 < 128 ? e + 2 : 127, l2 = e2 & 63;
            const int r2 = e2 < 64 ? __builtin_amdgcn_readlane(ilo, l2) : __builtin_amdgcn_readlane(ihi, l2);
            load_row8(b0, VB + (size_t)r2 * DM, lane);
            { const float w = (e + 1) < 64 ? readlane_f(wlo, l1) : readlane_f(whi, l1); axpy_row(acc, b1, w); }
        }
    }
    float* hrow = hout + (size_t)tk * DM;
    float ssq = 0.f;
#pragma unroll
    for (int j = 0; j < 8; ++j) {
        const f32x4 h0 = *(const GAS f32x4*)(hrow + 512 * j + 8 * lane), h1 = *(const GAS f32x4*)(hrow + 512 * j + 8 * lane + 4);
#pragma unroll
        for (int k = 0; k < 4; ++k) { acc[8 * j + k] += h0[k]; acc[8 * j + 4 + k] += h1[k]; }
#pragma unroll
        for (int k = 0; k < 8; ++k) ssq += acc[8 * j + k] * acc[8 * j + k];
    }
    const float rstd = 1.0f / sqrtf(wave_sum(ssq) * (1.f / DM) + RMS_EPS);
#pragma unroll
    for (int j = 0; j < 8; ++j) {
        const f32x4 g0 = *(const GAS f32x4*)(gfin + 512 * j + 8 * lane), g1 = *(const GAS f32x4*)(gfin + 512 * j + 8 * lane + 4);
        f32x4 o0, o1;
#pragma unroll
        for (int k = 0; k < 4; ++k) { o0[k] = acc[8 * j + k] * rstd * g0[k]; o1[k] = acc[8 * j + 4 + k] * rstd * g1[k]; }
        *(GAS f32x4*)(hrow + 512 * j + 8 * lane) = o0; *(GAS f32x4*)(hrow + 512 * j + 8 * lane + 4) = o1;
    }
}

struct Args { const float* in[21]; float* out; unsigned char* ws; int ph_lo, ph_hi; };
static_assert(sizeof(Args) == 21 * 8 + 8 + 8 + 8, "Args has no padding");

__global__ void __launch_bounds__(NWAVES * 64, 2) hymba_fwd(Args args) {
    extern __shared__ __attribute__((aligned(16))) unsigned char lds_raw[];
    LAS unsigned char* lds = (LAS unsigned char*)lds_raw;
    volatile LAS unsigned* MISC = (volatile LAS unsigned*)(lds + MISC_OFF);
    const int tid = threadIdx.x, lane = tid & 63, wave = __builtin_amdgcn_readfirstlane(tid >> 6);
    const int G = gridDim.x; const int bx = blockIdx.x;
    const int vcu = (G % 8 == 0) ? (bx % 8) * (G / 8) + bx / 8 : bx;
    unsigned char* ws = args.ws;
    gu32* ctl = (gu32*)(ws + WS_CTL);
    for (int u = tid; u < (LDS_BYTES - LDSCTL_OFF) / 4; u += NWAVES * 64) ((LAS unsigned*)(lds + LDSCTL_OFF))[u] = 0u;
    __syncthreads();
    XcdBarrier bar = xcd_barrier_post((unsigned*)(ctl + CW_BAR), MISC + 8);
    const int lo = args.ph_lo, hi = args.ph_hi;
#ifdef PH_ONLY
#define IN(k) ((k) == PH_ONLY && lo <= (k) && (k) < hi)
#else
#define IN(k) (lo <= (k) && (k) < hi)
#endif
#define SEAM(k) do { if (IN(k) && IN((k) + 1)) xcd_barrier(bar); } while (0)

    const float* x = args.in[0]; const float* mem = args.in[1]; const float* norm_mix = args.in[2]; const float* w_in = args.in[3];
    const float* swa_sink = args.in[4]; const float* nat_rel_bias = args.in[5]; const float* out_norm_swa = args.in[6]; const float* out_norm_nat = args.in[7];
    const float* w_out = args.in[8]; const float* norm_mem_q = args.in[9]; const float* norm_mem_kv = args.in[10]; const float* w_mem_q = args.in[11];
    const float* w_mem_k = args.in[12]; const float* w_mem_v = args.in[13]; const float* w_mem_o = args.in[14]; const float* norm_ffn = args.in[15];
    const float* w_peer_q = args.in[16]; const float* peer_sub_keys = args.in[17]; const float* peer_u = args.in[18]; const float* peer_v = args.in[19];
    const float* norm_final = args.in[20];
    float* out = args.out;
    float* ropec = (float*)(ws + WS_ROPE); float* ropes = ropec + 2048 * 64;
    bf16* SKB = (bf16*)(ws + WS_SKB);
    bf16* WIN_T = (bf16*)(ws + WS_WIN); bf16* WOUT_T = (bf16*)(ws + WS_WOUT); bf16* WMQ_T = (bf16*)(ws + WS_WMQ); bf16* WMKV_T = (bf16*)(ws + WS_WMKV);
    bf16* WMO_T = (bf16*)(ws + WS_WMO); bf16* WPQ_T = (bf16*)(ws + WS_WPQ); bf16* UB = (bf16*)(ws + WS_UB); bf16* VB = (bf16*)(ws + WS_VB);
    bf16* XN = (bf16*)(ws + WS_XN); bf16* QKV = (bf16*)(ws + WS_QKV); bf16* OB = (bf16*)(ws + WS_OB); bf16* MEMN = (bf16*)(ws + WS_MEMN);
    bf16* KVM = (bf16*)(ws + WS_KVM); bf16* QM = (bf16*)(ws + WS_QM); bf16* OM = (bf16*)(ws + WS_OM); bf16* QP = (bf16*)(ws + WS_QP);
    int* IDX = (int*)(ws + WS_IDX); float* GATE = (float*)(ws + WS_GATE);
    const int gw = vcu * NWAVES + wave, NGW = G * NWAVES;

    if (IN(0)) {
        LAS float* scr = (LAS float*)(lds + wave * 16384);
        constexpr int I_IN = (DM / 64) * (INW / 32), I_OUT = (DM / 64) * (DM / 32), I_MQ = (DM / 64) * (MEMW / 32), I_MO = (MEMW / 64) * (DM / 32), I_PQ = (DM / 64) * (PQW / 32);
        constexpr int NITEMS = I_IN + I_OUT + 3 * I_MQ + I_MO + I_PQ;
        for (int it = gw; it < NITEMS; it += NGW) {
            int r = it;
            if (r < I_IN) { p0_transpose_item(w_in, DM, INW, WIN_T, 0, scr, r, lane); continue; } r -= I_IN;
            if (r < I_OUT) { p0_transpose_item(w_out, DM, DM, WOUT_T, 0, scr, r, lane); continue; } r -= I_OUT;
            if (r < I_MQ) { p0_transpose_item(w_mem_q, DM, MEMW, WMQ_T, 0, scr, r, lane); continue; } r -= I_MQ;
            if (r < I_MQ) { p0_transpose_item(w_mem_k, DM, MEMW, WMKV_T, 0, scr, r, lane); continue; } r -= I_MQ;
            if (r < I_MQ) { p0_transpose_item(w_mem_v, DM, MEMW, WMKV_T, MEMW, scr, r, lane); continue; } r -= I_MQ;
            if (r < I_MO) { p0_transpose_item(w_mem_o, MEMW, DM, WMO_T, 0, scr, r, lane); continue; } r -= I_MO;
            p0_transpose_item(w_peer_q, DM, PQW, WPQ_T, 0, scr, r, lane);
        }
        for (int m = gw; m < T_TOK; m += NGW) rms_row_to_bf16(x + (size_t)m * DM, norm_mix, XN + (size_t)m * DM, lane);
        for (int m = gw; m < NBATCH * MEMLEN; m += NGW) rms_row_to_bf16(mem + (size_t)m * DM, norm_mem_kv, MEMN + (size_t)m * DM, lane);
        {
            const size_t nchunk = (size_t)NEXP * DM / 512;
            for (size_t c = gw; c < nchunk; c += (size_t)NGW * 2) {
                const size_t c2 = c + NGW < nchunk ? c + NGW : c;
                const size_t e0 = c * 512 + 8 * lane, e1 = c2 * 512 + 8 * lane;
                const f32x4 a0 = *(const GAS f32x4*)(peer_u + e0), a1 = *(const GAS f32x4*)(peer_u + e0 + 4), b0 = *(const GAS f32x4*)(peer_v + e0), b1 = *(const GAS f32x4*)(peer_v + e0 + 4);
                const f32x4 c0 = *(const GAS f32x4*)(peer_u + e1), c1 = *(const GAS f32x4*)(peer_u + e1 + 4), d0 = *(const GAS f32x4*)(peer_v + e1), d1 = *(const GAS f32x4*)(peer_v + e1 + 4);
                v4u w; w.x = cvtpk(a0.x, a0.y); w.y = cvtpk(a0.z, a0.w); w.z = cvtpk(a1.x, a1.y); w.w = cvtpk(a1.z, a1.w); *(GAS v4u*)(UB + e0) = w;
                w.x = cvtpk(b0.x, b0.y); w.y = cvtpk(b0.z, b0.w); w.z = cvtpk(b1.x, b1.y); w.w = cvtpk(b1.z, b1.w); *(GAS v4u*)(VB + e0) = w;
                w.x = cvtpk(c0.x, c0.y); w.y = cvtpk(c0.z, c0.w); w.z = cvtpk(c1.x, c1.y); w.w = cvtpk(c1.z, c1.w); *(GAS v4u*)(UB + e1) = w;
                w.x = cvtpk(d0.x, d0.y); w.y = cvtpk(d0.z, d0.w); w.z = cvtpk(d1.x, d1.y); w.w = cvtpk(d1.z, d1.w); *(GAS v4u*)(VB + e1) = w;
            }
        }
        for (int e = (gw * 64 + lane) * 4; e < 8 * 2 * 128 * 128; e += NGW * 64 * 4) { const f32x4 a = *(const GAS f32x4*)(peer_sub_keys + e); u32x2 w; w.x = cvtpk(a.x, a.y); w.y = cvtpk(a.z, a.w); *(GAS u32x2*)(SKB + e) = w; }
        for (int e = gw * 64 + lane; e < 2048 * 64; e += NGW * 64) {
            const int pos = e >> 6, i = e & 63;
            const float inv = fexp2(-(float)i * (13.287712379549449f / 64.0f));
            const float ang = (float)pos * inv;
            const float rev = ang * 0.15915494309189535f; const float fr = rev - floorf(rev);
            ropec[e] = __builtin_amdgcn_cosf(fr); ropes[e] = __builtin_amdgcn_sinf(fr);
        }
    }
    SEAM(0);
    if (IN(1)) {
        { pg8::Gemm g{XN, WIN_T, T_TOK, INW, DM}; pg8::StaticOrder S; S.init(T_TOK, INW, G, bx);
          pg8::EpiBf16<0> E{QKV, INW, nullptr, 0, 0, 1.f};
          pg8::gemm_phase<pg8::EpiBf16<0>, pg8::StaticOrder, true, true>(lds, g, S, E); }
        { pg8::Gemm g{MEMN, WMKV_T, NBATCH * MEMLEN, 2 * MEMW, DM}; pg8::StaticOrder S; S.init(NBATCH * MEMLEN, 2 * MEMW, G, (bx + G / 2) % G);
          pg8::EpiBf16<0> E{KVM, 2 * MEMW, nullptr, 0, 0, 1.f};
          pg8::gemm_phase<pg8::EpiBf16<0>, pg8::StaticOrder, true, true>(lds, g, S, E); }
    }
    SEAM(1);
    if (IN(2)) {
        for (int u = bx; u < 1024; u += G) {
#ifndef NO_SWA
            if (u < 512) swa_unit(lds, u, QKV, OB, swa_sink, ropec, ropes);
#endif
#ifndef NO_NAT
            if (u >= 512) nat_unit(lds, u - 512, QKV, OB, nat_rel_bias);
#endif
        }
    }
    SEAM(2);
    if (IN(3)) { for (int m = gw; m < T_TOK; m += NGW) mix_row_norm(OB + (size_t)m * DM, out_norm_swa, out_norm_nat, lane); }
    SEAM(3);
    if (IN(4)) {
        pg8::Gemm g{OB, WOUT_T, T_TOK, DM, DM}; pg8::StaticOrder S; S.init(T_TOK, DM, G, bx);
        EpiResF32 E{x, out, DM, 1.f};
        pg8::gemm_phase<EpiResF32, pg8::StaticOrder, true, true>(lds, g, S, E);
    }
    SEAM(4);
    if (IN(5)) { for (int m = gw; m < T_TOK; m += NGW) rms_row_to_bf16(out + (size_t)m * DM, norm_mem_q, XN + (size_t)m * DM, lane); }
    SEAM(5);
    if (IN(6)) {
        pg8::Gemm g{XN, WMQ_T, T_TOK, MEMW, DM}; pg8::StaticOrder S; S.init(T_TOK, MEMW, G, bx);
        pg8::EpiBf16<0> E{QM, MEMW, nullptr, 0, 0, 1.f};
        pg8::gemm_phase<pg8::EpiBf16<0>, pg8::StaticOrder, true, true>(lds, g, S, E);
    }
    SEAM(6);
    if (IN(7)) { for (int u = bx; u < 256; u += G) mem_unit(lds, u, QM, KVM, OM); }
    SEAM(7);
    if (IN(8)) {
        pg8::Gemm g{OM, WMO_T, T_TOK, DM, MEMW}; pg8::StaticOrder S; S.init(T_TOK, DM, G, bx);
#ifdef DBG_NO_MEM
        EpiResF32 E{out, out, DM, 0.f};
#else
        EpiResF32 E{out, out, DM, 1.f};
#endif
        pg8::gemm_phase<EpiResF32, pg8::StaticOrder, true, true>(lds, g, S, E);
    }
    SEAM(8);
    if (IN(9)) { for (int m = gw; m < T_TOK; m += NGW) rms_row_to_bf16(out + (size_t)m * DM, norm_ffn, XN + (size_t)m * DM, lane); }
    SEAM(9);
    if (IN(10)) {
        pg8::Gemm g{XN, WPQ_T, T_TOK, PQW, DM}; pg8::StaticOrder S; S.init(T_TOK, PQW, G, bx);
        pg8::EpiBf16<0> E{QP, PQW, nullptr, 0, 0, 1.f};
        pg8::gemm_phase<pg8::EpiBf16<0>, pg8::StaticOrder, true, true>(lds, g, S, E);
    }
    SEAM(10);
    if (IN(11)) { for (int u = bx; u < 256; u += G) route_unit(lds, u, QP, SKB, IDX, GATE); }
    SEAM(11);
    if (IN(12)) { for (int tk = gw; tk < T_TOK; tk += NGW) peer_token(tk, XN, IDX, GATE, UB, VB, out, norm_final, lane); }
#undef IN
#undef SEAM
}

constexpr int N_PHASES = 13;
#ifndef MK_N_LAUNCHES
#define MK_N_LAUNCHES 1
#endif

extern "C" void kernel_launch(void* const* d_in, const int* in_sizes, int n_in, void* d_out, int out_size, void* d_ws, size_t ws_size, hipStream_t stream) {
    static int grid = 0;
    if (grid == 0) {
        if (n_in != 21 || in_sizes[0] != T_TOK * DM || out_size != T_TOK * DM || ws_size < WS_END) { fprintf(stderr, "kernel_launch: unexpected shapes (n_in %d in0 %d out %d ws %zu)\n", n_in, n_in > 0 ? in_sizes[0] : -1, out_size, ws_size); grid = -1; return; }
        int dev = 0, cus = 0, per_cu = 0;
        if (hipGetDevice(&dev) != hipSuccess || hipDeviceGetAttribute(&cus, hipDeviceAttributeMultiprocessorCount, dev) != hipSuccess) { grid = -1; return; }
        if (hipFuncSetAttribute((const void*)hymba_fwd, hipFuncAttributeMaxDynamicSharedMemorySize, LDS_BYTES) != hipSuccess) { fprintf(stderr, "kernel_launch: hipFuncSetAttribute failed\n"); grid = -1; return; }
        if (hipOccupancyMaxActiveBlocksPerMultiprocessor(&per_cu, (const void*)hymba_fwd, NWAVES * 64, LDS_BYTES) != hipSuccess || per_cu < 1) fprintf(stderr, "kernel_launch: occupancy query says %d\n", per_cu);
        (void)hipGetLastError();
        grid = cus;
    }
    if (grid < 0) return;
    if (hipMemsetAsync((char*)d_ws + WS_CTL, 0, CTL_ZERO_BYTES, stream) != hipSuccess) return;
    Args a{};
    for (int i = 0; i < 21; ++i) a.in[i] = (const float*)d_in[i];
    a.out = (float*)d_out; a.ws = (unsigned char*)d_ws;
#if MK_N_LAUNCHES == 1
    a.ph_lo = 0; a.ph_hi = N_PHASES;
    hipLaunchKernelGGL(hymba_fwd, dim3(grid), dim3(NWAVES * 64), LDS_BYTES, stream, a);
#else
    for (int p = 0; p < N_PHASES; ++p) { a.ph_lo = p; a.ph_hi = p + 1; hipLaunchKernelGGL(hymba_fwd, dim3(grid), dim3(NWAVES * 64), LDS_BYTES, stream, a); }
#endif
}
```

```cpp
#include <hip/hip_runtime.h>
#include <cstdio>
#include <cstdint>
namespace pg8 {
#define PG8_LAS __attribute__((address_space(3)))
typedef unsigned short bf16_t;
typedef short bf16x8 __attribute__((ext_vector_type(8)));
typedef float f32x4 __attribute__((ext_vector_type(4)));
typedef unsigned u32x4 __attribute__((ext_vector_type(4)));
constexpr int BM = 256, BK = 64, HALF = 128, HTB = HALF * BK * 2  , STAGE_BYTES = 8 * HTB, NXCD = 8, WGM = 8;

__host__ __device__ __forceinline__ int lds_byte(int r, int c) { const int st = (r >> 4) * 2 + (c >> 5), rr = r & 15, cc = c & 31, ob = rr * 64 + cc * 2; return st * 1024 + (ob ^ (((ob >> 9) & 1) << 5)); }
__host__ __device__ __forceinline__ void stage_rc(int b, int& R, int& C) { const int st = b / 1024, sb = b % 1024, swz = sb ^ (((sb >> 9) & 1) << 5); R = (st >> 1) * 16 + swz / 64; C = (st & 1) * 32 + (swz % 64) / 2; }
__host__ __device__ __forceinline__ int perm32(int rho) { const int n = rho >> 4, i = rho & 15; return 8 * (i >> 2) + 4 * n + (i & 3); }

struct Unit { int pm, pn; };
struct Gemm { const bf16_t* A; const bf16_t* Bt; int M, N, K; };

struct StaticOrder {
    int nM, nN, nwg, G, c;
    __host__ __device__ void init(int M, int N, int G_, int c_) { nM = M / BM; nN = N / BM; nwg = nM * nN; G = G_; c = c_; }
    __host__ __device__ bool next(int i, Unit& u) const {
        const long L = (long)i * G + c; if (L >= nwg) return false;
        int wgid = (int)L; { const int q = nwg / NXCD, r = nwg % NXCD, xcd = wgid % NXCD, off = wgid / NXCD; wgid = (xcd < r ? xcd * (q + 1) : r * (q + 1) + (xcd - r) * q) + off; }
        const int nig = WGM * nN, gid = wgid / nig, fm = gid * WGM, gsz = (nM - fm) < WGM ? (nM - fm) : WGM;
        u.pm = fm + ((wgid % nig) % gsz); u.pn = (wgid % nig) / gsz; return true;
    }
    __device__ __forceinline__ void a_ready(const Unit&) const {}
    __device__ __forceinline__ void done(const Unit&) const {}
};

__device__ __forceinline__ unsigned cvt_pk_bf16(float lo, float hi) { unsigned r; asm volatile("v_cvt_pk_bf16_f32 %0, %1, %2" : "=v"(r) : "v"(lo), "v"(hi)); return r; }
typedef float f32x2 __attribute__((ext_vector_type(2)));
__device__ __forceinline__ f32x2 gelu_pk(f32x2 v) {
    const f32x2 av = __builtin_elementwise_abs(v), d = av * 0.2316418882f + 1.0f;
    f32x2 t; t.x = __builtin_amdgcn_rcpf(d.x); t.y = __builtin_amdgcn_rcpf(d.y);
    f32x2 q = t * 0.5307027145f + (-0.7265760135f); q = q * t + 0.7107068705f; q = q * t + (-0.142248368f); q = q * t + 0.127414796f; q = q * t;
    const f32x2 s = (v * v) * (-0.72134752044f);
    f32x2 e; e.x = __builtin_amdgcn_exp2f(s.x); e.y = __builtin_amdgcn_exp2f(s.y);
    const f32x2 m = v * (q * e), r = v - m;
    f32x2 o; o.x = v.x < 0.f ? m.x : r.x; o.y = v.y < 0.f ? m.y : r.y; return o;
}

template <int ACT  > struct EpiBf16 {
    static constexpr bool PERM = true, AFTER_DRAIN = false; static_assert(ACT == 0 || ACT == 1, "EpiBf16: ACT is 0 (none) or 1 (gelu_pk)");
    bf16_t* O; int ldc; const float* bias; int split_cols; size_t split_stride; float scale0;
    __device__ __forceinline__ void operator()(const f32x4 (&acc)[2][2][4][2], const Unit& u, int wr, int wc, int fr, int fq) const {
        const int row0 = u.pm * BM + wr * 64 + fr; int colt = u.pn * BM; bf16_t* base = O;
        float sc = 1.f; if (split_cols) { const int t = colt / split_cols; base += (size_t)t * split_stride; colt -= t * split_cols; if (t == 0) sc = scale0; }
        const int col0 = colt + wc * 32 + 8 * fq, bcol0 = u.pn * BM + wc * 32 + 8 * fq;
        f32x4 bv[2][2];
#pragma unroll
        for (int bj = 0; bj < 2; ++bj)
#pragma unroll
            for (int n = 0; n < 2; ++n) bv[bj][n] = bias ? *(const f32x4*)(bias + bcol0 + bj * HALF + 4 * n) : (f32x4){0.f, 0.f, 0.f, 0.f};
#pragma unroll
        for (int ai = 0; ai < 2; ++ai)
#pragma unroll
            for (int m = 0; m < 4; ++m) { bf16_t* rowp = base + (size_t)(row0 + ai * HALF + m * 16) * ldc + col0;
#pragma unroll
                for (int bj = 0; bj < 2; ++bj) { f32x4 v0 = acc[ai][bj][m][0] + bv[bj][0], v1 = acc[ai][bj][m][1] + bv[bj][1];
                    if (ACT == 1) { f32x2 a = gelu_pk((f32x2){v0[0], v0[1]}), b = gelu_pk((f32x2){v0[2], v0[3]}), c = gelu_pk((f32x2){v1[0], v1[1]}), d = gelu_pk((f32x2){v1[2], v1[3]});
                        v0 = (f32x4){a.x, a.y, b.x, b.y}; v1 = (f32x4){c.x, c.y, d.x, d.y}; }
                    v0 = v0 * sc; v1 = v1 * sc; u32x4 w; w.x = cvt_pk_bf16(v0[0], v0[1]); w.y = cvt_pk_bf16(v0[2], v0[3]); w.z = cvt_pk_bf16(v1[0], v1[1]); w.w = cvt_pk_bf16(v1[2], v1[3]);
                    *(u32x4*)(rowp + bj * HALF) = w; } }
    }
};

struct PanelStats {
    unsigned* xbuf;
    unsigned* cnt;
    unsigned* tmo;
    int ntn; float eps;
    unsigned code;
    __device__ __forceinline__ bool run(const f32x4 (&v)[2][2][4][2], const Unit& u, int wr, int wc, int fr, int fq, PG8_LAS unsigned char* lds, int wid, int lane) const {
        typedef float f32x2v __attribute__((ext_vector_type(2)));
        PG8_LAS f32x2v* P = (PG8_LAS f32x2v*)lds;
        PG8_LAS f32x2v* S = (PG8_LAS f32x2v*)(lds + 8192);
        PG8_LAS unsigned* flag = (PG8_LAS unsigned*)(lds + 8192 + 2048);
#pragma unroll
        for (int ai = 0; ai < 2; ++ai)
#pragma unroll
            for (int m = 0; m < 4; ++m) {
                float s = 0.f;
#pragma unroll
                for (int bj = 0; bj < 2; ++bj)
#pragma unroll
                    for (int n = 0; n < 2; ++n) { const f32x4 x = v[ai][bj][m][n]; s += (x[0] + x[1]) + (x[2] + x[3]); }
                s += __shfl_xor(s, 16); s += __shfl_xor(s, 32);
                const float mw = s * (1.0f / 64.0f); float q = 0.f;
#pragma unroll
                for (int bj = 0; bj < 2; ++bj)
#pragma unroll
                    for (int n = 0; n < 2; ++n) { const f32x4 d = v[ai][bj][m][n] - mw; q += (d[0] * d[0] + d[1] * d[1]) + (d[2] * d[2] + d[3] * d[3]); }
                q += __shfl_xor(q, 16); q += __shfl_xor(q, 32);
                if (fq == 0) P[(ai * HALF + wr * 64 + m * 16 + fr) * 4 + wc] = (f32x2v){mw, q};
            }
        asm volatile("s_waitcnt lgkmcnt(0)" ::: "memory"); __builtin_amdgcn_s_barrier(); asm volatile("" ::: "memory");
#if defined(BROKEN_EXCHANGE_NO_WAIT)
#warning BROKEN CONTROL BUILD: the row-statistics exchange does not wait; results are wrong by design
        if (blockIdx.x >= 64) { const long long t0_ = clock64(); while (clock64() - t0_ < 60000) __builtin_amdgcn_s_sleep(8); }
#endif
        const int row = wid * 32 + (lane & 31);
        if (lane < 32) {
            const f32x2v a = P[row * 4 + 0], b = P[row * 4 + 1], c = P[row * 4 + 2], d = P[row * 4 + 3];
            const float mt = (a.x + b.x + c.x + d.x) * 0.25f;
            const float da = a.x - mt, db = b.x - mt, dc = c.x - mt, dd = d.x - mt;
            const float m2 = (a.y + b.y) + (c.y + d.y) + 64.0f * ((da * da + db * db) + (dc * dc + dd * dd));
            unsigned long long* slot = (unsigned long long*)xbuf + ((size_t)(u.pm * BM + row) * 4 + u.pn);
            __hip_atomic_store(slot, ((unsigned long long)__float_as_uint(m2) << 32) | __float_as_uint(mt), __ATOMIC_RELAXED, __HIP_MEMORY_SCOPE_AGENT);
        }
        asm volatile("s_waitcnt vmcnt(0)" ::: "memory");
        if (lane == 0) __hip_atomic_fetch_add(cnt + 64 * u.pm, 1u, __ATOMIC_RELAXED, __HIP_MEMORY_SCOPE_AGENT);
        if (wid == 0) {
            bool dead = false; const unsigned long long t0 = __builtin_amdgcn_s_memrealtime(); const unsigned want = 8u * (unsigned)ntn;
            for (;;) {
#if defined(BROKEN_EXCHANGE_NO_WAIT)
                break;
#endif
                if ((unsigned)__builtin_amdgcn_readfirstlane(__hip_atomic_load(cnt + 64 * u.pm, __ATOMIC_RELAXED, __HIP_MEMORY_SCOPE_AGENT)) >= want) break;
                if (__builtin_amdgcn_s_memrealtime() - t0 > 2000000ull) {
                    if (lane == 0) { unsigned expect = 0u; __hip_atomic_compare_exchange_strong(tmo + 1, &expect, code | (unsigned)(u.pm & 0xff), __ATOMIC_RELAXED, __ATOMIC_RELAXED, __HIP_MEMORY_SCOPE_AGENT);
                                     __hip_atomic_store(tmo, 1u, __ATOMIC_RELAXED, __HIP_MEMORY_SCOPE_AGENT); }
                    dead = true; break; }
                __builtin_amdgcn_s_sleep(2);
            }
            __builtin_amdgcn_fence(__ATOMIC_ACQUIRE, "agent");
            if (lane == 0) flag[0] = dead ? 1u : 0u;
        }
        asm volatile("s_waitcnt vmcnt(0) lgkmcnt(0)" ::: "memory"); __builtin_amdgcn_s_barrier(); asm volatile("" ::: "memory");
        const bool bad = flag[0] != 0u;
        if (lane < 32) {
            const unsigned long long* slot = (const unsigned long long*)xbuf + (size_t)(u.pm * BM + row) * 4; float mt[4], m2[4]; float ms = 0.f;
#pragma unroll
            for (int t = 0; t < 4; ++t) { if (t < ntn) { const unsigned long long w = __hip_atomic_load(slot + t, __ATOMIC_RELAXED, __HIP_MEMORY_SCOPE_AGENT); mt[t] = __uint_as_float((unsigned)w); m2[t] = __uint_as_float((unsigned)(w >> 32)); } else { mt[t] = 0.f; m2[t] = 0.f; } ms += mt[t]; }
            const float mean = ms / (float)ntn; float q = 0.f;
#pragma unroll
            for (int t = 0; t < 4; ++t) if (t < ntn) { const float dm = mt[t] - mean; q += m2[t] + 256.0f * dm * dm; }
            S[row] = (f32x2v){mean, 1.0f / sqrtf(q / (256.0f * (float)ntn) + eps)};
        }
        asm volatile("s_waitcnt lgkmcnt(0)" ::: "memory"); __builtin_amdgcn_s_barrier(); asm volatile("" ::: "memory");
        return bad;
    }
};
struct EpiLnRes {
    static constexpr bool PERM = false, AFTER_DRAIN = true;
    const float* base; float* out; int ldc; const float* bias; PanelStats st; unsigned poison;
    __device__ __forceinline__ void fused(f32x4 (&acc)[2][2][4][2], const Unit& u, int wr, int wc, int fr, int fq, PG8_LAS unsigned char* lds, int wid, int lane) const {
        typedef float f32x2v __attribute__((ext_vector_type(2)));
        const PG8_LAS f32x2v* S = (const PG8_LAS f32x2v*)(lds + 8192);
        const int col0 = u.pn * BM + wc * 32 + 4 * fq;
#pragma unroll
        for (int bj = 0; bj < 2; ++bj)
#pragma unroll
            for (int n = 0; n < 2; ++n) { const f32x4 bv = bias ? *(const f32x4*)(bias + col0 + bj * HALF + n * 16) : (f32x4){0.f, 0.f, 0.f, 0.f};
#pragma unroll
                for (int ai = 0; ai < 2; ++ai)
#pragma unroll
                    for (int m = 0; m < 4; ++m) acc[ai][bj][m][n] += bv; }
        f32x4 pre[4][2][2];
#pragma unroll
        for (int m = 0; m < 4; ++m) { const size_t off = (size_t)(u.pm * BM + wr * 64 + m * 16 + fr) * ldc + col0;
#pragma unroll
            for (int bj = 0; bj < 2; ++bj)
#pragma unroll
                for (int n = 0; n < 2; ++n) pre[m][bj][n] = *(const f32x4*)(base + off + bj * HALF + n * 16); }
        const bool bad = st.run(acc, u, wr, wc, fr, fq, lds, wid, lane) || poison != 0u;
        const float qnan = __builtin_nanf("");
#pragma unroll
        for (int ai = 0; ai < 2; ++ai)
#pragma unroll
            for (int m = 0; m < 4; ++m) { const int r = ai * HALF + wr * 64 + m * 16 + fr; const f32x2v sr = S[r]; const size_t off = (size_t)(u.pm * BM + r) * ldc + col0;
#pragma unroll
                for (int bj = 0; bj < 2; ++bj)
#pragma unroll
                    for (int n = 0; n < 2; ++n) { const f32x4 bs = ai == 0 ? pre[m][bj][n] : *(const f32x4*)(base + off + bj * HALF + n * 16); f32x4 o = bs + (acc[ai][bj][m][n] - sr.x) * sr.y;
                        if (bad) o = (f32x4){qnan, qnan, qnan, qnan}; *(f32x4*)(out + off + bj * HALF + n * 16) = o; }
                if (m & 1) asm volatile("" ::: "memory"); }
    }
};
struct EpiLnResLn {
    static constexpr bool PERM = false, AFTER_DRAIN = true;
    const float* base; float* out; bf16_t* xn; int ldc; const float* bias; PanelStats st1, st2; unsigned poison;
    __device__ __forceinline__ void fused(f32x4 (&acc)[2][2][4][2], const Unit& u, int wr, int wc, int fr, int fq, PG8_LAS unsigned char* lds, int wid, int lane) const {
        typedef float f32x2v __attribute__((ext_vector_type(2))); typedef unsigned u32x2v __attribute__((ext_vector_type(2)));
        const PG8_LAS f32x2v* S = (const PG8_LAS f32x2v*)(lds + 8192);
        const int col0 = u.pn * BM + wc * 32 + 4 * fq;
#pragma unroll
        for (int bj = 0; bj < 2; ++bj)
#pragma unroll
            for (int n = 0; n < 2; ++n) { const f32x4 bv = bias ? *(const f32x4*)(bias + col0 + bj * HALF + n * 16) : (f32x4){0.f, 0.f, 0.f, 0.f};
#pragma unroll
                for (int ai = 0; ai < 2; ++ai)
#pragma unroll
                    for (int m = 0; m < 4; ++m) acc[ai][bj][m][n] += bv; }
        bool bad = st1.run(acc, u, wr, wc, fr, fq, lds, wid, lane) || poison != 0u;
        const float qnan = __builtin_nanf("");
#pragma unroll
        for (int ai = 0; ai < 2; ++ai)
#pragma unroll
            for (int m = 0; m < 4; ++m) { const int r = ai * HALF + wr * 64 + m * 16 + fr; const f32x2v sr = S[r]; const size_t off = (size_t)(u.pm * BM + r) * ldc + col0;
#pragma unroll
                for (int bj = 0; bj < 2; ++bj)
#pragma unroll
                    for (int n = 0; n < 2; ++n) { const f32x4 bs = *(const f32x4*)(base + off + bj * HALF + n * 16); acc[ai][bj][m][n] = bs + (acc[ai][bj][m][n] - sr.x) * sr.y; }
                asm volatile("" : "+v"(acc[ai][0][m][0]), "+v"(acc[ai][0][m][1]), "+v"(acc[ai][1][m][0]), "+v"(acc[ai][1][m][1]));
                if (m & 1) asm volatile("" ::: "memory"); }
        const bool bad1 = bad;
        bad = st2.run(acc, u, wr, wc, fr, fq, lds, wid, lane) || bad;
#pragma unroll
        for (int ai = 0; ai < 2; ++ai)
#pragma unroll
            for (int m = 0; m < 4; ++m) { const int r = ai * HALF + wr * 64 + m * 16 + fr; const f32x2v sr = S[r]; const size_t off = (size_t)(u.pm * BM + r) * ldc + col0;
#pragma unroll
                for (int bj = 0; bj < 2; ++bj)
#pragma unroll
                    for (int n = 0; n < 2; ++n) { const f32x4 x1 = acc[ai][bj][m][n]; *(f32x4*)(out + off + bj * HALF + n * 16) = bad1 ? (f32x4){qnan, qnan, qnan, qnan} : x1;
                        const f32x4 o = (x1 - sr.x) * sr.y; u32x2v w; w.x = cvt_pk_bf16(o[0], o[1]); w.y = cvt_pk_bf16(o[2], o[3]);
                        if (bad) { w.x = 0x7fc07fc0u; w.y = 0x7fc07fc0u; } *(u32x2v*)(xn + off + bj * HALF + n * 16) = w; }
                asm volatile("" ::: "memory"); }
    }
};

template <class Epi, class Sched, bool ALIGN_EPI = false, bool SP2 = false, bool MID = false>
__device__ __forceinline__ void gemm_phase(PG8_LAS unsigned char* lds, const Gemm g, const Sched& S, const Epi& E) {
    const int tid = threadIdx.x, wid = __builtin_amdgcn_readfirstlane(tid >> 6), lane = tid & 63, wr = wid >> 2, wc = wid & 3, fr = lane & 15, fq = lane >> 4;
    const int K = g.K, nt = K / BK;
    unsigned voffA[2], voffB[2];
#pragma unroll
    for (int i = 0; i < 2; ++i) { int R, C; stage_rc(tid * 16 + i * 8192, R, C); const int Rb = Epi::PERM ? ((R & ~31) + perm32(R & 31)) : R;
        voffA[i] = (unsigned)(R * K + C) * 2u; voffB[i] = (unsigned)(Rb * K + C) * 2u; }
    const size_t kstep = (size_t)(BK * 2);
    const size_t hstep = (size_t)HALF * K * 2;
    const size_t tstep = 2 * hstep;
    const unsigned ldsw = (unsigned)wid * 1024u;
    const int aoff = lds_byte(wr * 64 + fr, fq * 8), boff = lds_byte(wc * 32 + fr, fq * 8);
#define PG8_SA(b, h) (((b) * 2 + (h)) * HTB)
#define PG8_SB(b, h) ((4 + (b) * 2 + (h)) * HTB)
#define PG8_STAGE(bufoff, gbase, voff) do { _Pragma("unroll") for (int _i = 0; _i < 2; ++_i) \
        __builtin_amdgcn_global_load_lds((const unsigned*)((const char*)(gbase) + (voff)[_i]), (PG8_LAS unsigned*)(lds + (bufoff) + ldsw + _i * 8192), 16, 0, 0); } while (0)
#define PG8_LDA(dst, b, h) do { _Pragma("unroll") for (int m = 0; m < 4; ++m) _Pragma("unroll") for (int k = 0; k < 2; ++k) dst[m][k] = *(const PG8_LAS bf16x8*)(lds + PG8_SA(b, h) + aoff + m * 2048 + k * 1024); } while (0)
#define PG8_LDB(dst, b, h) do { _Pragma("unroll") for (int n = 0; n < 2; ++n) _Pragma("unroll") for (int k = 0; k < 2; ++k) dst[n][k] = *(const PG8_LAS bf16x8*)(lds + PG8_SB(b, h) + boff + n * 2048 + k * 1024); } while (0)
#define PG8_MMA(ai, bj, At, Bt) do { __builtin_amdgcn_s_setprio(1); _Pragma("unroll") for (int m = 0; m < 4; ++m) _Pragma("unroll") for (int n = 0; n < 2; ++n) _Pragma("unroll") for (int k = 0; k < 2; ++k) \
        acc[ai][bj][m][n] = __builtin_amdgcn_mfma_f32_16x16x32_bf16(Bt[n][k], At[m][k], acc[ai][bj][m][n], 0, 0, 0); __builtin_amdgcn_s_setprio(0); } while (0)
#define PG8_WAIT_V(n) asm volatile("s_waitcnt vmcnt(" #n ")" ::: "memory")
#define PG8_WAIT_L(n) asm volatile("s_waitcnt lgkmcnt(" #n ")" ::: "memory")
#define PG8_BAR __builtin_amdgcn_s_barrier()
#define PG8_SCHED __builtin_amdgcn_sched_barrier(0)
    Unit cur, nxt; int ui = 0;
    if (!S.next(0, cur)) return;
    f32x4 acc[2][2][4][2];
#pragma unroll
    for (int a = 0; a < 2; ++a)
#pragma unroll
        for (int b = 0; b < 2; ++b)
#pragma unroll
            for (int m = 0; m < 4; ++m)
#pragma unroll
                for (int n = 0; n < 2; ++n) acc[a][b][m][n] = (f32x4){0.f, 0.f, 0.f, 0.f};
    bf16x8 At[4][2], B0[2][2], B1[2][2];
    const char* cA = (const char*)g.A + (size_t)cur.pm * tstep; const char* cB = (const char*)g.Bt + (size_t)cur.pn * tstep;
    if constexpr (MID) E.load_mid(cur);
    S.a_ready(cur);
    if constexpr (SP2) {
        PG8_STAGE(PG8_SB(0, 0), cB, voffB); PG8_STAGE(PG8_SB(0, 1), cB + hstep, voffB); PG8_STAGE(PG8_SA(0, 0), cA, voffA); PG8_STAGE(PG8_SA(0, 1), cA + hstep, voffA);
        if (wr == 1) PG8_BAR;
        PG8_WAIT_V(2); PG8_BAR;
        PG8_STAGE(PG8_SB(1, 0), cB + kstep, voffB); PG8_STAGE(PG8_SA(1, 0), cA + kstep, voffA); PG8_STAGE(PG8_SB(1, 1), cB + hstep + kstep, voffB);
        PG8_WAIT_V(6); PG8_BAR;
    } else {
        PG8_STAGE(PG8_SB(0, 0), cB, voffB); PG8_STAGE(PG8_SA(0, 0), cA, voffA); PG8_STAGE(PG8_SB(0, 1), cB + hstep, voffB); PG8_STAGE(PG8_SA(0, 1), cA + hstep, voffA);
        if (wr == 1) PG8_BAR;
        PG8_WAIT_V(4); PG8_BAR;
        PG8_STAGE(PG8_SB(1, 0), cB + kstep, voffB); PG8_STAGE(PG8_SA(1, 0), cA + kstep, voffA); PG8_STAGE(PG8_SB(1, 1), cB + hstep + kstep, voffB);
        PG8_WAIT_V(6); PG8_BAR;
    }
    for (;;) {
        const bool has_next = S.next(ui + 1, nxt);
        const char* nA = has_next ? (const char*)g.A + (size_t)nxt.pm * tstep : cA; const char* nB = has_next ? (const char*)g.Bt + (size_t)nxt.pn * tstep : cB;
        for (int t = 0; t < nt; t += 2) {
            if constexpr (MID) { if (t == nt / 2) {
#pragma unroll
                for (int a = 0; a < 2; ++a)
#pragma unroll
                    for (int m = 0; m < 4; ++m)
#pragma unroll
                        for (int b = 0; b < 2; ++b)
#pragma unroll
                            for (int n = 0; n < 2; ++n) acc[a][b][m][n] = acc[a][b][m][n] * E.mid(a * 128 + wr * 64 + m * 16 + fr);
            } }
            const bool last = (t == nt - 2);
            const char* a1 = cA + (size_t)(t + 1) * kstep;
            const char* a2 = last ? nA : cA + (size_t)(t + 2) * kstep; const char* b2 = last ? nB : cB + (size_t)(t + 2) * kstep;
            const char* a3 = a2 + kstep; const char* b3 = b2 + kstep;
            if (last && has_next) S.a_ready(nxt);
            if constexpr (SP2) {
            PG8_LDB(B0, 0, 0); PG8_LDB(B1, 0, 1); PG8_SCHED; PG8_LDA(At, 0, 0); PG8_STAGE(PG8_SA(1, 1), a1 + hstep, voffA);
            PG8_WAIT_V(8); PG8_WAIT_L(0); PG8_BAR; PG8_MMA(0, 0, At, B0); PG8_MMA(0, 1, At, B1); PG8_BAR; PG8_SCHED;
            PG8_LDA(At, 0, 1); PG8_STAGE(PG8_SB(0, 0), b2, voffB); PG8_STAGE(PG8_SB(0, 1), b2 + hstep, voffB); PG8_STAGE(PG8_SA(0, 0), a2, voffA);
            PG8_WAIT_V(8); PG8_WAIT_L(0); PG8_BAR; PG8_MMA(1, 0, At, B0); PG8_MMA(1, 1, At, B1); PG8_BAR; PG8_SCHED;
            PG8_LDB(B0, 1, 0); PG8_LDB(B1, 1, 1); PG8_SCHED; PG8_LDA(At, 1, 0); PG8_STAGE(PG8_SA(0, 1), a2 + hstep, voffA);
            PG8_WAIT_V(8); PG8_WAIT_L(0); PG8_BAR; PG8_MMA(0, 0, At, B0); PG8_MMA(0, 1, At, B1); PG8_BAR; PG8_SCHED;
            PG8_LDA(At, 1, 1); PG8_STAGE(PG8_SB(1, 0), b3, voffB); PG8_STAGE(PG8_SB(1, 1), b3 + hstep, voffB); PG8_STAGE(PG8_SA(1, 0), a3, voffA);
            PG8_WAIT_V(8); PG8_WAIT_L(0); PG8_BAR; PG8_MMA(1, 0, At, B0); PG8_MMA(1, 1, At, B1); PG8_BAR; PG8_SCHED;
            } else {
            PG8_LDB(B0, 0, 0); PG8_SCHED; PG8_LDA(At, 0, 0); PG8_STAGE(PG8_SA(1, 1), a1 + hstep, voffA);
            PG8_WAIT_L(8); PG8_BAR; PG8_WAIT_L(0); PG8_MMA(0, 0, At, B0); PG8_BAR; PG8_SCHED;
            PG8_LDB(B1, 0, 1); PG8_STAGE(PG8_SB(0, 0), b2, voffB);
            PG8_BAR; PG8_WAIT_L(0); PG8_MMA(0, 1, At, B1); PG8_BAR;
            PG8_LDA(At, 0, 1); PG8_STAGE(PG8_SA(0, 0), a2, voffA);
            PG8_BAR; PG8_WAIT_L(0); PG8_MMA(1, 0, At, B0); PG8_BAR; PG8_SCHED;
            PG8_STAGE(PG8_SB(0, 1), b2 + hstep, voffB);
            PG8_WAIT_V(6); PG8_BAR; PG8_MMA(1, 1, At, B1); PG8_BAR;
            PG8_LDB(B0, 1, 0); PG8_SCHED; PG8_LDA(At, 1, 0); PG8_STAGE(PG8_SA(0, 1), a2 + hstep, voffA);
            PG8_WAIT_L(8); PG8_BAR; PG8_WAIT_L(0); PG8_MMA(0, 0, At, B0); PG8_BAR; PG8_SCHED;
            PG8_LDB(B1, 1, 1); PG8_STAGE(PG8_SB(1, 0), b3, voffB);
            PG8_BAR; PG8_WAIT_L(0); PG8_MMA(0, 1, At, B1); PG8_BAR;
            PG8_LDA(At, 1, 1); PG8_STAGE(PG8_SA(1, 0), a3, voffA);
            PG8_BAR; PG8_WAIT_L(0); PG8_MMA(1, 0, At, B0); PG8_BAR; PG8_SCHED;
            PG8_STAGE(PG8_SB(1, 1), b3 + hstep, voffB);
            PG8_WAIT_V(6); PG8_BAR; PG8_MMA(1, 1, At, B1); PG8_BAR;
            }
        }
        if constexpr (ALIGN_EPI) { if (wr == 0) PG8_BAR; }
        if constexpr (!Epi::AFTER_DRAIN) { E(acc, cur, wr, wc, fr, fq); S.done(cur); }
        if (!has_next) break;
#pragma unroll
        for (int a = 0; a < 2; ++a)
#pragma unroll
            for (int b = 0; b < 2; ++b)
#pragma unroll
                for (int m = 0; m < 4; ++m)
#pragma unroll
                    for (int n = 0; n < 2; ++n) acc[a][b][m][n] = (f32x4){0.f, 0.f, 0.f, 0.f};
        cur = nxt; cA = nA; cB = nB; ++ui;
        if constexpr (MID) E.load_mid(cur);
        if constexpr (ALIGN_EPI) { if (wr == 1) PG8_BAR; }
    }
    PG8_WAIT_V(0);
    if constexpr (!ALIGN_EPI) { if (wr == 0) PG8_BAR; }
    PG8_BAR;
    if constexpr (Epi::AFTER_DRAIN) { E.fused(acc, cur, wr, wc, fr, fq, lds, wid, lane); S.done(cur); }
#undef PG8_SA
#undef PG8_SB
#undef PG8_STAGE
#undef PG8_LDA
#undef PG8_LDB
#undef PG8_MMA
#undef PG8_WAIT_V
#undef PG8_WAIT_L
#undef PG8_BAR
#undef PG8_SCHED
}
}
#define GAS __attribute__((address_space(1)))
#define LAS __attribute__((address_space(3)))
typedef unsigned short bf16;
typedef unsigned v4u __attribute__((ext_vector_type(4)));
typedef float f32x4 __attribute__((ext_vector_type(4)));
typedef short bf16x8 __attribute__((ext_vector_type(8)));
typedef GAS unsigned gu32;
typedef GAS unsigned long long gu64;
#define RLX_AGENT __ATOMIC_RELAXED, __HIP_MEMORY_SCOPE_AGENT
#define LDS_WAIT() asm volatile("s_waitcnt lgkmcnt(0)" ::: "memory")
#define VM_WAIT() asm volatile("s_waitcnt vmcnt(0)" ::: "memory")
__device__ __forceinline__ unsigned long long rt() { return __builtin_amdgcn_s_memrealtime(); }
__device__ __forceinline__ unsigned f2bf(float f) { unsigned u = __builtin_bit_cast(unsigned, f); return (u + 0x7fffu + ((u >> 16) & 1u)) >> 16; }
__device__ __forceinline__ unsigned pk2(float lo, float hi) { return f2bf(lo) | (f2bf(hi) << 16); }

#define XB_TMO      128
#define XB_XCNT(j)  (256  + 64 * (j))
#define XB_XSUB(j)  (1280 + 64 * (j))
#define XB_XGEN(j)  (2304 + 64 * (j))
#define XB_TOP      3328
#define XB_TOPGEN   3392
#define XCD_BAR_WORDS 3456
#define XB_SPIN_CAP (1u << 18)

__device__ __forceinline__ unsigned xb_ld(unsigned* p)              { return __hip_atomic_load(p, __ATOMIC_RELAXED, __HIP_MEMORY_SCOPE_AGENT); }
__device__ __forceinline__ unsigned xb_add(unsigned* p, unsigned v) { return __hip_atomic_fetch_add(p, v, __ATOMIC_RELAXED, __HIP_MEMORY_SCOPE_AGENT); }
__device__ __forceinline__ unsigned xb_xcc_id() { return (unsigned)__builtin_amdgcn_s_getreg((3 << 11) | 20) & 0xFu; }
#define XB_SPIN(cond, bar) do { unsigned _sp = 0; while (cond) { __builtin_amdgcn_s_sleep(1); \
    if ((++_sp & 255u) == 0u) { if (xb_ld(&(bar)[XB_TMO])) break; if (_sp > XB_SPIN_CAP) { atomicAdd(&(bar)[XB_TMO], 1u); break; } } } } while (0)

struct XcdBarrier {
    unsigned* bar; unsigned x;
    volatile LAS unsigned* st;
};

__device__ __forceinline__ XcdBarrier xcd_barrier_post(unsigned* bar, volatile LAS unsigned* st) {
    XcdBarrier b; b.bar = bar; b.x = xb_xcc_id(); b.st = st;
    if (threadIdx.x == 0) (void)xb_add(&bar[XB_XCNT(b.x)], 1u);
    return b;
}
__device__ __forceinline__ void xcd_barrier_complete(unsigned* bar, unsigned x, unsigned& nloc, unsigned& nx) {
    const unsigned G = gridDim.x * gridDim.y * gridDim.z;
    unsigned sum, cnt, mine, sp = 0u;
    for (;;) {
        sum = 0u; cnt = 0u; mine = 0u;
#pragma unroll
        for (unsigned j = 0; j < 16; ++j) { const unsigned c = xb_ld(&bar[XB_XCNT(j)]); sum += c; cnt += (c > 0u) ? 1u : 0u; mine = (j == x) ? c : mine; }
        if (sum == G) break;
        __builtin_amdgcn_s_sleep(1);
        if ((++sp & 255u) == 0u) { if (xb_ld(&bar[XB_TMO])) break; if (sp > XB_SPIN_CAP) { atomicAdd(&bar[XB_TMO], 1u); break; } }
    }
    nloc = mine > 0u ? mine : 1u; nx = cnt > 0u ? cnt : 1u;
}

__device__ __forceinline__ void xcd_barrier(const XcdBarrier& b) {
    asm volatile("s_waitcnt vmcnt(0)" ::: "memory");
    __syncthreads();
    if (threadIdx.x == 0) {
        unsigned* bar = b.bar;
        __builtin_amdgcn_s_waitcnt(0);
        unsigned nloc = b.st[0], nx = b.st[1];
        if (nloc == 0u) { xcd_barrier_complete(bar, b.x, nloc, nx); b.st[0] = nloc; b.st[1] = nx; }
        const unsigned old = xb_add(&bar[XB_XSUB(b.x)], 1u);
        const unsigned gen = old / nloc;
        if (old + 1u == (gen + 1u) * nloc) {
            __builtin_amdgcn_fence(__ATOMIC_RELEASE, "agent");
            asm volatile("s_waitcnt vmcnt(0)" ::: "memory");
            const unsigned og = xb_add(&bar[XB_TOP], 1u);
            const unsigned tg = og / nx;
            if (og + 1u == (tg + 1u) * nx) xb_add(&bar[XB_TOPGEN], 1u);
            else XB_SPIN(xb_ld(&bar[XB_TOPGEN]) == tg, bar);
            __builtin_amdgcn_fence(__ATOMIC_ACQUIRE, "agent");
            xb_add(&bar[XB_XGEN(b.x)], 1u);
            asm volatile("s_waitcnt vmcnt(0)" ::: "memory");
        } else {
            XB_SPIN(xb_ld(&bar[XB_XGEN(b.x)]) == gen, bar);
            __builtin_amdgcn_fence(__ATOMIC_ACQUIRE, "agent");
            asm volatile("s_waitcnt vmcnt(0)" ::: "memory");
        }
    }
    __syncthreads();
}

#define VF16 1
#define FUSE_ROUTE 1
#ifndef XB_SPIN_CAP2
#define XB_SPIN_CAP2 1
#endif
constexpr int NWAVES = 8;
constexpr int T_TOK = 8192, DM = 4096, SEQ = 2048, NBATCH = 4;
constexpr int INW = 9216;
constexpr int C_QA = 0, C_KA = 2048, C_VA = 2560, C_QB = 3072, C_KB = 5120, C_VB = 7168;
constexpr int MEMLEN = 256, MEMW = 1024;
constexpr int NEXP = 16384, PQW = 2048;
constexpr float RMS_EPS = 1e-6f;
constexpr float LOG2E = 1.4426950408889634f;

constexpr size_t MiB = 1u << 20;
constexpr size_t WS_CTL = 0, CTL_ZERO_BYTES = 32768;
constexpr size_t WS_ROPE = 1 * MiB;
constexpr size_t WS_SKB = 2 * MiB;
constexpr size_t WS_WIN = 4 * MiB;
constexpr size_t WS_WOUT = 76 * MiB;
constexpr size_t WS_WMQ = 108 * MiB;
constexpr size_t WS_WMKV = 116 * MiB;
constexpr size_t WS_WMO = 132 * MiB;
constexpr size_t WS_WPQ = 140 * MiB;
constexpr size_t WS_UB = 156 * MiB;
constexpr size_t WS_VB = 284 * MiB;
constexpr size_t WS_UQ = 156 * MiB, WS_VQ = 220 * MiB;
constexpr size_t WS_SU = 3 * MiB, WS_SV = 3 * MiB + 65536;
constexpr size_t WS_SX = 3 * MiB + 131072;
constexpr size_t WS_XQ = 284 * MiB;
constexpr size_t SLICE_BYTES = (size_t)NEXP * 128;
constexpr size_t WS_XN = 412 * MiB;
constexpr size_t WS_QKV = 476 * MiB;
constexpr size_t WS_OB = 620 * MiB;
constexpr size_t WS_MEMN = 684 * MiB;
constexpr size_t WS_KVM = 692 * MiB;
constexpr size_t WS_QM = 696 * MiB;
constexpr size_t WS_OM = 712 * MiB;
constexpr size_t WS_QP = 728 * MiB;
constexpr size_t WS_IDX = 760 * MiB;
constexpr size_t WS_GATE = 764 * MiB;
constexpr size_t WS_END = 768 * MiB;
constexpr int CW_BAR = 4096;
constexpr size_t WS_SSQ1 = 65536, WS_SSQ2 = 65536 + 32768, WS_SSQA = 131072, WS_SSQB = 131072 + 32768, WS_SSQ0 = 229376;

constexpr int RING_BYTES = 131072;
constexpr int LDSCTL_OFF = RING_BYTES, MISC_OFF = LDSCTL_OFF + 320;
constexpr int LDS_BYTES = 147456;

typedef float f32x16 __attribute__((ext_vector_type(16)));
typedef float f32x2 __attribute__((ext_vector_type(2)));
typedef short s16x4 __attribute__((ext_vector_type(4)));
typedef __bf16 bf16x2_t __attribute__((ext_vector_type(2)));
typedef unsigned u32x2 __attribute__((ext_vector_type(2)));
#define DI __device__ __forceinline__
#define MFMA32(a, b, c) __builtin_amdgcn_mfma_f32_32x32x16_bf16((a), (b), (c), 0, 0, 0)

DI unsigned cvtpk(float lo, float hi) { f32x2 v = {lo, hi}; bf16x2_t b = __builtin_convertvector(v, bf16x2_t); return __builtin_bit_cast(unsigned, b); }
DI float bflo(unsigned u) { return __uint_as_float(u << 16); }
DI float bfhi(unsigned u) { return __uint_as_float(u & 0xffff0000u); }
DI int crow(int i, int h) { return (i & 3) + 8 * (i >> 2) + 4 * h; }
DI float wave_sum(float v) {
#pragma unroll
    for (int o = 1; o < 64; o <<= 1) v += __shfl_xor(v, o);
    return v;
}
DI float fexp2(float x) { return __builtin_amdgcn_exp2f(x); }
DI bf16x8 pack8(const f32x16& x, int s) {
    v4u p; p.x = cvtpk(x[8 * s + 0], x[8 * s + 1]); p.y = cvtpk(x[8 * s + 2], x[8 * s + 3]); p.z = cvtpk(x[8 * s + 4], x[8 * s + 5]); p.w = cvtpk(x[8 * s + 6], x[8 * s + 7]);
    return __builtin_bit_cast(bf16x8, p);
}
typedef short v4i16_t __attribute__((ext_vector_type(4)));
DI s16x4 vtr(const LAS unsigned char* p) { return __builtin_bit_cast(s16x4, __builtin_amdgcn_ds_read_tr16_b64_v4i16((LAS v4i16_t*)p)); }

DI void p0_transpose_item(const float* W, int K, int N, bf16* WT, int row_off, LAS float* scr, int item, int lane, const float* gk0 = nullptr, const float* gk1 = nullptr) {
    const int nblk = N / 32, kb = item / nblk, nb = item % nblk, k0 = 64 * kb, n0 = 32 * nb;
#pragma unroll 8
    for (int i = 0; i < 32; ++i) { const int kk = 2 * i + (lane >> 5); scr[kk * 33 + (lane & 31)] = W[(size_t)(k0 + kk) * N + n0 + (lane & 31)]; }
    LDS_WAIT(); asm volatile("" ::: "memory");
    const int c = lane & 7;
    f32x4 ga = {1.f, 1.f, 1.f, 1.f}, gb = ga;
    if (gk0) { const int kg = k0 + 8 * c; const float* gp = kg < 2048 ? gk0 + kg : gk1 + (kg - 2048); ga = *(const GAS f32x4*)gp; gb = *(const GAS f32x4*)(gp + 4); }
#pragma unroll
    for (int j = 0; j < 4; ++j) { const int n = (lane >> 3) + 8 * j; const LAS float* s = scr + (8 * c) * 33 + n;
        v4u o; o.x = cvtpk(s[0 * 33] * ga.x, s[1 * 33] * ga.y); o.y = cvtpk(s[2 * 33] * ga.z, s[3 * 33] * ga.w); o.z = cvtpk(s[4 * 33] * gb.x, s[5 * 33] * gb.y); o.w = cvtpk(s[6 * 33] * gb.z, s[7 * 33] * gb.w);
        *(GAS v4u*)(WT + (size_t)(row_off + n0 + n) * K + k0 + 8 * c) = o; }
    LDS_WAIT(); asm volatile("" ::: "memory");
}
DI void rms_row_to_bf16(const float* xrow, const float* gain, bf16* orow, int lane) {
    const GAS f32x4* xr = (const GAS f32x4*)xrow + lane;
    f32x4 v[16]; float s = 0.f;
#pragma unroll
    for (int j = 0; j < 16; ++j) { v[j] = xr[64 * j]; s += (v[j].x * v[j].x + v[j].y * v[j].y) + (v[j].z * v[j].z + v[j].w * v[j].w); }
    const float rstd = 1.0f / sqrtf(wave_sum(s) * (1.f / DM) + RMS_EPS);
    const GAS f32x4* gr = (const GAS f32x4*)gain + lane;
    GAS u32x2* o8 = (GAS u32x2*)orow + lane;
#pragma unroll
    for (int j = 0; j < 16; ++j) { const f32x4 g = gr[64 * j]; u32x2 w; w.x = cvtpk(v[j].x * rstd * g.x, v[j].y * rstd * g.y); w.y = cvtpk(v[j].z * rstd * g.z, v[j].w * rstd * g.w); o8[64 * j] = w; }
}
DI void row_to_bf16_ssq(const float* xrow, bf16* orow, float* ssq, int lane) {
    const GAS f32x4* xr = (const GAS f32x4*)xrow + lane;
    GAS u32x2* o8 = (GAS u32x2*)orow + lane; float s = 0.f;
#pragma unroll
    for (int j = 0; j < 16; ++j) { const f32x4 v = xr[64 * j]; s += (v.x * v.x + v.y * v.y) + (v.z * v.z + v.w * v.w);
        u32x2 w; w.x = cvtpk(v.x, v.y); w.y = cvtpk(v.z, v.w); o8[64 * j] = w; }
    s = wave_sum(s);
    if (lane == 0) *ssq = s;
}
DI void mix_row_norm(bf16* orow, const float* ga, const float* gb, int lane) {
    GAS v4u* p = (GAS v4u*)orow + lane;
    v4u v[8]; float sa = 0.f, sb = 0.f;
#pragma unroll
    for (int j = 0; j < 8; ++j) { v[j] = p[64 * j]; float s = 0.f;
#pragma unroll
        for (int k = 0; k < 4; ++k) { const float a = bflo(v[j][k]), b = bfhi(v[j][k]); s += a * a + b * b; }
        if (j < 4) sa += s; else sb += s; }
    const float ra = 1.0f / sqrtf(wave_sum(sa) * (1.f / 2048.f) + RMS_EPS), rb = 1.0f / sqrtf(wave_sum(sb) * (1.f / 2048.f) + RMS_EPS);
#pragma unroll
    for (int j = 0; j < 8; ++j) { const float rs = j < 4 ? ra : rb; const float* gp = (j < 4 ? ga : gb) + ((lane + 64 * (j & 3)) * 8);
        const f32x4 g0 = *(const GAS f32x4*)gp, g1 = *(const GAS f32x4*)(gp + 4); v4u w;
        w.x = cvtpk(bflo(v[j].x) * rs * g0.x, bfhi(v[j].x) * rs * g0.y); w.y = cvtpk(bflo(v[j].y) * rs * g0.z, bfhi(v[j].y) * rs * g0.w);
        w.z = cvtpk(bflo(v[j].z) * rs * g1.x, bfhi(v[j].z) * rs * g1.y); w.w = cvtpk(bflo(v[j].w) * rs * g1.z, bfhi(v[j].w) * rs * g1.w);
        p[64 * j] = w; }
}

struct EpiResF32 {
    static constexpr bool PERM = false, AFTER_DRAIN = false;
    const float* base; float* out; int ldc; float sc;
    __device__ __forceinline__ void operator()(const pg8::f32x4 (&acc)[2][2][4][2], const pg8::Unit& u, int wr, int wc, int fr, int fq) const {
        const int col0 = u.pn * 256 + wc * 32 + 4 * fq;
#pragma unroll
        for (int ai = 0; ai < 2; ++ai)
#pragma unroll
            for (int m = 0; m < 4; ++m) { const int r = ai * 128 + wr * 64 + m * 16 + fr; const size_t off = (size_t)(u.pm * 256 + r) * ldc + col0;
#pragma unroll
                for (int bj = 0; bj < 2; ++bj)
#pragma unroll
                    for (int n = 0; n < 2; ++n) { const pg8::f32x4 bs = *(const pg8::f32x4*)(base + off + bj * 128 + n * 16); *(pg8::f32x4*)(out + off + bj * 128 + n * 16) = bs + acc[ai][bj][m][n] * sc; } }
    }
};

struct EpiResNorm {
    static constexpr bool PERM = false, AFTER_DRAIN = false;
    const float* base; float* out; bf16* xn; const float* gain; float* ssq; int ldc;
    __device__ __forceinline__ void operator()(const pg8::f32x4 (&acc)[2][2][4][2], const pg8::Unit& u, int wr, int wc, int fr, int fq) const {
        const int col0 = u.pn * 256 + wc * 32 + 4 * fq;
        pg8::f32x4 gv[2][2];
#pragma unroll
        for (int bj = 0; bj < 2; ++bj)
#pragma unroll
            for (int n = 0; n < 2; ++n) gv[bj][n] = *(const pg8::f32x4*)(gain + col0 + bj * 128 + n * 16);
#pragma unroll
        for (int ai = 0; ai < 2; ++ai)
#pragma unroll
            for (int m = 0; m < 4; ++m) { const int r = u.pm * 256 + ai * 128 + wr * 64 + m * 16 + fr; const size_t off = (size_t)r * ldc + col0; float part = 0.f;
#pragma unroll
                for (int bj = 0; bj < 2; ++bj)
#pragma unroll
                    for (int n = 0; n < 2; ++n) { const pg8::f32x4 bs = *(const pg8::f32x4*)(base + off + bj * 128 + n * 16); const pg8::f32x4 v = bs + acc[ai][bj][m][n];
                        *(pg8::f32x4*)(out + off + bj * 128 + n * 16) = v; part += (v[0] * v[0] + v[1] * v[1]) + (v[2] * v[2] + v[3] * v[3]);
                        const pg8::f32x4 g = gv[bj][n]; u32x2 w; w.x = cvtpk(v[0] * g[0], v[1] * g[1]); w.y = cvtpk(v[2] * g[2], v[3] * g[3]);
                        *(u32x2*)(xn + off + bj * 128 + n * 16) = w; }
                part += __shfl_xor(part, 16); part += __shfl_xor(part, 32);
                if (fq == 0) atomicAdd(ssq + r, part); }
    }
};
struct EpiResNormMid {
    static constexpr bool PERM = false, AFTER_DRAIN = false;
    const float* base; float* out; bf16* xn; const float* gain; float* ssq; int ldc; const float* ssqa; const float* ssqb;
    LAS float* midtab;
    __device__ __forceinline__ void load_mid(const pg8::Unit& u) const {
        if (threadIdx.x < 256) { const int r = u.pm * 256 + (int)threadIdx.x;
            midtab[threadIdx.x] = sqrtf((ssqb[r] * (1.f / 2048.f) + RMS_EPS) / (ssqa[r] * (1.f / 2048.f) + RMS_EPS)); }
    }
    __device__ __forceinline__ float mid(int row_in_tile) const { return midtab[row_in_tile]; }
    __device__ __forceinline__ void operator()(const pg8::f32x4 (&acc)[2][2][4][2], const pg8::Unit& u, int wr, int wc, int fr, int fq) const {
        const int col0 = u.pn * 256 + wc * 32 + 4 * fq;
        pg8::f32x4 gv[2][2];
#pragma unroll
        for (int bj = 0; bj < 2; ++bj)
#pragma unroll
            for (int n = 0; n < 2; ++n) gv[bj][n] = *(const pg8::f32x4*)(gain + col0 + bj * 128 + n * 16);
#pragma unroll
        for (int ai = 0; ai < 2; ++ai)
#pragma unroll
            for (int m = 0; m < 4; ++m) { const int r = u.pm * 256 + ai * 128 + wr * 64 + m * 16 + fr; const size_t off = (size_t)r * ldc + col0; float part = 0.f;
                const float rsb = 1.0f / sqrtf(ssqb[r] * (1.f / 2048.f) + RMS_EPS);
#pragma unroll
                for (int bj = 0; bj < 2; ++bj)
#pragma unroll
                    for (int n = 0; n < 2; ++n) { const pg8::f32x4 bs = *(const pg8::f32x4*)(base + off + bj * 128 + n * 16); const pg8::f32x4 v = bs + acc[ai][bj][m][n] * rsb;
                        *(pg8::f32x4*)(out + off + bj * 128 + n * 16) = v; part += (v[0] * v[0] + v[1] * v[1]) + (v[2] * v[2] + v[3] * v[3]);
                        const pg8::f32x4 g = gv[bj][n]; u32x2 w; w.x = cvtpk(v[0] * g[0], v[1] * g[1]); w.y = cvtpk(v[2] * g[2], v[3] * g[3]);
                        *(u32x2*)(xn + off + bj * 128 + n * 16) = w; }
                part += __shfl_xor(part, 16); part += __shfl_xor(part, 32);
                if (fq == 0) atomicAdd(ssq + r, part); }
    }
};
struct EpiResHMid {
    static constexpr bool PERM = true, AFTER_DRAIN = false;
    bf16* H; float* ssq; int ldc; const float* ssqa; const float* ssqb; LAS float* midtab;
    __device__ __forceinline__ void load_mid(const pg8::Unit& u) const {
        if (threadIdx.x < 256) { const int r = u.pm * 256 + (int)threadIdx.x;
            midtab[threadIdx.x] = sqrtf((ssqb[r] * (1.f / 2048.f) + RMS_EPS) / (ssqa[r] * (1.f / 2048.f) + RMS_EPS)); }
    }
    __device__ __forceinline__ float mid(int row_in_tile) const { return midtab[row_in_tile]; }
    __device__ __forceinline__ void operator()(const pg8::f32x4 (&acc)[2][2][4][2], const pg8::Unit& u, int wr, int wc, int fr, int fq) const {
        const int col0 = u.pn * 256 + wc * 32 + 8 * fq;
#pragma unroll
        for (int ai = 0; ai < 2; ++ai)
#pragma unroll
            for (int m = 0; m < 4; ++m) { const int r = u.pm * 256 + ai * 128 + wr * 64 + m * 16 + fr; bf16* rowp = H + (size_t)r * ldc + col0; float part = 0.f;
                const float rsb = 1.0f / sqrtf(ssqb[r] * (1.f / 2048.f) + RMS_EPS);
#pragma unroll
                for (int bj = 0; bj < 2; ++bj) { const v4u hb = *(const v4u*)(rowp + bj * 128); float v[8];
#pragma unroll
                    for (int n = 0; n < 2; ++n)
#pragma unroll
                        for (int c = 0; c < 2; ++c) { const unsigned w2 = hb[2 * n + c]; v[4 * n + 2 * c] = bflo(w2) + acc[ai][bj][m][n][2 * c] * rsb; v[4 * n + 2 * c + 1] = bfhi(w2) + acc[ai][bj][m][n][2 * c + 1] * rsb; }
                    v4u w;
#pragma unroll
                    for (int c = 0; c < 4; ++c) { part += v[2 * c] * v[2 * c] + v[2 * c + 1] * v[2 * c + 1]; w[c] = cvtpk(v[2 * c], v[2 * c + 1]); }
                    *(v4u*)(rowp + bj * 128) = w; }
                part += __shfl_xor(part, 16); part += __shfl_xor(part, 32);
                if (fq == 0) atomicAdd(ssq + r, part); }
    }
};
struct EpiResH {
    static constexpr bool PERM = true, AFTER_DRAIN = false;
    bf16* H; float* ssq; int ldc;
    __device__ __forceinline__ void operator()(const pg8::f32x4 (&acc)[2][2][4][2], const pg8::Unit& u, int wr, int wc, int fr, int fq) const {
        const int col0 = u.pn * 256 + wc * 32 + 8 * fq;
#pragma unroll
        for (int ai = 0; ai < 2; ++ai)
#pragma unroll
            for (int m = 0; m < 4; ++m) { const int r = u.pm * 256 + ai * 128 + wr * 64 + m * 16 + fr; bf16* rowp = H + (size_t)r * ldc + col0; float part = 0.f;
#pragma unroll
                for (int bj = 0; bj < 2; ++bj) { const v4u hb = *(const v4u*)(rowp + bj * 128); float v[8];
#pragma unroll
                    for (int n = 0; n < 2; ++n)
#pragma unroll
                        for (int c = 0; c < 2; ++c) { const unsigned w2 = hb[2 * n + c]; v[4 * n + 2 * c] = bflo(w2) + acc[ai][bj][m][n][2 * c]; v[4 * n + 2 * c + 1] = bfhi(w2) + acc[ai][bj][m][n][2 * c + 1]; }
                    v4u w;
#pragma unroll
                    for (int c = 0; c < 4; ++c) { part += v[2 * c] * v[2 * c] + v[2 * c + 1] * v[2 * c + 1]; w[c] = cvtpk(v[2 * c], v[2 * c + 1]); }
                    *(v4u*)(rowp + bj * 128) = w; }
                part += __shfl_xor(part, 16); part += __shfl_xor(part, 32);
                if (fq == 0) atomicAdd(ssq + r, part); }
    }
};
struct EpiBf16RowScale {
    static constexpr bool PERM = true, AFTER_DRAIN = false;
    bf16* O; int ldc; const float* ssq;
    __device__ __forceinline__ void operator()(const pg8::f32x4 (&acc)[2][2][4][2], const pg8::Unit& u, int wr, int wc, int fr, int fq) const {
        const int row0 = u.pm * 256 + wr * 64 + fr, col0 = u.pn * 256 + wc * 32 + 8 * fq;
#pragma unroll
        for (int ai = 0; ai < 2; ++ai)
#pragma unroll
            for (int m = 0; m < 4; ++m) { const int row = row0 + ai * 128 + m * 16; const float rs = 1.0f / sqrtf(ssq[row] * (1.f / DM) + RMS_EPS); bf16* rowp = O + (size_t)row * ldc + col0;
#pragma unroll
                for (int bj = 0; bj < 2; ++bj) { const pg8::f32x4 v0 = acc[ai][bj][m][0] * rs, v1 = acc[ai][bj][m][1] * rs;
                    v4u w; w.x = cvtpk(v0[0], v0[1]); w.y = cvtpk(v0[2], v0[3]); w.z = cvtpk(v1[0], v1[1]); w.w = cvtpk(v1[2], v1[3]);
                    *(v4u*)(rowp + bj * 128) = w; } }
    }
};

template <int NSTEP, int KP>
DI f32x16 qk_tile(const LAS unsigned char* Kt, const bf16x8* qf, int r, int h) {
    f32x16 s;
#pragma unroll
    for (int i = 0; i < 16; ++i) s[i] = 0.f;
    const LAS unsigned char* kp = Kt + r * KP + h * 16;
#pragma unroll
    for (int st = 0; st < NSTEP; ++st) { const bf16x8 a = *(const LAS bf16x8*)(kp + st * 32); s = MFMA32(a, qf[st], s); }
    return s;
}
template <int NDB, int VP>
DI void pv_tile(f32x16* o, const LAS unsigned char* Vt, const f32x16& p, int lane) {
    const int h = lane >> 5, q = (lane & 15) >> 2, pp = lane & 3, blk = (lane >> 4) & 1;
    const bf16x8 p0 = pack8(p, 0), p1 = pack8(p, 1);
    const LAS unsigned char* vb = Vt + (4 * h + q) * VP + blk * 32 + pp * 8;
#pragma unroll
    for (int db = 0; db < NDB; ++db) {
        const s16x4 l0 = vtr(vb + db * 64), h0 = vtr(vb + 8 * VP + db * 64), l1 = vtr(vb + 16 * VP + db * 64), h1 = vtr(vb + 24 * VP + db * 64);
        const bf16x8 v0 = __builtin_shufflevector(l0, h0, 0, 1, 2, 3, 4, 5, 6, 7), v1 = __builtin_shufflevector(l1, h1, 0, 1, 2, 3, 4, 5, 6, 7);
        o[db] = MFMA32(v0, p0, o[db]); o[db] = MFMA32(v1, p1, o[db]);
    }
}
DI float softmax_tile(f32x16& s, float& m, float& l) {
    float mx = s[0];
#pragma unroll
    for (int i = 1; i < 16; ++i) mx = fmaxf(mx, s[i]);
    mx = fmaxf(mx, __shfl_xor(mx, 32));
    const float mn = fmaxf(m, mx), alpha = fexp2(m - mn); m = mn;
    float sum = 0.f;
#pragma unroll
    for (int i = 0; i < 16; ++i) { s[i] = fexp2(s[i] - mn); sum += s[i]; }
    l = l * alpha + sum;
    return alpha;
}
template <int NDB> DI void scale_o(f32x16* o, float alpha) {
#pragma unroll
    for (int db = 0; db < NDB; ++db)
#pragma unroll
        for (int i = 0; i < 16; ++i) o[db][i] *= alpha;
}
struct MaskNone { DI void operator()(f32x16&, int) const {} };
struct MaskSwa { int qpos, k0; int h;
    DI void operator()(f32x16& s, int st2) const {
#pragma unroll
        for (int i = 0; i < 16; ++i) { const int d = qpos - (k0 + 32 * st2 + crow(i, h)); s[i] = (d <= 128 && d >= -128) ? s[i] : -3.0e30f; } } };
struct MaskNat { const LAS float* brow; int t0;
    DI void operator()(f32x16& s, int st2) const {
        float bv[16];
#pragma unroll
        for (int i = 0; i < 16; ++i) bv[i] = brow[32 * st2 + (i & 3) + 8 * (i >> 2)];
        __builtin_amdgcn_sched_barrier(0);
#pragma unroll
        for (int i = 0; i < 16; ++i) { const int kc0 = 32 * st2 + (i & 3) + 8 * (i >> 2); s[i] = ((unsigned)(t0 + kc0) < 16u) ? s[i] + bv[i] : -3.0e30f; } } };
template <int NSTEP, int KP, int NDB, int VP, class Mask>
DI void tile64(const LAS unsigned char* Kb, const LAS unsigned char* Vb, const bf16x8* qf, f32x16* o, float& m, float& l, int lane, const Mask& mask, unsigned long long* tq = nullptr, bool domask = true) {
    const int r = lane & 31, h = lane >> 5;
#ifdef PROBE_TILE
    unsigned long long t0_ = clock64();
#define TT(i_) do { if (tq) { asm volatile("s_waitcnt vmcnt(0) lgkmcnt(0)" ::: "memory"); asm volatile("s_nop 15\n\ts_nop 15" :: "v"(s0), "v"(s1)); const unsigned long long n_ = clock64(); tq[i_] += n_ - t0_; t0_ = n_; } } while (0)
#else
#define TT(i_) do {} while (0)
#endif
    f32x16 s0, s1;
#pragma unroll
    for (int i = 0; i < 16; ++i) { s0[i] = 0.f; s1[i] = 0.f; }
    const LAS unsigned char* kp = Kb + r * KP + h * 16;
#pragma unroll
    for (int st = 0; st < NSTEP; ++st) { const bf16x8 a0 = *(const LAS bf16x8*)(kp + st * 32), a1 = *(const LAS bf16x8*)(kp + 32 * KP + st * 32);
        s0 = MFMA32(a0, qf[st], s0); s1 = MFMA32(a1, qf[st], s1); }
    TT(0);
    if (domask) { mask(s0, 0); mask(s1, 1); }
#ifdef PROBE_SPLIT
    TT(1);
#endif
    float mx0 = fmaxf(s0[0], s1[0]), mx1 = fmaxf(s0[1], s1[1]);
#pragma unroll
    for (int i = 2; i < 16; i += 2) { mx0 = fmaxf(mx0, fmaxf(s0[i], s1[i])); mx1 = fmaxf(mx1, fmaxf(s0[i + 1], s1[i + 1])); }
    float mx = fmaxf(mx0, mx1);
    { const auto sw = __builtin_amdgcn_permlane32_swap(__float_as_uint(mx), __float_as_uint(mx), false, false); mx = fmaxf(__uint_as_float(sw[0]), __uint_as_float(sw[1])); }
    const float mn = fmaxf(m, mx), alpha = fexp2(m - mn); m = mn;
    float sum0 = 0.f, sum1 = 0.f;
#pragma unroll
    for (int i = 0; i < 16; ++i) { s0[i] = fexp2(s0[i] - mn); s1[i] = fexp2(s1[i] - mn); sum0 += s0[i]; sum1 += s1[i]; }
    l = l * alpha + (sum0 + sum1);
    scale_o<NDB>(o, alpha);
#ifdef PROBE_SPLIT
    TT(2);
#else
    TT(1);
#endif
    const int q = (lane & 15) >> 2, pp = lane & 3, blk = (lane >> 4) & 1;
    const bf16x8 p00 = pack8(s0, 0), p01 = pack8(s0, 1), p10 = pack8(s1, 0), p11 = pack8(s1, 1);
    const LAS unsigned char* vb = Vb + (4 * h + q) * VP + blk * 32 + pp * 8;
#pragma unroll
    for (int db = 0; db < NDB; ++db) {
        const s16x4 a0 = vtr(vb + db * 64), a1 = vtr(vb + 8 * VP + db * 64), a2 = vtr(vb + 16 * VP + db * 64), a3 = vtr(vb + 24 * VP + db * 64);
        const s16x4 b0 = vtr(vb + 32 * VP + db * 64), b1 = vtr(vb + 40 * VP + db * 64), b2 = vtr(vb + 48 * VP + db * 64), b3 = vtr(vb + 56 * VP + db * 64);
        const bf16x8 v00 = __builtin_shufflevector(a0, a1, 0, 1, 2, 3, 4, 5, 6, 7), v01 = __builtin_shufflevector(a2, a3, 0, 1, 2, 3, 4, 5, 6, 7);
        const bf16x8 v10 = __builtin_shufflevector(b0, b1, 0, 1, 2, 3, 4, 5, 6, 7), v11 = __builtin_shufflevector(b2, b3, 0, 1, 2, 3, 4, 5, 6, 7);
        o[db] = MFMA32(v00, p00, o[db]); o[db] = MFMA32(v01, p01, o[db]); o[db] = MFMA32(v10, p10, o[db]); o[db] = MFMA32(v11, p11, o[db]);
    }
#if defined(PROBE_TILE) && !defined(PROBE_SPLIT)
    if (tq) { asm volatile("s_nop 15\n\ts_nop 15" :: "v"(o[0]), "v"(o[1]), "v"(o[2]), "v"(o[3])); const unsigned long long n_ = clock64(); tq[2] += n_ - t0_; }
#endif
#undef TT
}
template <int NDB> DI void store_o(const f32x16* o, float inv, bf16* orow, int h, float* ssq = nullptr) {
    float part = 0.f;
#pragma unroll
    for (int db = 0; db < NDB; ++db)
#pragma unroll
        for (int g = 0; g < 4; ++g) { const float a0 = o[db][4 * g] * inv, a1 = o[db][4 * g + 1] * inv, a2 = o[db][4 * g + 2] * inv, a3 = o[db][4 * g + 3] * inv;
            part += (a0 * a0 + a1 * a1) + (a2 * a2 + a3 * a3);
            u32x2 w; w.x = cvtpk(a0, a1); w.y = cvtpk(a2, a3);
            *(GAS u32x2*)(orow + 32 * db + 8 * g + 4 * h) = w; }
    if (ssq) { part += __shfl_xor(part, 32); if (h == 0) atomicAdd(ssq, part); }
}

constexpr int KP128 = 272, VP128 = 320, KP256 = 528, VP256 = 576;
constexpr int ATT_K_OFF = 0, ATT_V_OFF = 34816, ATT_BIAS_OFF = 72704;

constexpr int A2_K = 0, A2_V = 17408, A2_BUF = 37888, A2_BIAS = 76800;
template <bool SKIPC = false> DI void swa_unit(LAS unsigned char* lds, int u, const bf16* QKV, bf16* OB, const float* sink, const float* ropec, const float* ropes, float* SSQA) {
    const int tid = threadIdx.x, lane = tid & 63, wid = __builtin_amdgcn_readfirstlane(tid >> 6), r = lane & 31, h = lane >> 5;
    const int qb = u & 31, kvh = (u >> 5) & 3, b = u >> 7;
    const int q0 = qb * 64, g = wid >> 1, sub = wid & 1, head = kvh * 4 + g;
    const int qpos = q0 + 32 * sub + r;
    const size_t tok = (size_t)b * SEQ + qpos;
    const float QS = 0.08838834764831845f * LOG2E;
    const int t_lo = qb - 2 < 0 ? 0 : qb - 2, t_hi = qb + 2 > 31 ? 31 : qb + 2;
    const int skey = tid >> 3, sc = tid & 7;
    v4u s_lo, s_hi, s_v0, s_v1; int s_kpos = 0;
#define SWA_LOAD(kt_) do { const int kpos_ = (kt_) * 64 + skey; const size_t ktok_ = (size_t)b * SEQ + kpos_; \
        const bf16* kp_ = QKV + ktok_ * INW + C_KA + kvh * 128 + 8 * sc; s_lo = *(const GAS v4u*)kp_; s_hi = *(const GAS v4u*)(kp_ + 64); \
        const bf16* vp_ = QKV + ktok_ * INW + C_VA + kvh * 128 + 8 * sc; s_v0 = *(const GAS v4u*)vp_; s_v1 = *(const GAS v4u*)(vp_ + 64); \
        s_kpos = kpos_; } while (0)
#define SWA_WRITE(buf_) do { float cc_[8], ss_[8]; _Pragma("unroll") for (int k_ = 0; k_ < 8; ++k_) { const float inv_ = fexp2(-(float)(8 * sc + k_) * (13.287712379549449f / 64.0f)); \
            const float rev_ = ((float)s_kpos * inv_) * 0.15915494309189535f; const float fr_ = rev_ - floorf(rev_); cc_[k_] = __builtin_amdgcn_cosf(fr_); ss_[k_] = __builtin_amdgcn_sinf(fr_); } \
        v4u a_, b_; _Pragma("unroll") for (int k_ = 0; k_ < 4; ++k_) { const float x1a = bflo(s_lo[k_]), x1b = bfhi(s_lo[k_]), x2a = bflo(s_hi[k_]), x2b = bfhi(s_hi[k_]); \
            a_[k_] = cvtpk(x1a * cc_[2 * k_] - x2a * ss_[2 * k_], x1b * cc_[2 * k_ + 1] - x2b * ss_[2 * k_ + 1]); \
            b_[k_] = cvtpk(x2a * cc_[2 * k_] + x1a * ss_[2 * k_], x2b * cc_[2 * k_ + 1] + x1b * ss_[2 * k_ + 1]); } \
        LAS unsigned char* bb_ = lds + (buf_) * A2_BUF; \
        *(LAS v4u*)(bb_ + A2_K + skey * KP128 + 16 * sc) = a_; *(LAS v4u*)(bb_ + A2_K + skey * KP128 + 128 + 16 * sc) = b_; \
        *(LAS v4u*)(bb_ + A2_V + skey * VP128 + 16 * sc) = s_v0; *(LAS v4u*)(bb_ + A2_V + skey * VP128 + 128 + 16 * sc) = s_v1; } while (0)
    bf16x8 qf[8];
    {
        const bf16* qp = QKV + tok * INW + C_QA + head * 128 + 8 * h;
#pragma unroll
        for (int st = 0; st < 4; ++st) {
            const v4u lo = *(const GAS v4u*)(qp + 16 * st), hi = *(const GAS v4u*)(qp + 16 * st + 64);
            const float* cp = ropec + (size_t)qpos * 64 + 16 * st + 8 * h; const float* sp = ropes + (size_t)qpos * 64 + 16 * st + 8 * h;
            const f32x4 c0 = *(const GAS f32x4*)cp, c1 = *(const GAS f32x4*)(cp + 4), s0 = *(const GAS f32x4*)sp, s1 = *(const GAS f32x4*)(sp + 4);
            float x1[8], x2[8], cc[8], ss[8];
#pragma unroll
            for (int k = 0; k < 4; ++k) { x1[2 * k] = bflo(lo[k]); x1[2 * k + 1] = bfhi(lo[k]); x2[2 * k] = bflo(hi[k]); x2[2 * k + 1] = bfhi(hi[k]); cc[k] = c0[k]; cc[4 + k] = c1[k]; ss[k] = s0[k]; ss[4 + k] = s1[k]; }
            v4u a, bq;
#pragma unroll
            for (int k = 0; k < 4; ++k) {
                a[k] = cvtpk((x1[2 * k] * cc[2 * k] - x2[2 * k] * ss[2 * k]) * QS, (x1[2 * k + 1] * cc[2 * k + 1] - x2[2 * k + 1] * ss[2 * k + 1]) * QS);
                bq[k] = cvtpk((x2[2 * k] * cc[2 * k] + x1[2 * k] * ss[2 * k]) * QS, (x2[2 * k + 1] * cc[2 * k + 1] + x1[2 * k + 1] * ss[2 * k + 1]) * QS);
            }
            qf[st] = __builtin_bit_cast(bf16x8, a); qf[st + 4] = __builtin_bit_cast(bf16x8, bq);
        }
    }
    asm volatile("" ::: "memory");
    SWA_LOAD(t_lo);
    float m = sink[head] * LOG2E, l = (h == 0) ? 1.f : 0.f;
    f32x16 o[4];
#pragma unroll
    for (int db = 0; db < 4; ++db)
#pragma unroll
        for (int i = 0; i < 16; ++i) o[db][i] = 0.f;
    __syncthreads();
    SWA_WRITE(0);
    __syncthreads();
    int buf = 0;
    for (int kt = t_lo; kt <= t_hi; ++kt) {
        if (kt < t_hi) SWA_LOAD(kt + 1);
        const LAS unsigned char* bb = lds + buf * A2_BUF;
        if (!SKIPC) { const MaskSwa mk{qpos, kt * 64, h}; tile64<8, KP128, 4, VP128>(bb + A2_K, bb + A2_V, qf, o, m, l, lane, mk, nullptr, kt <= qb - 2 || kt >= qb + 2); }
        if (kt < t_hi) SWA_WRITE(buf ^ 1);
        __syncthreads();
        buf ^= 1;
    }
#undef SWA_LOAD
#undef SWA_WRITE
    const float lt = l + __shfl_xor(l, 32);
    store_o<4>(o, 1.0f / lt, OB + tok * DM + head * 128, h, SSQA + tok);
}

#define PROBE_PTR ((unsigned char*)SSQB - WS_SSQB + 262144)
DI void nat_unit(LAS unsigned char* lds, int u, const bf16* QKV, bf16* OB, const float* relb, float* SSQB) {
    const int tid = threadIdx.x, lane = tid & 63, wid = __builtin_amdgcn_readfirstlane(tid >> 6), r = lane & 31, h = lane >> 5;
    const int rb = u & 7, head = (u >> 3) & 15, b = u >> 7;
    const int r0 = rb * 4, qrow = r0 + (wid >> 1), qcol = 32 * (wid & 1) + r;
    const size_t tok = (size_t)b * SEQ + qrow * 64 + qcol;
    const float QS = 0.08838834764831845f * LOG2E;
    int kr_lo = r0 - 4; kr_lo = kr_lo < 0 ? 0 : (kr_lo > 24 ? 24 : kr_lo);
    int kr_hi = r0 + 3 - 4; kr_hi = (kr_hi < 0 ? 0 : (kr_hi > 24 ? 24 : kr_hi)) + 7;
    int rs = qrow - 4; rs = rs < 0 ? 0 : (rs > 24 ? 24 : rs);
    int cs = qcol - 8; cs = cs < 0 ? 0 : (cs > 48 ? 48 : cs);
    const int skey = tid >> 3, sc = tid & 7;
    v4u s_k0, s_k1, s_v0, s_v1;
#define NAT_LOAD(kr_) do { const size_t ktok_ = (size_t)b * SEQ + (kr_) * 64 + skey; \
        const bf16* kp_ = QKV + ktok_ * INW + C_KB + head * 128 + 8 * sc; s_k0 = *(const GAS v4u*)kp_; s_k1 = *(const GAS v4u*)(kp_ + 64); \
        const bf16* vp_ = QKV + ktok_ * INW + C_VB + head * 128 + 8 * sc; s_v0 = *(const GAS v4u*)vp_; s_v1 = *(const GAS v4u*)(vp_ + 64); } while (0)
#define NAT_WRITE(buf_) do { LAS unsigned char* bb_ = lds + (buf_) * A2_BUF; \
        *(LAS v4u*)(bb_ + A2_K + skey * KP128 + 16 * sc) = s_k0; *(LAS v4u*)(bb_ + A2_K + skey * KP128 + 128 + 16 * sc) = s_k1; \
        *(LAS v4u*)(bb_ + A2_V + skey * VP128 + 16 * sc) = s_v0; *(LAS v4u*)(bb_ + A2_V + skey * VP128 + 128 + 16 * sc) = s_v1; } while (0)
    NAT_LOAD(kr_lo);
    bf16x8 qf[8];
    {
        const bf16* qp = QKV + tok * INW + C_QB + head * 128 + 8 * h;
#pragma unroll
        for (int st = 0; st < 8; ++st) { const v4u x = *(const GAS v4u*)(qp + 16 * st); v4u a;
#pragma unroll
            for (int k = 0; k < 4; ++k) a[k] = cvtpk(bflo(x[k]) * QS, bfhi(x[k]) * QS);
            qf[st] = __builtin_bit_cast(bf16x8, a); }
    }
    float m = -1.0e30f, l = 0.f;
    f32x16 o[4];
#pragma unroll
    for (int db = 0; db < 4; ++db)
#pragma unroll
        for (int i = 0; i < 16; ++i) o[db][i] = 0.f;
    __syncthreads();
    LAS float* bias = (LAS float*)(lds + A2_BIAS) + 64;
    if (tid < 465) bias[tid] = relb[head * 465 + tid] * LOG2E;
    NAT_WRITE(0);
    __syncthreads();
    int buf = 0;
#ifdef PROBE_TILE
    unsigned long long tq_[3] = {0, 0, 0};
#endif
#ifdef PROBE_TIMING
    unsigned long long tc_ = 0, tw_ = 0, tb_ = 0, t0_ = clock64(), tt0_ = t0_;
#define TSTAMP(acc_) do { asm volatile("s_waitcnt vmcnt(0) lgkmcnt(0)" ::: "memory"); const unsigned long long n_ = clock64(); acc_ += n_ - t0_; t0_ = n_; } while (0)
#else
#define TSTAMP(acc_) do {} while (0)
#endif
    for (int kr = kr_lo; kr <= kr_hi; ++kr) {
        if (kr < kr_hi) NAT_LOAD(kr + 1);
        if (kr >= rs && kr < rs + 8) {
            const LAS unsigned char* bb = lds + buf * A2_BUF;
            int dr = kr - qrow + 7; dr = dr < 0 ? 0 : (dr > 14 ? 14 : dr);
            int boff = 15 - qcol + 4 * h, t0 = 4 * h - cs;
            asm volatile("" : "+v"(boff), "+v"(t0));
            const LAS float* brow = bias + dr * 31 + boff;
#ifdef PROBE_TILE
            { const MaskNat mk{brow, t0}; tile64<8, KP128, 4, VP128>(bb + A2_K, bb + A2_V, qf, o, m, l, lane, mk, tq_); }
#else
            { const MaskNat mk{brow, t0}; tile64<8, KP128, 4, VP128>(bb + A2_K, bb + A2_V, qf, o, m, l, lane, mk); }
#endif
        }
#ifdef PROBE_TIMING
        { asm volatile("s_waitcnt lgkmcnt(0)" ::: "memory"); const unsigned long long n_ = clock64(); tc_ += n_ - t0_; t0_ = n_; }
        TSTAMP(tw_);
#endif
        if (kr < kr_hi) NAT_WRITE(buf ^ 1);
        __syncthreads();
        TSTAMP(tb_);
        buf ^= 1;
    }
#ifdef PROBE_TIMING
#ifdef PROBE_TILE
    if (blockIdx.x == 0 && tid == 0) { unsigned long long* pt = (unsigned long long*)PROBE_PTR; pt[0] += tq_[0]; pt[1] += tq_[1]; pt[2] += tq_[2]; pt[3] += tc_; }
#else
    if (blockIdx.x == 0 && tid == 0) { unsigned long long* pt = (unsigned long long*)PROBE_PTR; pt[0] += tc_; pt[1] += tw_; pt[2] += tb_; pt[3] += clock64() - tt0_; }
#endif
#endif
#undef TSTAMP
#undef NAT_LOAD
#undef NAT_WRITE
    const float lt = l + __shfl_xor(l, 32);
    store_o<4>(o, 1.0f / lt, OB + tok * DM + 2048 + head * 128, h, SSQB + tok);
}

DI void mem_unit(LAS unsigned char* lds, int u, const bf16* QM, const bf16* KVM, bf16* OM) {
    const int tid = threadIdx.x, lane = tid & 63, wid = __builtin_amdgcn_readfirstlane(tid >> 6), r = lane & 31, h = lane >> 5;
    const int qblk = u & 15, mh = (u >> 4) & 3, b = u >> 6;
    const int qsub = wid >> 1, dh = wid & 1;
    const size_t tok = (size_t)b * SEQ + qblk * 128 + 32 * qsub + r;
    const float QS = 0.0625f * LOG2E;
    bf16x8 qf[16];
    {
        const bf16* qp = QM + tok * MEMW + mh * 256 + 8 * h;
#pragma unroll
        for (int st = 0; st < 16; ++st) { const v4u x = *(const GAS v4u*)(qp + 16 * st); v4u a;
#pragma unroll
            for (int k = 0; k < 4; ++k) a[k] = cvtpk(bflo(x[k]) * QS, bfhi(x[k]) * QS);
            qf[st] = __builtin_bit_cast(bf16x8, a); }
    }
    float m = -1.0e30f, l = 0.f;
    f32x16 o[4];
#pragma unroll
    for (int db = 0; db < 4; ++db)
#pragma unroll
        for (int i = 0; i < 16; ++i) o[db][i] = 0.f;
    for (int kt = 0; kt < 4; ++kt) {
        __syncthreads();
#pragma unroll
        for (int it = 0; it < 4; ++it) {
            const int ch = tid + 512 * it, key = ch >> 5, c = ch & 31;
            const bf16* kp = KVM + (size_t)(b * MEMLEN + kt * 64 + key) * 2048 + mh * 256 + 8 * c;
            const v4u kv = *(const GAS v4u*)kp, vv = *(const GAS v4u*)(kp + 1024);
            *(LAS v4u*)(lds + ATT_K_OFF + key * KP256 + 16 * c) = kv; *(LAS v4u*)(lds + ATT_V_OFF + key * VP256 + 16 * c) = vv;
        }
        __syncthreads();
        { const MaskNone mk; tile64<16, KP256, 4, VP256>(lds + ATT_K_OFF, lds + ATT_V_OFF + dh * 256, qf, o, m, l, lane, mk); }
    }
    const float lt = l + __shfl_xor(l, 32);
    store_o<4>(o, 1.0f / lt, OM + tok * MEMW + mh * 256 + dh * 128, h);
}

DI unsigned f2sort(float f) { const unsigned u = __float_as_uint(f); return u ^ ((unsigned)((int)u >> 31) | 0x80000000u); }
DI float sort2f(unsigned k) { const unsigned u = (k & 0x80000000u) ? (k ^ 0x80000000u) : ~k; return __uint_as_float(u); }
constexpr int RT_SK_OFF = 0, RT_A_OFF = 69632;
struct constexpr_cand { int a, b; };
__host__ __device__ constexpr constexpr_cand cand_ab(int n) {
    int c = 0;
    for (int a = 0; a < 16; ++a) for (int b = 0; b < 16; ++b) if ((a + 1) * (b + 1) <= 16) { if (c == n) return constexpr_cand{a, b}; ++c; }
    return constexpr_cand{0, 0};
}
DI unsigned selu(int h, unsigned a, unsigned b) { asm volatile("" : "+v"(a), "+v"(b)); return h ? b : a; }
DI float self(int h, float a, float b) { asm volatile("" : "+v"(a), "+v"(b)); return h ? b : a; }
DI void ce_desc(unsigned& a, unsigned& b) { const unsigned hi = a > b ? a : b, lo = a > b ? b : a; a = hi; b = lo; }
template <int LOGN> DI void bitonic_merge_desc(unsigned (&x)[1 << LOGN]) {
#pragma unroll
    for (int lj = LOGN - 1; lj >= 0; --lj)
#pragma unroll
        for (int i = 0; i < (1 << LOGN); ++i) { const int l = i ^ (1 << lj); if (l > i) ce_desc(x[i], x[l]); }
}
DI void bitonic_sort16_desc(unsigned (&x)[16]) {
#pragma unroll
    for (int lk = 1; lk <= 4; ++lk)
#pragma unroll
        for (int lj = lk - 1; lj >= 0; --lj)
#pragma unroll
            for (int i = 0; i < 16; ++i) { const int l = i ^ (1 << lj); if (l > i) { if ((i & (1 << lk)) == 0) ce_desc(x[i], x[l]); else ce_desc(x[l], x[i]); } }
}
DI void top16_merge(unsigned (&a)[16], const unsigned (&b)[16]) {
#pragma unroll
    for (int i = 0; i < 16; ++i) a[i] = a[i] > b[15 - i] ? a[i] : b[15 - i];
    bitonic_merge_desc<4>(a);
}
DI void top16_xlane(unsigned (&a)[16]) {
    unsigned o[16];
#pragma unroll
    for (int i = 0; i < 16; ++i) o[i] = (unsigned)__shfl_xor((int)a[i], 32);
    top16_merge(a, o);
}
DI void route_unit(LAS unsigned char* lds, int u, const bf16* QP, const bf16* SKB, int* IDX, float* GATE) {
    const int tid = threadIdx.x, lane = tid & 63, wid = __builtin_amdgcn_readfirstlane(tid >> 6), r = lane & 31, h = lane >> 5;
    const int hd = u & 7, tile = u >> 3;
    const size_t tok = (size_t)tile * 256 + 32 * wid + r;
    __syncthreads();
#pragma unroll
    for (int it = 0; it < 8; ++it) { const int ch = tid + 512 * it, row = ch >> 4, c = ch & 15;
        const v4u x = *(const GAS v4u*)(SKB + ((size_t)hd * 256 + row) * 128 + 8 * c);
        *(LAS v4u*)(lds + RT_SK_OFF + row * 272 + 16 * c) = x; }
    __syncthreads();
    LAS unsigned* A = (LAS unsigned*)(lds + RT_A_OFF);
    const int tslot = wid * 32 + r;
    unsigned top[2][16];
#pragma unroll
    for (int c = 0; c < 2; ++c) {
        bf16x8 qf[8];
        const bf16* qp = QP + tok * PQW + hd * 256 + c * 128 + 8 * h;
#pragma unroll
        for (int st = 0; st < 8; ++st) qf[st] = __builtin_bit_cast(bf16x8, *(const GAS v4u*)(qp + 16 * st));
        unsigned g0[16], g1[16];
#pragma unroll
        for (int kt = 0; kt < 4; ++kt) {
            const f32x16 s = qk_tile<8, 272>(lds + RT_SK_OFF + (c * 128 + 32 * kt) * 272, qf, r, h);
            unsigned pk[16];
#pragma unroll
            for (int i = 0; i < 16; ++i) pk[i] = (f2sort(s[i]) & ~0x7Fu) | (unsigned)(127 - (32 * kt + crow(i, h)));
            bitonic_sort16_desc(pk);
            if (kt == 0) {
#pragma unroll
                for (int i = 0; i < 16; ++i) g0[i] = pk[i];
            } else if (kt == 1) { top16_merge(g0, pk); }
            else if (kt == 2) {
#pragma unroll
                for (int i = 0; i < 16; ++i) g1[i] = pk[i];
            } else { top16_merge(g1, pk); }
        }
        top16_merge(g0, g1);
        top16_xlane(g0);
#pragma unroll
        for (int i = 0; i < 16; ++i) { top[c][i] = g0[i]; if (h == 0) A[(c * 16 + i) * 256 + tslot] = g0[i]; }
    }
    float v1[16], v2[16];
#pragma unroll
    for (int a = 0; a < 16; ++a) { v1[a] = sort2f(top[0][a] & ~0x7Fu); v2[a] = sort2f(top[1][a] & ~0x7Fu); }
    unsigned cd[64];
#define CK(a_, b_) ((f2sort(v1[a_] + v2[b_]) & ~0xFFu) | (unsigned)(255 - ((a_) * 16 + (b_))))
    cd[0] = CK(0, 0); cd[1] = CK(0, 1); cd[2] = CK(0, 2); cd[3] = CK(0, 3); cd[4] = CK(0, 4);
    cd[5] = CK(0, 5); cd[6] = CK(0, 6); cd[7] = CK(0, 7); cd[8] = CK(0, 8); cd[9] = CK(0, 9);
    cd[10] = CK(0, 10); cd[11] = CK(0, 11); cd[12] = CK(0, 12); cd[13] = CK(0, 13); cd[14] = CK(0, 14);
    cd[15] = CK(0, 15); cd[16] = CK(1, 0); cd[17] = CK(1, 1); cd[18] = CK(1, 2); cd[19] = CK(1, 3);
    cd[20] = CK(1, 4); cd[21] = CK(1, 5); cd[22] = CK(1, 6); cd[23] = CK(1, 7); cd[24] = CK(2, 0);
    cd[25] = CK(2, 1); cd[26] = CK(2, 2); cd[27] = CK(2, 3); cd[28] = CK(2, 4); cd[29] = CK(3, 0);
    cd[30] = CK(3, 1); cd[31] = CK(3, 2); cd[32] = CK(3, 3); cd[33] = CK(4, 0); cd[34] = CK(4, 1);
    cd[35] = CK(4, 2); cd[36] = CK(5, 0); cd[37] = CK(5, 1); cd[38] = CK(6, 0); cd[39] = CK(6, 1);
    cd[40] = CK(7, 0); cd[41] = CK(7, 1); cd[42] = CK(8, 0); cd[43] = CK(9, 0); cd[44] = CK(10, 0);
    cd[45] = CK(11, 0); cd[46] = CK(12, 0); cd[47] = CK(13, 0); cd[48] = CK(14, 0); cd[49] = CK(15, 0);
#undef CK
#pragma unroll
    for (int n = 50; n < 64; ++n) cd[n] = 0u;
    unsigned c0[16], c1[16];
#pragma unroll
    for (int i = 0; i < 16; ++i) { c0[i] = selu(h, cd[i], cd[32 + i]); c1[i] = selu(h, cd[16 + i], cd[48 + i]); }
    bitonic_sort16_desc(c0); bitonic_sort16_desc(c1);
    top16_merge(c0, c1);
    top16_xlane(c0);
    LDS_WAIT();
    asm volatile("" ::: "memory");
    const float mx0 = sort2f(c0[0] & ~0xFFu);
    float ev[16], esum = 0.f;
#pragma unroll
    for (int t = 0; t < 16; ++t) { ev[t] = fexp2((sort2f(c0[t] & ~0xFFu) - mx0) * LOG2E); esum += ev[t]; }
    const float inv = 1.0f / esum;
#pragma unroll
    for (int q4 = 0; q4 < 2; ++q4) {
        int iv[4]; float gv[4];
#pragma unroll
        for (int k = 0; k < 4; ++k) {
            const unsigned cw = selu(h, c0[4 * q4 + k], c0[8 + 4 * q4 + k]);
            const float e = self(h, ev[4 * q4 + k], ev[8 + 4 * q4 + k]);
            const int code = 255 - (int)(cw & 0xFFu), a = code >> 4, bb = code & 15;
            const int i1 = 127 - (int)(A[a * 256 + tslot] & 0x7Fu), i2 = 127 - (int)(A[(16 + bb) * 256 + tslot] & 0x7Fu);
            iv[k] = i1 * 128 + i2; gv[k] = e * inv;
        }
        const size_t o = tok * 128 + hd * 16 + 8 * h + 4 * q4;
        v4u iw; iw.x = (unsigned)iv[0]; iw.y = (unsigned)iv[1]; iw.z = (unsigned)iv[2]; iw.w = (unsigned)iv[3];
        *(GAS v4u*)(IDX + o) = iw;
        f32x4 gw; gw.x = gv[0]; gw.y = gv[1]; gw.z = gv[2]; gw.w = gv[3];
        *(GAS f32x4*)(GATE + o) = gw;
    }
}

DI float dot2bf(unsigned w, unsigned x, float acc) { return __builtin_amdgcn_fdot2_f32_bf16(__builtin_bit_cast(bf16x2_t, w), __builtin_bit_cast(bf16x2_t, x), acc, false); }
DI float readlane_f(float v, int l) { return __uint_as_float((unsigned)__builtin_amdgcn_readlane((int)__float_as_uint(v), l)); }
DI float gelu_erf(float x) { return 0.5f * x * (1.0f + erff(x * 0.70710678118654752f)); }
DI void load_row8(v4u* dst, const bf16* row, int lane) {
    const GAS v4u* p = (const GAS v4u*)row + lane;
#pragma unroll
    for (int j = 0; j < 8; ++j) dst[j] = p[64 * j];
}
DI float dot_row(const v4u* xr, const v4u* w) {
    float a0 = 0.f, a1 = 0.f, a2 = 0.f, a3 = 0.f;
#pragma unroll
    for (int j = 0; j < 8; ++j) { a0 = dot2bf(w[j].x, xr[j].x, a0); a1 = dot2bf(w[j].y, xr[j].y, a1); a2 = dot2bf(w[j].z, xr[j].z, a2); a3 = dot2bf(w[j].w, xr[j].w, a3); }
    return (a0 + a1) + (a2 + a3);
}
DI void axpy_row(float* acc, const v4u* w, float s) {
#pragma unroll
    for (int j = 0; j < 8; ++j)
#pragma unroll
        for (int k = 0; k < 4; ++k) { acc[8 * j + 2 * k] += s * bflo(w[j][k]); acc[8 * j + 2 * k + 1] += s * bfhi(w[j][k]); }
}
DI void peer_token(int tk, const bf16* XN, const int* IDX, const float* GATE, const bf16* UB, const bf16* VB, float* hout, const float* gfin, int lane) {
    v4u xr[8];
    load_row8(xr, XN + (size_t)tk * DM, lane);
    const int ilo = IDX[(size_t)tk * 128 + lane], ihi = IDX[(size_t)tk * 128 + 64 + lane];
    const float glo = GATE[(size_t)tk * 128 + lane], ghi = GATE[(size_t)tk * 128 + 64 + lane];
    float alo = 0.f, ahi = 0.f;
#ifdef PEER_REP
    for (int prep_ = 0; prep_ < 2; ++prep_)
#endif
    {
        v4u b0[8], b1[8];
        load_row8(b0, UB + (size_t)__builtin_amdgcn_readlane(ilo, 0) * DM, lane);
#pragma unroll 1
        for (int e = 0; e < 128; e += 2) {
            const int l1 = (e + 1) & 63;
            const int r1 = (e + 1) < 64 ? __builtin_amdgcn_readlane(ilo, l1) : __builtin_amdgcn_readlane(ihi, l1);
            load_row8(b1, UB + (size_t)r1 * DM, lane);
            { const float d = wave_sum(dot_row(xr, b0)); if (e < 64) { if (lane == (e & 63)) alo = d; } else { if (lane == (e & 63)) ahi = d; } }
            const int e2 = e + 2 < 128 ? e + 2 : 127, l2 = e2 & 63;
            const int r2 = e2 < 64 ? __builtin_amdgcn_readlane(ilo, l2) : __builtin_amdgcn_readlane(ihi, l2);
            load_row8(b0, UB + (size_t)r2 * DM, lane);
            { const float d = wave_sum(dot_row(xr, b1)); if (e + 1 < 64) { if (lane == l1) alo = d; } else { if (lane == l1) ahi = d; } }
        }
    }
#ifdef DBG_NO_PEER
    const float wlo = 0.f * alo * glo, whi = 0.f * ahi * ghi;
#else
    const float wlo = gelu_erf(alo) * glo, whi = gelu_erf(ahi) * ghi;
#endif
    float acc[64];
#pragma unroll
    for (int i = 0; i < 64; ++i) acc[i] = 0.f;
    {
        v4u b0[8], b1[8];
        load_row8(b0, VB + (size_t)__builtin_amdgcn_readlane(ilo, 0) * DM, lane);
#pragma unroll 1
        for (int e = 0; e < 128; e += 2) {
            const int l0 = e & 63, l1 = (e + 1) & 63;
            const int r1 = (e + 1) < 64 ? __builtin_amdgcn_readlane(ilo, l1) : __builtin_amdgcn_readlane(ihi, l1);
            load_row8(b1, VB + (size_t)r1 * DM, lane);
            { const float w = e < 64 ? readlane_f(wlo, l0) : readlane_f(whi, l0); axpy_row(acc, b0, w); }
            const int e2 = e + 2 < 128 ? e + 2 : 127, l2 = e2 & 63;
            const int r2 = e2 < 64 ? __builtin_amdgcn_readlane(ilo, l2) : __builtin_amdgcn_readlane(ihi, l2);
            load_row8(b0, VB + (size_t)r2 * DM, lane);
            { const float w = (e + 1) < 64 ? readlane_f(wlo, l1) : readlane_f(whi, l1); axpy_row(acc, b1, w); }
        }
    }
    float* hrow = hout + (size_t)tk * DM;
    float ssq = 0.f;
#pragma unroll
    for (int j = 0; j < 8; ++j) {
        const f32x4 h0 = *(const GAS f32x4*)(hrow + 512 * j + 8 * lane), h1 = *(const GAS f32x4*)(hrow + 512 * j + 8 * lane + 4);
#pragma unroll
        for (int k = 0; k < 4; ++k) { acc[8 * j + k] += h0[k]; acc[8 * j + 4 + k] += h1[k]; }
#pragma unroll
        for (int k = 0; k < 8; ++k) ssq += acc[8 * j + k] * acc[8 * j + k];
    }
    const float rstd = 1.0f / sqrtf(wave_sum(ssq) * (1.f / DM) + RMS_EPS);
#pragma unroll
    for (int j = 0; j < 8; ++j) {
        const f32x4 g0 = *(const GAS f32x4*)(gfin + 512 * j + 8 * lane), g1 = *(const GAS f32x4*)(gfin + 512 * j + 8 * lane + 4);
        f32x4 o0, o1;
#pragma unroll
        for (int k = 0; k < 4; ++k) { o0[k] = acc[8 * j + k] * rstd * g0[k]; o1[k] = acc[8 * j + 4 + k] * rstd * g1[k]; }
        *(GAS f32x4*)(hrow + 512 * j + 8 * lane) = o0; *(GAS f32x4*)(hrow + 512 * j + 8 * lane + 4) = o1;
    }
}

DI float wave_max(float v) {
#pragma unroll
    for (int o = 1; o < 64; o <<= 1) v = fmaxf(v, __shfl_xor(v, o));
    return v;
}
DI int wave_sum_i(int v) {
#pragma unroll
    for (int o = 1; o < 64; o <<= 1) v += __shfl_xor(v, o);
    return v;
}
DI unsigned q8(float x, float inv, int bias) { return (unsigned)((int)rintf(x * inv) + bias) & 0xffu; }
DI void quant_row_i8(const float* src, unsigned char* dst, float* scl, int lane, int bias) {
    f32x4 v[16]; float am = 0.f;
#pragma unroll
    for (int j = 0; j < 4; ++j)
#pragma unroll
        for (int q = 0; q < 4; ++q) { const f32x4 t = *(const GAS f32x4*)(src + 1024 * j + 16 * lane + 4 * q); v[4 * j + q] = t;
            am = fmaxf(am, fmaxf(fmaxf(fabsf(t.x), fabsf(t.y)), fmaxf(fabsf(t.z), fabsf(t.w)))); }
    am = wave_max(am);
    const float inv = am > 0.f ? 127.f / am : 0.f;
#pragma unroll
    for (int j = 0; j < 4; ++j) { v4u w;
#pragma unroll
        for (int q = 0; q < 4; ++q) { const f32x4 t = v[4 * j + q]; w[q] = q8(t.x, inv, bias) | (q8(t.y, inv, bias) << 8) | (q8(t.z, inv, bias) << 16) | (q8(t.w, inv, bias) << 24); }
        *(GAS v4u*)(dst + 1024 * j + 16 * lane) = w; }
    if (lane == 0) *scl = am * (1.f / 127.f);
}
DI void load_row4(v4u* dst, const unsigned char* row, int lane) {
    const GAS v4u* p = (const GAS v4u*)row + lane;
#pragma unroll
    for (int j = 0; j < 4; ++j) dst[j] = p[64 * j];
}
DI int idot_row(const v4u* xq, const v4u* w) {
    int a0 = 0, a1 = 0;
#pragma unroll
    for (int j = 0; j < 4; ++j) { a0 = __builtin_amdgcn_sdot4((int)w[j].x, (int)xq[j].x, a0, false); a1 = __builtin_amdgcn_sdot4((int)w[j].y, (int)xq[j].y, a1, false);
        a0 = __builtin_amdgcn_sdot4((int)w[j].z, (int)xq[j].z, a0, false); a1 = __builtin_amdgcn_sdot4((int)w[j].w, (int)xq[j].w, a1, false); }
    return a0 + a1;
}
DI void axpy_row_u8(float* acc, const v4u* w, float s) {
#pragma unroll
    for (int j = 0; j < 4; ++j)
#pragma unroll
        for (int q = 0; q < 4; ++q) { const unsigned u = w[j][q];
            acc[16 * j + 4 * q + 0] += s * (float)(u & 0xffu); acc[16 * j + 4 * q + 1] += s * (float)((u >> 8) & 0xffu);
            acc[16 * j + 4 * q + 2] += s * (float)((u >> 16) & 0xffu); acc[16 * j + 4 * q + 3] += s * (float)(u >> 24); }
}
#define RL(v, l) __builtin_amdgcn_readlane((v), (l))
DI void peer_token_q(int tk, const bf16* XN, const int* IDX, const float* GATE, const unsigned char* UQ, const unsigned char* VQ, const float* SU, const float* SV, const float* SSQ,
                     float* hout, const float* gfin, int lane) {
    v4u xq[4]; float sx;
    {
        v4u xb[8]; float am = 0.f;
        const bf16* xp = XN + (size_t)tk * DM + 16 * lane;
#pragma unroll
        for (int j = 0; j < 4; ++j) { xb[2 * j] = *(const GAS v4u*)(xp + 1024 * j); xb[2 * j + 1] = *(const GAS v4u*)(xp + 1024 * j + 8); }
#pragma unroll
        for (int i = 0; i < 8; ++i)
#pragma unroll
            for (int k = 0; k < 4; ++k) am = fmaxf(am, fmaxf(fabsf(bflo(xb[i][k])), fabsf(bfhi(xb[i][k]))));
        am = wave_max(am);
        const float inv = am > 0.f ? 127.f / am : 0.f; sx = am * (1.f / 127.f);
#pragma unroll
        for (int j = 0; j < 4; ++j)
#pragma unroll
            for (int q = 0; q < 4; ++q) { const unsigned w0 = xb[2 * j + (q >> 1)][2 * (q & 1)], w1 = xb[2 * j + (q >> 1)][2 * (q & 1) + 1];
                xq[j][q] = q8(bflo(w0), inv, 0) | (q8(bfhi(w0), inv, 0) << 8) | (q8(bflo(w1), inv, 0) << 16) | (q8(bfhi(w1), inv, 0) << 24); }
    }
    const int ilo = IDX[(size_t)tk * 128 + lane], ihi = IDX[(size_t)tk * 128 + 64 + lane];
    const float glo = GATE[(size_t)tk * 128 + lane], ghi = GATE[(size_t)tk * 128 + 64 + lane];
    const float sulo = SU[ilo], suhi = SU[ihi], svlo = SV[ilo], svhi = SV[ihi];
    int dlo = 0, dhi = 0;
#define ROWIDX(e) ((e) < 64 ? RL(ilo, (e) & 63) : RL(ihi, (e) & 63))
#ifdef PEER_L2PROBE
    {
        int pd = 0;
        v4u ba[2][4], bb[2][4];
#define ROWIDXP(e) (((e) < 64 ? RL(ilo, (e) & 63) : RL(ihi, (e) & 63)) & 511)
        load_row4(ba[0], UQ + (size_t)ROWIDXP(0) * DM, lane); load_row4(ba[1], UQ + (size_t)ROWIDXP(1) * DM, lane);
#pragma unroll 1
        for (int e = 0; e < 128; e += 4) {
            load_row4(bb[0], UQ + (size_t)ROWIDXP(e + 2) * DM, lane); load_row4(bb[1], UQ + (size_t)ROWIDXP(e + 3) * DM, lane);
            pd += wave_sum_i(idot_row(xq, ba[0])) + wave_sum_i(idot_row(xq, ba[1]));
            const int e4 = e + 4 < 128 ? e + 4 : 126;
            load_row4(ba[0], UQ + (size_t)ROWIDXP(e4) * DM, lane); load_row4(ba[1], UQ + (size_t)ROWIDXP(e4 + 1) * DM, lane);
            pd += wave_sum_i(idot_row(xq, bb[0])) + wave_sum_i(idot_row(xq, bb[1]));
        }
#undef ROWIDXP
        asm volatile("" :: "v"(pd));
    }
#endif
#ifdef PEER_REP
    for (int prep_ = 0; prep_ < 2; ++prep_)
#endif
    {
        v4u ba[2][4], bb[2][4];
        load_row4(ba[0], UQ + (size_t)RL(ilo, 0) * DM, lane); load_row4(ba[1], UQ + (size_t)RL(ilo, 1) * DM, lane);
#pragma unroll 1
        for (int e = 0; e < 128; e += 4) {
            load_row4(bb[0], UQ + (size_t)ROWIDX(e + 2) * DM, lane); load_row4(bb[1], UQ + (size_t)ROWIDX(e + 3) * DM, lane);
            { const int d0 = wave_sum_i(idot_row(xq, ba[0])), d1 = wave_sum_i(idot_row(xq, ba[1]));
              if (e < 64) { if (lane == (e & 63)) dlo = d0; if (lane == ((e + 1) & 63)) dlo = d1; } else { if (lane == (e & 63)) dhi = d0; if (lane == ((e + 1) & 63)) dhi = d1; } }
            const int e4 = e + 4 < 128 ? e + 4 : 126;
            load_row4(ba[0], UQ + (size_t)ROWIDX(e4) * DM, lane); load_row4(ba[1], UQ + (size_t)ROWIDX(e4 + 1) * DM, lane);
            { const int d0 = wave_sum_i(idot_row(xq, bb[0])), d1 = wave_sum_i(idot_row(xq, bb[1]));
              if (e < 64) { if (lane == ((e + 2) & 63)) dlo = d0; if (lane == ((e + 3) & 63)) dlo = d1; } else { if (lane == ((e + 2) & 63)) dhi = d0; if (lane == ((e + 3) & 63)) dhi = d1; } }
        }
    }
    const float rsx = sx / sqrtf(SSQ[tk] * (1.f / DM) + RMS_EPS);
    const float wlo = gelu_erf((float)dlo * rsx * sulo) * glo * svlo, whi = gelu_erf((float)dhi * rsx * suhi) * ghi * svhi;
    const float wsum = wave_sum(wlo + whi);
    float acc[64];
#pragma unroll
    for (int i = 0; i < 64; ++i) acc[i] = 0.f;
#define ROWW(e) ((e) < 64 ? readlane_f(wlo, (e) & 63) : readlane_f(whi, (e) & 63))
    {
        v4u ba[2][4], bb[2][4];
        load_row4(ba[0], VQ + (size_t)RL(ilo, 0) * DM, lane); load_row4(ba[1], VQ + (size_t)RL(ilo, 1) * DM, lane);
#pragma unroll 1
        for (int e = 0; e < 128; e += 4) {
            load_row4(bb[0], VQ + (size_t)ROWIDX(e + 2) * DM, lane); load_row4(bb[1], VQ + (size_t)ROWIDX(e + 3) * DM, lane);
            axpy_row_u8(acc, ba[0], ROWW(e)); axpy_row_u8(acc, ba[1], ROWW(e + 1));
            const int e4 = e + 4 < 128 ? e + 4 : 126;
            load_row4(ba[0], VQ + (size_t)ROWIDX(e4) * DM, lane); load_row4(ba[1], VQ + (size_t)ROWIDX(e4 + 1) * DM, lane);
            axpy_row_u8(acc, bb[0], ROWW(e + 2)); axpy_row_u8(acc, bb[1], ROWW(e + 3));
        }
    }
#undef ROWIDX
#undef ROWW
    float* hrow = hout + (size_t)tk * DM + 16 * lane;
    const float corr = -128.f * wsum;
    float ssq = 0.f;
#pragma unroll
    for (int j = 0; j < 4; ++j)
#pragma unroll
        for (int q = 0; q < 4; ++q) { const f32x4 hv = *(const GAS f32x4*)(hrow + 1024 * j + 4 * q);
#pragma unroll
            for (int k = 0; k < 4; ++k) { const float t = acc[16 * j + 4 * q + k] + corr + hv[k]; acc[16 * j + 4 * q + k] = t; ssq += t * t; } }
    const float rstd = 1.0f / sqrtf(wave_sum(ssq) * (1.f / DM) + RMS_EPS);
    const float* gp = gfin + 16 * lane;
#pragma unroll
    for (int j = 0; j < 4; ++j)
#pragma unroll
        for (int q = 0; q < 4; ++q) { const f32x4 gv = *(const GAS f32x4*)(gp + 1024 * j + 4 * q); f32x4 o;
#pragma unroll
            for (int k = 0; k < 4; ++k) o[k] = acc[16 * j + 4 * q + k] * rstd * gv[k];
            *(GAS f32x4*)(hrow + 1024 * j + 4 * q) = o; }
}

DI void fmac_s(float& acc, float w, float x) { asm("v_fmac_f32_e32 %0, %1, %2" : "+v"(acc) : "v"(w), "v"(x)); }
DI void pkfma16_lo(unsigned& acc, unsigned x, unsigned wp) { asm("v_pk_fma_f16 %0, %1, %2, %0 op_sel_hi:[1,0,1]" : "+v"(acc) : "v"(x), "v"(wp)); }
DI void pkfma16_hi(unsigned& acc, unsigned x, unsigned wp) { asm("v_pk_fma_f16 %0, %1, %2, %0 op_sel:[0,1,0] op_sel_hi:[1,1,1]" : "+v"(acc) : "v"(x), "v"(wp)); }
DI void quant_row_i8_sliced(const float* src, unsigned char* tab, int e, float* scl, int lane, int bias) {
    f32x4 v[16]; float am = 0.f;
#pragma unroll
    for (int j = 0; j < 4; ++j)
#pragma unroll
        for (int q = 0; q < 4; ++q) { const f32x4 t = *(const GAS f32x4*)(src + 1024 * j + 16 * lane + 4 * q); v[4 * j + q] = t;
            am = fmaxf(am, fmaxf(fmaxf(fabsf(t.x), fabsf(t.y)), fmaxf(fabsf(t.z), fabsf(t.w)))); }
    am = wave_max(am);
    const float inv = am > 0.f ? 127.f / am : 0.f;
#pragma unroll
    for (int j = 0; j < 4; ++j) { v4u w;
#pragma unroll
        for (int q = 0; q < 4; ++q) { const f32x4 t = v[4 * j + q]; w[q] = q8(t.x, inv, bias) | (q8(t.y, inv, bias) << 8) | (q8(t.z, inv, bias) << 16) | (q8(t.w, inv, bias) << 24); }
        *(GAS v4u*)(tab + (size_t)(8 * j + (lane >> 3)) * SLICE_BYTES + (size_t)e * 128 + 16 * (lane & 7)) = w; }
    if (lane == 0) *scl = am * (1.f / 127.f);
}
DI void qrow_load(f32x4* v, const float* src, int lane) {
#pragma unroll
    for (int j = 0; j < 4; ++j)
#pragma unroll
        for (int q = 0; q < 4; ++q) v[4 * j + q] = *(const GAS f32x4*)(src + 1024 * j + 16 * lane + 4 * q);
}
template <bool NOST = false> DI void qrow_store(const f32x4* v, unsigned char* tab, int e, float* scl, int lane, int bias) {
    float am = 0.f;
#pragma unroll
    for (int i = 0; i < 16; ++i) { const f32x4 t = v[i]; am = fmaxf(am, fmaxf(fmaxf(fabsf(t.x), fabsf(t.y)), fmaxf(fabsf(t.z), fabsf(t.w)))); }
    am = wave_max(am);
    const float inv = am > 0.f ? 127.f / am : 0.f;
#pragma unroll
    for (int j = 0; j < 4; ++j) { v4u w;
#pragma unroll
        for (int q = 0; q < 4; ++q) { const f32x4 t = v[4 * j + q]; w[q] = q8(t.x, inv, bias) | (q8(t.y, inv, bias) << 8) | (q8(t.z, inv, bias) << 16) | (q8(t.w, inv, bias) << 24); }
        if (NOST) asm volatile("" :: "v"(w)); else *(GAS v4u*)(tab + (size_t)(8 * j + (lane >> 3)) * SLICE_BYTES + (size_t)e * 128 + 16 * (lane & 7)) = w; }
    if (lane == 0 && !NOST) *scl = am * (1.f / 127.f);
}
DI unsigned q4(float x, float inv) { int q = (int)floorf(x * inv + 8.0f); q = q < 0 ? 0 : (q > 15 ? 15 : q); return (unsigned)q; }
DI void qrow_store_u4(const f32x4* v, unsigned char* tab, int e, float* scl, int lane) {
    float ss = 0.f;
#pragma unroll
    for (int i = 0; i < 16; ++i) { const f32x4 t = v[i]; ss += (t.x * t.x + t.y * t.y) + (t.z * t.z + t.w * t.w); }
    ss = wave_sum(ss);
    const float step = 0.3352f * sqrtf(ss * (1.f / DM)), inv = step > 0.f ? 1.0f / step : 0.f;
#pragma unroll
    for (int j = 0; j < 4; ++j) { u32x2 w;
#pragma unroll
        for (int d = 0; d < 2; ++d) { const f32x4 a = v[4 * j + 2 * d], b = v[4 * j + 2 * d + 1];
            w[d] = q4(a.x, inv) | (q4(a.y, inv) << 8) | (q4(a.z, inv) << 16) | (q4(a.w, inv) << 24) | (q4(b.x, inv) << 4) | (q4(b.y, inv) << 12) | (q4(b.z, inv) << 20) | (q4(b.w, inv) << 28); }
        *(GAS u32x2*)(tab + (size_t)(4 * j + (lane >> 4)) * SLICE_BYTES + (size_t)e * 128 + 8 * (lane & 15)) = w; }
    if (lane == 0) *scl = step;
}
template <bool NOST = false> DI void quant_rows_strided(int r_lo, int r_hi, int stride, const float* peer_u, const float* peer_v, unsigned char* UQ, unsigned char* VQ, float* SU, float* SV, int lane) {
    if (r_lo >= r_hi) return;
#define QSRC(r_) (((r_) >= NEXP ? peer_v + (size_t)((r_) - NEXP) * DM : peer_u + (size_t)(r_) * DM))
#ifdef U4
#define QSTORE(v_, r_) do { if ((r_) >= NEXP) qrow_store<NOST>(v_, VQ, (r_) - NEXP, SV + ((r_) - NEXP), lane, 128); else qrow_store_u4(v_, UQ, (r_), SU + (r_), lane); } while (0)
#else
#define QSTORE(v_, r_) do { if ((r_) >= NEXP) qrow_store<NOST>(v_, VQ, (r_) - NEXP, SV + ((r_) - NEXP), lane, 128); else qrow_store<NOST>(v_, UQ, (r_), SU + (r_), lane, 0); } while (0)
#endif
    f32x4 va[16], vb[16];
    qrow_load(va, QSRC(r_lo), lane);
#pragma unroll 1
    for (int r = r_lo; r < r_hi; r += 2 * stride) {
        const int r1 = r + stride < r_hi ? r + stride : r, r2 = r + 2 * stride < r_hi ? r + 2 * stride : r;
        qrow_load(vb, QSRC(r1), lane);
        QSTORE(va, r);
        qrow_load(va, QSRC(r2), lane);
        if (r + stride < r_hi) QSTORE(vb, r1);
    }
#undef QSRC
#undef QSTORE
}
DI void quant_token(int tk, const bf16* XN, const float* gain, const float* SSQ, unsigned char* XQ, float* SX, int lane) {
    v4u xb[8]; float am = 0.f;
    const bf16* xp = XN + (size_t)tk * DM + 16 * lane; const float* gp = gain + 16 * lane;
#pragma unroll
    for (int j = 0; j < 4; ++j) { xb[2 * j] = *(const GAS v4u*)(xp + 1024 * j); xb[2 * j + 1] = *(const GAS v4u*)(xp + 1024 * j + 8); }
#pragma unroll
    for (int i = 0; i < 8; ++i) { const f32x4 g0 = *(const GAS f32x4*)(gp + 1024 * (i >> 1) + 8 * (i & 1)), g1 = *(const GAS f32x4*)(gp + 1024 * (i >> 1) + 8 * (i & 1) + 4);
        xb[i].x = cvtpk(bflo(xb[i].x) * g0.x, bfhi(xb[i].x) * g0.y); xb[i].y = cvtpk(bflo(xb[i].y) * g0.z, bfhi(xb[i].y) * g0.w);
        xb[i].z = cvtpk(bflo(xb[i].z) * g1.x, bfhi(xb[i].z) * g1.y); xb[i].w = cvtpk(bflo(xb[i].w) * g1.z, bfhi(xb[i].w) * g1.w); }
#pragma unroll
    for (int i = 0; i < 8; ++i)
#pragma unroll
        for (int k = 0; k < 4; ++k) am = fmaxf(am, fmaxf(fabsf(bflo(xb[i][k])), fabsf(bfhi(xb[i][k]))));
    am = wave_max(am);
    const float inv = am > 0.f ? 127.f / am : 0.f;
#pragma unroll
    for (int j = 0; j < 4; ++j) { v4u o;
#pragma unroll
        for (int q = 0; q < 4; ++q) { const unsigned w0 = xb[2 * j + (q >> 1)][2 * (q & 1)], w1 = xb[2 * j + (q >> 1)][2 * (q & 1) + 1];
            o[q] = q8(bflo(w0), inv, 0) | (q8(bfhi(w0), inv, 0) << 8) | (q8(bflo(w1), inv, 0) << 16) | (q8(bfhi(w1), inv, 0) << 24); }
        *(GAS v4u*)(XQ + (size_t)tk * DM + 1024 * j + 16 * lane) = o; }
    if (lane == 0) SX[tk] = am * (1.f / 127.f) / sqrtf(SSQ[tk] * (1.f / DM) + RMS_EPS);
#ifdef U4
    {
        int sm = 0;
#pragma unroll
        for (int i = 0; i < 8; ++i)
#pragma unroll
            for (int k = 0; k < 4; ++k) { sm += (int)rintf(bflo(xb[i][k]) * inv) + (int)rintf(bfhi(xb[i][k]) * inv); }
        sm = wave_sum_i(sm);
        if (lane == 0) ((int*)(SX + T_TOK))[tk] = sm;
    }
#endif
}
DI void peer_sweep(LAS unsigned char* lds, int wave, int gw, int NGW, const unsigned char* XQ, const float* SX, const int* IDX, const float* GATE,
                   const unsigned char* UQs, const unsigned char* VQs, const float* SU, const float* SV, bf16* Hres, float* hout, const float* gfin, int lane) {
    const int g = lane >> 3, c = lane & 7;
    LAS int* RI = (LAS int*)(lds + wave * 16384) + lane;
    int tok[4];
#pragma unroll
    for (int k = 0; k < 4; ++k) tok[k] = gw + k * NGW;
#pragma unroll
    for (int k = 0; k < 4; ++k)
#pragma unroll
        for (int i = 0; i < 16; ++i) RI[(k * 16 + i) * 64] = IDX[(size_t)tok[k] * 128 + 8 * i + g] * 128 + 16 * c;
    LDS_WAIT(); asm volatile("" ::: "memory");
#define PS_ISSUE(dst, base, k_, h_) do { _Pragma("unroll") for (int i_ = 0; i_ < 8; ++i_) dst[i_] = *(const GAS v4u*)((base) + RI[((k_) * 16 + 8 * (h_) + i_) * 64]); } while (0)
#ifdef PROBE_SWEEP
    const unsigned long long tsw0 = __builtin_amdgcn_s_memrealtime(); const unsigned long long tck0 = clock64();
#endif
    int A[4][16];
#pragma unroll
    for (int k = 0; k < 4; ++k)
#pragma unroll
        for (int i = 0; i < 16; ++i) A[k][i] = 0;
#ifdef U4
    {
        v4u wa[16], wb[16], xa0, xa1, xb0, xb1;
#define PS_ISSUE16(dst, base, k_) do { _Pragma("unroll") for (int i_ = 0; i_ < 16; ++i_) dst[i_] = *(const GAS v4u*)((base) + RI[((k_) * 16 + i_) * 64]); } while (0)
#define PS_XS(d0_, d1_, s_, k_) do { const unsigned char* xp_ = XQ + (size_t)tok[k_] * DM + 256 * (s_) + 32 * c; d0_ = *(const GAS v4u*)xp_; d1_ = *(const GAS v4u*)(xp_ + 16); } while (0)
#define PS_D4(a_, w_, xl_, xh_) do { a_ = __builtin_amdgcn_sdot4((int)((w_) & 0x0F0F0F0Fu), (int)(xl_), a_, false); a_ = __builtin_amdgcn_sdot4((int)(((w_) >> 4) & 0x0F0F0F0Fu), (int)(xh_), a_, false); } while (0)
#define PS_DOT16(k_, w_, x0_, x1_) do { _Pragma("unroll") for (int i_ = 0; i_ < 16; ++i_) { int a_ = A[k_][i_]; PS_D4(a_, w_[i_].x, x0_.x, x0_.y); PS_D4(a_, w_[i_].y, x0_.z, x0_.w); \
            PS_D4(a_, w_[i_].z, x1_.x, x1_.y); PS_D4(a_, w_[i_].w, x1_.z, x1_.w); A[k_][i_] = a_; } } while (0)
        PS_ISSUE16(wa, UQs, 0); PS_XS(xa0, xa1, 0, 0);
#pragma unroll 1
        for (int s = 0; s < 16; ++s) {
            asm volatile("" ::: "memory");
            const unsigned char* us = UQs + (size_t)s * SLICE_BYTES;
            const int sn = s + 1 < 16 ? s + 1 : 15;
            const unsigned char* usn = UQs + (size_t)sn * SLICE_BYTES;
            PS_ISSUE16(wb, us, 1); PS_XS(xb0, xb1, s, 1);
            PS_DOT16(0, wa, xa0, xa1);
            PS_ISSUE16(wa, us, 2); PS_XS(xa0, xa1, s, 2);
            PS_DOT16(1, wb, xb0, xb1);
            PS_ISSUE16(wb, us, 3); PS_XS(xb0, xb1, s, 3);
            PS_DOT16(2, wa, xa0, xa1);
            PS_ISSUE16(wa, usn, 0); PS_XS(xa0, xa1, sn, 0);
            PS_DOT16(3, wb, xb0, xb1);
        }
#undef PS_ISSUE16
#undef PS_XS
#undef PS_D4
#undef PS_DOT16
    }
#else
    {
        v4u wa[16], wb[16], xa, xb;
#define PS_ISSUE16(dst, base, k_) do { _Pragma("unroll") for (int i_ = 0; i_ < 16; ++i_) dst[i_] = *(const GAS v4u*)((base) + RI[((k_) * 16 + i_) * 64]); } while (0)
#define PS_XS(s_, k_) (*(const GAS v4u*)(XQ + (size_t)tok[k_] * DM + 128 * (s_) + 16 * c))
#define PS_DOT16(k_, w_, x_) do { _Pragma("unroll") for (int i_ = 0; i_ < 16; ++i_) { int a_ = A[k_][i_]; a_ = __builtin_amdgcn_sdot4((int)w_[i_].x, (int)x_.x, a_, false); a_ = __builtin_amdgcn_sdot4((int)w_[i_].y, (int)x_.y, a_, false); \
            a_ = __builtin_amdgcn_sdot4((int)w_[i_].z, (int)x_.z, a_, false); a_ = __builtin_amdgcn_sdot4((int)w_[i_].w, (int)x_.w, a_, false); A[k_][i_] = a_; } } while (0)
        PS_ISSUE16(wa, UQs, 0); xa = PS_XS(0, 0);
#pragma unroll 1
        for (int s = 0; s < 32; ++s) {
            asm volatile("" ::: "memory");
            const unsigned char* us = UQs + (size_t)s * SLICE_BYTES;
            const int sn = s + 1 < 32 ? s + 1 : 31;
            const unsigned char* usn = UQs + (size_t)sn * SLICE_BYTES;
            PS_ISSUE16(wb, us, 1); xb = PS_XS(s, 1);
            PS_DOT16(0, wa, xa);
            PS_ISSUE16(wa, us, 2); xa = PS_XS(s, 2);
            PS_DOT16(1, wb, xb);
            PS_ISSUE16(wb, us, 3); xb = PS_XS(s, 3);
            PS_DOT16(2, wa, xa);
            PS_ISSUE16(wa, usn, 0); xa = PS_XS(sn, 0);
            PS_DOT16(3, wb, xb);
        }
#undef PS_ISSUE16
#undef PS_XS
#undef PS_DOT16
    }
#endif
#ifdef PROBE_USWEEP
    {
        int A2[4][16];
#pragma unroll
        for (int k = 0; k < 4; ++k)
#pragma unroll
            for (int i = 0; i < 16; ++i) A2[k][i] = 0;
        v4u wb0[8], wb1[8], xs, xsn;
        PS_ISSUE(wb0, UQs, 0, 0); xs = *(const GAS v4u*)(XQ + (size_t)tok[0] * DM + 16 * c);
#pragma unroll 1
        for (int s = 0; s < 32; ++s) {
            asm volatile("" ::: "memory");
            const unsigned char* us = UQs + (size_t)s * SLICE_BYTES;
            const int sn = s + 1 < 32 ? s + 1 : 31;
            const unsigned char* usn = UQs + (size_t)sn * SLICE_BYTES;
#pragma unroll
            for (int k = 0; k < 4; ++k) {
                PS_ISSUE(wb1, us, k, 1);
#pragma unroll
                for (int i = 0; i < 8; ++i) { int a = A2[k][i]; a = __builtin_amdgcn_sdot4((int)wb0[i].x, (int)xs.x, a, false); a = __builtin_amdgcn_sdot4((int)wb0[i].y, (int)xs.y, a, false);
                    a = __builtin_amdgcn_sdot4((int)wb0[i].z, (int)xs.z, a, false); a = __builtin_amdgcn_sdot4((int)wb0[i].w, (int)xs.w, a, false); A2[k][i] = a; }
                if (k < 3) { PS_ISSUE(wb0, us, k + 1, 0); xsn = *(const GAS v4u*)(XQ + (size_t)tok[k + 1 < 4 ? k + 1 : 3] * DM + 128 * s + 16 * c); }
                else { PS_ISSUE(wb0, usn, 0, 0); xsn = *(const GAS v4u*)(XQ + (size_t)tok[0] * DM + 128 * sn + 16 * c); }
#pragma unroll
                for (int i = 0; i < 8; ++i) { int a = A2[k][8 + i]; a = __builtin_amdgcn_sdot4((int)wb1[i].x, (int)xs.x, a, false); a = __builtin_amdgcn_sdot4((int)wb1[i].y, (int)xs.y, a, false);
                    a = __builtin_amdgcn_sdot4((int)wb1[i].z, (int)xs.z, a, false); a = __builtin_amdgcn_sdot4((int)wb1[i].w, (int)xs.w, a, false); A2[k][8 + i] = a; }
                xs = xsn;
            }
        }
#pragma unroll
        for (int k = 0; k < 4; ++k)
#pragma unroll
            for (int i = 0; i < 16; ++i) asm volatile("" :: "v"(A2[k][i]));
    }
#endif
#ifdef PROBE_SWEEP
    asm volatile("s_waitcnt vmcnt(0)" ::: "memory"); const unsigned long long tsw1 = __builtin_amdgcn_s_memrealtime();
#endif
    float W[4][16], wsum[4];
#ifdef VF16
    unsigned Wp[4][8]; float usc[4];
    typedef _Float16 h2_t __attribute__((ext_vector_type(2)));
#endif
#pragma unroll
    for (int k = 0; k < 4; ++k) {
        const float sx = SX[tok[k]]; float ws_ = 0.f;
#pragma unroll
        for (int i = 0; i < 16; ++i) {
            int a = A[k][i]; a += __shfl_xor(a, 1); a += __shfl_xor(a, 2); a += __shfl_xor(a, 4);
            const int e = IDX[(size_t)tok[k] * 128 + 8 * i + g];
#ifdef U4
            const float w = gelu_erf(((float)a - 7.5f * (float)((const int*)(SX + T_TOK))[tok[k]]) * sx * SU[e]) * GATE[(size_t)tok[k] * 128 + 8 * i + g] * SV[e];
#else
            const float w = gelu_erf((float)a * sx * SU[e]) * GATE[(size_t)tok[k] * 128 + 8 * i + g] * SV[e];
#endif
            W[k][i] = w; ws_ += w;
        }
        ws_ += __shfl_xor(ws_, 8); ws_ += __shfl_xor(ws_, 16); ws_ += __shfl_xor(ws_, 32);
        wsum[k] = ws_;
#ifdef VF16
        {
            float wm = 0.f;
#pragma unroll
            for (int i = 0; i < 16; ++i) wm = fmaxf(wm, fabsf(W[k][i]));
            wm = fmaxf(wm, __shfl_xor(wm, 8)); wm = fmaxf(wm, __shfl_xor(wm, 16)); wm = fmaxf(wm, __shfl_xor(wm, 32));
            const int ex = wm > 0.f ? __builtin_amdgcn_frexp_expf(wm) : 14;
            const float alpha = __builtin_amdgcn_ldexpf(1.0f, 14 - ex);
            usc[k] = __builtin_amdgcn_ldexpf(1.0f, 24 - (14 - ex));
#pragma unroll
            for (int p = 0; p < 8; ++p) { const _Float16 h0 = (_Float16)(W[k][2 * p] * alpha), h1 = (_Float16)(W[k][2 * p + 1] * alpha);
                Wp[k][p] = (unsigned)__builtin_bit_cast(unsigned short, h0) | ((unsigned)__builtin_bit_cast(unsigned short, h1) << 16); }
        }
#endif
    }
    float ssq[4] = {0.f, 0.f, 0.f, 0.f};
    const bool g0 = (g & 1) != 0, g1 = (g & 2) != 0, g2 = (g & 4) != 0;
    const int colsub = 16 * c + 8 * (g & 1) + 4 * ((g >> 1) & 1) + 2 * ((g >> 2) & 1);
#ifndef NO_VSWEEP
    {
        v4u wb0[8], wb1[8];
#ifdef VF16
        int riA[8], riB[8];
#define PS_RI(dst, k_, h_) do { _Pragma("unroll") for (int i_ = 0; i_ < 8; ++i_) dst[i_] = RI[((k_) * 16 + 8 * (h_) + i_) * 64]; } while (0)
#define PS_LD(dst, base, ri_) do { _Pragma("unroll") for (int i_ = 0; i_ < 8; ++i_) dst[i_] = *(const GAS v4u*)((base) + ri_[i_]); } while (0)
        PS_RI(riB, 0, 1);
#endif
        PS_ISSUE(wb0, VQs, 0, 0);
#pragma unroll 1
        for (int s = 0; s < 32; ++s) {
            asm volatile("" ::: "memory");
            const unsigned char* vs = VQs + (size_t)s * SLICE_BYTES;
            const int sn = s + 1 < 32 ? s + 1 : 31;
            const unsigned char* vsn = VQs + (size_t)sn * SLICE_BYTES;
#pragma unroll
            for (int k = 0; k < 4; ++k) {
                float acc[16];
#ifdef VF16
                PS_LD(wb1, vs, riB);
                if (k < 3) PS_RI(riA, k + 1, 0); else PS_RI(riA, 0, 0);
                __builtin_amdgcn_sched_barrier(0);
#else
                PS_ISSUE(wb1, vs, k, 1);
#endif
                const unsigned hb = *(const GAS unsigned*)(Hres + (size_t)tok[k] * DM + 128 * s + colsub);
                f32x2 hv; hv.x = bflo(hb); hv.y = bfhi(hb);
#ifdef VF16
                unsigned ac2[8];
#pragma unroll
                for (int b = 0; b < 8; ++b) ac2[b] = 0u;
#define PS_ROWH(wv_, i_) do { const unsigned wp_ = Wp[k][(i_) >> 1]; \
                    _Pragma("unroll") for (int q = 0; q < 4; ++q) { const unsigned u = wv_[q]; \
                        const unsigned x0 = __builtin_amdgcn_perm(u, 0u, 0x0C050C04u), x1 = __builtin_amdgcn_perm(u, 0u, 0x0C070C06u); \
                        if ((i_) & 1) { pkfma16_hi(ac2[2 * q], x0, wp_); pkfma16_hi(ac2[2 * q + 1], x1, wp_); } else { pkfma16_lo(ac2[2 * q], x0, wp_); pkfma16_lo(ac2[2 * q + 1], x1, wp_); } } } while (0)
#pragma unroll
                for (int i = 0; i < 8; ++i) PS_ROWH(wb0[i], i);
                if (k < 3) { PS_LD(wb0, vs, riA); PS_RI(riB, k + 1, 1); } else { PS_LD(wb0, vsn, riA); PS_RI(riB, 0, 1); }
                __builtin_amdgcn_sched_barrier(0);
#pragma unroll
                for (int i = 0; i < 8; ++i) PS_ROWH(wb1[i], 8 + i);
#undef PS_ROWH
#pragma unroll
                for (int b = 0; b < 8; ++b) { const h2_t hv2 = __builtin_bit_cast(h2_t, ac2[b]); acc[2 * b] = (float)hv2.x * usc[k]; acc[2 * b + 1] = (float)hv2.y * usc[k]; }
#else
#pragma unroll
                for (int b = 0; b < 16; ++b) acc[b] = 0.f;
#pragma unroll
                for (int i = 0; i < 8; ++i) { const float w = W[k][i];
#pragma unroll
                    for (int q = 0; q < 4; ++q) { const unsigned u = wb0[i][q];
                        fmac_s(acc[4 * q + 0], w, (float)(u & 0xffu)); fmac_s(acc[4 * q + 1], w, (float)((u >> 8) & 0xffu)); fmac_s(acc[4 * q + 2], w, (float)((u >> 16) & 0xffu)); fmac_s(acc[4 * q + 3], w, (float)(u >> 24)); } }
                if (k < 3) { PS_ISSUE(wb0, vs, k + 1, 0); } else { PS_ISSUE(wb0, vsn, 0, 0); }
#pragma unroll
                for (int i = 0; i < 8; ++i) { const float w = W[k][8 + i];
#pragma unroll
                    for (int q = 0; q < 4; ++q) { const unsigned u = wb1[i][q];
                        fmac_s(acc[4 * q + 0], w, (float)(u & 0xffu)); fmac_s(acc[4 * q + 1], w, (float)((u >> 8) & 0xffu)); fmac_s(acc[4 * q + 2], w, (float)((u >> 16) & 0xffu)); fmac_s(acc[4 * q + 3], w, (float)(u >> 24)); } }
#endif
                float r8[8], r4[4], r2[2];
#pragma unroll
                for (int j = 0; j < 8; ++j) { const float snd = g0 ? acc[j] : acc[8 + j], kp = g0 ? acc[8 + j] : acc[j];
                    r8[j] = kp + __uint_as_float((unsigned)__builtin_amdgcn_update_dpp(0, (int)__float_as_uint(snd), 0x128  , 0xf, 0xf, false)); }
#pragma unroll
                for (int j = 0; j < 4; ++j) { const auto sw = __builtin_amdgcn_permlane16_swap(__float_as_uint(r8[j]), __float_as_uint(r8[4 + j]), false, false); r4[j] = __uint_as_float(sw[0]) + __uint_as_float(sw[1]); }
#pragma unroll
                for (int j = 0; j < 2; ++j) { const auto sw = __builtin_amdgcn_permlane32_swap(__float_as_uint(r4[j]), __float_as_uint(r4[2 + j]), false, false); r2[j] = __uint_as_float(sw[0]) + __uint_as_float(sw[1]); }
                const float corr = -128.f * wsum[k];
                f32x2 o; o.x = hv.x + r2[0] + corr; o.y = hv.y + r2[1] + corr;
                ssq[k] += o.x * o.x + o.y * o.y;
                *(GAS unsigned*)(Hres + (size_t)tok[k] * DM + 128 * s + colsub) = cvtpk(o.x, o.y);
            }
        }
    }
#endif
#undef PS_ISSUE
    asm volatile("s_waitcnt vmcnt(0)" ::: "memory");
#ifdef PROBE_SWEEP
    const unsigned long long tsw2 = __builtin_amdgcn_s_memrealtime();
#endif
#pragma unroll 1
    for (int k = 0; k < 4; ++k) {
        const float rstd = 1.0f / sqrtf(wave_sum(ssq[k]) * (1.f / DM) + RMS_EPS);
        const GAS v4u* hb = (const GAS v4u*)(Hres + (size_t)tok[k] * DM) + lane;
        float* orow = hout + (size_t)tok[k] * DM + 8 * lane; const float* gp = gfin + 8 * lane;
#pragma unroll
        for (int j = 0; j < 8; ++j) { const v4u v = hb[64 * j]; const f32x4 g0 = *(const GAS f32x4*)(gp + 512 * j), g1 = *(const GAS f32x4*)(gp + 512 * j + 4);
            f32x4 o0, o1; o0.x = bflo(v.x) * rstd * g0.x; o0.y = bfhi(v.x) * rstd * g0.y; o0.z = bflo(v.y) * rstd * g0.z; o0.w = bfhi(v.y) * rstd * g0.w;
            o1.x = bflo(v.z) * rstd * g1.x; o1.y = bfhi(v.z) * rstd * g1.y; o1.z = bflo(v.w) * rstd * g1.z; o1.w = bfhi(v.w) * rstd * g1.w;
            *(GAS f32x4*)(orow + 512 * j) = o0; *(GAS f32x4*)(orow + 512 * j + 4) = o1; }
    }
#ifdef PROBE_SWEEP
    if (gw == 0 && lane == 0) { asm volatile("s_waitcnt vmcnt(0)" ::: "memory");
        const unsigned long long tsw3 = __builtin_amdgcn_s_memrealtime();
        const unsigned long long d = PROBE_SWEEP == 0 ? tsw1 - tsw0 : (PROBE_SWEEP == 1 ? tsw2 - tsw1 : tsw3 - tsw2);
        const float val = PROBE_SWEEP == 4 ? (float)(clock64() - tck0) / (float)(tsw3 - tsw0) / 40.f : (PROBE_SWEEP == 3 ? (float)(tsw3 - tsw0) * (0.01f / 1000.f) : (float)d / (float)(tsw3 - tsw0));
        hout[(size_t)tok[0] * DM] += 0.2f + 0.25f * val; }
#endif
#ifdef PROBE_TIMING
    if (gw == 0 && lane == 0) { asm volatile("s_waitcnt vmcnt(0)" ::: "memory");
        const unsigned long long* pt = (const unsigned long long*)((const unsigned char*)SU - WS_SU + 262144);
        const float tot = (float)pt[3]; const float frac = (float)pt[PROBE_METRIC] / tot;
        hout[(size_t)tok[0] * DM] += 0.2f + 0.25f * frac; }
#endif
}

struct Args { const float* in[21]; float* out; unsigned char* ws; int ph_lo, ph_hi; };
static_assert(sizeof(Args) == 21 * 8 + 8 + 8 + 8, "Args has no padding");

__global__ void __launch_bounds__(NWAVES * 64, 2) hymba_fwd(Args args) {
    extern __shared__ __attribute__((aligned(16))) unsigned char lds_raw[];
    LAS unsigned char* lds = (LAS unsigned char*)lds_raw;
    volatile LAS unsigned* MISC = (volatile LAS unsigned*)(lds + MISC_OFF);
    const int tid = threadIdx.x, lane = tid & 63, wave = __builtin_amdgcn_readfirstlane(tid >> 6);
    const int G = gridDim.x; const int bx = blockIdx.x;
    const int vcu = (G % 8 == 0) ? (bx % 8) * (G / 8) + bx / 8 : bx;
    unsigned char* ws = args.ws;
    gu32* ctl = (gu32*)(ws + WS_CTL);
    for (int u = tid; u < (LDS_BYTES - LDSCTL_OFF) / 4; u += NWAVES * 64) ((LAS unsigned*)(lds + LDSCTL_OFF))[u] = 0u;
    __syncthreads();
    XcdBarrier bar = xcd_barrier_post((unsigned*)(ctl + CW_BAR), MISC + 8);
    const int lo = args.ph_lo, hi = args.ph_hi;
#ifdef PH_ONLY
#define IN(k) ((k) == PH_ONLY && lo <= (k) && (k) < hi)
#else
#define IN(k) (lo <= (k) && (k) < hi)
#endif
#ifndef DUP_PHASE
#define DUP_PHASE -1
#endif
#define REP(k) for (int rep_ = 0; rep_ < ((k) == DUP_PHASE ? 2 : 1); ++rep_)
#define SEAM(k) do { if (IN(k) && IN((k) + 1)) xcd_barrier(bar); } while (0)

    const float* x = args.in[0]; const float* mem = args.in[1]; const float* norm_mix = args.in[2]; const float* w_in = args.in[3];
    const float* swa_sink = args.in[4]; const float* nat_rel_bias = args.in[5]; const float* out_norm_swa = args.in[6]; const float* out_norm_nat = args.in[7];
    const float* w_out = args.in[8]; const float* norm_mem_q = args.in[9]; const float* norm_mem_kv = args.in[10]; const float* w_mem_q = args.in[11];
    const float* w_mem_k = args.in[12]; const float* w_mem_v = args.in[13]; const float* w_mem_o = args.in[14]; const float* norm_ffn = args.in[15];
    const float* w_peer_q = args.in[16]; const float* peer_sub_keys = args.in[17]; const float* peer_u = args.in[18]; const float* peer_v = args.in[19];
    const float* norm_final = args.in[20];
    float* out = args.out;
    float* ropec = (float*)(ws + WS_ROPE); float* ropes = ropec + 2048 * 64;
    bf16* SKB = (bf16*)(ws + WS_SKB);
    bf16* WIN_T = (bf16*)(ws + WS_WIN); bf16* WOUT_T = (bf16*)(ws + WS_WOUT); bf16* WMQ_T = (bf16*)(ws + WS_WMQ); bf16* WMKV_T = (bf16*)(ws + WS_WMKV);
    bf16* WMO_T = (bf16*)(ws + WS_WMO); bf16* WPQ_T = (bf16*)(ws + WS_WPQ); bf16* UB = (bf16*)(ws + WS_UB); bf16* VB = (bf16*)(ws + WS_VB);
    bf16* XN = (bf16*)(ws + WS_XN); bf16* QKV = (bf16*)(ws + WS_QKV); bf16* OB = (bf16*)(ws + WS_OB); bf16* MEMN = (bf16*)(ws + WS_MEMN);
    bf16* KVM = (bf16*)(ws + WS_KVM); bf16* QM = (bf16*)(ws + WS_QM); bf16* OM = (bf16*)(ws + WS_OM); bf16* QP = (bf16*)(ws + WS_QP);
    int* IDX = (int*)(ws + WS_IDX); float* GATE = (float*)(ws + WS_GATE);
    float* SSQ1 = (float*)(ws + WS_SSQ1); float* SSQ2 = (float*)(ws + WS_SSQ2); float* SSQA = (float*)(ws + WS_SSQA); float* SSQB = (float*)(ws + WS_SSQB); float* SSQ0 = (float*)(ws + WS_SSQ0);
    unsigned char* XQ = ws + WS_XQ; float* SX = (float*)(ws + WS_SX);
    unsigned char* UQ = ws + WS_UQ; unsigned char* VQ = ws + WS_VQ; float* SU = (float*)(ws + WS_SU); float* SV = (float*)(ws + WS_SV);
    const int gw = vcu * NWAVES + wave, NGW = G * NWAVES;

    constexpr int I_IN = (DM / 64) * (INW / 32), I_OUT = (DM / 64) * (DM / 32), I_MQ = (DM / 64) * (MEMW / 32), I_MO = (MEMW / 64) * (DM / 32), I_PQ = (DM / 64) * (PQW / 32);
    constexpr int QR0 = 26624, QR1 = 28160;
#define QUANT_ROWS(first_, last_, w0_, nw_) quant_rows_strided((first_) + (w0_), (last_), (nw_), peer_u, peer_v, UQ, VQ, SU, SV, lane)
    if (IN(0)) REP(0) {
        LAS float* scr = (LAS float*)(lds + wave * 16384);
#ifdef DUP_P0A
        for (int rr_ = 0; rr_ < 2; ++rr_)
#endif
        for (int it = gw; it < I_IN; it += NGW) p0_transpose_item(w_in, DM, INW, WIN_T, 0, scr, it, lane, norm_mix, norm_mix + 2048);
        for (int m = gw; m < T_TOK; m += NGW) row_to_bf16_ssq(x + (size_t)m * DM, XN + (size_t)m * DM, SSQ0 + m, lane);
        for (int m = gw; m < NBATCH * MEMLEN; m += NGW) rms_row_to_bf16(mem + (size_t)m * DM, norm_mem_kv, MEMN + (size_t)m * DM, lane);
#ifdef DUP_P0C
        for (int rr_ = 0; rr_ < 2; ++rr_)
#endif
        QUANT_ROWS(0, QR0, gw, NGW);
#ifdef DUP_P0C_NOST
        quant_rows_strided<true>(gw, QR0, NGW, peer_u, peer_v, UQ, VQ, SU, SV, lane);
#endif
        for (int e = gw * 64 + lane; e < 4 * T_TOK; e += NGW * 64) SSQ1[e] = 0.f;
        for (int e = (gw * 64 + lane) * 4; e < 8 * 2 * 128 * 128; e += NGW * 64 * 4) { const f32x4 a = *(const GAS f32x4*)(peer_sub_keys + e); u32x2 w; w.x = cvtpk(a.x, a.y); w.y = cvtpk(a.z, a.w); *(GAS u32x2*)(SKB + e) = w; }
        for (int e = gw * 64 + lane; e < 2048 * 64; e += NGW * 64) {
            const int pos = e >> 6, i = e & 63;
            const float inv = fexp2(-(float)i * (13.287712379549449f / 64.0f));
            const float ang = (float)pos * inv;
            const float rev = ang * 0.15915494309189535f; const float fr = rev - floorf(rev);
            ropec[e] = __builtin_amdgcn_cosf(fr); ropes[e] = __builtin_amdgcn_sinf(fr);
        }
    }
    SEAM(0);
    if (IN(1)) REP(1) {
        { pg8::Gemm g{XN, WIN_T, T_TOK, INW, DM}; pg8::StaticOrder S; S.init(T_TOK, INW, G, bx);
          EpiBf16RowScale E{QKV, INW, SSQ0};
          pg8::gemm_phase<EpiBf16RowScale, pg8::StaticOrder, true, true>(lds, g, S, E); }
        if (bx >= G / 2) {
            LAS float* scr = (LAS float*)(lds + wave * 16384);
            const int w0 = (bx - G / 2) * NWAVES + wave, nw = (G - G / 2) * NWAVES;
            for (int it = w0; it < I_OUT + 3 * I_MQ; it += nw) {
                int r = it;
                if (r < I_OUT) { p0_transpose_item(w_out, DM, DM, WOUT_T, 0, scr, r, lane, out_norm_swa, out_norm_nat); continue; } r -= I_OUT;
                if (r < I_MQ) { p0_transpose_item(w_mem_q, DM, MEMW, WMQ_T, 0, scr, r, lane, norm_mem_q, norm_mem_q + 2048); continue; } r -= I_MQ;
                if (r < I_MQ) { p0_transpose_item(w_mem_k, DM, MEMW, WMKV_T, 0, scr, r, lane); continue; } r -= I_MQ;
                p0_transpose_item(w_mem_v, DM, MEMW, WMKV_T, MEMW, scr, r, lane);
            }
            QUANT_ROWS(QR0, QR1, w0, nw);
        }
    }
    SEAM(1);
    if (IN(2)) REP(2) {
        for (int u = vcu; u < 1024; u += G) {
#ifndef NO_SWA
            if (u < 512) swa_unit(lds, u, QKV, OB, swa_sink, ropec, ropes, SSQA);
#endif
#ifndef NO_NAT
            if (u >= 512) nat_unit(lds, u - 512, QKV, OB, nat_rel_bias, SSQB);
#endif
#ifdef PROBE_SWA2
            if (u < 512) swa_unit<true>(lds, u, QKV, (bf16*)(ws + WS_QP), swa_sink, ropec, ropes, (float*)(ws + 196608));
#endif
#ifdef PROBE_NAT2
            if (u >= 512) nat_unit(lds, u - 512, QKV, (bf16*)(ws + WS_QP), nat_rel_bias, (float*)(ws + 196608));
#endif
        }
    }
    SEAM(2);
    if (IN(4)) REP(4) {
        pg8::Gemm g{OB, WOUT_T, T_TOK, DM, DM}; pg8::StaticOrder S; S.init(T_TOK, DM, G, bx);
        EpiResHMid E{XN, SSQ1, DM, SSQA, SSQB, (LAS float*)(lds + RING_BYTES + 1024)};
        pg8::gemm_phase<EpiResHMid, pg8::StaticOrder, true, true, true>(lds, g, S, E);
    }
    SEAM(4);
    if (IN(6)) REP(6) {
        pg8::Gemm g{XN, WMQ_T, T_TOK, MEMW, DM}; pg8::StaticOrder S; S.init(T_TOK, MEMW, G, bx);
        EpiBf16RowScale E{QM, MEMW, SSQ1};
        pg8::gemm_phase<EpiBf16RowScale, pg8::StaticOrder, true, true>(lds, g, S, E);
        { pg8::Gemm g2{MEMN, WMKV_T, NBATCH * MEMLEN, 2 * MEMW, DM}; pg8::StaticOrder S2; S2.init(NBATCH * MEMLEN, 2 * MEMW, G, (bx + G / 2) % G);
          pg8::EpiBf16<0> E2{KVM, 2 * MEMW, nullptr, 0, 0, 1.f};
          pg8::gemm_phase<pg8::EpiBf16<0>, pg8::StaticOrder, true, true>(lds, g2, S2, E2); }
        if (bx >= G / 2 + 32) {
            LAS float* scr = (LAS float*)(lds + wave * 16384);
            const int w0 = (bx - (G / 2 + 32)) * NWAVES + wave, nw = (G - (G / 2 + 32)) * NWAVES;
            for (int it = w0; it < I_MO + I_PQ; it += nw) {
                if (it < I_MO) p0_transpose_item(w_mem_o, MEMW, DM, WMO_T, 0, scr, it, lane);
                else p0_transpose_item(w_peer_q, DM, PQW, WPQ_T, 0, scr, it - I_MO, lane, norm_ffn, norm_ffn + 2048);
            }
            QUANT_ROWS(QR1, 2 * NEXP, w0, nw);
        }
    }
    SEAM(6);
    if (IN(7)) REP(7) { for (int u = bx; u < 256; u += G) mem_unit(lds, u, QM, KVM, OM); }
    SEAM(7);
    if (IN(8)) {
        pg8::Gemm g{OM, WMO_T, T_TOK, DM, MEMW}; pg8::StaticOrder S; S.init(T_TOK, DM, G, bx);
        EpiResH E{XN, SSQ2, DM};
        pg8::gemm_phase<EpiResH, pg8::StaticOrder, true, true>(lds, g, S, E);
    }
    SEAM(8);
    if (IN(10)) REP(10) {
        pg8::Gemm g{XN, WPQ_T, T_TOK, PQW, DM}; pg8::StaticOrder S; S.init(T_TOK, PQW, G, bx);
        EpiBf16RowScale E{QP, PQW, SSQ2};
        pg8::gemm_phase<EpiBf16RowScale, pg8::StaticOrder, true, true>(lds, g, S, E);
#ifdef FUSE_ROUTE
        { pg8::Unit un; for (int i = 0; S.next(i, un); ++i) { asm volatile("s_waitcnt vmcnt(0)" ::: "memory"); route_unit(lds, un.pm * 8 + un.pn, QP, SKB, IDX, GATE); } }
        for (int m = gw; m < T_TOK; m += NGW) quant_token(m, XN, norm_ffn, SSQ2, XQ, SX, lane);
#endif
    }
#ifdef FUSE_ROUTE
    if (IN(10) && IN(12)) { xcd_barrier(bar); }
#else
    SEAM(10);
    if (IN(11)) REP(11) { for (int u = bx; u < 256; u += G) route_unit(lds, u, QP, SKB, IDX, GATE);
        for (int m = gw; m < T_TOK; m += NGW) quant_token(m, XN, norm_ffn, SSQ2, XQ, SX, lane); }
    SEAM(11);
#endif
    if (IN(12)) { __syncthreads(); peer_sweep(lds, wave, gw, NGW, XQ, SX, IDX, GATE, UQ, VQ, SU, SV, XN, out, norm_final, lane); }
#undef IN
#undef SEAM
}

constexpr int N_PHASES = 13;
#ifndef MK_N_LAUNCHES
#define MK_N_LAUNCHES 1
#endif

extern "C" void kernel_launch(void* const* d_in, const int* in_sizes, int n_in, void* d_out, int out_size, void* d_ws, size_t ws_size, hipStream_t stream) {
    static int grid = 0;
    if (grid == 0) {
        if (n_in != 21 || in_sizes[0] != T_TOK * DM || out_size != T_TOK * DM || ws_size < WS_END) { fprintf(stderr, "kernel_launch: unexpected shapes (n_in %d in0 %d out %d ws %zu)\n", n_in, n_in > 0 ? in_sizes[0] : -1, out_size, ws_size); grid = -1; return; }
        int dev = 0, cus = 0, per_cu = 0;
        if (hipGetDevice(&dev) != hipSuccess || hipDeviceGetAttribute(&cus, hipDeviceAttributeMultiprocessorCount, dev) != hipSuccess) { grid = -1; return; }
        if (hipFuncSetAttribute((const void*)hymba_fwd, hipFuncAttributeMaxDynamicSharedMemorySize, LDS_BYTES) != hipSuccess) { fprintf(stderr, "kernel_launch: hipFuncSetAttribute failed\n"); grid = -1; return; }
        if (hipOccupancyMaxActiveBlocksPerMultiprocessor(&per_cu, (const void*)hymba_fwd, NWAVES * 64, LDS_BYTES) != hipSuccess || per_cu < 1) fprintf(stderr, "kernel_launch: occupancy query says %d\n", per_cu);
        (void)hipGetLastError();
        grid = cus;
    }
    if (grid < 0) return;
    if (hipMemsetAsync((char*)d_ws + WS_CTL, 0, CTL_ZERO_BYTES, stream) != hipSuccess) return;
    Args a{};
    for (int i = 0; i < 21; ++i) a.in[i] = (const float*)d_in[i];
    a.out = (float*)d_out; a.ws = (unsigned char*)d_ws;
#if MK_N_LAUNCHES == 1
    a.ph_lo = 0; a.ph_hi = N_PHASES;
    hipLaunchKernelGGL(hymba_fwd, dim3(grid), dim3(NWAVES * 64), LDS_BYTES, stream, a);
#else
    for (int p = 0; p < N_PHASES; ++p) { a.ph_lo = p; a.ph_hi = p + 1; hipLaunchKernelGGL(hymba_fwd, dim3(grid), dim3(NWAVES * 64), LDS_BYTES, stream, a); }
#endif
}
```

```cpp
#include <hip/hip_runtime.h>
#include <cstdio>
#include <cstdint>
namespace pg8 {
#define PG8_LAS __attribute__((address_space(3)))
typedef unsigned short bf16_t;
typedef short bf16x8 __attribute__((ext_vector_type(8)));
typedef float f32x4 __attribute__((ext_vector_type(4)));
typedef unsigned u32x4 __attribute__((ext_vector_type(4)));
constexpr int BM = 256, BK = 64, HALF = 128, HTB = HALF * BK * 2  , STAGE_BYTES = 8 * HTB, NXCD = 8, WGM = 8;

__host__ __device__ __forceinline__ int lds_byte(int r, int c) { const int st = (r >> 4) * 2 + (c >> 5), rr = r & 15, cc = c & 31, ob = rr * 64 + cc * 2; return st * 1024 + (ob ^ (((ob >> 9) & 1) << 5)); }
__host__ __device__ __forceinline__ void stage_rc(int b, int& R, int& C) { const int st = b / 1024, sb = b % 1024, swz = sb ^ (((sb >> 9) & 1) << 5); R = (st >> 1) * 16 + swz / 64; C = (st & 1) * 32 + (swz % 64) / 2; }
__host__ __device__ __forceinline__ int perm32(int rho) { const int n = rho >> 4, i = rho & 15; return 8 * (i >> 2) + 4 * n + (i & 3); }

struct Unit { int pm, pn; };
struct Gemm { const bf16_t* A; const bf16_t* Bt; int M, N, K; };

struct StaticOrder {
    int nM, nN, nwg, G, c;
    __host__ __device__ void init(int M, int N, int G_, int c_) { nM = M / BM; nN = N / BM; nwg = nM * nN; G = G_; c = c_; }
    __host__ __device__ bool next(int i, Unit& u) const {
        const long L = (long)i * G + c; if (L >= nwg) return false;
        int wgid = (int)L; { const int q = nwg / NXCD, r = nwg % NXCD, xcd = wgid % NXCD, off = wgid / NXCD; wgid = (xcd < r ? xcd * (q + 1) : r * (q + 1) + (xcd - r) * q) + off; }
        const int nig = WGM * nN, gid = wgid / nig, fm = gid * WGM, gsz = (nM - fm) < WGM ? (nM - fm) : WGM;
        u.pm = fm + ((wgid % nig) % gsz); u.pn = (wgid % nig) / gsz; return true;
    }
    __device__ __forceinline__ void a_ready(const Unit&) const {}
    __device__ __forceinline__ void done(const Unit&) const {}
};

__device__ __forceinline__ unsigned cvt_pk_bf16(float lo, float hi) { unsigned r; asm volatile("v_cvt_pk_bf16_f32 %0, %1, %2" : "=v"(r) : "v"(lo), "v"(hi)); return r; }
typedef float f32x2 __attribute__((ext_vector_type(2)));
__device__ __forceinline__ f32x2 gelu_pk(f32x2 v) {
    const f32x2 av = __builtin_elementwise_abs(v), d = av * 0.2316418882f + 1.0f;
    f32x2 t; t.x = __builtin_amdgcn_rcpf(d.x); t.y = __builtin_amdgcn_rcpf(d.y);
    f32x2 q = t * 0.5307027145f + (-0.7265760135f); q = q * t + 0.7107068705f; q = q * t + (-0.142248368f); q = q * t + 0.127414796f; q = q * t;
    const f32x2 s = (v * v) * (-0.72134752044f);
    f32x2 e; e.x = __builtin_amdgcn_exp2f(s.x); e.y = __builtin_amdgcn_exp2f(s.y);
    const f32x2 m = v * (q * e), r = v - m;
    f32x2 o; o.x = v.x < 0.f ? m.x : r.x; o.y = v.y < 0.f ? m.y : r.y; return o;
}

template <int ACT  > struct EpiBf16 {
    static constexpr bool PERM = true, AFTER_DRAIN = false; static_assert(ACT == 0 || ACT == 1, "EpiBf16: ACT is 0 (none) or 1 (gelu_pk)");
    bf16_t* O; int ldc; const float* bias; int split_cols; size_t split_stride; float scale0;
    __device__ __forceinline__ void operator()(const f32x4 (&acc)[2][2][4][2], const Unit& u, int wr, int wc, int fr, int fq) const {
        const int row0 = u.pm * BM + wr * 64 + fr; int colt = u.pn * BM; bf16_t* base = O;
        float sc = 1.f; if (split_cols) { const int t = colt / split_cols; base += (size_t)t * split_stride; colt -= t * split_cols; if (t == 0) sc = scale0; }
        const int col0 = colt + wc * 32 + 8 * fq, bcol0 = u.pn * BM + wc * 32 + 8 * fq;
        f32x4 bv[2][2];
#pragma unroll
        for (int bj = 0; bj < 2; ++bj)
#pragma unroll
            for (int n = 0; n < 2; ++n) bv[bj][n] = bias ? *(const f32x4*)(bias + bcol0 + bj * HALF + 4 * n) : (f32x4){0.f, 0.f, 0.f, 0.f};
#pragma unroll
        for (int ai = 0; ai < 2; ++ai)
#pragma unroll
            for (int m = 0; m < 4; ++m) { bf16_t* rowp = base + (size_t)(row0 + ai * HALF + m * 16) * ldc + col0;
#pragma unroll
                for (int bj = 0; bj < 2; ++bj) { f32x4 v0 = acc[ai][bj][m][0] + bv[bj][0], v1 = acc[ai][bj][m][1] + bv[bj][1];
                    if (ACT == 1) { f32x2 a = gelu_pk((f32x2){v0[0], v0[1]}), b = gelu_pk((f32x2){v0[2], v0[3]}), c = gelu_pk((f32x2){v1[0], v1[1]}), d = gelu_pk((f32x2){v1[2], v1[3]});
                        v0 = (f32x4){a.x, a.y, b.x, b.y}; v1 = (f32x4){c.x, c.y, d.x, d.y}; }
                    v0 = v0 * sc; v1 = v1 * sc; u32x4 w; w.x = cvt_pk_bf16(v0[0], v0[1]); w.y = cvt_pk_bf16(v0[2], v0[3]); w.z = cvt_pk_bf16(v1[0], v1[1]); w.w = cvt_pk_bf16(v1[2], v1[3]);
                    *(u32x4*)(rowp + bj * HALF) = w; } }
    }
};

struct PanelStats {
    unsigned* xbuf;
    unsigned* cnt;
    unsigned* tmo;
    int ntn; float eps;
    unsigned code;
    __device__ __forceinline__ bool run(const f32x4 (&v)[2][2][4][2], const Unit& u, int wr, int wc, int fr, int fq, PG8_LAS unsigned char* lds, int wid, int lane) const {
        typedef float f32x2v __attribute__((ext_vector_type(2)));
        PG8_LAS f32x2v* P = (PG8_LAS f32x2v*)lds;
        PG8_LAS f32x2v* S = (PG8_LAS f32x2v*)(lds + 8192);
        PG8_LAS unsigned* flag = (PG8_LAS unsigned*)(lds + 8192 + 2048);
#pragma unroll
        for (int ai = 0; ai < 2; ++ai)
#pragma unroll
            for (int m = 0; m < 4; ++m) {
                float s = 0.f;
#pragma unroll
                for (int bj = 0; bj < 2; ++bj)
#pragma unroll
                    for (int n = 0; n < 2; ++n) { const f32x4 x = v[ai][bj][m][n]; s += (x[0] + x[1]) + (x[2] + x[3]); }
                s += __shfl_xor(s, 16); s += __shfl_xor(s, 32);
                const float mw = s * (1.0f / 64.0f); float q = 0.f;
#pragma unroll
                for (int bj = 0; bj < 2; ++bj)
#pragma unroll
                    for (int n = 0; n < 2; ++n) { const f32x4 d = v[ai][bj][m][n] - mw; q += (d[0] * d[0] + d[1] * d[1]) + (d[2] * d[2] + d[3] * d[3]); }
                q += __shfl_xor(q, 16); q += __shfl_xor(q, 32);
                if (fq == 0) P[(ai * HALF + wr * 64 + m * 16 + fr) * 4 + wc] = (f32x2v){mw, q};
            }
        asm volatile("s_waitcnt lgkmcnt(0)" ::: "memory"); __builtin_amdgcn_s_barrier(); asm volatile("" ::: "memory");
#if defined(BROKEN_EXCHANGE_NO_WAIT)
#warning BROKEN CONTROL BUILD: the row-statistics exchange does not wait; results are wrong by design
        if (blockIdx.x >= 64) { const long long t0_ = clock64(); while (clock64() - t0_ < 60000) __builtin_amdgcn_s_sleep(8); }
#endif
        const int row = wid * 32 + (lane & 31);
        if (lane < 32) {
            const f32x2v a = P[row * 4 + 0], b = P[row * 4 + 1], c = P[row * 4 + 2], d = P[row * 4 + 3];
            const float mt = (a.x + b.x + c.x + d.x) * 0.25f;
            const float da = a.x - mt, db = b.x - mt, dc = c.x - mt, dd = d.x - mt;
            const float m2 = (a.y + b.y) + (c.y + d.y) + 64.0f * ((da * da + db * db) + (dc * dc + dd * dd));
            unsigned long long* slot = (unsigned long long*)xbuf + ((size_t)(u.pm * BM + row) * 4 + u.pn);
            __hip_atomic_store(slot, ((unsigned long long)__float_as_uint(m2) << 32) | __float_as_uint(mt), __ATOMIC_RELAXED, __HIP_MEMORY_SCOPE_AGENT);
        }
        asm volatile("s_waitcnt vmcnt(0)" ::: "memory");
        if (lane == 0) __hip_atomic_fetch_add(cnt + 64 * u.pm, 1u, __ATOMIC_RELAXED, __HIP_MEMORY_SCOPE_AGENT);
        if (wid == 0) {
            bool dead = false; const unsigned long long t0 = __builtin_amdgcn_s_memrealtime(); const unsigned want = 8u * (unsigned)ntn;
            for (;;) {
#if defined(BROKEN_EXCHANGE_NO_WAIT)
                break;
#endif
                if ((unsigned)__builtin_amdgcn_readfirstlane(__hip_atomic_load(cnt + 64 * u.pm, __ATOMIC_RELAXED, __HIP_MEMORY_SCOPE_AGENT)) >= want) break;
                if (__builtin_amdgcn_s_memrealtime() - t0 > 2000000ull) {
                    if (lane == 0) { unsigned expect = 0u; __hip_atomic_compare_exchange_strong(tmo + 1, &expect, code | (unsigned)(u.pm & 0xff), __ATOMIC_RELAXED, __ATOMIC_RELAXED, __HIP_MEMORY_SCOPE_AGENT);
                                     __hip_atomic_store(tmo, 1u, __ATOMIC_RELAXED, __HIP_MEMORY_SCOPE_AGENT); }
                    dead = true; break; }
                __builtin_amdgcn_s_sleep(2);
            }
            __builtin_amdgcn_fence(__ATOMIC_ACQUIRE, "agent");
            if (lane == 0) flag[0] = dead ? 1u : 0u;
        }
        asm volatile("s_waitcnt vmcnt(0) lgkmcnt(0)" ::: "memory"); __builtin_amdgcn_s_barrier(); asm volatile("" ::: "memory");
        const bool bad = flag[0] != 0u;
        if (lane < 32) {
            const unsigned long long* slot = (const unsigned long long*)xbuf + (size_t)(u.pm * BM + row) * 4; float mt[4], m2[4]; float ms = 0.f;
#pragma unroll
            for (int t = 0; t < 4; ++t) { if (t < ntn) { const unsigned long long w = __hip_atomic_load(slot + t, __ATOMIC_RELAXED, __HIP_MEMORY_SCOPE_AGENT); mt[t] = __uint_as_float((unsigned)w); m2[t] = __uint_as_float((unsigned)(w >> 32)); } else { mt[t] = 0.f; m2[t] = 0.f; } ms += mt[t]; }
            const float mean = ms / (float)ntn; float q = 0.f;
#pragma unroll
            for (int t = 0; t < 4; ++t) if (t < ntn) { const float dm = mt[t] - mean; q += m2[t] + 256.0f * dm * dm; }
            S[row] = (f32x2v){mean, 1.0f / sqrtf(q / (256.0f * (float)ntn) + eps)};
        }
        asm volatile("s_waitcnt lgkmcnt(0)" ::: "memory"); __builtin_amdgcn_s_barrier(); asm volatile("" ::: "memory");
        return bad;
    }
};
struct EpiLnRes {
    static constexpr bool PERM = false, AFTER_DRAIN = true;
    const float* base; float* out; int ldc; const float* bias; PanelStats st; unsigned poison;
    __device__ __forceinline__ void fused(f32x4 (&acc)[2][2][4][2], const Unit& u, int wr, int wc, int fr, int fq, PG8_LAS unsigned char* lds, int wid, int lane) const {
        typedef float f32x2v __attribute__((ext_vector_type(2)));
        const PG8_LAS f32x2v* S = (const PG8_LAS f32x2v*)(lds + 8192);
        const int col0 = u.pn * BM + wc * 32 + 4 * fq;
#pragma unroll
        for (int bj = 0; bj < 2; ++bj)
#pragma unroll
            for (int n = 0; n < 2; ++n) { const f32x4 bv = bias ? *(const f32x4*)(bias + col0 + bj * HALF + n * 16) : (f32x4){0.f, 0.f, 0.f, 0.f};
#pragma unroll
                for (int ai = 0; ai < 2; ++ai)
#pragma unroll
                    for (int m = 0; m < 4; ++m) acc[ai][bj][m][n] += bv; }
        f32x4 pre[4][2][2];
#pragma unroll
        for (int m = 0; m < 4; ++m) { const size_t off = (size_t)(u.pm * BM + wr * 64 + m * 16 + fr) * ldc + col0;
#pragma unroll
            for (int bj = 0; bj < 2; ++bj)
#pragma unroll
                for (int n = 0; n < 2; ++n) pre[m][bj][n] = *(const f32x4*)(base + off + bj * HALF + n * 16); }
        const bool bad = st.run(acc, u, wr, wc, fr, fq, lds, wid, lane) || poison != 0u;
        const float qnan = __builtin_nanf("");
#pragma unroll
        for (int ai = 0; ai < 2; ++ai)
#pragma unroll
            for (int m = 0; m < 4; ++m) { const int r = ai * HALF + wr * 64 + m * 16 + fr; const f32x2v sr = S[r]; const size_t off = (size_t)(u.pm * BM + r) * ldc + col0;
#pragma unroll
                for (int bj = 0; bj < 2; ++bj)
#pragma unroll
                    for (int n = 0; n < 2; ++n) { const f32x4 bs = ai == 0 ? pre[m][bj][n] : *(const f32x4*)(base + off + bj * HALF + n * 16); f32x4 o = bs + (acc[ai][bj][m][n] - sr.x) * sr.y;
                        if (bad) o = (f32x4){qnan, qnan, qnan, qnan}; *(f32x4*)(out + off + bj * HALF + n * 16) = o; }
                if (m & 1) asm volatile("" ::: "memory"); }
    }
};
struct EpiLnResLn {
    static constexpr bool PERM = false, AFTER_DRAIN = true;
    const float* base; float* out; bf16_t* xn; int ldc; const float* bias; PanelStats st1, st2; unsigned poison;
    __device__ __forceinline__ void fused(f32x4 (&acc)[2][2][4][2], const Unit& u, int wr, int wc, int fr, int fq, PG8_LAS unsigned char* lds, int wid, int lane) const {
        typedef float f32x2v __attribute__((ext_vector_type(2))); typedef unsigned u32x2v __attribute__((ext_vector_type(2)));
        const PG8_LAS f32x2v* S = (const PG8_LAS f32x2v*)(lds + 8192);
        const int col0 = u.pn * BM + wc * 32 + 4 * fq;
#pragma unroll
        for (int bj = 0; bj < 2; ++bj)
#pragma unroll
            for (int n = 0; n < 2; ++n) { const f32x4 bv = bias ? *(const f32x4*)(bias + col0 + bj * HALF + n * 16) : (f32x4){0.f, 0.f, 0.f, 0.f};
#pragma unroll
                for (int ai = 0; ai < 2; ++ai)
#pragma unroll
                    for (int m = 0; m < 4; ++m) acc[ai][bj][m][n] += bv; }
        bool bad = st1.run(acc, u, wr, wc, fr, fq, lds, wid, lane) || poison != 0u;
        const float qnan = __builtin_nanf("");
#pragma unroll
        for (int ai = 0; ai < 2; ++ai)
#pragma unroll
            for (int m = 0; m < 4; ++m) { const int r = ai * HALF + wr * 64 + m * 16 + fr; const f32x2v sr = S[r]; const size_t off = (size_t)(u.pm * BM + r) * ldc + col0;
#pragma unroll
                for (int bj = 0; bj < 2; ++bj)
#pragma unroll
                    for (int n = 0; n < 2; ++n) { const f32x4 bs = *(const f32x4*)(base + off + bj * HALF + n * 16); acc[ai][bj][m][n] = bs + (acc[ai][bj][m][n] - sr.x) * sr.y; }
                asm volatile("" : "+v"(acc[ai][0][m][0]), "+v"(acc[ai][0][m][1]), "+v"(acc[ai][1][m][0]), "+v"(acc[ai][1][m][1]));
                if (m & 1) asm volatile("" ::: "memory"); }
        const bool bad1 = bad;
        bad = st2.run(acc, u, wr, wc, fr, fq, lds, wid, lane) || bad;
#pragma unroll
        for (int ai = 0; ai < 2; ++ai)
#pragma unroll
            for (int m = 0; m < 4; ++m) { const int r = ai * HALF + wr * 64 + m * 16 + fr; const f32x2v sr = S[r]; const size_t off = (size_t)(u.pm * BM + r) * ldc + col0;
#pragma unroll
                for (int bj = 0; bj < 2; ++bj)
#pragma unroll
                    for (int n = 0; n < 2; ++n) { const f32x4 x1 = acc[ai][bj][m][n]; *(f32x4*)(out + off + bj * HALF + n * 16) = bad1 ? (f32x4){qnan, qnan, qnan, qnan} : x1;
                        const f32x4 o = (x1 - sr.x) * sr.y; u32x2v w; w.x = cvt_pk_bf16(o[0], o[1]); w.y = cvt_pk_bf16(o[2], o[3]);
                        if (bad) { w.x = 0x7fc07fc0u; w.y = 0x7fc07fc0u; } *(u32x2v*)(xn + off + bj * HALF + n * 16) = w; }
                asm volatile("" ::: "memory"); }
    }
};

template <class Epi, class Sched, bool ALIGN_EPI = false, bool SP2 = false, bool MID = false>
__device__ __forceinline__ void gemm_phase(PG8_LAS unsigned char* lds, const Gemm g, const Sched& S, const Epi& E) {
    const int tid = threadIdx.x, wid = __builtin_amdgcn_readfirstlane(tid >> 6), lane = tid & 63, wr = wid >> 2, wc = wid & 3, fr = lane & 15, fq = lane >> 4;
    const int K = g.K, nt = K / BK;
    unsigned voffA[2], voffB[2];
#pragma unroll
    for (int i = 0; i < 2; ++i) { int R, C; stage_rc(tid * 16 + i * 8192, R, C); const int Rb = Epi::PERM ? ((R & ~31) + perm32(R & 31)) : R;
        voffA[i] = (unsigned)(R * K + C) * 2u; voffB[i] = (unsigned)(Rb * K + C) * 2u; }
    const size_t kstep = (size_t)(BK * 2);
    const size_t hstep = (size_t)HALF * K * 2;
    const size_t tstep = 2 * hstep;
    const unsigned ldsw = (unsigned)wid * 1024u;
    const int aoff = lds_byte(wr * 64 + fr, fq * 8), boff = lds_byte(wc * 32 + fr, fq * 8);
#define PG8_SA(b, h) (((b) * 2 + (h)) * HTB)
#define PG8_SB(b, h) ((4 + (b) * 2 + (h)) * HTB)
#define PG8_STAGE(bufoff, gbase, voff) do { _Pragma("unroll") for (int _i = 0; _i < 2; ++_i) \
        __builtin_amdgcn_global_load_lds((const unsigned*)((const char*)(gbase) + (voff)[_i]), (PG8_LAS unsigned*)(lds + (bufoff) + ldsw + _i * 8192), 16, 0, 0); } while (0)
#define PG8_LDA(dst, b, h) do { _Pragma("unroll") for (int m = 0; m < 4; ++m) _Pragma("unroll") for (int k = 0; k < 2; ++k) dst[m][k] = *(const PG8_LAS bf16x8*)(lds + PG8_SA(b, h) + aoff + m * 2048 + k * 1024); } while (0)
#define PG8_LDB(dst, b, h) do { _Pragma("unroll") for (int n = 0; n < 2; ++n) _Pragma("unroll") for (int k = 0; k < 2; ++k) dst[n][k] = *(const PG8_LAS bf16x8*)(lds + PG8_SB(b, h) + boff + n * 2048 + k * 1024); } while (0)
#define PG8_MMA(ai, bj, At, Bt) do { __builtin_amdgcn_s_setprio(1); _Pragma("unroll") for (int m = 0; m < 4; ++m) _Pragma("unroll") for (int n = 0; n < 2; ++n) _Pragma("unroll") for (int k = 0; k < 2; ++k) \
        acc[ai][bj][m][n] = __builtin_amdgcn_mfma_f32_16x16x32_bf16(Bt[n][k], At[m][k], acc[ai][bj][m][n], 0, 0, 0); __builtin_amdgcn_s_setprio(0); } while (0)
#define PG8_WAIT_V(n) asm volatile("s_waitcnt vmcnt(" #n ")" ::: "memory")
#define PG8_WAIT_L(n) asm volatile("s_waitcnt lgkmcnt(" #n ")" ::: "memory")
#define PG8_BAR __builtin_amdgcn_s_barrier()
#define PG8_SCHED __builtin_amdgcn_sched_barrier(0)
    Unit cur, nxt; int ui = 0;
    if (!S.next(0, cur)) return;
    f32x4 acc[2][2][4][2];
#pragma unroll
    for (int a = 0; a < 2; ++a)
#pragma unroll
        for (int b = 0; b < 2; ++b)
#pragma unroll
            for (int m = 0; m < 4; ++m)
#pragma unroll
                for (int n = 0; n < 2; ++n) acc[a][b][m][n] = (f32x4){0.f, 0.f, 0.f, 0.f};
    bf16x8 At[4][2], B0[2][2], B1[2][2];
    const char* cA = (const char*)g.A + (size_t)cur.pm * tstep; const char* cB = (const char*)g.Bt + (size_t)cur.pn * tstep;
    if constexpr (MID) E.load_mid(cur);
    S.a_ready(cur);
    if constexpr (SP2) {
        PG8_STAGE(PG8_SB(0, 0), cB, voffB); PG8_STAGE(PG8_SB(0, 1), cB + hstep, voffB); PG8_STAGE(PG8_SA(0, 0), cA, voffA); PG8_STAGE(PG8_SA(0, 1), cA + hstep, voffA);
        if (wr == 1) PG8_BAR;
        PG8_WAIT_V(2); PG8_BAR;
        PG8_STAGE(PG8_SB(1, 0), cB + kstep, voffB); PG8_STAGE(PG8_SA(1, 0), cA + kstep, voffA); PG8_STAGE(PG8_SB(1, 1), cB + hstep + kstep, voffB);
        PG8_WAIT_V(6); PG8_BAR;
    } else {
        PG8_STAGE(PG8_SB(0, 0), cB, voffB); PG8_STAGE(PG8_SA(0, 0), cA, voffA); PG8_STAGE(PG8_SB(0, 1), cB + hstep, voffB); PG8_STAGE(PG8_SA(0, 1), cA + hstep, voffA);
        if (wr == 1) PG8_BAR;
        PG8_WAIT_V(4); PG8_BAR;
        PG8_STAGE(PG8_SB(1, 0), cB + kstep, voffB); PG8_STAGE(PG8_SA(1, 0), cA + kstep, voffA); PG8_STAGE(PG8_SB(1, 1), cB + hstep + kstep, voffB);
        PG8_WAIT_V(6); PG8_BAR;
    }
    for (;;) {
        const bool has_next = S.next(ui + 1, nxt);
        const char* nA = has_next ? (const char*)g.A + (size_t)nxt.pm * tstep : cA; const char* nB = has_next ? (const char*)g.Bt + (size_t)nxt.pn * tstep : cB;
        for (int t = 0; t < nt; t += 2) {
            if constexpr (MID) { if (t == nt / 2) {
#pragma unroll
                for (int a = 0; a < 2; ++a)
#pragma unroll
                    for (int m = 0; m < 4; ++m)
#pragma unroll
                        for (int b = 0; b < 2; ++b)
#pragma unroll
                            for (int n = 0; n < 2; ++n) acc[a][b][m][n] = acc[a][b][m][n] * E.mid(a * 128 + wr * 64 + m * 16 + fr);
            } }
            const bool last = (t == nt - 2);
            const char* a1 = cA + (size_t)(t + 1) * kstep;
            const char* a2 = last ? nA : cA + (size_t)(t + 2) * kstep; const char* b2 = last ? nB : cB + (size_t)(t + 2) * kstep;
            const char* a3 = a2 + kstep; const char* b3 = b2 + kstep;
            if (last && has_next) S.a_ready(nxt);
            if constexpr (SP2) {
            PG8_LDB(B0, 0, 0); PG8_LDB(B1, 0, 1); PG8_SCHED; PG8_LDA(At, 0, 0); PG8_STAGE(PG8_SA(1, 1), a1 + hstep, voffA);
            PG8_WAIT_V(8); PG8_WAIT_L(0); PG8_BAR; PG8_MMA(0, 0, At, B0); PG8_MMA(0, 1, At, B1); PG8_BAR; PG8_SCHED;
            PG8_LDA(At, 0, 1); PG8_STAGE(PG8_SB(0, 0), b2, voffB); PG8_STAGE(PG8_SB(0, 1), b2 + hstep, voffB); PG8_STAGE(PG8_SA(0, 0), a2, voffA);
            PG8_WAIT_V(8); PG8_WAIT_L(0); PG8_BAR; PG8_MMA(1, 0, At, B0); PG8_MMA(1, 1, At, B1); PG8_BAR; PG8_SCHED;
            PG8_LDB(B0, 1, 0); PG8_LDB(B1, 1, 1); PG8_SCHED; PG8_LDA(At, 1, 0); PG8_STAGE(PG8_SA(0, 1), a2 + hstep, voffA);
            PG8_WAIT_V(8); PG8_WAIT_L(0); PG8_BAR; PG8_MMA(0, 0, At, B0); PG8_MMA(0, 1, At, B1); PG8_BAR; PG8_SCHED;
            PG8_LDA(At, 1, 1); PG8_STAGE(PG8_SB(1, 0), b3, voffB); PG8_STAGE(PG8_SB(1, 1), b3 + hstep, voffB); PG8_STAGE(PG8_SA(1, 0), a3, voffA);
            PG8_WAIT_V(8); PG8_WAIT_L(0); PG8_BAR; PG8_MMA(1, 0, At, B0); PG8_MMA(1, 1, At, B1); PG8_BAR; PG8_SCHED;
            } else {
            PG8_LDB(B0, 0, 0); PG8_SCHED; PG8_LDA(At, 0, 0); PG8_STAGE(PG8_SA(1, 1), a1 + hstep, voffA);
            PG8_WAIT_L(8); PG8_BAR; PG8_WAIT_L(0); PG8_MMA(0, 0, At, B0); PG8_BAR; PG8_SCHED;
            PG8_LDB(B1, 0, 1); PG8_STAGE(PG8_SB(0, 0), b2, voffB);
            PG8_BAR; PG8_WAIT_L(0); PG8_MMA(0, 1, At, B1); PG8_BAR;
            PG8_LDA(At, 0, 1); PG8_STAGE(PG8_SA(0, 0), a2, voffA);
            PG8_BAR; PG8_WAIT_L(0); PG8_MMA(1, 0, At, B0); PG8_BAR; PG8_SCHED;
            PG8_STAGE(PG8_SB(0, 1), b2 + hstep, voffB);
            PG8_WAIT_V(6); PG8_BAR; PG8_MMA(1, 1, At, B1); PG8_BAR;
            PG8_LDB(B0, 1, 0); PG8_SCHED; PG8_LDA(At, 1, 0); PG8_STAGE(PG8_SA(0, 1), a2 + hstep, voffA);
            PG8_WAIT_L(8); PG8_BAR; PG8_WAIT_L(0); PG8_MMA(0, 0, At, B0); PG8_BAR; PG8_SCHED;
            PG8_LDB(B1, 1, 1); PG8_STAGE(PG8_SB(1, 0), b3, voffB);
            PG8_BAR; PG8_WAIT_L(0); PG8_MMA(0, 1, At, B1); PG8_BAR;
            PG8_LDA(At, 1, 1); PG8_STAGE(PG8_SA(1, 0), a3, voffA);
            PG8_BAR; PG8_WAIT_L(0); PG8_MMA(1, 0, At, B0); PG8_BAR; PG8_SCHED;
            PG8_STAGE(PG8_SB(1, 1), b3 + hstep, voffB);
            PG8_WAIT_V(6); PG8_BAR; PG8_MMA(1, 1, At, B1); PG8_BAR;
            }
        }
        if constexpr (ALIGN_EPI) { if (wr == 0) PG8_BAR; }
        if constexpr (!Epi::AFTER_DRAIN) { E(acc, cur, wr, wc, fr, fq); S.done(cur); }
        if (!has_next) break;
#pragma unroll
        for (int a = 0; a < 2; ++a)
#pragma unroll
            for (int b = 0; b < 2; ++b)
#pragma unroll
                for (int m = 0; m < 4; ++m)
#pragma unroll
                    for (int n = 0; n < 2; ++n) acc[a][b][m][n] = (f32x4){0.f, 0.f, 0.f, 0.f};
        cur = nxt; cA = nA; cB = nB; ++ui;
        if constexpr (MID) E.load_mid(cur);
        if constexpr (ALIGN_EPI) { if (wr == 1) PG8_BAR; }
    }
    PG8_WAIT_V(0);
    if constexpr (!ALIGN_EPI) { if (wr == 0) PG8_BAR; }
    PG8_BAR;
    if constexpr (Epi::AFTER_DRAIN) { E.fused(acc, cur, wr, wc, fr, fq, lds, wid, lane); S.done(cur); }
#undef PG8_SA
#undef PG8_SB
#undef PG8_STAGE
#undef PG8_LDA
#undef PG8_LDB
#undef PG8_MMA
#undef PG8_WAIT_V
#undef PG8_WAIT_L
#undef PG8_BAR
#undef PG8_SCHED
}
}
#define GAS __attribute__((address_space(1)))
#define LAS __attribute__((address_space(3)))
typedef unsigned short bf16;
typedef unsigned v4u __attribute__((ext_vector_type(4)));
typedef float f32x4 __attribute__((ext_vector_type(4)));
typedef short bf16x8 __attribute__((ext_vector_type(8)));
typedef GAS unsigned gu32;
typedef GAS unsigned long long gu64;
#define RLX_AGENT __ATOMIC_RELAXED, __HIP_MEMORY_SCOPE_AGENT
#define LDS_WAIT() asm volatile("s_waitcnt lgkmcnt(0)" ::: "memory")
#define VM_WAIT() asm volatile("s_waitcnt vmcnt(0)" ::: "memory")
__device__ __forceinline__ unsigned long long rt() { return __builtin_amdgcn_s_memrealtime(); }
__device__ __forceinline__ unsigned f2bf(float f) { unsigned u = __builtin_bit_cast(unsigned, f); return (u + 0x7fffu + ((u >> 16) & 1u)) >> 16; }
__device__ __forceinline__ unsigned pk2(float lo, float hi) { return f2bf(lo) | (f2bf(hi) << 16); }

#define XB_TMO      128
#define XB_XCNT(j)  (256  + 64 * (j))
#define XB_XSUB(j)  (1280 + 64 * (j))
#define XB_XGEN(j)  (2304 + 64 * (j))
#define XB_TOP      3328
#define XB_TOPGEN   3392
#define XCD_BAR_WORDS 3456
#define XB_SPIN_CAP (1u << 18)

__device__ __forceinline__ unsigned xb_ld(unsigned* p)              { return __hip_atomic_load(p, __ATOMIC_RELAXED, __HIP_MEMORY_SCOPE_AGENT); }
__device__ __forceinline__ unsigned xb_add(unsigned* p, unsigned v) { return __hip_atomic_fetch_add(p, v, __ATOMIC_RELAXED, __HIP_MEMORY_SCOPE_AGENT); }
__device__ __forceinline__ unsigned xb_xcc_id() { return (unsigned)__builtin_amdgcn_s_getreg((3 << 11) | 20) & 0xFu; }
#define XB_SPIN(cond, bar) do { unsigned _sp = 0; while (cond) { __builtin_amdgcn_s_sleep(1); \
    if ((++_sp & 255u) == 0u) { if (xb_ld(&(bar)[XB_TMO])) break; if (_sp > XB_SPIN_CAP) { atomicAdd(&(bar)[XB_TMO], 1u); break; } } } } while (0)

struct XcdBarrier {
    unsigned* bar; unsigned x;
    volatile LAS unsigned* st;
};

__device__ __forceinline__ XcdBarrier xcd_barrier_post(unsigned* bar, volatile LAS unsigned* st) {
    XcdBarrier b; b.bar = bar; b.x = xb_xcc_id(); b.st = st;
    if (threadIdx.x == 0) (void)xb_add(&bar[XB_XCNT(b.x)], 1u);
    return b;
}
__device__ __forceinline__ void xcd_barrier_complete(unsigned* bar, unsigned x, unsigned& nloc, unsigned& nx) {
    const unsigned G = gridDim.x * gridDim.y * gridDim.z;
    unsigned sum, cnt, mine, sp = 0u;
    for (;;) {
        sum = 0u; cnt = 0u; mine = 0u;
#pragma unroll
        for (unsigned j = 0; j < 16; ++j) { const unsigned c = xb_ld(&bar[XB_XCNT(j)]); sum += c; cnt += (c > 0u) ? 1u : 0u; mine = (j == x) ? c : mine; }
        if (sum == G) break;
        __builtin_amdgcn_s_sleep(1);
        if ((++sp & 255u) == 0u) { if (xb_ld(&bar[XB_TMO])) break; if (sp > XB_SPIN_CAP) { atomicAdd(&bar[XB_TMO], 1u); break; } }
    }
    nloc = mine > 0u ? mine : 1u; nx = cnt > 0u ? cnt : 1u;
}

__device__ __forceinline__ void xcd_barrier(const XcdBarrier& b) {
    asm volatile("s_waitcnt vmcnt(0)" ::: "memory");
    __syncthreads();
    if (threadIdx.x == 0) {
        unsigned* bar = b.bar;
        __builtin_amdgcn_s_waitcnt(0);
        unsigned nloc = b.st[0], nx = b.st[1];
        if (nloc == 0u) { xcd_barrier_complete(bar, b.x, nloc, nx); b.st[0] = nloc; b.st[1] = nx; }
        const unsigned old = xb_add(&bar[XB_XSUB(b.x)], 1u);
        const unsigned gen = old / nloc;
        if (old + 1u == (gen + 1u) * nloc) {
            __builtin_amdgcn_fence(__ATOMIC_RELEASE, "agent");
            asm volatile("s_waitcnt vmcnt(0)" ::: "memory");
            const unsigned og = xb_add(&bar[XB_TOP], 1u);
            const unsigned tg = og / nx;
            if (og + 1u == (tg + 1u) * nx) xb_add(&bar[XB_TOPGEN], 1u);
            else XB_SPIN(xb_ld(&bar[XB_TOPGEN]) == tg, bar);
            __builtin_amdgcn_fence(__ATOMIC_ACQUIRE, "agent");
            xb_add(&bar[XB_XGEN(b.x)], 1u);
            asm volatile("s_waitcnt vmcnt(0)" ::: "memory");
        } else {
            XB_SPIN(xb_ld(&bar[XB_XGEN(b.x)]) == gen, bar);
            __builtin_amdgcn_fence(__ATOMIC_ACQUIRE, "agent");
            asm volatile("s_waitcnt vmcnt(0)" ::: "memory");
        }
    }
    __syncthreads();
}

#define VF16 1
#define FUSE_ROUTE 1
#ifndef XB_SPIN_CAP2
#define XB_SPIN_CAP2 1
#endif
constexpr int NWAVES = 8;
constexpr int T_TOK = 8192, DM = 4096, SEQ = 2048, NBATCH = 4;
constexpr int INW = 9216;
constexpr int C_QA = 0, C_KA = 2048, C_VA = 2560, C_QB = 3072, C_KB = 5120, C_VB = 7168;
constexpr int MEMLEN = 256, MEMW = 1024;
constexpr int NEXP = 16384, PQW = 2048;
constexpr float RMS_EPS = 1e-6f;
constexpr float LOG2E = 1.4426950408889634f;

constexpr size_t MiB = 1u << 20;
constexpr size_t WS_CTL = 0, CTL_ZERO_BYTES = 32768;
constexpr size_t WS_ROPE = 1 * MiB;
constexpr size_t WS_SKB = 2 * MiB;
constexpr size_t WS_WIN = 4 * MiB;
constexpr size_t WS_WOUT = 76 * MiB;
constexpr size_t WS_WMQ = 108 * MiB;
constexpr size_t WS_WMKV = 116 * MiB;
constexpr size_t WS_WMO = 132 * MiB;
constexpr size_t WS_WPQ = 140 * MiB;
constexpr size_t WS_UB = 156 * MiB;
constexpr size_t WS_VB = 284 * MiB;
constexpr size_t WS_UQ = 156 * MiB, WS_VQ = 220 * MiB;
constexpr size_t WS_SU = 3 * MiB, WS_SV = 3 * MiB + 65536;
constexpr size_t WS_SX = 3 * MiB + 131072;
constexpr size_t WS_XQ = 284 * MiB;
constexpr size_t SLICE_BYTES = (size_t)NEXP * 128;
constexpr size_t WS_XN = 412 * MiB;
constexpr size_t WS_QKV = 476 * MiB;
constexpr size_t WS_OB = 620 * MiB;
constexpr size_t WS_MEMN = 684 * MiB;
constexpr size_t WS_KVM = 692 * MiB;
constexpr size_t WS_QM = 696 * MiB;
constexpr size_t WS_OM = 712 * MiB;
constexpr size_t WS_QP = 728 * MiB;
constexpr size_t WS_IDX = 760 * MiB;
constexpr size_t WS_GATE = 764 * MiB;
constexpr size_t WS_END = 768 * MiB;
constexpr int CW_BAR = 4096;
constexpr size_t WS_SSQ1 = 65536, WS_SSQ2 = 65536 + 32768, WS_SSQA = 131072, WS_SSQB = 131072 + 32768, WS_SSQ0 = 229376;

constexpr int RING_BYTES = 131072;
constexpr int LDSCTL_OFF = RING_BYTES, MISC_OFF = LDSCTL_OFF + 320;
constexpr int LDS_BYTES = 147456;

typedef float f32x16 __attribute__((ext_vector_type(16)));
typedef float f32x2 __attribute__((ext_vector_type(2)));
typedef short s16x4 __attribute__((ext_vector_type(4)));
typedef __bf16 bf16x2_t __attribute__((ext_vector_type(2)));
typedef unsigned u32x2 __attribute__((ext_vector_type(2)));
#define DI __device__ __forceinline__
#define MFMA32(a, b, c) __builtin_amdgcn_mfma_f32_32x32x16_bf16((a), (b), (c), 0, 0, 0)

DI unsigned cvtpk(float lo, float hi) { f32x2 v = {lo, hi}; bf16x2_t b = __builtin_convertvector(v, bf16x2_t); return __builtin_bit_cast(unsigned, b); }
DI float bflo(unsigned u) { return __uint_as_float(u << 16); }
DI float bfhi(unsigned u) { return __uint_as_float(u & 0xffff0000u); }
DI int crow(int i, int h) { return (i & 3) + 8 * (i >> 2) + 4 * h; }
DI float wave_sum(float v) {
#pragma unroll
    for (int o = 1; o < 64; o <<= 1) v += __shfl_xor(v, o);
    return v;
}
DI float fexp2(float x) { return __builtin_amdgcn_exp2f(x); }
DI bf16x8 pack8(const f32x16& x, int s) {
    v4u p; p.x = cvtpk(x[8 * s + 0], x[8 * s + 1]); p.y = cvtpk(x[8 * s + 2], x[8 * s + 3]); p.z = cvtpk(x[8 * s + 4], x[8 * s + 5]); p.w = cvtpk(x[8 * s + 6], x[8 * s + 7]);
    return __builtin_bit_cast(bf16x8, p);
}
typedef short v4i16_t __attribute__((ext_vector_type(4)));
DI s16x4 vtr(const LAS unsigned char* p) { return __builtin_bit_cast(s16x4, __builtin_amdgcn_ds_read_tr16_b64_v4i16((LAS v4i16_t*)p)); }

DI void p0_transpose_item(const float* W, int K, int N, bf16* WT, int row_off, LAS float* scr, int item, int lane, const float* gk0 = nullptr, const float* gk1 = nullptr) {
    const int nblk = N / 32, kb = item / nblk, nb = item % nblk, k0 = 64 * kb, n0 = 32 * nb;
#pragma unroll 8
    for (int i = 0; i < 32; ++i) { const int kk = 2 * i + (lane >> 5); scr[kk * 33 + (lane & 31)] = W[(size_t)(k0 + kk) * N + n0 + (lane & 31)]; }
    LDS_WAIT(); asm volatile("" ::: "memory");
    const int c = lane & 7;
    f32x4 ga = {1.f, 1.f, 1.f, 1.f}, gb = ga;
    if (gk0) { const int kg = k0 + 8 * c; const float* gp = kg < 2048 ? gk0 + kg : gk1 + (kg - 2048); ga = *(const GAS f32x4*)gp; gb = *(const GAS f32x4*)(gp + 4); }
#pragma unroll
    for (int j = 0; j < 4; ++j) { const int n = (lane >> 3) + 8 * j; const LAS float* s = scr + (8 * c) * 33 + n;
        v4u o; o.x = cvtpk(s[0 * 33] * ga.x, s[1 * 33] * ga.y); o.y = cvtpk(s[2 * 33] * ga.z, s[3 * 33] * ga.w); o.z = cvtpk(s[4 * 33] * gb.x, s[5 * 33] * gb.y); o.w = cvtpk(s[6 * 33] * gb.z, s[7 * 33] * gb.w);
        *(GAS v4u*)(WT + (size_t)(row_off + n0 + n) * K + k0 + 8 * c) = o; }
    LDS_WAIT(); asm volatile("" ::: "memory");
}
DI void rms_row_to_bf16(const float* xrow, const float* gain, bf16* orow, int lane) {
    const GAS f32x4* xr = (const GAS f32x4*)xrow + lane;
    f32x4 v[16]; float s = 0.f;
#pragma unroll
    for (int j = 0; j < 16; ++j) { v[j] = xr[64 * j]; s += (v[j].x * v[j].x + v[j].y * v[j].y) + (v[j].z * v[j].z + v[j].w * v[j].w); }
    const float rstd = 1.0f / sqrtf(wave_sum(s) * (1.f / DM) + RMS_EPS);
    const GAS f32x4* gr = (const GAS f32x4*)gain + lane;
    GAS u32x2* o8 = (GAS u32x2*)orow + lane;
#pragma unroll
    for (int j = 0; j < 16; ++j) { const f32x4 g = gr[64 * j]; u32x2 w; w.x = cvtpk(v[j].x * rstd * g.x, v[j].y * rstd * g.y); w.y = cvtpk(v[j].z * rstd * g.z, v[j].w * rstd * g.w); o8[64 * j] = w; }
}
DI void row_to_bf16_ssq(const float* xrow, bf16* orow, float* ssq, int lane) {
    const GAS f32x4* xr = (const GAS f32x4*)xrow + lane;
    GAS u32x2* o8 = (GAS u32x2*)orow + lane; float s = 0.f;
#pragma unroll
    for (int j = 0; j < 16; ++j) { const f32x4 v = xr[64 * j]; s += (v.x * v.x + v.y * v.y) + (v.z * v.z + v.w * v.w);
        u32x2 w; w.x = cvtpk(v.x, v.y); w.y = cvtpk(v.z, v.w); o8[64 * j] = w; }
    s = wave_sum(s);
    if (lane == 0) *ssq = s;
}
DI void mix_row_norm(bf16* orow, const float* ga, const float* gb, int lane) {
    GAS v4u* p = (GAS v4u*)orow + lane;
    v4u v[8]; float sa = 0.f, sb = 0.f;
#pragma unroll
    for (int j = 0; j < 8; ++j) { v[j] = p[64 * j]; float s = 0.f;
#pragma unroll
        for (int k = 0; k < 4; ++k) { const float a = bflo(v[j][k]), b = bfhi(v[j][k]); s += a * a + b * b; }
        if (j < 4) sa += s; else sb += s; }
    const float ra = 1.0f / sqrtf(wave_sum(sa) * (1.f / 2048.f) + RMS_EPS), rb = 1.0f / sqrtf(wave_sum(sb) * (1.f / 2048.f) + RMS_EPS);
#pragma unroll
    for (int j = 0; j < 8; ++j) { const float rs = j < 4 ? ra : rb; const float* gp = (j < 4 ? ga : gb) + ((lane + 64 * (j & 3)) * 8);
        const f32x4 g0 = *(const GAS f32x4*)gp, g1 = *(const GAS f32x4*)(gp + 4); v4u w;
        w.x = cvtpk(bflo(v[j].x) * rs * g0.x, bfhi(v[j].x) * rs * g0.y); w.y = cvtpk(bflo(v[j].y) * rs * g0.z, bfhi(v[j].y) * rs * g0.w);
        w.z = cvtpk(bflo(v[j].z) * rs * g1.x, bfhi(v[j].z) * rs * g1.y); w.w = cvtpk(bflo(v[j].w) * rs * g1.z, bfhi(v[j].w) * rs * g1.w);
        p[64 * j] = w; }
}

struct EpiResF32 {
    static constexpr bool PERM = false, AFTER_DRAIN = false;
    const float* base; float* out; int ldc; float sc;
    __device__ __forceinline__ void operator()(const pg8::f32x4 (&acc)[2][2][4][2], const pg8::Unit& u, int wr, int wc, int fr, int fq) const {
        const int col0 = u.pn * 256 + wc * 32 + 4 * fq;
#pragma unroll
        for (int ai = 0; ai < 2; ++ai)
#pragma unroll
            for (int m = 0; m < 4; ++m) { const int r = ai * 128 + wr * 64 + m * 16 + fr; const size_t off = (size_t)(u.pm * 256 + r) * ldc + col0;
#pragma unroll
                for (int bj = 0; bj < 2; ++bj)
#pragma unroll
                    for (int n = 0; n < 2; ++n) { const pg8::f32x4 bs = *(const pg8::f32x4*)(base + off + bj * 128 + n * 16); *(pg8::f32x4*)(out + off + bj * 128 + n * 16) = bs + acc[ai][bj][m][n] * sc; } }
    }
};

struct EpiResNorm {
    static constexpr bool PERM = false, AFTER_DRAIN = false;
    const float* base; float* out; bf16* xn; const float* gain; float* ssq; int ldc;
    __device__ __forceinline__ void operator()(const pg8::f32x4 (&acc)[2][2][4][2], const pg8::Unit& u, int wr, int wc, int fr, int fq) const {
        const int col0 = u.pn * 256 + wc * 32 + 4 * fq;
        pg8::f32x4 gv[2][2];
#pragma unroll
        for (int bj = 0; bj < 2; ++bj)
#pragma unroll
            for (int n = 0; n < 2; ++n) gv[bj][n] = *(const pg8::f32x4*)(gain + col0 + bj * 128 + n * 16);
#pragma unroll
        for (int ai = 0; ai < 2; ++ai)
#pragma unroll
            for (int m = 0; m < 4; ++m) { const int r = u.pm * 256 + ai * 128 + wr * 64 + m * 16 + fr; const size_t off = (size_t)r * ldc + col0; float part = 0.f;
#pragma unroll
                for (int bj = 0; bj < 2; ++bj)
#pragma unroll
                    for (int n = 0; n < 2; ++n) { const pg8::f32x4 bs = *(const pg8::f32x4*)(base + off + bj * 128 + n * 16); const pg8::f32x4 v = bs + acc[ai][bj][m][n];
                        *(pg8::f32x4*)(out + off + bj * 128 + n * 16) = v; part += (v[0] * v[0] + v[1] * v[1]) + (v[2] * v[2] + v[3] * v[3]);
                        const pg8::f32x4 g = gv[bj][n]; u32x2 w; w.x = cvtpk(v[0] * g[0], v[1] * g[1]); w.y = cvtpk(v[2] * g[2], v[3] * g[3]);
                        *(u32x2*)(xn + off + bj * 128 + n * 16) = w; }
                part += __shfl_xor(part, 16); part += __shfl_xor(part, 32);
                if (fq == 0) atomicAdd(ssq + r, part); }
    }
};
struct EpiResNormMid {
    static constexpr bool PERM = false, AFTER_DRAIN = false;
    const float* base; float* out; bf16* xn; const float* gain; float* ssq; int ldc; const float* ssqa; const float* ssqb;
    LAS float* midtab;
    __device__ __forceinline__ void load_mid(const pg8::Unit& u) const {
        if (threadIdx.x < 256) { const int r = u.pm * 256 + (int)threadIdx.x;
            midtab[threadIdx.x] = sqrtf((ssqb[r] * (1.f / 2048.f) + RMS_EPS) / (ssqa[r] * (1.f / 2048.f) + RMS_EPS)); }
    }
    __device__ __forceinline__ float mid(int row_in_tile) const { return midtab[row_in_tile]; }
    __device__ __forceinline__ void operator()(const pg8::f32x4 (&acc)[2][2][4][2], const pg8::Unit& u, int wr, int wc, int fr, int fq) const {
        const int col0 = u.pn * 256 + wc * 32 + 4 * fq;
        pg8::f32x4 gv[2][2];
#pragma unroll
        for (int bj = 0; bj < 2; ++bj)
#pragma unroll
            for (int n = 0; n < 2; ++n) gv[bj][n] = *(const pg8::f32x4*)(gain + col0 + bj * 128 + n * 16);
#pragma unroll
        for (int ai = 0; ai < 2; ++ai)
#pragma unroll
            for (int m = 0; m < 4; ++m) { const int r = u.pm * 256 + ai * 128 + wr * 64 + m * 16 + fr; const size_t off = (size_t)r * ldc + col0; float part = 0.f;
                const float rsb = 1.0f / sqrtf(ssqb[r] * (1.f / 2048.f) + RMS_EPS);
#pragma unroll
                for (int bj = 0; bj < 2; ++bj)
#pragma unroll
                    for (int n = 0; n < 2; ++n) { const pg8::f32x4 bs = *(const pg8::f32x4*)(base + off + bj * 128 + n * 16); const pg8::f32x4 v = bs + acc[ai][bj][m][n] * rsb;
                        *(pg8::f32x4*)(out + off + bj * 128 + n * 16) = v; part += (v[0] * v[0] + v[1] * v[1]) + (v[2] * v[2] + v[3] * v[3]);
                        const pg8::f32x4 g = gv[bj][n]; u32x2 w; w.x = cvtpk(v[0] * g[0], v[1] * g[1]); w.y = cvtpk(v[2] * g[2], v[3] * g[3]);
                        *(u32x2*)(xn + off + bj * 128 + n * 16) = w; }
                part += __shfl_xor(part, 16); part += __shfl_xor(part, 32);
                if (fq == 0) atomicAdd(ssq + r, part); }
    }
};
struct EpiResHMid {
    static constexpr bool PERM = true, AFTER_DRAIN = false;
    bf16* H; float* ssq; int ldc; const float* ssqa; const float* ssqb; LAS float* midtab;
    __device__ __forceinline__ void load_mid(const pg8::Unit& u) const {
        if (threadIdx.x < 256) { const int r = u.pm * 256 + (int)threadIdx.x;
            midtab[threadIdx.x] = sqrtf((ssqb[r] * (1.f / 2048.f) + RMS_EPS) / (ssqa[r] * (1.f / 2048.f) + RMS_EPS)); }
    }
    __device__ __forceinline__ float mid(int row_in_tile) const { return midtab[row_in_tile]; }
    __device__ __forceinline__ void operator()(const pg8::f32x4 (&acc)[2][2][4][2], const pg8::Unit& u, int wr, int wc, int fr, int fq) const {
        const int col0 = u.pn * 256 + wc * 32 + 8 * fq;
#pragma unroll
        for (int ai = 0; ai < 2; ++ai)
#pragma unroll
            for (int m = 0; m < 4; ++m) { const int r = u.pm * 256 + ai * 128 + wr * 64 + m * 16 + fr; bf16* rowp = H + (size_t)r * ldc + col0; float part = 0.f;
                const float rsb = 1.0f / sqrtf(ssqb[r] * (1.f / 2048.f) + RMS_EPS);
#pragma unroll
                for (int bj = 0; bj < 2; ++bj) { const v4u hb = *(const v4u*)(rowp + bj * 128); float v[8];
#pragma unroll
                    for (int n = 0; n < 2; ++n)
#pragma unroll
                        for (int c = 0; c < 2; ++c) { const unsigned w2 = hb[2 * n + c]; v[4 * n + 2 * c] = bflo(w2) + acc[ai][bj][m][n][2 * c] * rsb; v[4 * n + 2 * c + 1] = bfhi(w2) + acc[ai][bj][m][n][2 * c + 1] * rsb; }
                    v4u w;
#pragma unroll
                    for (int c = 0; c < 4; ++c) { part += v[2 * c] * v[2 * c] + v[2 * c + 1] * v[2 * c + 1]; w[c] = cvtpk(v[2 * c], v[2 * c + 1]); }
                    *(v4u*)(rowp + bj * 128) = w; }
                part += __shfl_xor(part, 16); part += __shfl_xor(part, 32);
                if (fq == 0) atomicAdd(ssq + r, part); }
    }
};
struct EpiResH {
    static constexpr bool PERM = true, AFTER_DRAIN = false;
    bf16* H; float* ssq; int ldc;
    __device__ __forceinline__ void operator()(const pg8::f32x4 (&acc)[2][2][4][2], const pg8::Unit& u, int wr, int wc, int fr, int fq) const {
        const int col0 = u.pn * 256 + wc * 32 + 8 * fq;
#pragma unroll
        for (int ai = 0; ai < 2; ++ai)
#pragma unroll
            for (int m = 0; m < 4; ++m) { const int r = u.pm * 256 + ai * 128 + wr * 64 + m * 16 + fr; bf16* rowp = H + (size_t)r * ldc + col0; float part = 0.f;
#pragma unroll
                for (int bj = 0; bj < 2; ++bj) { const v4u hb = *(const v4u*)(rowp + bj * 128); float v[8];
#pragma unroll
                    for (int n = 0; n < 2; ++n)
#pragma unroll
                        for (int c = 0; c < 2; ++c) { const unsigned w2 = hb[2 * n + c]; v[4 * n + 2 * c] = bflo(w2) + acc[ai][bj][m][n][2 * c]; v[4 * n + 2 * c + 1] = bfhi(w2) + acc[ai][bj][m][n][2 * c + 1]; }
                    v4u w;
#pragma unroll
                    for (int c = 0; c < 4; ++c) { part += v[2 * c] * v[2 * c] + v[2 * c + 1] * v[2 * c + 1]; w[c] = cvtpk(v[2 * c], v[2 * c + 1]); }
                    *(v4u*)(rowp + bj * 128) = w; }
                part += __shfl_xor(part, 16); part += __shfl_xor(part, 32);
                if (fq == 0) atomicAdd(ssq + r, part); }
    }
};
struct EpiBf16RowScale {
    static constexpr bool PERM = true, AFTER_DRAIN = false;
    bf16* O; int ldc; const float* ssq;
    __device__ __forceinline__ void operator()(const pg8::f32x4 (&acc)[2][2][4][2], const pg8::Unit& u, int wr, int wc, int fr, int fq) const {
        const int row0 = u.pm * 256 + wr * 64 + fr, col0 = u.pn * 256 + wc * 32 + 8 * fq;
#pragma unroll
        for (int ai = 0; ai < 2; ++ai)
#pragma unroll
            for (int m = 0; m < 4; ++m) { const int row = row0 + ai * 128 + m * 16; const float rs = 1.0f / sqrtf(ssq[row] * (1.f / DM) + RMS_EPS); bf16* rowp = O + (size_t)row * ldc + col0;
#pragma unroll
                for (int bj = 0; bj < 2; ++bj) { const pg8::f32x4 v0 = acc[ai][bj][m][0] * rs, v1 = acc[ai][bj][m][1] * rs;
                    v4u w; w.x = cvtpk(v0[0], v0[1]); w.y = cvtpk(v0[2], v0[3]); w.z = cvtpk(v1[0], v1[1]); w.w = cvtpk(v1[2], v1[3]);
                    *(v4u*)(rowp + bj * 128) = w; } }
    }
};

template <int NSTEP, int KP>
DI f32x16 qk_tile(const LAS unsigned char* Kt, const bf16x8* qf, int r, int h) {
    f32x16 s;
#pragma unroll
    for (int i = 0; i < 16; ++i) s[i] = 0.f;
    const LAS unsigned char* kp = Kt + r * KP + h * 16;
#pragma unroll
    for (int st = 0; st < NSTEP; ++st) { const bf16x8 a = *(const LAS bf16x8*)(kp + st * 32); s = MFMA32(a, qf[st], s); }
    return s;
}
template <int NDB, int VP>
DI void pv_tile(f32x16* o, const LAS unsigned char* Vt, const f32x16& p, int lane) {
    const int h = lane >> 5, q = (lane & 15) >> 2, pp = lane & 3, blk = (lane >> 4) & 1;
    const bf16x8 p0 = pack8(p, 0), p1 = pack8(p, 1);
    const LAS unsigned char* vb = Vt + (4 * h + q) * VP + blk * 32 + pp * 8;
#pragma unroll
    for (int db = 0; db < NDB; ++db) {
        const s16x4 l0 = vtr(vb + db * 64), h0 = vtr(vb + 8 * VP + db * 64), l1 = vtr(vb + 16 * VP + db * 64), h1 = vtr(vb + 24 * VP + db * 64);
        const bf16x8 v0 = __builtin_shufflevector(l0, h0, 0, 1, 2, 3, 4, 5, 6, 7), v1 = __builtin_shufflevector(l1, h1, 0, 1, 2, 3, 4, 5, 6, 7);
        o[db] = MFMA32(v0, p0, o[db]); o[db] = MFMA32(v1, p1, o[db]);
    }
}
DI float softmax_tile(f32x16& s, float& m, float& l) {
    float mx = s[0];
#pragma unroll
    for (int i = 1; i < 16; ++i) mx = fmaxf(mx, s[i]);
    mx = fmaxf(mx, __shfl_xor(mx, 32));
    const float mn = fmaxf(m, mx), alpha = fexp2(m - mn); m = mn;
    float sum = 0.f;
#pragma unroll
    for (int i = 0; i < 16; ++i) { s[i] = fexp2(s[i] - mn); sum += s[i]; }
    l = l * alpha + sum;
    return alpha;
}
DI float fmul_s(float a, float b) { float r; asm("v_mul_f32_e32 %0, %1, %2" : "=v"(r) : "v"(a), "v"(b)); return r; }
template <int NDB> DI void scale_o(f32x16* o, float alpha) {
#pragma unroll
    for (int db = 0; db < NDB; ++db)
#pragma unroll
        for (int i = 0; i < 16; ++i) o[db][i] *= alpha;
}
struct MaskNone { DI void operator()(f32x16&, int) const {} };
struct MaskSwa { int qpos, k0; int h;
    DI void operator()(f32x16& s, int st2) const {
#pragma unroll
        for (int i = 0; i < 16; ++i) { const int d = qpos - (k0 + 32 * st2 + crow(i, h)); s[i] = (d <= 128 && d >= -128) ? s[i] : -3.0e30f; } } };
struct MaskNat { const LAS float* brow; int t0;
    DI void operator()(f32x16& s, int st2) const {
        float bv[16];
#pragma unroll
        for (int i = 0; i < 16; ++i) bv[i] = brow[32 * st2 + (i & 3) + 8 * (i >> 2)];
        __builtin_amdgcn_sched_barrier(0);
#pragma unroll
        for (int i = 0; i < 16; ++i) { const int kc0 = 32 * st2 + (i & 3) + 8 * (i >> 2); s[i] = ((unsigned)(t0 + kc0) < 16u) ? s[i] + bv[i] : -3.0e30f; } } };
template <int NSTEP, int KP, int NDB, int VP, class Mask>
DI void tile64(const LAS unsigned char* Kb, const LAS unsigned char* Vb, const bf16x8* qf, f32x16* o, float& m, float& l, int lane, const Mask& mask, unsigned long long* tq = nullptr, bool domask = true) {
    const int r = lane & 31, h = lane >> 5;
#ifdef PROBE_TILE
    unsigned long long t0_ = clock64();
#define TT(i_) do { if (tq) { asm volatile("s_waitcnt vmcnt(0) lgkmcnt(0)" ::: "memory"); asm volatile("s_nop 15\n\ts_nop 15" :: "v"(s0), "v"(s1)); const unsigned long long n_ = clock64(); tq[i_] += n_ - t0_; t0_ = n_; } } while (0)
#else
#define TT(i_) do {} while (0)
#endif
    f32x16 s0, s1;
#pragma unroll
    for (int i = 0; i < 16; ++i) { s0[i] = 0.f; s1[i] = 0.f; }
    const LAS unsigned char* kp = Kb + r * KP + h * 16;
#pragma unroll
    for (int st = 0; st < NSTEP; ++st) { const bf16x8 a0 = *(const LAS bf16x8*)(kp + st * 32), a1 = *(const LAS bf16x8*)(kp + 32 * KP + st * 32);
        s0 = MFMA32(a0, qf[st], s0); s1 = MFMA32(a1, qf[st], s1); }
    TT(0);
    if (domask) { mask(s0, 0); mask(s1, 1); }
#ifdef PROBE_SPLIT
    TT(1);
#endif
    float mx0 = fmaxf(s0[0], s1[0]), mx1 = fmaxf(s0[1], s1[1]);
#pragma unroll
    for (int i = 2; i < 16; i += 2) { mx0 = fmaxf(mx0, fmaxf(s0[i], s1[i])); mx1 = fmaxf(mx1, fmaxf(s0[i + 1], s1[i + 1])); }
    float mx = fmaxf(mx0, mx1);
    { const auto sw = __builtin_amdgcn_permlane32_swap(__float_as_uint(mx), __float_as_uint(mx), false, false); mx = fmaxf(__uint_as_float(sw[0]), __uint_as_float(sw[1])); }
    const float mn = fmaxf(m, mx), alpha = fexp2(m - mn); m = mn;
    float sum0 = 0.f, sum1 = 0.f;
#pragma unroll
    for (int i = 0; i < 16; ++i) { s0[i] = fexp2(s0[i] - mn); s1[i] = fexp2(s1[i] - mn); sum0 += s0[i]; sum1 += s1[i]; }
    l = l * alpha + (sum0 + sum1);
    scale_o<NDB>(o, alpha);
#ifdef PROBE_SPLIT
    TT(2);
#else
    TT(1);
#endif
    const int q = (lane & 15) >> 2, pp = lane & 3, blk = (lane >> 4) & 1;
    const bf16x8 p00 = pack8(s0, 0), p01 = pack8(s0, 1), p10 = pack8(s1, 0), p11 = pack8(s1, 1);
    const LAS unsigned char* vb = Vb + (4 * h + q) * VP + blk * 32 + pp * 8;
#pragma unroll
    for (int db = 0; db < NDB; ++db) {
        const s16x4 a0 = vtr(vb + db * 64), a1 = vtr(vb + 8 * VP + db * 64), a2 = vtr(vb + 16 * VP + db * 64), a3 = vtr(vb + 24 * VP + db * 64);
        const s16x4 b0 = vtr(vb + 32 * VP + db * 64), b1 = vtr(vb + 40 * VP + db * 64), b2 = vtr(vb + 48 * VP + db * 64), b3 = vtr(vb + 56 * VP + db * 64);
        const bf16x8 v00 = __builtin_shufflevector(a0, a1, 0, 1, 2, 3, 4, 5, 6, 7), v01 = __builtin_shufflevector(a2, a3, 0, 1, 2, 3, 4, 5, 6, 7);
        const bf16x8 v10 = __builtin_shufflevector(b0, b1, 0, 1, 2, 3, 4, 5, 6, 7), v11 = __builtin_shufflevector(b2, b3, 0, 1, 2, 3, 4, 5, 6, 7);
        o[db] = MFMA32(v00, p00, o[db]); o[db] = MFMA32(v01, p01, o[db]); o[db] = MFMA32(v10, p10, o[db]); o[db] = MFMA32(v11, p11, o[db]);
    }
#if defined(PROBE_TILE) && !defined(PROBE_SPLIT)
    if (tq) { asm volatile("s_nop 15\n\ts_nop 15" :: "v"(o[0]), "v"(o[1]), "v"(o[2]), "v"(o[3])); const unsigned long long n_ = clock64(); tq[2] += n_ - t0_; }
#endif
#undef TT
}
template <int NDB> DI void store_o(const f32x16* o, float inv, bf16* orow, int h, float* ssq = nullptr) {
    float part = 0.f;
#pragma unroll
    for (int db = 0; db < NDB; ++db)
#pragma unroll
        for (int gp = 0; gp < 2; ++gp) {
            unsigned ax, ay, bx, by;
            { const int g = 2 * gp; const float a0 = o[db][4 * g] * inv, a1 = o[db][4 * g + 1] * inv, a2 = o[db][4 * g + 2] * inv, a3 = o[db][4 * g + 3] * inv;
              part += (a0 * a0 + a1 * a1) + (a2 * a2 + a3 * a3); ax = cvtpk(a0, a1); ay = cvtpk(a2, a3); }
            { const int g = 2 * gp + 1; const float a0 = o[db][4 * g] * inv, a1 = o[db][4 * g + 1] * inv, a2 = o[db][4 * g + 2] * inv, a3 = o[db][4 * g + 3] * inv;
              part += (a0 * a0 + a1 * a1) + (a2 * a2 + a3 * a3); bx = cvtpk(a0, a1); by = cvtpk(a2, a3); }
            const auto sx = __builtin_amdgcn_permlane32_swap(ax, bx, false, false), sy = __builtin_amdgcn_permlane32_swap(ay, by, false, false);
            v4u w; w.x = sx[0]; w.y = sy[0]; w.z = sx[1]; w.w = sy[1];
            *(GAS v4u*)(orow + 32 * db + 16 * gp + 8 * h) = w; }
    if (ssq) { part += __shfl_xor(part, 32); if (h == 0) atomicAdd(ssq, part); }
}

constexpr int KP128 = 272, VP128 = 320, KP256 = 528, VP256 = 576;
constexpr int ATT_K_OFF = 0, ATT_V_OFF = 34816, ATT_BIAS_OFF = 72704;

constexpr int A2_K = 0, A2_V = 17408, A2_BUF = 37888, A2_BIAS = 76800;
template <bool SKIPC = false> DI void swa_unit(LAS unsigned char* lds, int u, const bf16* QKV, bf16* OB, const float* sink, const float* ropec, const float* ropes, float* SSQA) {
    const int tid = threadIdx.x, lane = tid & 63, wid = __builtin_amdgcn_readfirstlane(tid >> 6), r = lane & 31, h = lane >> 5;
    const int qb = u & 31, kvh = (u >> 5) & 3, b = u >> 7;
    const int q0 = qb * 64, g = wid >> 1, sub = wid & 1, head = kvh * 4 + g;
    const int qpos = q0 + 32 * sub + r;
    const size_t tok = (size_t)b * SEQ + qpos;
    const float QS = 0.08838834764831845f * LOG2E;
    const int t_lo = qb - 2 < 0 ? 0 : qb - 2, t_hi = qb + 2 > 31 ? 31 : qb + 2;
    const int skey = tid >> 3, sc = tid & 7;
    v4u s_lo, s_hi, s_v0, s_v1; int s_kpos = 0;
#define SWA_LOAD(kt_) do { const int kpos_ = (kt_) * 64 + skey; const size_t ktok_ = (size_t)b * SEQ + kpos_; \
        const bf16* kp_ = QKV + ktok_ * INW + C_KA + kvh * 128 + 8 * sc; s_lo = *(const GAS v4u*)kp_; s_hi = *(const GAS v4u*)(kp_ + 64); \
        const bf16* vp_ = QKV + ktok_ * INW + C_VA + kvh * 128 + 8 * sc; s_v0 = *(const GAS v4u*)vp_; s_v1 = *(const GAS v4u*)(vp_ + 64); \
        s_kpos = kpos_; } while (0)
#define SWA_WRITE(buf_) do { float cc_[8], ss_[8]; _Pragma("unroll") for (int k_ = 0; k_ < 8; ++k_) { const float inv_ = fexp2(-(float)(8 * sc + k_) * (13.287712379549449f / 64.0f)); \
            const float rev_ = ((float)s_kpos * inv_) * 0.15915494309189535f; const float fr_ = rev_ - floorf(rev_); cc_[k_] = __builtin_amdgcn_cosf(fr_); ss_[k_] = __builtin_amdgcn_sinf(fr_); } \
        v4u a_, b_; _Pragma("unroll") for (int k_ = 0; k_ < 4; ++k_) { const float x1a = bflo(s_lo[k_]), x1b = bfhi(s_lo[k_]), x2a = bflo(s_hi[k_]), x2b = bfhi(s_hi[k_]); \
            a_[k_] = cvtpk(x1a * cc_[2 * k_] - x2a * ss_[2 * k_], x1b * cc_[2 * k_ + 1] - x2b * ss_[2 * k_ + 1]); \
            b_[k_] = cvtpk(x2a * cc_[2 * k_] + x1a * ss_[2 * k_], x2b * cc_[2 * k_ + 1] + x1b * ss_[2 * k_ + 1]); } \
        LAS unsigned char* bb_ = lds + (buf_) * A2_BUF; \
        *(LAS v4u*)(bb_ + A2_K + skey * KP128 + 16 * sc) = a_; *(LAS v4u*)(bb_ + A2_K + skey * KP128 + 128 + 16 * sc) = b_; \
        *(LAS v4u*)(bb_ + A2_V + skey * VP128 + 16 * sc) = s_v0; *(LAS v4u*)(bb_ + A2_V + skey * VP128 + 128 + 16 * sc) = s_v1; } while (0)
    bf16x8 qf[8];
    {
        const bf16* qp = QKV + tok * INW + C_QA + head * 128 + 8 * h;
#pragma unroll
        for (int st = 0; st < 4; ++st) {
            const v4u lo = *(const GAS v4u*)(qp + 16 * st), hi = *(const GAS v4u*)(qp + 16 * st + 64);
            const float* cp = ropec + (size_t)qpos * 64 + 16 * st + 8 * h; const float* sp = ropes + (size_t)qpos * 64 + 16 * st + 8 * h;
            const f32x4 c0 = *(const GAS f32x4*)cp, c1 = *(const GAS f32x4*)(cp + 4), s0 = *(const GAS f32x4*)sp, s1 = *(const GAS f32x4*)(sp + 4);
            float x1[8], x2[8], cc[8], ss[8];
#pragma unroll
            for (int k = 0; k < 4; ++k) { x1[2 * k] = bflo(lo[k]); x1[2 * k + 1] = bfhi(lo[k]); x2[2 * k] = bflo(hi[k]); x2[2 * k + 1] = bfhi(hi[k]); cc[k] = c0[k]; cc[4 + k] = c1[k]; ss[k] = s0[k]; ss[4 + k] = s1[k]; }
            v4u a, bq;
#pragma unroll
            for (int k = 0; k < 4; ++k) {
                a[k] = cvtpk((x1[2 * k] * cc[2 * k] - x2[2 * k] * ss[2 * k]) * QS, (x1[2 * k + 1] * cc[2 * k + 1] - x2[2 * k + 1] * ss[2 * k + 1]) * QS);
                bq[k] = cvtpk((x2[2 * k] * cc[2 * k] + x1[2 * k] * ss[2 * k]) * QS, (x2[2 * k + 1] * cc[2 * k + 1] + x1[2 * k + 1] * ss[2 * k + 1]) * QS);
            }
            qf[st] = __builtin_bit_cast(bf16x8, a); qf[st + 4] = __builtin_bit_cast(bf16x8, bq);
        }
    }
    asm volatile("" ::: "memory");
    SWA_LOAD(t_lo);
    float m = sink[head] * LOG2E, l = (h == 0) ? 1.f : 0.f;
    f32x16 o[4];
#pragma unroll
    for (int db = 0; db < 4; ++db)
#pragma unroll
        for (int i = 0; i < 16; ++i) o[db][i] = 0.f;
    __syncthreads();
    SWA_WRITE(0);
    __syncthreads();
    int buf = 0;
    for (int kt = t_lo; kt <= t_hi; ++kt) {
        if (kt < t_hi) SWA_LOAD(kt + 1);
        const LAS unsigned char* bb = lds + buf * A2_BUF;
        if (!SKIPC) { const MaskSwa mk{qpos, kt * 64, h}; tile64<8, KP128, 4, VP128>(bb + A2_K, bb + A2_V, qf, o, m, l, lane, mk, nullptr, kt <= qb - 2 || kt >= qb + 2); }
        if (kt < t_hi) SWA_WRITE(buf ^ 1);
        __syncthreads();
        buf ^= 1;
    }
#undef SWA_LOAD
#undef SWA_WRITE
    const float lt = l + __shfl_xor(l, 32);
    store_o<4>(o, 1.0f / lt, OB + tok * DM + head * 128, h, SSQA + tok);
}

#define PROBE_PTR ((unsigned char*)SSQB - WS_SSQB + 262144)
DI void nat_unit(LAS unsigned char* lds, int u, const bf16* QKV, bf16* OB, const float* relb, float* SSQB) {
    const int tid = threadIdx.x, lane = tid & 63, wid = __builtin_amdgcn_readfirstlane(tid >> 6), r = lane & 31, h = lane >> 5;
    const int rb = u & 7, head = (u >> 3) & 15, b = u >> 7;
    const int r0 = rb * 4, qrow = r0 + (wid >> 1), qcol = 32 * (wid & 1) + r;
    const size_t tok = (size_t)b * SEQ + qrow * 64 + qcol;
    const float QS = 0.08838834764831845f * LOG2E;
    int kr_lo = r0 - 4; kr_lo = kr_lo < 0 ? 0 : (kr_lo > 24 ? 24 : kr_lo);
    int kr_hi = r0 + 3 - 4; kr_hi = (kr_hi < 0 ? 0 : (kr_hi > 24 ? 24 : kr_hi)) + 7;
    int rs = qrow - 4; rs = rs < 0 ? 0 : (rs > 24 ? 24 : rs);
    int cs = qcol - 8; cs = cs < 0 ? 0 : (cs > 48 ? 48 : cs);
    const int skey = tid >> 3, sc = tid & 7;
    v4u s_k0, s_k1, s_v0, s_v1;
#define NAT_LOAD(kr_) do { const size_t ktok_ = (size_t)b * SEQ + (kr_) * 64 + skey; \
        const bf16* kp_ = QKV + ktok_ * INW + C_KB + head * 128 + 8 * sc; s_k0 = *(const GAS v4u*)kp_; s_k1 = *(const GAS v4u*)(kp_ + 64); \
        const bf16* vp_ = QKV + ktok_ * INW + C_VB + head * 128 + 8 * sc; s_v0 = *(const GAS v4u*)vp_; s_v1 = *(const GAS v4u*)(vp_ + 64); } while (0)
#define NAT_WRITE(buf_) do { LAS unsigned char* bb_ = lds + (buf_) * A2_BUF; \
        *(LAS v4u*)(bb_ + A2_K + skey * KP128 + 16 * sc) = s_k0; *(LAS v4u*)(bb_ + A2_K + skey * KP128 + 128 + 16 * sc) = s_k1; \
        *(LAS v4u*)(bb_ + A2_V + skey * VP128 + 16 * sc) = s_v0; *(LAS v4u*)(bb_ + A2_V + skey * VP128 + 128 + 16 * sc) = s_v1; } while (0)
    NAT_LOAD(kr_lo);
    bf16x8 qf[8];
    {
        const bf16* qp = QKV + tok * INW + C_QB + head * 128 + 8 * h;
#pragma unroll
        for (int st = 0; st < 8; ++st) { const v4u x = *(const GAS v4u*)(qp + 16 * st); v4u a;
#pragma unroll
            for (int k = 0; k < 4; ++k) a[k] = cvtpk(bflo(x[k]) * QS, bfhi(x[k]) * QS);
            qf[st] = __builtin_bit_cast(bf16x8, a); }
    }
    float m = -1.0e30f, l = 0.f;
    f32x16 o[4];
#pragma unroll
    for (int db = 0; db < 4; ++db)
#pragma unroll
        for (int i = 0; i < 16; ++i) o[db][i] = 0.f;
    __syncthreads();
    LAS float* bias = (LAS float*)(lds + A2_BIAS) + 64;
    if (tid < 465) bias[tid] = relb[head * 465 + tid] * LOG2E;
    NAT_WRITE(0);
    __syncthreads();
    int buf = 0;
#ifdef PROBE_TILE
    unsigned long long tq_[3] = {0, 0, 0};
#endif
#ifdef PROBE_TIMING
    unsigned long long tc_ = 0, tw_ = 0, tb_ = 0, t0_ = clock64(), tt0_ = t0_;
#define TSTAMP(acc_) do { asm volatile("s_waitcnt vmcnt(0) lgkmcnt(0)" ::: "memory"); const unsigned long long n_ = clock64(); acc_ += n_ - t0_; t0_ = n_; } while (0)
#else
#define TSTAMP(acc_) do {} while (0)
#endif
    for (int kr = kr_lo; kr <= kr_hi; ++kr) {
        if (kr < kr_hi) NAT_LOAD(kr + 1);
        if (kr >= rs && kr < rs + 8) {
            const LAS unsigned char* bb = lds + buf * A2_BUF;
            int dr = kr - qrow + 7; dr = dr < 0 ? 0 : (dr > 14 ? 14 : dr);
            int boff = 15 - qcol + 4 * h, t0 = 4 * h - cs;
            asm volatile("" : "+v"(boff), "+v"(t0));
            const LAS float* brow = bias + dr * 31 + boff;
#ifdef PROBE_TILE
            { const MaskNat mk{brow, t0}; tile64<8, KP128, 4, VP128>(bb + A2_K, bb + A2_V, qf, o, m, l, lane, mk, tq_); }
#else
            { const MaskNat mk{brow, t0}; tile64<8, KP128, 4, VP128>(bb + A2_K, bb + A2_V, qf, o, m, l, lane, mk); }
#endif
        }
#ifdef PROBE_TIMING
        { asm volatile("s_waitcnt lgkmcnt(0)" ::: "memory"); const unsigned long long n_ = clock64(); tc_ += n_ - t0_; t0_ = n_; }
        TSTAMP(tw_);
#endif
        if (kr < kr_hi) NAT_WRITE(buf ^ 1);
        __syncthreads();
        TSTAMP(tb_);
        buf ^= 1;
    }
#ifdef PROBE_TIMING
#ifdef PROBE_TILE
    if (blockIdx.x == 0 && tid == 0) { unsigned long long* pt = (unsigned long long*)PROBE_PTR; pt[0] += tq_[0]; pt[1] += tq_[1]; pt[2] += tq_[2]; pt[3] += tc_; }
#else
    if (blockIdx.x == 0 && tid == 0) { unsigned long long* pt = (unsigned long long*)PROBE_PTR; pt[0] += tc_; pt[1] += tw_; pt[2] += tb_; pt[3] += clock64() - tt0_; }
#endif
#endif
#undef TSTAMP
#undef NAT_LOAD
#undef NAT_WRITE
    const float lt = l + __shfl_xor(l, 32);
    store_o<4>(o, 1.0f / lt, OB + tok * DM + 2048 + head * 128, h, SSQB + tok);
}

DI void mem_unit(LAS unsigned char* lds, int u, const bf16* QM, const bf16* KVM, bf16* OM) {
    const int tid = threadIdx.x, lane = tid & 63, wid = __builtin_amdgcn_readfirstlane(tid >> 6), r = lane & 31, h = lane >> 5;
    const int qblk = u & 15, mh = (u >> 4) & 3, b = u >> 6;
    const int qsub = wid >> 1, dh = wid & 1;
    const size_t tok = (size_t)b * SEQ + qblk * 128 + 32 * qsub + r;
    const float QS = 0.0625f * LOG2E;
    bf16x8 qf[16];
    {
        const bf16* qp = QM + tok * MEMW + mh * 256 + 8 * h;
#pragma unroll
        for (int st = 0; st < 16; ++st) { const v4u x = *(const GAS v4u*)(qp + 16 * st); v4u a;
#pragma unroll
            for (int k = 0; k < 4; ++k) a[k] = cvtpk(bflo(x[k]) * QS, bfhi(x[k]) * QS);
            qf[st] = __builtin_bit_cast(bf16x8, a); }
    }
    float m = -1.0e30f, l = 0.f;
    f32x16 o[4];
#pragma unroll
    for (int db = 0; db < 4; ++db)
#pragma unroll
        for (int i = 0; i < 16; ++i) o[db][i] = 0.f;
    for (int kt = 0; kt < 4; ++kt) {
        __syncthreads();
#pragma unroll
        for (int it = 0; it < 4; ++it) {
            const int ch = tid + 512 * it, key = ch >> 5, c = ch & 31;
            const bf16* kp = KVM + (size_t)(b * MEMLEN + kt * 64 + key) * 2048 + mh * 256 + 8 * c;
            const v4u kv = *(const GAS v4u*)kp, vv = *(const GAS v4u*)(kp + 1024);
            *(LAS v4u*)(lds + ATT_K_OFF + key * KP256 + 16 * c) = kv; *(LAS v4u*)(lds + ATT_V_OFF + key * VP256 + 16 * c) = vv;
        }
        __syncthreads();
        { const MaskNone mk; tile64<16, KP256, 4, VP256>(lds + ATT_K_OFF, lds + ATT_V_OFF + dh * 256, qf, o, m, l, lane, mk); }
    }
    const float lt = l + __shfl_xor(l, 32);
    store_o<4>(o, 1.0f / lt, OM + tok * MEMW + mh * 256 + dh * 128, h);
}

DI unsigned f2sort(float f) { const unsigned u = __float_as_uint(f); return u ^ ((unsigned)((int)u >> 31) | 0x80000000u); }
DI float sort2f(unsigned k) { const unsigned u = (k & 0x80000000u) ? (k ^ 0x80000000u) : ~k; return __uint_as_float(u); }
constexpr int RT_SK_OFF = 0, RT_A_OFF = 69632;
struct constexpr_cand { int a, b; };
__host__ __device__ constexpr constexpr_cand cand_ab(int n) {
    int c = 0;
    for (int a = 0; a < 16; ++a) for (int b = 0; b < 16; ++b) if ((a + 1) * (b + 1) <= 16) { if (c == n) return constexpr_cand{a, b}; ++c; }
    return constexpr_cand{0, 0};
}
DI unsigned selu(int h, unsigned a, unsigned b) { asm volatile("" : "+v"(a), "+v"(b)); return h ? b : a; }
DI float self(int h, float a, float b) { asm volatile("" : "+v"(a), "+v"(b)); return h ? b : a; }
DI void ce_desc(unsigned& a, unsigned& b) { const unsigned hi = a > b ? a : b, lo = a > b ? b : a; a = hi; b = lo; }
template <int LOGN> DI void bitonic_merge_desc(unsigned (&x)[1 << LOGN]) {
#pragma unroll
    for (int lj = LOGN - 1; lj >= 0; --lj)
#pragma unroll
        for (int i = 0; i < (1 << LOGN); ++i) { const int l = i ^ (1 << lj); if (l > i) ce_desc(x[i], x[l]); }
}
DI void bitonic_sort16_desc(unsigned (&x)[16]) {
#pragma unroll
    for (int lk = 1; lk <= 4; ++lk)
#pragma unroll
        for (int lj = lk - 1; lj >= 0; --lj)
#pragma unroll
            for (int i = 0; i < 16; ++i) { const int l = i ^ (1 << lj); if (l > i) { if ((i & (1 << lk)) == 0) ce_desc(x[i], x[l]); else ce_desc(x[l], x[i]); } }
}
DI void top16_merge(unsigned (&a)[16], const unsigned (&b)[16]) {
#pragma unroll
    for (int i = 0; i < 16; ++i) a[i] = a[i] > b[15 - i] ? a[i] : b[15 - i];
    bitonic_merge_desc<4>(a);
}
DI void top16_xlane(unsigned (&a)[16]) {
    unsigned o[16];
#pragma unroll
    for (int i = 0; i < 16; ++i) o[i] = (unsigned)__shfl_xor((int)a[i], 32);
    top16_merge(a, o);
}
DI void route_unit(LAS unsigned char* lds, int u, const bf16* QP, const bf16* SKB, int* IDX, float* GATE) {
    const int tid = threadIdx.x, lane = tid & 63, wid = __builtin_amdgcn_readfirstlane(tid >> 6), r = lane & 31, h = lane >> 5;
    const int hd = u & 7, tile = u >> 3;
    const size_t tok = (size_t)tile * 256 + 32 * wid + r;
    __syncthreads();
#pragma unroll
    for (int it = 0; it < 8; ++it) { const int ch = tid + 512 * it, row = ch >> 4, c = ch & 15;
        const v4u x = *(const GAS v4u*)(SKB + ((size_t)hd * 256 + row) * 128 + 8 * c);
        *(LAS v4u*)(lds + RT_SK_OFF + row * 272 + 16 * c) = x; }
    __syncthreads();
    LAS unsigned* A = (LAS unsigned*)(lds + RT_A_OFF);
    const int tslot = wid * 32 + r;
    unsigned top[2][16];
#pragma unroll
    for (int c = 0; c < 2; ++c) {
        bf16x8 qf[8];
        const bf16* qp = QP + tok * PQW + hd * 256 + c * 128 + 8 * h;
#pragma unroll
        for (int st = 0; st < 8; ++st) qf[st] = __builtin_bit_cast(bf16x8, *(const GAS v4u*)(qp + 16 * st));
        unsigned g0[16], g1[16];
#pragma unroll
        for (int kt = 0; kt < 4; ++kt) {
            const f32x16 s = qk_tile<8, 272>(lds + RT_SK_OFF + (c * 128 + 32 * kt) * 272, qf, r, h);
            unsigned pk[16];
#pragma unroll
            for (int i = 0; i < 16; ++i) pk[i] = (f2sort(s[i]) & ~0x7Fu) | (unsigned)(127 - (32 * kt + crow(i, h)));
            bitonic_sort16_desc(pk);
            if (kt == 0) {
#pragma unroll
                for (int i = 0; i < 16; ++i) g0[i] = pk[i];
            } else if (kt == 1) { top16_merge(g0, pk); }
            else if (kt == 2) {
#pragma unroll
                for (int i = 0; i < 16; ++i) g1[i] = pk[i];
            } else { top16_merge(g1, pk); }
        }
        top16_merge(g0, g1);
        top16_xlane(g0);
#pragma unroll
        for (int i = 0; i < 16; ++i) { top[c][i] = g0[i]; if (h == 0) A[(c * 16 + i) * 256 + tslot] = g0[i]; }
    }
    float v1[16], v2[16];
#pragma unroll
    for (int a = 0; a < 16; ++a) { v1[a] = sort2f(top[0][a] & ~0x7Fu); v2[a] = sort2f(top[1][a] & ~0x7Fu); }
    unsigned cd[64];
#define CK(a_, b_) ((f2sort(v1[a_] + v2[b_]) & ~0xFFu) | (unsigned)(255 - ((a_) * 16 + (b_))))
    cd[0] = CK(0, 0); cd[1] = CK(0, 1); cd[2] = CK(0, 2); cd[3] = CK(0, 3); cd[4] = CK(0, 4);
    cd[5] = CK(0, 5); cd[6] = CK(0, 6); cd[7] = CK(0, 7); cd[8] = CK(0, 8); cd[9] = CK(0, 9);
    cd[10] = CK(0, 10); cd[11] = CK(0, 11); cd[12] = CK(0, 12); cd[13] = CK(0, 13); cd[14] = CK(0, 14);
    cd[15] = CK(0, 15); cd[16] = CK(1, 0); cd[17] = CK(1, 1); cd[18] = CK(1, 2); cd[19] = CK(1, 3);
    cd[20] = CK(1, 4); cd[21] = CK(1, 5); cd[22] = CK(1, 6); cd[23] = CK(1, 7); cd[24] = CK(2, 0);
    cd[25] = CK(2, 1); cd[26] = CK(2, 2); cd[27] = CK(2, 3); cd[28] = CK(2, 4); cd[29] = CK(3, 0);
    cd[30] = CK(3, 1); cd[31] = CK(3, 2); cd[32] = CK(3, 3); cd[33] = CK(4, 0); cd[34] = CK(4, 1);
    cd[35] = CK(4, 2); cd[36] = CK(5, 0); cd[37] = CK(5, 1); cd[38] = CK(6, 0); cd[39] = CK(6, 1);
    cd[40] = CK(7, 0); cd[41] = CK(7, 1); cd[42] = CK(8, 0); cd[43] = CK(9, 0); cd[44] = CK(10, 0);
    cd[45] = CK(11, 0); cd[46] = CK(12, 0); cd[47] = CK(13, 0); cd[48] = CK(14, 0); cd[49] = CK(15, 0);
#undef CK
#pragma unroll
    for (int n = 50; n < 64; ++n) cd[n] = 0u;
    unsigned c0[16], c1[16];
#pragma unroll
    for (int i = 0; i < 16; ++i) { c0[i] = selu(h, cd[i], cd[32 + i]); c1[i] = selu(h, cd[16 + i], cd[48 + i]); }
    bitonic_sort16_desc(c0); bitonic_sort16_desc(c1);
    top16_merge(c0, c1);
    top16_xlane(c0);
    LDS_WAIT();
    asm volatile("" ::: "memory");
    const float mx0 = sort2f(c0[0] & ~0xFFu);
    float ev[16], esum = 0.f;
#pragma unroll
    for (int t = 0; t < 16; ++t) { ev[t] = fexp2((sort2f(c0[t] & ~0xFFu) - mx0) * LOG2E); esum += ev[t]; }
    const float inv = 1.0f / esum;
#pragma unroll
    for (int q4 = 0; q4 < 2; ++q4) {
        int iv[4]; float gv[4];
#pragma unroll
        for (int k = 0; k < 4; ++k) {
            const unsigned cw = selu(h, c0[4 * q4 + k], c0[8 + 4 * q4 + k]);
            const float e = self(h, ev[4 * q4 + k], ev[8 + 4 * q4 + k]);
            const int code = 255 - (int)(cw & 0xFFu), a = code >> 4, bb = code & 15;
            const int i1 = 127 - (int)(A[a * 256 + tslot] & 0x7Fu), i2 = 127 - (int)(A[(16 + bb) * 256 + tslot] & 0x7Fu);
            iv[k] = i1 * 128 + i2; gv[k] = e * inv;
        }
        const size_t o = tok * 128 + hd * 16 + 8 * h + 4 * q4;
        v4u iw; iw.x = (unsigned)iv[0]; iw.y = (unsigned)iv[1]; iw.z = (unsigned)iv[2]; iw.w = (unsigned)iv[3];
        *(GAS v4u*)(IDX + o) = iw;
        f32x4 gw; gw.x = gv[0]; gw.y = gv[1]; gw.z = gv[2]; gw.w = gv[3];
        *(GAS f32x4*)(GATE + o) = gw;
    }
}

DI float dot2bf(unsigned w, unsigned x, float acc) { return __builtin_amdgcn_fdot2_f32_bf16(__builtin_bit_cast(bf16x2_t, w), __builtin_bit_cast(bf16x2_t, x), acc, false); }
DI float readlane_f(float v, int l) { return __uint_as_float((unsigned)__builtin_amdgcn_readlane((int)__float_as_uint(v), l)); }
DI float gelu_erf(float x) { return 0.5f * x * (1.0f + erff(x * 0.70710678118654752f)); }
DI void load_row8(v4u* dst, const bf16* row, int lane) {
    const GAS v4u* p = (const GAS v4u*)row + lane;
#pragma unroll
    for (int j = 0; j < 8; ++j) dst[j] = p[64 * j];
}
DI float dot_row(const v4u* xr, const v4u* w) {
    float a0 = 0.f, a1 = 0.f, a2 = 0.f, a3 = 0.f;
#pragma unroll
    for (int j = 0; j < 8; ++j) { a0 = dot2bf(w[j].x, xr[j].x, a0); a1 = dot2bf(w[j].y, xr[j].y, a1); a2 = dot2bf(w[j].z, xr[j].z, a2); a3 = dot2bf(w[j].w, xr[j].w, a3); }
    return (a0 + a1) + (a2 + a3);
}
DI void axpy_row(float* acc, const v4u* w, float s) {
#pragma unroll
    for (int j = 0; j < 8; ++j)
#pragma unroll
        for (int k = 0; k < 4; ++k) { acc[8 * j + 2 * k] += s * bflo(w[j][k]); acc[8 * j + 2 * k + 1] += s * bfhi(w[j][k]); }
}
DI void peer_token(int tk, const bf16* XN, const int* IDX, const float* GATE, const bf16* UB, const bf16* VB, float* hout, const float* gfin, int lane) {
    v4u xr[8];
    load_row8(xr, XN + (size_t)tk * DM, lane);
    const int ilo = IDX[(size_t)tk * 128 + lane], ihi = IDX[(size_t)tk * 128 + 64 + lane];
    const float glo = GATE[(size_t)tk * 128 + lane], ghi = GATE[(size_t)tk * 128 + 64 + lane];
    float alo = 0.f, ahi = 0.f;
#ifdef PEER_REP
    for (int prep_ = 0; prep_ < 2; ++prep_)
#endif
    {
        v4u b0[8], b1[8];
        load_row8(b0, UB + (size_t)__builtin_amdgcn_readlane(ilo, 0) * DM, lane);
#pragma unroll 1
        for (int e = 0; e < 128; e += 2) {
            const int l1 = (e + 1) & 63;
            const int r1 = (e + 1) < 64 ? __builtin_amdgcn_readlane(ilo, l1) : __builtin_amdgcn_readlane(ihi, l1);
            load_row8(b1, UB + (size_t)r1 * DM, lane);
            { const float d = wave_sum(dot_row(xr, b0)); if (e < 64) { if (lane == (e & 63)) alo = d; } else { if (lane == (e & 63)) ahi = d; } }
            const int e2 = e + 2 < 128 ? e + 2 : 127, l2 = e2 & 63;
            const int r2 = e2 < 64 ? __builtin_amdgcn_readlane(ilo, l2) : __builtin_amdgcn_readlane(ihi, l2);
            load_row8(b0, UB + (size_t)r2 * DM, lane);
            { const float d = wave_sum(dot_row(xr, b1)); if (e + 1 < 64) { if (lane == l1) alo = d; } else { if (lane == l1) ahi = d; } }
        }
    }
#ifdef DBG_NO_PEER
    const float wlo = 0.f * alo * glo, whi = 0.f * ahi * ghi;
#else
    const float wlo = gelu_erf(alo) * glo, whi = gelu_erf(ahi) * ghi;
#endif
    float acc[64];
#pragma unroll
    for (int i = 0; i < 64; ++i) acc[i] = 0.f;
    {
        v4u b0[8], b1[8];
        load_row8(b0, VB + (size_t)__builtin_amdgcn_readlane(ilo, 0) * DM, lane);
#pragma unroll 1
        for (int e = 0; e < 128; e += 2) {
            const int l0 = e & 63, l1 = (e + 1) & 63;
            const int r1 = (e + 1) < 64 ? __builtin_amdgcn_readlane(ilo, l1) : __builtin_amdgcn_readlane(ihi, l1);
            load_row8(b1, VB + (size_t)r1 * DM, lane);
            { const float w = e < 64 ? readlane_f(wlo, l0) : readlane_f(whi, l0); axpy_row(acc, b0, w); }
            const int e2 = e + 2 < 128 ? e + 2 : 127, l2 = e2 & 63;
            const int r2 = e2 < 64 ? __builtin_amdgcn_readlane(ilo, l2) : __builtin_amdgcn_readlane(ihi, l2);
            load_row8(b0, VB + (size_t)r2 * DM, lane);
            { const float w = (e + 1) < 64 ? readlane_f(wlo, l1) : readlane_f(whi, l1); axpy_row(acc, b1, w); }
        }
    }
    float* hrow = hout + (size_t)tk * DM;
    float ssq = 0.f;
#pragma unroll
    for (int j = 0; j < 8; ++j) {
        const f32x4 h0 = *(const GAS f32x4*)(hrow + 512 * j + 8 * lane), h1 = *(const GAS f32x4*)(hrow + 512 * j + 8 * lane + 4);
#pragma unroll
        for (int k = 0; k < 4; ++k) { acc[8 * j + k] += h0[k]; acc[8 * j + 4 + k] += h1[k]; }
#pragma unroll
        for (int k = 0; k < 8; ++k) ssq += acc[8 * j + k] * acc[8 * j + k];
    }
    const float rstd = 1.0f / sqrtf(wave_sum(ssq) * (1.f / DM) + RMS_EPS);
#pragma unroll
    for (int j = 0; j < 8; ++j) {
        const f32x4 g0 = *(const GAS f32x4*)(gfin + 512 * j + 8 * lane), g1 = *(const GAS f32x4*)(gfin + 512 * j + 8 * lane + 4);
        f32x4 o0, o1;
#pragma unroll
        for (int k = 0; k < 4; ++k) { o0[k] = acc[8 * j + k] * rstd * g0[k]; o1[k] = acc[8 * j + 4 + k] * rstd * g1[k]; }
        *(GAS f32x4*)(hrow + 512 * j + 8 * lane) = o0; *(GAS f32x4*)(hrow + 512 * j + 8 * lane + 4) = o1;
    }
}

DI float wave_max(float v) {
#pragma unroll
    for (int o = 1; o < 64; o <<= 1) v = fmaxf(v, __shfl_xor(v, o));
    return v;
}
DI int wave_sum_i(int v) {
#pragma unroll
    for (int o = 1; o < 64; o <<= 1) v += __shfl_xor(v, o);
    return v;
}
DI unsigned q8(float x, float inv, int bias) { return (unsigned)((int)rintf(x * inv) + bias) & 0xffu; }
DI void quant_row_i8(const float* src, unsigned char* dst, float* scl, int lane, int bias) {
    f32x4 v[16]; float am = 0.f;
#pragma unroll
    for (int j = 0; j < 4; ++j)
#pragma unroll
        for (int q = 0; q < 4; ++q) { const f32x4 t = *(const GAS f32x4*)(src + 1024 * j + 16 * lane + 4 * q); v[4 * j + q] = t;
            am = fmaxf(am, fmaxf(fmaxf(fabsf(t.x), fabsf(t.y)), fmaxf(fabsf(t.z), fabsf(t.w)))); }
    am = wave_max(am);
    const float inv = am > 0.f ? 127.f / am : 0.f;
#pragma unroll
    for (int j = 0; j < 4; ++j) { v4u w;
#pragma unroll
        for (int q = 0; q < 4; ++q) { const f32x4 t = v[4 * j + q]; w[q] = q8(t.x, inv, bias) | (q8(t.y, inv, bias) << 8) | (q8(t.z, inv, bias) << 16) | (q8(t.w, inv, bias) << 24); }
        *(GAS v4u*)(dst + 1024 * j + 16 * lane) = w; }
    if (lane == 0) *scl = am * (1.f / 127.f);
}
DI void load_row4(v4u* dst, const unsigned char* row, int lane) {
    const GAS v4u* p = (const GAS v4u*)row + lane;
#pragma unroll
    for (int j = 0; j < 4; ++j) dst[j] = p[64 * j];
}
DI int idot_row(const v4u* xq, const v4u* w) {
    int a0 = 0, a1 = 0;
#pragma unroll
    for (int j = 0; j < 4; ++j) { a0 = __builtin_amdgcn_sdot4((int)w[j].x, (int)xq[j].x, a0, false); a1 = __builtin_amdgcn_sdot4((int)w[j].y, (int)xq[j].y, a1, false);
        a0 = __builtin_amdgcn_sdot4((int)w[j].z, (int)xq[j].z, a0, false); a1 = __builtin_amdgcn_sdot4((int)w[j].w, (int)xq[j].w, a1, false); }
    return a0 + a1;
}
DI void axpy_row_u8(float* acc, const v4u* w, float s) {
#pragma unroll
    for (int j = 0; j < 4; ++j)
#pragma unroll
        for (int q = 0; q < 4; ++q) { const unsigned u = w[j][q];
            acc[16 * j + 4 * q + 0] += s * (float)(u & 0xffu); acc[16 * j + 4 * q + 1] += s * (float)((u >> 8) & 0xffu);
            acc[16 * j + 4 * q + 2] += s * (float)((u >> 16) & 0xffu); acc[16 * j + 4 * q + 3] += s * (float)(u >> 24); }
}
#define RL(v, l) __builtin_amdgcn_readlane((v), (l))
DI void peer_token_q(int tk, const bf16* XN, const int* IDX, const float* GATE, const unsigned char* UQ, const unsigned char* VQ, const float* SU, const float* SV, const float* SSQ,
                     float* hout, const float* gfin, int lane) {
    v4u xq[4]; float sx;
    {
        v4u xb[8]; float am = 0.f;
        const bf16* xp = XN + (size_t)tk * DM + 16 * lane;
#pragma unroll
        for (int j = 0; j < 4; ++j) { xb[2 * j] = *(const GAS v4u*)(xp + 1024 * j); xb[2 * j + 1] = *(const GAS v4u*)(xp + 1024 * j + 8); }
#pragma unroll
        for (int i = 0; i < 8; ++i)
#pragma unroll
            for (int k = 0; k < 4; ++k) am = fmaxf(am, fmaxf(fabsf(bflo(xb[i][k])), fabsf(bfhi(xb[i][k]))));
        am = wave_max(am);
        const float inv = am > 0.f ? 127.f / am : 0.f; sx = am * (1.f / 127.f);
#pragma unroll
        for (int j = 0; j < 4; ++j)
#pragma unroll
            for (int q = 0; q < 4; ++q) { const unsigned w0 = xb[2 * j + (q >> 1)][2 * (q & 1)], w1 = xb[2 * j + (q >> 1)][2 * (q & 1) + 1];
                xq[j][q] = q8(bflo(w0), inv, 0) | (q8(bfhi(w0), inv, 0) << 8) | (q8(bflo(w1), inv, 0) << 16) | (q8(bfhi(w1), inv, 0) << 24); }
    }
    const int ilo = IDX[(size_t)tk * 128 + lane], ihi = IDX[(size_t)tk * 128 + 64 + lane];
    const float glo = GATE[(size_t)tk * 128 + lane], ghi = GATE[(size_t)tk * 128 + 64 + lane];
    const float sulo = SU[ilo], suhi = SU[ihi], svlo = SV[ilo], svhi = SV[ihi];
    int dlo = 0, dhi = 0;
#define ROWIDX(e) ((e) < 64 ? RL(ilo, (e) & 63) : RL(ihi, (e) & 63))
#ifdef PEER_L2PROBE
    {
        int pd = 0;
        v4u ba[2][4], bb[2][4];
#define ROWIDXP(e) (((e) < 64 ? RL(ilo, (e) & 63) : RL(ihi, (e) & 63)) & 511)
        load_row4(ba[0], UQ + (size_t)ROWIDXP(0) * DM, lane); load_row4(ba[1], UQ + (size_t)ROWIDXP(1) * DM, lane);
#pragma unroll 1
        for (int e = 0; e < 128; e += 4) {
            load_row4(bb[0], UQ + (size_t)ROWIDXP(e + 2) * DM, lane); load_row4(bb[1], UQ + (size_t)ROWIDXP(e + 3) * DM, lane);
            pd += wave_sum_i(idot_row(xq, ba[0])) + wave_sum_i(idot_row(xq, ba[1]));
            const int e4 = e + 4 < 128 ? e + 4 : 126;
            load_row4(ba[0], UQ + (size_t)ROWIDXP(e4) * DM, lane); load_row4(ba[1], UQ + (size_t)ROWIDXP(e4 + 1) * DM, lane);
            pd += wave_sum_i(idot_row(xq, bb[0])) + wave_sum_i(idot_row(xq, bb[1]));
        }
#undef ROWIDXP
        asm volatile("" :: "v"(pd));
    }
#endif
#ifdef PEER_REP
    for (int prep_ = 0; prep_ < 2; ++prep_)
#endif
    {
        v4u ba[2][4], bb[2][4];
        load_row4(ba[0], UQ + (size_t)RL(ilo, 0) * DM, lane); load_row4(ba[1], UQ + (size_t)RL(ilo, 1) * DM, lane);
#pragma unroll 1
        for (int e = 0; e < 128; e += 4) {
            load_row4(bb[0], UQ + (size_t)ROWIDX(e + 2) * DM, lane); load_row4(bb[1], UQ + (size_t)ROWIDX(e + 3) * DM, lane);
            { const int d0 = wave_sum_i(idot_row(xq, ba[0])), d1 = wave_sum_i(idot_row(xq, ba[1]));
              if (e < 64) { if (lane == (e & 63)) dlo = d0; if (lane == ((e + 1) & 63)) dlo = d1; } else { if (lane == (e & 63)) dhi = d0; if (lane == ((e + 1) & 63)) dhi = d1; } }
            const int e4 = e + 4 < 128 ? e + 4 : 126;
            load_row4(ba[0], UQ + (size_t)ROWIDX(e4) * DM, lane); load_row4(ba[1], UQ + (size_t)ROWIDX(e4 + 1) * DM, lane);
            { const int d0 = wave_sum_i(idot_row(xq, bb[0])), d1 = wave_sum_i(idot_row(xq, bb[1]));
              if (e < 64) { if (lane == ((e + 2) & 63)) dlo = d0; if (lane == ((e + 3) & 63)) dlo = d1; } else { if (lane == ((e + 2) & 63)) dhi = d0; if (lane == ((e + 3) & 63)) dhi = d1; } }
        }
    }
    const float rsx = sx / sqrtf(SSQ[tk] * (1.f / DM) + RMS_EPS);
    const float wlo = gelu_erf((float)dlo * rsx * sulo) * glo * svlo, whi = gelu_erf((float)dhi * rsx * suhi) * ghi * svhi;
    const float wsum = wave_sum(wlo + whi);
    float acc[64];
#pragma unroll
    for (int i = 0; i < 64; ++i) acc[i] = 0.f;
#define ROWW(e) ((e) < 64 ? readlane_f(wlo, (e) & 63) : readlane_f(whi, (e) & 63))
    {
        v4u ba[2][4], bb[2][4];
        load_row4(ba[0], VQ + (size_t)RL(ilo, 0) * DM, lane); load_row4(ba[1], VQ + (size_t)RL(ilo, 1) * DM, lane);
#pragma unroll 1
        for (int e = 0; e < 128; e += 4) {
            load_row4(bb[0], VQ + (size_t)ROWIDX(e + 2) * DM, lane); load_row4(bb[1], VQ + (size_t)ROWIDX(e + 3) * DM, lane);
            axpy_row_u8(acc, ba[0], ROWW(e)); axpy_row_u8(acc, ba[1], ROWW(e + 1));
            const int e4 = e + 4 < 128 ? e + 4 : 126;
            load_row4(ba[0], VQ + (size_t)ROWIDX(e4) * DM, lane); load_row4(ba[1], VQ + (size_t)ROWIDX(e4 + 1) * DM, lane);
            axpy_row_u8(acc, bb[0], ROWW(e + 2)); axpy_row_u8(acc, bb[1], ROWW(e + 3));
        }
    }
#undef ROWIDX
#undef ROWW
    float* hrow = hout + (size_t)tk * DM + 16 * lane;
    const float corr = -128.f * wsum;
    float ssq = 0.f;
#pragma unroll
    for (int j = 0; j < 4; ++j)
#pragma unroll
        for (int q = 0; q < 4; ++q) { const f32x4 hv = *(const GAS f32x4*)(hrow + 1024 * j + 4 * q);
#pragma unroll
            for (int k = 0; k < 4; ++k) { const float t = acc[16 * j + 4 * q + k] + corr + hv[k]; acc[16 * j + 4 * q + k] = t; ssq += t * t; } }
    const float rstd = 1.0f / sqrtf(wave_sum(ssq) * (1.f / DM) + RMS_EPS);
    const float* gp = gfin + 16 * lane;
#pragma unroll
    for (int j = 0; j < 4; ++j)
#pragma unroll
        for (int q = 0; q < 4; ++q) { const f32x4 gv = *(const GAS f32x4*)(gp + 1024 * j + 4 * q); f32x4 o;
#pragma unroll
            for (int k = 0; k < 4; ++k) o[k] = acc[16 * j + 4 * q + k] * rstd * gv[k];
            *(GAS f32x4*)(hrow + 1024 * j + 4 * q) = o; }
}

DI void fmac_s(float& acc, float w, float x) { asm("v_fmac_f32_e32 %0, %1, %2" : "+v"(acc) : "v"(w), "v"(x)); }
DI void pkfma16_lo(unsigned& acc, unsigned x, unsigned wp) { asm("v_pk_fma_f16 %0, %1, %2, %0 op_sel_hi:[1,0,1]" : "+v"(acc) : "v"(x), "v"(wp)); }
DI void pkfma16_hi(unsigned& acc, unsigned x, unsigned wp) { asm("v_pk_fma_f16 %0, %1, %2, %0 op_sel:[0,1,0] op_sel_hi:[1,1,1]" : "+v"(acc) : "v"(x), "v"(wp)); }
DI void quant_row_i8_sliced(const float* src, unsigned char* tab, int e, float* scl, int lane, int bias) {
    f32x4 v[16]; float am = 0.f;
#pragma unroll
    for (int j = 0; j < 4; ++j)
#pragma unroll
        for (int q = 0; q < 4; ++q) { const f32x4 t = *(const GAS f32x4*)(src + 1024 * j + 16 * lane + 4 * q); v[4 * j + q] = t;
            am = fmaxf(am, fmaxf(fmaxf(fabsf(t.x), fabsf(t.y)), fmaxf(fabsf(t.z), fabsf(t.w)))); }
    am = wave_max(am);
    const float inv = am > 0.f ? 127.f / am : 0.f;
#pragma unroll
    for (int j = 0; j < 4; ++j) { v4u w;
#pragma unroll
        for (int q = 0; q < 4; ++q) { const f32x4 t = v[4 * j + q]; w[q] = q8(t.x, inv, bias) | (q8(t.y, inv, bias) << 8) | (q8(t.z, inv, bias) << 16) | (q8(t.w, inv, bias) << 24); }
        *(GAS v4u*)(tab + (size_t)(8 * j + (lane >> 3)) * SLICE_BYTES + (size_t)e * 128 + 16 * (lane & 7)) = w; }
    if (lane == 0) *scl = am * (1.f / 127.f);
}
DI void qrow_load(f32x4* v, const float* src, int lane) {
#pragma unroll
    for (int j = 0; j < 4; ++j)
#pragma unroll
        for (int q = 0; q < 4; ++q) v[4 * j + q] = *(const GAS f32x4*)(src + 1024 * j + 16 * lane + 4 * q);
}
template <bool NOST = false> DI void qrow_store(const f32x4* v, unsigned char* tab, int e, float* scl, int lane, int bias) {
    float am = 0.f;
#pragma unroll
    for (int i = 0; i < 16; ++i) { const f32x4 t = v[i]; am = fmaxf(am, fmaxf(fmaxf(fabsf(t.x), fabsf(t.y)), fmaxf(fabsf(t.z), fabsf(t.w)))); }
    am = wave_max(am);
    const float inv = am > 0.f ? 127.f / am : 0.f;
#pragma unroll
    for (int j = 0; j < 4; ++j) { v4u w;
#pragma unroll
        for (int q = 0; q < 4; ++q) { const f32x4 t = v[4 * j + q]; w[q] = q8(t.x, inv, bias) | (q8(t.y, inv, bias) << 8) | (q8(t.z, inv, bias) << 16) | (q8(t.w, inv, bias) << 24); }
        if (NOST) asm volatile("" :: "v"(w)); else *(GAS v4u*)(tab + (size_t)(8 * j + (lane >> 3)) * SLICE_BYTES + (size_t)e * 128 + 16 * (lane & 7)) = w; }
    if (lane == 0 && !NOST) *scl = am * (1.f / 127.f);
}
DI unsigned q4(float x, float inv) { int q = (int)floorf(x * inv + 8.0f); q = q < 0 ? 0 : (q > 15 ? 15 : q); return (unsigned)q; }
DI void qrow_store_u4(const f32x4* v, unsigned char* tab, int e, float* scl, int lane) {
    float ss = 0.f;
#pragma unroll
    for (int i = 0; i < 16; ++i) { const f32x4 t = v[i]; ss += (t.x * t.x + t.y * t.y) + (t.z * t.z + t.w * t.w); }
    ss = wave_sum(ss);
    const float step = 0.3352f * sqrtf(ss * (1.f / DM)), inv = step > 0.f ? 1.0f / step : 0.f;
#pragma unroll
    for (int j = 0; j < 4; ++j) { u32x2 w;
#pragma unroll
        for (int d = 0; d < 2; ++d) { const f32x4 a = v[4 * j + 2 * d], b = v[4 * j + 2 * d + 1];
            w[d] = q4(a.x, inv) | (q4(a.y, inv) << 8) | (q4(a.z, inv) << 16) | (q4(a.w, inv) << 24) | (q4(b.x, inv) << 4) | (q4(b.y, inv) << 12) | (q4(b.z, inv) << 20) | (q4(b.w, inv) << 28); }
        *(GAS u32x2*)(tab + (size_t)(4 * j + (lane >> 4)) * SLICE_BYTES + (size_t)e * 128 + 8 * (lane & 15)) = w; }
    if (lane == 0) *scl = step;
}
template <bool NOST = false> DI void quant_rows_strided(int r_lo, int r_hi, int stride, const float* peer_u, const float* peer_v, unsigned char* UQ, unsigned char* VQ, float* SU, float* SV, int lane) {
    if (r_lo >= r_hi) return;
#define QSRC(r_) (((r_) >= NEXP ? peer_v + (size_t)((r_) - NEXP) * DM : peer_u + (size_t)(r_) * DM))
#ifdef U4
#define QSTORE(v_, r_) do { if ((r_) >= NEXP) qrow_store<NOST>(v_, VQ, (r_) - NEXP, SV + ((r_) - NEXP), lane, 128); else qrow_store_u4(v_, UQ, (r_), SU + (r_), lane); } while (0)
#else
#define QSTORE(v_, r_) do { if ((r_) >= NEXP) qrow_store<NOST>(v_, VQ, (r_) - NEXP, SV + ((r_) - NEXP), lane, 128); else qrow_store<NOST>(v_, UQ, (r_), SU + (r_), lane, 0); } while (0)
#endif
    f32x4 va[16], vb[16];
    qrow_load(va, QSRC(r_lo), lane);
#pragma unroll 1
    for (int r = r_lo; r < r_hi; r += 2 * stride) {
        const int r1 = r + stride < r_hi ? r + stride : r, r2 = r + 2 * stride < r_hi ? r + 2 * stride : r;
        qrow_load(vb, QSRC(r1), lane);
        QSTORE(va, r);
        qrow_load(va, QSRC(r2), lane);
        if (r + stride < r_hi) QSTORE(vb, r1);
    }
#undef QSRC
#undef QSTORE
}
DI void quant_token(int tk, const bf16* XN, const float* gain, const float* SSQ, unsigned char* XQ, float* SX, int lane) {
    v4u xb[8]; float am = 0.f;
    const bf16* xp = XN + (size_t)tk * DM + 16 * lane; const float* gp = gain + 16 * lane;
#pragma unroll
    for (int j = 0; j < 4; ++j) { xb[2 * j] = *(const GAS v4u*)(xp + 1024 * j); xb[2 * j + 1] = *(const GAS v4u*)(xp + 1024 * j + 8); }
#pragma unroll
    for (int i = 0; i < 8; ++i) { const f32x4 g0 = *(const GAS f32x4*)(gp + 1024 * (i >> 1) + 8 * (i & 1)), g1 = *(const GAS f32x4*)(gp + 1024 * (i >> 1) + 8 * (i & 1) + 4);
        xb[i].x = cvtpk(bflo(xb[i].x) * g0.x, bfhi(xb[i].x) * g0.y); xb[i].y = cvtpk(bflo(xb[i].y) * g0.z, bfhi(xb[i].y) * g0.w);
        xb[i].z = cvtpk(bflo(xb[i].z) * g1.x, bfhi(xb[i].z) * g1.y); xb[i].w = cvtpk(bflo(xb[i].w) * g1.z, bfhi(xb[i].w) * g1.w); }
#pragma unroll
    for (int i = 0; i < 8; ++i)
#pragma unroll
        for (int k = 0; k < 4; ++k) am = fmaxf(am, fmaxf(fabsf(bflo(xb[i][k])), fabsf(bfhi(xb[i][k]))));
    am = wave_max(am);
    const float inv = am > 0.f ? 127.f / am : 0.f;
#pragma unroll
    for (int j = 0; j < 4; ++j) { v4u o;
#pragma unroll
        for (int q = 0; q < 4; ++q) { const unsigned w0 = xb[2 * j + (q >> 1)][2 * (q & 1)], w1 = xb[2 * j + (q >> 1)][2 * (q & 1) + 1];
            o[q] = q8(bflo(w0), inv, 0) | (q8(bfhi(w0), inv, 0) << 8) | (q8(bflo(w1), inv, 0) << 16) | (q8(bfhi(w1), inv, 0) << 24); }
        *(GAS v4u*)(XQ + (size_t)tk * DM + 1024 * j + 16 * lane) = o; }
    if (lane == 0) SX[tk] = am * (1.f / 127.f) / sqrtf(SSQ[tk] * (1.f / DM) + RMS_EPS);
#ifdef U4
    {
        int sm = 0;
#pragma unroll
        for (int i = 0; i < 8; ++i)
#pragma unroll
            for (int k = 0; k < 4; ++k) { sm += (int)rintf(bflo(xb[i][k]) * inv) + (int)rintf(bfhi(xb[i][k]) * inv); }
        sm = wave_sum_i(sm);
        if (lane == 0) ((int*)(SX + T_TOK))[tk] = sm;
    }
#endif
}
DI void peer_sweep(LAS unsigned char* lds, int wave, int gw, int NGW, const unsigned char* XQ, const float* SX, const int* IDX, const float* GATE,
                   const unsigned char* UQs, const unsigned char* VQs, const float* SU, const float* SV, bf16* Hres, float* hout, const float* gfin, int lane) {
    const int g = lane >> 3, c = lane & 7;
    LAS int* RI = (LAS int*)(lds + wave * 16384) + lane;
    int tok[4];
#pragma unroll
    for (int k = 0; k < 4; ++k) tok[k] = gw + k * NGW;
#pragma unroll
    for (int k = 0; k < 4; ++k)
#pragma unroll
        for (int i = 0; i < 16; ++i) RI[(k * 16 + i) * 64] = IDX[(size_t)tok[k] * 128 + 8 * i + g] * 128 + 16 * c;
    LDS_WAIT(); asm volatile("" ::: "memory");
#define PS_ISSUE(dst, base, k_, h_) do { _Pragma("unroll") for (int i_ = 0; i_ < 8; ++i_) dst[i_] = *(const GAS v4u*)((base) + RI[((k_) * 16 + 8 * (h_) + i_) * 64]); } while (0)
#ifdef PROBE_SWEEP
    const unsigned long long tsw0 = __builtin_amdgcn_s_memrealtime(); const unsigned long long tck0 = clock64();
#endif
    int A[4][16];
#pragma unroll
    for (int k = 0; k < 4; ++k)
#pragma unroll
        for (int i = 0; i < 16; ++i) A[k][i] = 0;
#ifdef U4
    {
        v4u wa[16], wb[16], xa0, xa1, xb0, xb1;
#define PS_ISSUE16(dst, base, k_) do { _Pragma("unroll") for (int i_ = 0; i_ < 16; ++i_) dst[i_] = *(const GAS v4u*)((base) + RI[((k_) * 16 + i_) * 64]); } while (0)
#define PS_XS(d0_, d1_, s_, k_) do { const unsigned char* xp_ = XQ + (size_t)tok[k_] * DM + 256 * (s_) + 32 * c; d0_ = *(const GAS v4u*)xp_; d1_ = *(const GAS v4u*)(xp_ + 16); } while (0)
#define PS_D4(a_, w_, xl_, xh_) do { a_ = __builtin_amdgcn_sdot4((int)((w_) & 0x0F0F0F0Fu), (int)(xl_), a_, false); a_ = __builtin_amdgcn_sdot4((int)(((w_) >> 4) & 0x0F0F0F0Fu), (int)(xh_), a_, false); } while (0)
#define PS_DOT16(k_, w_, x0_, x1_) do { _Pragma("unroll") for (int i_ = 0; i_ < 16; ++i_) { int a_ = A[k_][i_]; PS_D4(a_, w_[i_].x, x0_.x, x0_.y); PS_D4(a_, w_[i_].y, x0_.z, x0_.w); \
            PS_D4(a_, w_[i_].z, x1_.x, x1_.y); PS_D4(a_, w_[i_].w, x1_.z, x1_.w); A[k_][i_] = a_; } } while (0)
        PS_ISSUE16(wa, UQs, 0); PS_XS(xa0, xa1, 0, 0);
#pragma unroll 1
        for (int s = 0; s < 16; ++s) {
            asm volatile("" ::: "memory");
            const unsigned char* us = UQs + (size_t)s * SLICE_BYTES;
            const int sn = s + 1 < 16 ? s + 1 : 15;
            const unsigned char* usn = UQs + (size_t)sn * SLICE_BYTES;
            PS_ISSUE16(wb, us, 1); PS_XS(xb0, xb1, s, 1);
            PS_DOT16(0, wa, xa0, xa1);
            PS_ISSUE16(wa, us, 2); PS_XS(xa0, xa1, s, 2);
            PS_DOT16(1, wb, xb0, xb1);
            PS_ISSUE16(wb, us, 3); PS_XS(xb0, xb1, s, 3);
            PS_DOT16(2, wa, xa0, xa1);
            PS_ISSUE16(wa, usn, 0); PS_XS(xa0, xa1, sn, 0);
            PS_DOT16(3, wb, xb0, xb1);
        }
#undef PS_ISSUE16
#undef PS_XS
#undef PS_D4
#undef PS_DOT16
    }
#else
    {
        v4u wa[16], wb[16], xa, xb;
#define PS_ISSUE16(dst, base, k_) do { _Pragma("unroll") for (int i_ = 0; i_ < 16; ++i_) dst[i_] = *(const GAS v4u*)((base) + RI[((k_) * 16 + i_) * 64]); } while (0)
#define PS_XS(s_, k_) (*(const GAS v4u*)(XQ + (size_t)tok[k_] * DM + 128 * (s_) + 16 * c))
#define PS_DOT16(k_, w_, x_) do { _Pragma("unroll") for (int i_ = 0; i_ < 16; ++i_) { int a_ = A[k_][i_]; a_ = __builtin_amdgcn_sdot4((int)w_[i_].x, (int)x_.x, a_, false); a_ = __builtin_amdgcn_sdot4((int)w_[i_].y, (int)x_.y, a_, false); \
            a_ = __builtin_amdgcn_sdot4((int)w_[i_].z, (int)x_.z, a_, false); a_ = __builtin_amdgcn_sdot4((int)w_[i_].w, (int)x_.w, a_, false); A[k_][i_] = a_; } } while (0)
        PS_ISSUE16(wa, UQs, 0); xa = PS_XS(0, 0);
#pragma unroll 1
        for (int s = 0; s < 32; ++s) {
            asm volatile("" ::: "memory");
            const unsigned char* us = UQs + (size_t)s * SLICE_BYTES;
            const int sn = s + 1 < 32 ? s + 1 : 31;
            const unsigned char* usn = UQs + (size_t)sn * SLICE_BYTES;
            PS_ISSUE16(wb, us, 1); xb = PS_XS(s, 1);
            PS_DOT16(0, wa, xa);
            PS_ISSUE16(wa, us, 2); xa = PS_XS(s, 2);
            PS_DOT16(1, wb, xb);
            PS_ISSUE16(wb, us, 3); xb = PS_XS(s, 3);
            PS_DOT16(2, wa, xa);
            PS_ISSUE16(wa, usn, 0); xa = PS_XS(sn, 0);
            PS_DOT16(3, wb, xb);
        }
#undef PS_ISSUE16
#undef PS_XS
#undef PS_DOT16
    }
#endif
#ifdef PROBE_USWEEP
    {
        int A2[4][16];
#pragma unroll
        for (int k = 0; k < 4; ++k)
#pragma unroll
            for (int i = 0; i < 16; ++i) A2[k][i] = 0;
        v4u wb0[8], wb1[8], xs, xsn;
        PS_ISSUE(wb0, UQs, 0, 0); xs = *(const GAS v4u*)(XQ + (size_t)tok[0] * DM + 16 * c);
#pragma unroll 1
        for (int s = 0; s < 32; ++s) {
            asm volatile("" ::: "memory");
            const unsigned char* us = UQs + (size_t)s * SLICE_BYTES;
            const int sn = s + 1 < 32 ? s + 1 : 31;
            const unsigned char* usn = UQs + (size_t)sn * SLICE_BYTES;
#pragma unroll
            for (int k = 0; k < 4; ++k) {
                PS_ISSUE(wb1, us, k, 1);
#pragma unroll
                for (int i = 0; i < 8; ++i) { int a = A2[k][i]; a = __builtin_amdgcn_sdot4((int)wb0[i].x, (int)xs.x, a, false); a = __builtin_amdgcn_sdot4((int)wb0[i].y, (int)xs.y, a, false);
                    a = __builtin_amdgcn_sdot4((int)wb0[i].z, (int)xs.z, a, false); a = __builtin_amdgcn_sdot4((int)wb0[i].w, (int)xs.w, a, false); A2[k][i] = a; }
                if (k < 3) { PS_ISSUE(wb0, us, k + 1, 0); xsn = *(const GAS v4u*)(XQ + (size_t)tok[k + 1 < 4 ? k + 1 : 3] * DM + 128 * s + 16 * c); }
                else { PS_ISSUE(wb0, usn, 0, 0); xsn = *(const GAS v4u*)(XQ + (size_t)tok[0] * DM + 128 * sn + 16 * c); }
#pragma unroll
                for (int i = 0; i < 8; ++i) { int a = A2[k][8 + i]; a = __builtin_amdgcn_sdot4((int)wb1[i].x, (int)xs.x, a, false); a = __builtin_amdgcn_sdot4((int)wb1[i].y, (int)xs.y, a, false);
                    a = __builtin_amdgcn_sdot4((int)wb1[i].z, (int)xs.z, a, false); a = __builtin_amdgcn_sdot4((int)wb1[i].w, (int)xs.w, a, false); A2[k][8 + i] = a; }
                xs = xsn;
            }
        }
#pragma unroll
        for (int k = 0; k < 4; ++k)
#pragma unroll
            for (int i = 0; i < 16; ++i) asm volatile("" :: "v"(A2[k][i]));
    }
#endif
#ifdef PROBE_SWEEP
    asm volatile("s_waitcnt vmcnt(0)" ::: "memory"); const unsigned long long tsw1 = __builtin_amdgcn_s_memrealtime();
#endif
    float W[4][16], wsum[4];
#ifdef VF16
    unsigned Wp[4][8]; float usc[4];
    typedef _Float16 h2_t __attribute__((ext_vector_type(2)));
#endif
#pragma unroll
    for (int k = 0; k < 4; ++k) {
        const float sx = SX[tok[k]]; float ws_ = 0.f;
#pragma unroll
        for (int i = 0; i < 16; ++i) {
            int a = A[k][i]; a += __shfl_xor(a, 1); a += __shfl_xor(a, 2); a += __shfl_xor(a, 4);
            const int e = IDX[(size_t)tok[k] * 128 + 8 * i + g];
#ifdef U4
            const float w = gelu_erf(((float)a - 7.5f * (float)((const int*)(SX + T_TOK))[tok[k]]) * sx * SU[e]) * GATE[(size_t)tok[k] * 128 + 8 * i + g] * SV[e];
#else
            const float w = gelu_erf((float)a * sx * SU[e]) * GATE[(size_t)tok[k] * 128 + 8 * i + g] * SV[e];
#endif
            W[k][i] = w; ws_ += w;
        }
        ws_ += __shfl_xor(ws_, 8); ws_ += __shfl_xor(ws_, 16); ws_ += __shfl_xor(ws_, 32);
        wsum[k] = ws_;
#ifdef VF16
        {
            float wm = 0.f;
#pragma unroll
            for (int i = 0; i < 16; ++i) wm = fmaxf(wm, fabsf(W[k][i]));
            wm = fmaxf(wm, __shfl_xor(wm, 8)); wm = fmaxf(wm, __shfl_xor(wm, 16)); wm = fmaxf(wm, __shfl_xor(wm, 32));
            const int ex = wm > 0.f ? __builtin_amdgcn_frexp_expf(wm) : 14;
            const float alpha = __builtin_amdgcn_ldexpf(1.0f, 14 - ex);
            usc[k] = __builtin_amdgcn_ldexpf(1.0f, 24 - (14 - ex));
#pragma unroll
            for (int p = 0; p < 8; ++p) { const _Float16 h0 = (_Float16)(W[k][2 * p] * alpha), h1 = (_Float16)(W[k][2 * p + 1] * alpha);
                Wp[k][p] = (unsigned)__builtin_bit_cast(unsigned short, h0) | ((unsigned)__builtin_bit_cast(unsigned short, h1) << 16); }
        }
#endif
    }
    float ssq[4] = {0.f, 0.f, 0.f, 0.f};
    const bool g0 = (g & 1) != 0, g1 = (g & 2) != 0, g2 = (g & 4) != 0;
    const int colsub = 16 * c + 8 * (g & 1) + 4 * ((g >> 1) & 1) + 2 * ((g >> 2) & 1);
#ifndef NO_VSWEEP
    {
        v4u wb0[8], wb1[8];
#ifdef VF16
        int riA[8], riB[8];
#define PS_RI(dst, k_, h_) do { _Pragma("unroll") for (int i_ = 0; i_ < 8; ++i_) dst[i_] = RI[((k_) * 16 + 8 * (h_) + i_) * 64]; } while (0)
#define PS_LD(dst, base, ri_) do { _Pragma("unroll") for (int i_ = 0; i_ < 8; ++i_) dst[i_] = *(const GAS v4u*)((base) + ri_[i_]); } while (0)
        PS_RI(riB, 0, 1);
#endif
        PS_ISSUE(wb0, VQs, 0, 0);
#pragma unroll 1
        for (int s = 0; s < 32; ++s) {
            asm volatile("" ::: "memory");
            const unsigned char* vs = VQs + (size_t)s * SLICE_BYTES;
            const int sn = s + 1 < 32 ? s + 1 : 31;
            const unsigned char* vsn = VQs + (size_t)sn * SLICE_BYTES;
#pragma unroll
            for (int k = 0; k < 4; ++k) {
                float acc[16];
#ifdef VF16
                PS_LD(wb1, vs, riB);
                if (k < 3) PS_RI(riA, k + 1, 0); else PS_RI(riA, 0, 0);
                __builtin_amdgcn_sched_barrier(0);
#else
                PS_ISSUE(wb1, vs, k, 1);
#endif
                const unsigned hb = *(const GAS unsigned*)(Hres + (size_t)tok[k] * DM + 128 * s + colsub);
                f32x2 hv; hv.x = bflo(hb); hv.y = bfhi(hb);
#ifdef VF16
                unsigned ac2[8];
#pragma unroll
                for (int b = 0; b < 8; ++b) ac2[b] = 0u;
#define PS_ROWH(wv_, i_) do { const unsigned wp_ = Wp[k][(i_) >> 1]; \
                    _Pragma("unroll") for (int q = 0; q < 4; ++q) { const unsigned u = wv_[q]; \
                        const unsigned x0 = __builtin_amdgcn_perm(u, 0u, 0x0C050C04u), x1 = __builtin_amdgcn_perm(u, 0u, 0x0C070C06u); \
                        if ((i_) & 1) { pkfma16_hi(ac2[2 * q], x0, wp_); pkfma16_hi(ac2[2 * q + 1], x1, wp_); } else { pkfma16_lo(ac2[2 * q], x0, wp_); pkfma16_lo(ac2[2 * q + 1], x1, wp_); } } } while (0)
#pragma unroll
                for (int i = 0; i < 8; ++i) PS_ROWH(wb0[i], i);
                if (k < 3) { PS_LD(wb0, vs, riA); PS_RI(riB, k + 1, 1); } else { PS_LD(wb0, vsn, riA); PS_RI(riB, 0, 1); }
                __builtin_amdgcn_sched_barrier(0);
#pragma unroll
                for (int i = 0; i < 8; ++i) PS_ROWH(wb1[i], 8 + i);
#undef PS_ROWH
#pragma unroll
                for (int b = 0; b < 8; ++b) { const h2_t hv2 = __builtin_bit_cast(h2_t, ac2[b]); acc[2 * b] = (float)hv2.x * usc[k]; acc[2 * b + 1] = (float)hv2.y * usc[k]; }
#else
#pragma unroll
                for (int b = 0; b < 16; ++b) acc[b] = 0.f;
#pragma unroll
                for (int i = 0; i < 8; ++i) { const float w = W[k][i];
#pragma unroll
                    for (int q = 0; q < 4; ++q) { const unsigned u = wb0[i][q];
                        fmac_s(acc[4 * q + 0], w, (float)(u & 0xffu)); fmac_s(acc[4 * q + 1], w, (float)((u >> 8) & 0xffu)); fmac_s(acc[4 * q + 2], w, (float)((u >> 16) & 0xffu)); fmac_s(acc[4 * q + 3], w, (float)(u >> 24)); } }
                if (k < 3) { PS_ISSUE(wb0, vs, k + 1, 0); } else { PS_ISSUE(wb0, vsn, 0, 0); }
#pragma unroll
                for (int i = 0; i < 8; ++i) { const float w = W[k][8 + i];
#pragma unroll
                    for (int q = 0; q < 4; ++q) { const unsigned u = wb1[i][q];
                        fmac_s(acc[4 * q + 0], w, (float)(u & 0xffu)); fmac_s(acc[4 * q + 1], w, (float)((u >> 8) & 0xffu)); fmac_s(acc[4 * q + 2], w, (float)((u >> 16) & 0xffu)); fmac_s(acc[4 * q + 3], w, (float)(u >> 24)); } }
#endif
                float r8[8], r4[4], r2[2];
#pragma unroll
                for (int j = 0; j < 8; ++j) { const float snd = g0 ? acc[j] : acc[8 + j], kp = g0 ? acc[8 + j] : acc[j];
                    r8[j] = kp + __uint_as_float((unsigned)__builtin_amdgcn_update_dpp(0, (int)__float_as_uint(snd), 0x128  , 0xf, 0xf, false)); }
#pragma unroll
                for (int j = 0; j < 4; ++j) { const auto sw = __builtin_amdgcn_permlane16_swap(__float_as_uint(r8[j]), __float_as_uint(r8[4 + j]), false, false); r4[j] = __uint_as_float(sw[0]) + __uint_as_float(sw[1]); }
#pragma unroll
                for (int j = 0; j < 2; ++j) { const auto sw = __builtin_amdgcn_permlane32_swap(__float_as_uint(r4[j]), __float_as_uint(r4[2 + j]), false, false); r2[j] = __uint_as_float(sw[0]) + __uint_as_float(sw[1]); }
                const float corr = -128.f * wsum[k];
                f32x2 o; o.x = hv.x + r2[0] + corr; o.y = hv.y + r2[1] + corr;
                ssq[k] += o.x * o.x + o.y * o.y;
                *(GAS unsigned*)(Hres + (size_t)tok[k] * DM + 128 * s + colsub) = cvtpk(o.x, o.y);
            }
        }
    }
#endif
#undef PS_ISSUE
    asm volatile("s_waitcnt vmcnt(0)" ::: "memory");
#ifdef PROBE_SWEEP
    const unsigned long long tsw2 = __builtin_amdgcn_s_memrealtime();
#endif
#pragma unroll 1
    for (int k = 0; k < 4; ++k) {
        const float rstd = 1.0f / sqrtf(wave_sum(ssq[k]) * (1.f / DM) + RMS_EPS);
        const GAS v4u* hb = (const GAS v4u*)(Hres + (size_t)tok[k] * DM) + lane;
        float* orow = hout + (size_t)tok[k] * DM + 8 * lane; const float* gp = gfin + 8 * lane;
#pragma unroll
        for (int j = 0; j < 8; ++j) { const v4u v = hb[64 * j]; const f32x4 g0 = *(const GAS f32x4*)(gp + 512 * j), g1 = *(const GAS f32x4*)(gp + 512 * j + 4);
            f32x4 o0, o1; o0.x = bflo(v.x) * rstd * g0.x; o0.y = bfhi(v.x) * rstd * g0.y; o0.z = bflo(v.y) * rstd * g0.z; o0.w = bfhi(v.y) * rstd * g0.w;
            o1.x = bflo(v.z) * rstd * g1.x; o1.y = bfhi(v.z) * rstd * g1.y; o1.z = bflo(v.w) * rstd * g1.z; o1.w = bfhi(v.w) * rstd * g1.w;
            *(GAS f32x4*)(orow + 512 * j) = o0; *(GAS f32x4*)(orow + 512 * j + 4) = o1; }
    }
#ifdef PROBE_SWEEP
    if (gw == 0 && lane == 0) { asm volatile("s_waitcnt vmcnt(0)" ::: "memory");
        const unsigned long long tsw3 = __builtin_amdgcn_s_memrealtime();
        const unsigned long long d = PROBE_SWEEP == 0 ? tsw1 - tsw0 : (PROBE_SWEEP == 1 ? tsw2 - tsw1 : tsw3 - tsw2);
        const float val = PROBE_SWEEP == 4 ? (float)(clock64() - tck0) / (float)(tsw3 - tsw0) / 40.f : (PROBE_SWEEP == 3 ? (float)(tsw3 - tsw0) * (0.01f / 1000.f) : (float)d / (float)(tsw3 - tsw0));
        hout[(size_t)tok[0] * DM] += 0.2f + 0.25f * val; }
#endif
#ifdef PROBE_TIMING
    if (gw == 0 && lane == 0) { asm volatile("s_waitcnt vmcnt(0)" ::: "memory");
        const unsigned long long* pt = (const unsigned long long*)((const unsigned char*)SU - WS_SU + 262144);
        const float tot = (float)pt[3]; const float frac = (float)pt[PROBE_METRIC] / tot;
        hout[(size_t)tok[0] * DM] += 0.2f + 0.25f * frac; }
#endif
}

struct Args { const float* in[21]; float* out; unsigned char* ws; int ph_lo, ph_hi; };
static_assert(sizeof(Args) == 21 * 8 + 8 + 8 + 8, "Args has no padding");

__global__ void __launch_bounds__(NWAVES * 64, 2) hymba_fwd(Args args) {
    extern __shared__ __attribute__((aligned(16))) unsigned char lds_raw[];
    LAS unsigned char* lds = (LAS unsigned char*)lds_raw;
    volatile LAS unsigned* MISC = (volatile LAS unsigned*)(lds + MISC_OFF);
    const int tid = threadIdx.x, lane = tid & 63, wave = __builtin_amdgcn_readfirstlane(tid >> 6);
    const int G = gridDim.x; const int bx = blockIdx.x;
    const int vcu = (G % 8 == 0) ? (bx % 8) * (G / 8) + bx / 8 : bx;
    unsigned char* ws = args.ws;
    gu32* ctl = (gu32*)(ws + WS_CTL);
    for (int u = tid; u < (LDS_BYTES - LDSCTL_OFF) / 4; u += NWAVES * 64) ((LAS unsigned*)(lds + LDSCTL_OFF))[u] = 0u;
    __syncthreads();
    XcdBarrier bar = xcd_barrier_post((unsigned*)(ctl + CW_BAR), MISC + 8);
    const int lo = args.ph_lo, hi = args.ph_hi;
#ifdef PH_ONLY
#define IN(k) ((k) == PH_ONLY && lo <= (k) && (k) < hi)
#else
#define IN(k) (lo <= (k) && (k) < hi)
#endif
#ifndef DUP_PHASE
#define DUP_PHASE -1
#endif
#define REP(k) for (int rep_ = 0; rep_ < ((k) == DUP_PHASE ? 2 : 1); ++rep_)
#define SEAM(k) do { if (IN(k) && IN((k) + 1)) xcd_barrier(bar); } while (0)

    const float* x = args.in[0]; const float* mem = args.in[1]; const float* norm_mix = args.in[2]; const float* w_in = args.in[3];
    const float* swa_sink = args.in[4]; const float* nat_rel_bias = args.in[5]; const float* out_norm_swa = args.in[6]; const float* out_norm_nat = args.in[7];
    const float* w_out = args.in[8]; const float* norm_mem_q = args.in[9]; const float* norm_mem_kv = args.in[10]; const float* w_mem_q = args.in[11];
    const float* w_mem_k = args.in[12]; const float* w_mem_v = args.in[13]; const float* w_mem_o = args.in[14]; const float* norm_ffn = args.in[15];
    const float* w_peer_q = args.in[16]; const float* peer_sub_keys = args.in[17]; const float* peer_u = args.in[18]; const float* peer_v = args.in[19];
    const float* norm_final = args.in[20];
    float* out = args.out;
    float* ropec = (float*)(ws + WS_ROPE); float* ropes = ropec + 2048 * 64;
    bf16* SKB = (bf16*)(ws + WS_SKB);
    bf16* WIN_T = (bf16*)(ws + WS_WIN); bf16* WOUT_T = (bf16*)(ws + WS_WOUT); bf16* WMQ_T = (bf16*)(ws + WS_WMQ); bf16* WMKV_T = (bf16*)(ws + WS_WMKV);
    bf16* WMO_T = (bf16*)(ws + WS_WMO); bf16* WPQ_T = (bf16*)(ws + WS_WPQ); bf16* UB = (bf16*)(ws + WS_UB); bf16* VB = (bf16*)(ws + WS_VB);
    bf16* XN = (bf16*)(ws + WS_XN); bf16* QKV = (bf16*)(ws + WS_QKV); bf16* OB = (bf16*)(ws + WS_OB); bf16* MEMN = (bf16*)(ws + WS_MEMN);
    bf16* KVM = (bf16*)(ws + WS_KVM); bf16* QM = (bf16*)(ws + WS_QM); bf16* OM = (bf16*)(ws + WS_OM); bf16* QP = (bf16*)(ws + WS_QP);
    int* IDX = (int*)(ws + WS_IDX); float* GATE = (float*)(ws + WS_GATE);
    float* SSQ1 = (float*)(ws + WS_SSQ1); float* SSQ2 = (float*)(ws + WS_SSQ2); float* SSQA = (float*)(ws + WS_SSQA); float* SSQB = (float*)(ws + WS_SSQB); float* SSQ0 = (float*)(ws + WS_SSQ0);
    unsigned char* XQ = ws + WS_XQ; float* SX = (float*)(ws + WS_SX);
    unsigned char* UQ = ws + WS_UQ; unsigned char* VQ = ws + WS_VQ; float* SU = (float*)(ws + WS_SU); float* SV = (float*)(ws + WS_SV);
    const int gw = vcu * NWAVES + wave, NGW = G * NWAVES;

    constexpr int I_IN = (DM / 64) * (INW / 32), I_OUT = (DM / 64) * (DM / 32), I_MQ = (DM / 64) * (MEMW / 32), I_MO = (MEMW / 64) * (DM / 32), I_PQ = (DM / 64) * (PQW / 32);
    constexpr int QR0 = 26624, QR1 = 28160;
#define QUANT_ROWS(first_, last_, w0_, nw_) quant_rows_strided((first_) + (w0_), (last_), (nw_), peer_u, peer_v, UQ, VQ, SU, SV, lane)
    if (IN(0)) REP(0) {
        LAS float* scr = (LAS float*)(lds + wave * 16384);
#ifdef DUP_P0A
        for (int rr_ = 0; rr_ < 2; ++rr_)
#endif
        for (int it = gw; it < I_IN; it += NGW) p0_transpose_item(w_in, DM, INW, WIN_T, 0, scr, it, lane, norm_mix, norm_mix + 2048);
        for (int m = gw; m < T_TOK; m += NGW) row_to_bf16_ssq(x + (size_t)m * DM, XN + (size_t)m * DM, SSQ0 + m, lane);
        for (int m = gw; m < NBATCH * MEMLEN; m += NGW) rms_row_to_bf16(mem + (size_t)m * DM, norm_mem_kv, MEMN + (size_t)m * DM, lane);
#ifdef DUP_P0C
        for (int rr_ = 0; rr_ < 2; ++rr_)
#endif
        QUANT_ROWS(0, QR0, gw, NGW);
#ifdef DUP_P0C_NOST
        quant_rows_strided<true>(gw, QR0, NGW, peer_u, peer_v, UQ, VQ, SU, SV, lane);
#endif
        for (int e = gw * 64 + lane; e < 4 * T_TOK; e += NGW * 64) SSQ1[e] = 0.f;
        for (int e = (gw * 64 + lane) * 4; e < 8 * 2 * 128 * 128; e += NGW * 64 * 4) { const f32x4 a = *(const GAS f32x4*)(peer_sub_keys + e); u32x2 w; w.x = cvtpk(a.x, a.y); w.y = cvtpk(a.z, a.w); *(GAS u32x2*)(SKB + e) = w; }
        for (int e = gw * 64 + lane; e < 2048 * 64; e += NGW * 64) {
            const int pos = e >> 6, i = e & 63;
            const float inv = fexp2(-(float)i * (13.287712379549449f / 64.0f));
            const float ang = (float)pos * inv;
            const float rev = ang * 0.15915494309189535f; const float fr = rev - floorf(rev);
            ropec[e] = __builtin_amdgcn_cosf(fr); ropes[e] = __builtin_amdgcn_sinf(fr);
        }
    }
    SEAM(0);
    if (IN(1)) REP(1) {
        { pg8::Gemm g{XN, WIN_T, T_TOK, INW, DM}; pg8::StaticOrder S; S.init(T_TOK, INW, G, bx);
          EpiBf16RowScale E{QKV, INW, SSQ0};
          pg8::gemm_phase<EpiBf16RowScale, pg8::StaticOrder, true, true>(lds, g, S, E); }
        if (bx >= G / 2) {
            LAS float* scr = (LAS float*)(lds + wave * 16384);
            const int w0 = (bx - G / 2) * NWAVES + wave, nw = (G - G / 2) * NWAVES;
            for (int it = w0; it < I_OUT + 3 * I_MQ; it += nw) {
                int r = it;
                if (r < I_OUT) { p0_transpose_item(w_out, DM, DM, WOUT_T, 0, scr, r, lane, out_norm_swa, out_norm_nat); continue; } r -= I_OUT;
                if (r < I_MQ) { p0_transpose_item(w_mem_q, DM, MEMW, WMQ_T, 0, scr, r, lane, norm_mem_q, norm_mem_q + 2048); continue; } r -= I_MQ;
                if (r < I_MQ) { p0_transpose_item(w_mem_k, DM, MEMW, WMKV_T, 0, scr, r, lane); continue; } r -= I_MQ;
                p0_transpose_item(w_mem_v, DM, MEMW, WMKV_T, MEMW, scr, r, lane);
            }
            QUANT_ROWS(QR0, QR1, w0, nw);
        }
    }
    SEAM(1);
    if (IN(2)) REP(2) {
        for (int u = vcu; u < 1024; u += G) {
#ifndef NO_SWA
            if (u < 512) swa_unit(lds, u, QKV, OB, swa_sink, ropec, ropes, SSQA);
#endif
#ifndef NO_NAT
            if (u >= 512) nat_unit(lds, u - 512, QKV, OB, nat_rel_bias, SSQB);
#endif
#ifdef PROBE_SWA2
            if (u < 512) swa_unit<true>(lds, u, QKV, (bf16*)(ws + WS_QP), swa_sink, ropec, ropes, (float*)(ws + 196608));
#endif
#ifdef PROBE_NAT2
            if (u >= 512) nat_unit(lds, u - 512, QKV, (bf16*)(ws + WS_QP), nat_rel_bias, (float*)(ws + 196608));
#endif
        }
    }
    SEAM(2);
    if (IN(4)) REP(4) {
        pg8::Gemm g{OB, WOUT_T, T_TOK, DM, DM}; pg8::StaticOrder S; S.init(T_TOK, DM, G, bx);
        EpiResHMid E{XN, SSQ1, DM, SSQA, SSQB, (LAS float*)(lds + RING_BYTES + 1024)};
        pg8::gemm_phase<EpiResHMid, pg8::StaticOrder, true, true, true>(lds, g, S, E);
    }
    SEAM(4);
    if (IN(6)) REP(6) {
        pg8::Gemm g{XN, WMQ_T, T_TOK, MEMW, DM}; pg8::StaticOrder S; S.init(T_TOK, MEMW, G, bx);
        EpiBf16RowScale E{QM, MEMW, SSQ1};
        pg8::gemm_phase<EpiBf16RowScale, pg8::StaticOrder, true, true>(lds, g, S, E);
        { pg8::Gemm g2{MEMN, WMKV_T, NBATCH * MEMLEN, 2 * MEMW, DM}; pg8::StaticOrder S2; S2.init(NBATCH * MEMLEN, 2 * MEMW, G, (bx + G / 2) % G);
          pg8::EpiBf16<0> E2{KVM, 2 * MEMW, nullptr, 0, 0, 1.f};
          pg8::gemm_phase<pg8::EpiBf16<0>, pg8::StaticOrder, true, true>(lds, g2, S2, E2); }
        if (bx >= G / 2 + 32) {
            LAS float* scr = (LAS float*)(lds + wave * 16384);
            const int w0 = (bx - (G / 2 + 32)) * NWAVES + wave, nw = (G - (G / 2 + 32)) * NWAVES;
            for (int it = w0; it < I_MO + I_PQ; it += nw) {
                if (it < I_MO) p0_transpose_item(w_mem_o, MEMW, DM, WMO_T, 0, scr, it, lane);
                else p0_transpose_item(w_peer_q, DM, PQW, WPQ_T, 0, scr, it - I_MO, lane, norm_ffn, norm_ffn + 2048);
            }
            QUANT_ROWS(QR1, 2 * NEXP, w0, nw);
        }
    }
    SEAM(6);
    if (IN(7)) REP(7) { for (int u = bx; u < 256; u += G) mem_unit(lds, u, QM, KVM, OM); }
    SEAM(7);
    if (IN(8)) {
        pg8::Gemm g{OM, WMO_T, T_TOK, DM, MEMW}; pg8::StaticOrder S; S.init(T_TOK, DM, G, bx);
        EpiResH E{XN, SSQ2, DM};
        pg8::gemm_phase<EpiResH, pg8::StaticOrder, true, true>(lds, g, S, E);
    }
    SEAM(8);
    if (IN(10)) REP(10) {
        pg8::Gemm g{XN, WPQ_T, T_TOK, PQW, DM}; pg8::StaticOrder S; S.init(T_TOK, PQW, G, bx);
        EpiBf16RowScale E{QP, PQW, SSQ2};
        pg8::gemm_phase<EpiBf16RowScale, pg8::StaticOrder, true, true>(lds, g, S, E);
#ifdef FUSE_ROUTE
        { pg8::Unit un; for (int i = 0; S.next(i, un); ++i) { asm volatile("s_waitcnt vmcnt(0)" ::: "memory"); route_unit(lds, un.pm * 8 + un.pn, QP, SKB, IDX, GATE); } }
        for (int m = gw; m < T_TOK; m += NGW) quant_token(m, XN, norm_ffn, SSQ2, XQ, SX, lane);
#endif
    }
#ifdef FUSE_ROUTE
    if (IN(10) && IN(12)) { xcd_barrier(bar); }
#else
    SEAM(10);
    if (IN(11)) REP(11) { for (int u = bx; u < 256; u += G) route_unit(lds, u, QP, SKB, IDX, GATE);
        for (int m = gw; m < T_TOK; m += NGW) quant_token(m, XN, norm_ffn, SSQ2, XQ, SX, lane); }
    SEAM(11);
#endif
    if (IN(12)) { __syncthreads(); peer_sweep(lds, wave, gw, NGW, XQ, SX, IDX, GATE, UQ, VQ, SU, SV, XN, out, norm_final, lane); }
#undef IN
#undef SEAM
}

constexpr int N_PHASES = 13;
#ifndef MK_N_LAUNCHES
#define MK_N_LAUNCHES 1
#endif

extern "C" void kernel_launch(void* const* d_in, const int* in_sizes, int n_in, void* d_out, int out_size, void* d_ws, size_t ws_size, hipStream_t stream) {
    static int grid = 0;
    if (grid == 0) {
        if (n_in != 21 || in_sizes[0] != T_TOK * DM || out_size != T_TOK * DM || ws_size < WS_END) { fprintf(stderr, "kernel_launch: unexpected shapes (n_in %d in0 %d out %d ws %zu)\n", n_in, n_in > 0 ? in_sizes[0] : -1, out_size, ws_size); grid = -1; return; }
        int dev = 0, cus = 0, per_cu = 0;
        if (hipGetDevice(&dev) != hipSuccess || hipDeviceGetAttribute(&cus, hipDeviceAttributeMultiprocessorCount, dev) != hipSuccess) { grid = -1; return; }
        if (hipFuncSetAttribute((const void*)hymba_fwd, hipFuncAttributeMaxDynamicSharedMemorySize, LDS_BYTES) != hipSuccess) { fprintf(stderr, "kernel_launch: hipFuncSetAttribute failed\n"); grid = -1; return; }
        if (hipOccupancyMaxActiveBlocksPerMultiprocessor(&per_cu, (const void*)hymba_fwd, NWAVES * 64, LDS_BYTES) != hipSuccess || per_cu < 1) fprintf(stderr, "kernel_launch: occupancy query says %d\n", per_cu);
        (void)hipGetLastError();
        grid = cus;
    }
    if (grid < 0) return;
    if (hipMemsetAsync((char*)d_ws + WS_CTL, 0, CTL_ZERO_BYTES, stream) != hipSuccess) return;
    Args a{};
    for (int i = 0; i < 21; ++i) a.in[i] = (const float*)d_in[i];
    a.out = (float*)d_out; a.ws = (unsigned char*)d_ws;
#if MK_N_LAUNCHES == 1
    a.ph_lo = 0; a.ph_hi = N_PHASES;
    hipLaunchKernelGGL(hymba_fwd, dim3(grid), dim3(NWAVES * 64), LDS_BYTES, stream, a);
#else
    for (int p = 0; p < N_PHASES; ++p) { a.ph_lo = p; a.ph_hi = p + 1; hipLaunchKernelGGL(hymba_fwd, dim3(grid), dim3(NWAVES * 64), LDS_BYTES, stream, a); }
#endif
}
```

```cpp
#define QKV_I8
#define WOUT_I8
#include <hip/hip_runtime.h>
#include <cstdio>
#include <cstdint>
namespace pg8 {
#define PG8_LAS __attribute__((address_space(3)))
typedef unsigned short bf16_t;
typedef short bf16x8 __attribute__((ext_vector_type(8)));
typedef float f32x4 __attribute__((ext_vector_type(4)));
typedef unsigned u32x4 __attribute__((ext_vector_type(4)));
constexpr int BM = 256, BK = 64, HALF = 128, HTB = HALF * BK * 2  , STAGE_BYTES = 8 * HTB, NXCD = 8, WGM = 8;

__host__ __device__ __forceinline__ int lds_byte(int r, int c) { const int st = (r >> 4) * 2 + (c >> 5), rr = r & 15, cc = c & 31, ob = rr * 64 + cc * 2; return st * 1024 + (ob ^ (((ob >> 9) & 1) << 5)); }
__host__ __device__ __forceinline__ void stage_rc(int b, int& R, int& C) { const int st = b / 1024, sb = b % 1024, swz = sb ^ (((sb >> 9) & 1) << 5); R = (st >> 1) * 16 + swz / 64; C = (st & 1) * 32 + (swz % 64) / 2; }
__host__ __device__ __forceinline__ int perm32(int rho) { const int n = rho >> 4, i = rho & 15; return 8 * (i >> 2) + 4 * n + (i & 3); }

struct Unit { int pm, pn; };
struct Gemm { const bf16_t* A; const bf16_t* Bt; int M, N, K; };

struct StaticOrder {
    int nM, nN, nwg, G, c;
    __host__ __device__ void init(int M, int N, int G_, int c_) { nM = M / BM; nN = N / BM; nwg = nM * nN; G = G_; c = c_; }
    __host__ __device__ bool next(int i, Unit& u) const {
        const long L = (long)i * G + c; if (L >= nwg) return false;
        int wgid = (int)L; { const int q = nwg / NXCD, r = nwg % NXCD, xcd = wgid % NXCD, off = wgid / NXCD; wgid = (xcd < r ? xcd * (q + 1) : r * (q + 1) + (xcd - r) * q) + off; }
        const int nig = WGM * nN, gid = wgid / nig, fm = gid * WGM, gsz = (nM - fm) < WGM ? (nM - fm) : WGM;
        u.pm = fm + ((wgid % nig) % gsz); u.pn = (wgid % nig) / gsz; return true;
    }
    __device__ __forceinline__ void a_ready(const Unit&) const {}
    __device__ __forceinline__ void done(const Unit&) const {}
};

__device__ __forceinline__ unsigned cvt_pk_bf16(float lo, float hi) { unsigned r; asm volatile("v_cvt_pk_bf16_f32 %0, %1, %2" : "=v"(r) : "v"(lo), "v"(hi)); return r; }
typedef float f32x2 __attribute__((ext_vector_type(2)));
__device__ __forceinline__ f32x2 gelu_pk(f32x2 v) {
    const f32x2 av = __builtin_elementwise_abs(v), d = av * 0.2316418882f + 1.0f;
    f32x2 t; t.x = __builtin_amdgcn_rcpf(d.x); t.y = __builtin_amdgcn_rcpf(d.y);
    f32x2 q = t * 0.5307027145f + (-0.7265760135f); q = q * t + 0.7107068705f; q = q * t + (-0.142248368f); q = q * t + 0.127414796f; q = q * t;
    const f32x2 s = (v * v) * (-0.72134752044f);
    f32x2 e; e.x = __builtin_amdgcn_exp2f(s.x); e.y = __builtin_amdgcn_exp2f(s.y);
    const f32x2 m = v * (q * e), r = v - m;
    f32x2 o; o.x = v.x < 0.f ? m.x : r.x; o.y = v.y < 0.f ? m.y : r.y; return o;
}

template <int ACT  > struct EpiBf16 {
    static constexpr bool PERM = true, AFTER_DRAIN = false; static_assert(ACT == 0 || ACT == 1, "EpiBf16: ACT is 0 (none) or 1 (gelu_pk)");
    bf16_t* O; int ldc; const float* bias; int split_cols; size_t split_stride; float scale0;
    __device__ __forceinline__ void operator()(const f32x4 (&acc)[2][2][4][2], const Unit& u, int wr, int wc, int fr, int fq) const {
        const int row0 = u.pm * BM + wr * 64 + fr; int colt = u.pn * BM; bf16_t* base = O;
        float sc = 1.f; if (split_cols) { const int t = colt / split_cols; base += (size_t)t * split_stride; colt -= t * split_cols; if (t == 0) sc = scale0; }
        const int col0 = colt + wc * 32 + 8 * fq, bcol0 = u.pn * BM + wc * 32 + 8 * fq;
        f32x4 bv[2][2];
#pragma unroll
        for (int bj = 0; bj < 2; ++bj)
#pragma unroll
            for (int n = 0; n < 2; ++n) bv[bj][n] = bias ? *(const f32x4*)(bias + bcol0 + bj * HALF + 4 * n) : (f32x4){0.f, 0.f, 0.f, 0.f};
#pragma unroll
        for (int ai = 0; ai < 2; ++ai)
#pragma unroll
            for (int m = 0; m < 4; ++m) { bf16_t* rowp = base + (size_t)(row0 + ai * HALF + m * 16) * ldc + col0;
#pragma unroll
                for (int bj = 0; bj < 2; ++bj) { f32x4 v0 = acc[ai][bj][m][0] + bv[bj][0], v1 = acc[ai][bj][m][1] + bv[bj][1];
                    if (ACT == 1) { f32x2 a = gelu_pk((f32x2){v0[0], v0[1]}), b = gelu_pk((f32x2){v0[2], v0[3]}), c = gelu_pk((f32x2){v1[0], v1[1]}), d = gelu_pk((f32x2){v1[2], v1[3]});
                        v0 = (f32x4){a.x, a.y, b.x, b.y}; v1 = (f32x4){c.x, c.y, d.x, d.y}; }
                    v0 = v0 * sc; v1 = v1 * sc; u32x4 w; w.x = cvt_pk_bf16(v0[0], v0[1]); w.y = cvt_pk_bf16(v0[2], v0[3]); w.z = cvt_pk_bf16(v1[0], v1[1]); w.w = cvt_pk_bf16(v1[2], v1[3]);
                    *(u32x4*)(rowp + bj * HALF) = w; } }
    }
};

struct PanelStats {
    unsigned* xbuf;
    unsigned* cnt;
    unsigned* tmo;
    int ntn; float eps;
    unsigned code;
    __device__ __forceinline__ bool run(const f32x4 (&v)[2][2][4][2], const Unit& u, int wr, int wc, int fr, int fq, PG8_LAS unsigned char* lds, int wid, int lane) const {
        typedef float f32x2v __attribute__((ext_vector_type(2)));
        PG8_LAS f32x2v* P = (PG8_LAS f32x2v*)lds;
        PG8_LAS f32x2v* S = (PG8_LAS f32x2v*)(lds + 8192);
        PG8_LAS unsigned* flag = (PG8_LAS unsigned*)(lds + 8192 + 2048);
#pragma unroll
        for (int ai = 0; ai < 2; ++ai)
#pragma unroll
            for (int m = 0; m < 4; ++m) {
                float s = 0.f;
#pragma unroll
                for (int bj = 0; bj < 2; ++bj)
#pragma unroll
                    for (int n = 0; n < 2; ++n) { const f32x4 x = v[ai][bj][m][n]; s += (x[0] + x[1]) + (x[2] + x[3]); }
                s += __shfl_xor(s, 16); s += __shfl_xor(s, 32);
                const float mw = s * (1.0f / 64.0f); float q = 0.f;
#pragma unroll
                for (int bj = 0; bj < 2; ++bj)
#pragma unroll
                    for (int n = 0; n < 2; ++n) { const f32x4 d = v[ai][bj][m][n] - mw; q += (d[0] * d[0] + d[1] * d[1]) + (d[2] * d[2] + d[3] * d[3]); }
                q += __shfl_xor(q, 16); q += __shfl_xor(q, 32);
                if (fq == 0) P[(ai * HALF + wr * 64 + m * 16 + fr) * 4 + wc] = (f32x2v){mw, q};
            }
        asm volatile("s_waitcnt lgkmcnt(0)" ::: "memory"); __builtin_amdgcn_s_barrier(); asm volatile("" ::: "memory");
#if defined(BROKEN_EXCHANGE_NO_WAIT)
#warning BROKEN CONTROL BUILD: the row-statistics exchange does not wait; results are wrong by design
        if (blockIdx.x >= 64) { const long long t0_ = clock64(); while (clock64() - t0_ < 60000) __builtin_amdgcn_s_sleep(8); }
#endif
        const int row = wid * 32 + (lane & 31);
        if (lane < 32) {
            const f32x2v a = P[row * 4 + 0], b = P[row * 4 + 1], c = P[row * 4 + 2], d = P[row * 4 + 3];
            const float mt = (a.x + b.x + c.x + d.x) * 0.25f;
            const float da = a.x - mt, db = b.x - mt, dc = c.x - mt, dd = d.x - mt;
            const float m2 = (a.y + b.y) + (c.y + d.y) + 64.0f * ((da * da + db * db) + (dc * dc + dd * dd));
            unsigned long long* slot = (unsigned long long*)xbuf + ((size_t)(u.pm * BM + row) * 4 + u.pn);
            __hip_atomic_store(slot, ((unsigned long long)__float_as_uint(m2) << 32) | __float_as_uint(mt), __ATOMIC_RELAXED, __HIP_MEMORY_SCOPE_AGENT);
        }
        asm volatile("s_waitcnt vmcnt(0)" ::: "memory");
        if (lane == 0) __hip_atomic_fetch_add(cnt + 64 * u.pm, 1u, __ATOMIC_RELAXED, __HIP_MEMORY_SCOPE_AGENT);
        if (wid == 0) {
            bool dead = false; const unsigned long long t0 = __builtin_amdgcn_s_memrealtime(); const unsigned want = 8u * (unsigned)ntn;
            for (;;) {
#if defined(BROKEN_EXCHANGE_NO_WAIT)
                break;
#endif
                if ((unsigned)__builtin_amdgcn_readfirstlane(__hip_atomic_load(cnt + 64 * u.pm, __ATOMIC_RELAXED, __HIP_MEMORY_SCOPE_AGENT)) >= want) break;
                if (__builtin_amdgcn_s_memrealtime() - t0 > 2000000ull) {
                    if (lane == 0) { unsigned expect = 0u; __hip_atomic_compare_exchange_strong(tmo + 1, &expect, code | (unsigned)(u.pm & 0xff), __ATOMIC_RELAXED, __ATOMIC_RELAXED, __HIP_MEMORY_SCOPE_AGENT);
                                     __hip_atomic_store(tmo, 1u, __ATOMIC_RELAXED, __HIP_MEMORY_SCOPE_AGENT); }
                    dead = true; break; }
                __builtin_amdgcn_s_sleep(2);
            }
            __builtin_amdgcn_fence(__ATOMIC_ACQUIRE, "agent");
            if (lane == 0) flag[0] = dead ? 1u : 0u;
        }
        asm volatile("s_waitcnt vmcnt(0) lgkmcnt(0)" ::: "memory"); __builtin_amdgcn_s_barrier(); asm volatile("" ::: "memory");
        const bool bad = flag[0] != 0u;
        if (lane < 32) {
            const unsigned long long* slot = (const unsigned long long*)xbuf + (size_t)(u.pm * BM + row) * 4; float mt[4], m2[4]; float ms = 0.f;
#pragma unroll
            for (int t = 0; t < 4; ++t) { if (t < ntn) { const unsigned long long w = __hip_atomic_load(slot + t, __ATOMIC_RELAXED, __HIP_MEMORY_SCOPE_AGENT); mt[t] = __uint_as_float((unsigned)w); m2[t] = __uint_as_float((unsigned)(w >> 32)); } else { mt[t] = 0.f; m2[t] = 0.f; } ms += mt[t]; }
            const float mean = ms / (float)ntn; float q = 0.f;
#pragma unroll
            for (int t = 0; t < 4; ++t) if (t < ntn) { const float dm = mt[t] - mean; q += m2[t] + 256.0f * dm * dm; }
            S[row] = (f32x2v){mean, 1.0f / sqrtf(q / (256.0f * (float)ntn) + eps)};
        }
        asm volatile("s_waitcnt lgkmcnt(0)" ::: "memory"); __builtin_amdgcn_s_barrier(); asm volatile("" ::: "memory");
        return bad;
    }
};
struct EpiLnRes {
    static constexpr bool PERM = false, AFTER_DRAIN = true;
    const float* base; float* out; int ldc; const float* bias; PanelStats st; unsigned poison;
    __device__ __forceinline__ void fused(f32x4 (&acc)[2][2][4][2], const Unit& u, int wr, int wc, int fr, int fq, PG8_LAS unsigned char* lds, int wid, int lane) const {
        typedef float f32x2v __attribute__((ext_vector_type(2)));
        const PG8_LAS f32x2v* S = (const PG8_LAS f32x2v*)(lds + 8192);
        const int col0 = u.pn * BM + wc * 32 + 4 * fq;
#pragma unroll
        for (int bj = 0; bj < 2; ++bj)
#pragma unroll
            for (int n = 0; n < 2; ++n) { const f32x4 bv = bias ? *(const f32x4*)(bias + col0 + bj * HALF + n * 16) : (f32x4){0.f, 0.f, 0.f, 0.f};
#pragma unroll
                for (int ai = 0; ai < 2; ++ai)
#pragma unroll
                    for (int m = 0; m < 4; ++m) acc[ai][bj][m][n] += bv; }
        f32x4 pre[4][2][2];
#pragma unroll
        for (int m = 0; m < 4; ++m) { const size_t off = (size_t)(u.pm * BM + wr * 64 + m * 16 + fr) * ldc + col0;
#pragma unroll
            for (int bj = 0; bj < 2; ++bj)
#pragma unroll
                for (int n = 0; n < 2; ++n) pre[m][bj][n] = *(const f32x4*)(base + off + bj * HALF + n * 16); }
        const bool bad = st.run(acc, u, wr, wc, fr, fq, lds, wid, lane) || poison != 0u;
        const float qnan = __builtin_nanf("");
#pragma unroll
        for (int ai = 0; ai < 2; ++ai)
#pragma unroll
            for (int m = 0; m < 4; ++m) { const int r = ai * HALF + wr * 64 + m * 16 + fr; const f32x2v sr = S[r]; const size_t off = (size_t)(u.pm * BM + r) * ldc + col0;
#pragma unroll
                for (int bj = 0; bj < 2; ++bj)
#pragma unroll
                    for (int n = 0; n < 2; ++n) { const f32x4 bs = ai == 0 ? pre[m][bj][n] : *(const f32x4*)(base + off + bj * HALF + n * 16); f32x4 o = bs + (acc[ai][bj][m][n] - sr.x) * sr.y;
                        if (bad) o = (f32x4){qnan, qnan, qnan, qnan}; *(f32x4*)(out + off + bj * HALF + n * 16) = o; }
                if (m & 1) asm volatile("" ::: "memory"); }
    }
};
struct EpiLnResLn {
    static constexpr bool PERM = false, AFTER_DRAIN = true;
    const float* base; float* out; bf16_t* xn; int ldc; const float* bias; PanelStats st1, st2; unsigned poison;
    __device__ __forceinline__ void fused(f32x4 (&acc)[2][2][4][2], const Unit& u, int wr, int wc, int fr, int fq, PG8_LAS unsigned char* lds, int wid, int lane) const {
        typedef float f32x2v __attribute__((ext_vector_type(2))); typedef unsigned u32x2v __attribute__((ext_vector_type(2)));
        const PG8_LAS f32x2v* S = (const PG8_LAS f32x2v*)(lds + 8192);
        const int col0 = u.pn * BM + wc * 32 + 4 * fq;
#pragma unroll
        for (int bj = 0; bj < 2; ++bj)
#pragma unroll
            for (int n = 0; n < 2; ++n) { const f32x4 bv = bias ? *(const f32x4*)(bias + col0 + bj * HALF + n * 16) : (f32x4){0.f, 0.f, 0.f, 0.f};
#pragma unroll
                for (int ai = 0; ai < 2; ++ai)
#pragma unroll
                    for (int m = 0; m < 4; ++m) acc[ai][bj][m][n] += bv; }
        bool bad = st1.run(acc, u, wr, wc, fr, fq, lds, wid, lane) || poison != 0u;
        const float qnan = __builtin_nanf("");
#pragma unroll
        for (int ai = 0; ai < 2; ++ai)
#pragma unroll
            for (int m = 0; m < 4; ++m) { const int r = ai * HALF + wr * 64 + m * 16 + fr; const f32x2v sr = S[r]; const size_t off = (size_t)(u.pm * BM + r) * ldc + col0;
#pragma unroll
                for (int bj = 0; bj < 2; ++bj)
#pragma unroll
                    for (int n = 0; n < 2; ++n) { const f32x4 bs = *(const f32x4*)(base + off + bj * HALF + n * 16); acc[ai][bj][m][n] = bs + (acc[ai][bj][m][n] - sr.x) * sr.y; }
                asm volatile("" : "+v"(acc[ai][0][m][0]), "+v"(acc[ai][0][m][1]), "+v"(acc[ai][1][m][0]), "+v"(acc[ai][1][m][1]));
                if (m & 1) asm volatile("" ::: "memory"); }
        const bool bad1 = bad;
        bad = st2.run(acc, u, wr, wc, fr, fq, lds, wid, lane) || bad;
#pragma unroll
        for (int ai = 0; ai < 2; ++ai)
#pragma unroll
            for (int m = 0; m < 4; ++m) { const int r = ai * HALF + wr * 64 + m * 16 + fr; const f32x2v sr = S[r]; const size_t off = (size_t)(u.pm * BM + r) * ldc + col0;
#pragma unroll
                for (int bj = 0; bj < 2; ++bj)
#pragma unroll
                    for (int n = 0; n < 2; ++n) { const f32x4 x1 = acc[ai][bj][m][n]; *(f32x4*)(out + off + bj * HALF + n * 16) = bad1 ? (f32x4){qnan, qnan, qnan, qnan} : x1;
                        const f32x4 o = (x1 - sr.x) * sr.y; u32x2v w; w.x = cvt_pk_bf16(o[0], o[1]); w.y = cvt_pk_bf16(o[2], o[3]);
                        if (bad) { w.x = 0x7fc07fc0u; w.y = 0x7fc07fc0u; } *(u32x2v*)(xn + off + bj * HALF + n * 16) = w; }
                asm volatile("" ::: "memory"); }
    }
};

typedef int i32x4 __attribute__((ext_vector_type(4)));
template <bool I8> __device__ __forceinline__ f32x4 pg8_mma(bf16x8 b, bf16x8 a, f32x4 c) {
    if constexpr (I8) return __builtin_bit_cast(f32x4, __builtin_amdgcn_mfma_i32_16x16x64_i8(__builtin_bit_cast(i32x4, b), __builtin_bit_cast(i32x4, a), __builtin_bit_cast(i32x4, c), 0, 0, 0));
    else return __builtin_amdgcn_mfma_f32_16x16x32_bf16(b, a, c, 0, 0, 0);
}
template <class Epi, class Sched, bool ALIGN_EPI = false, bool SP2 = false, bool MID = false, bool I8 = false>
__device__ __forceinline__ void gemm_phase(PG8_LAS unsigned char* lds, const Gemm g, const Sched& S, const Epi& E) {
    const int tid = threadIdx.x, wid = __builtin_amdgcn_readfirstlane(tid >> 6), lane = tid & 63, wr = wid >> 2, wc = wid & 3, fr = lane & 15, fq = lane >> 4;
    const int K = g.K, nt = K / BK;
    unsigned voffA[2], voffB[2];
#pragma unroll
    for (int i = 0; i < 2; ++i) { int R, C; stage_rc(tid * 16 + i * 8192, R, C); const int Rb = Epi::PERM ? ((R & ~31) + perm32(R & 31)) : R;
        voffA[i] = (unsigned)(R * K + C) * 2u; voffB[i] = (unsigned)(Rb * K + C) * 2u; }
    const size_t kstep = (size_t)(BK * 2);
    const size_t hstep = (size_t)HALF * K * 2;
    const size_t tstep = 2 * hstep;
    const unsigned ldsw = (unsigned)wid * 1024u;
    const int aoff = lds_byte(wr * 64 + fr, fq * 8), boff = lds_byte(wc * 32 + fr, fq * 8);
#define PG8_SA(b, h) (((b) * 2 + (h)) * HTB)
#define PG8_SB(b, h) ((4 + (b) * 2 + (h)) * HTB)
#define PG8_STAGE(bufoff, gbase, voff) do { _Pragma("unroll") for (int _i = 0; _i < 2; ++_i) \
        __builtin_amdgcn_global_load_lds((const unsigned*)((const char*)(gbase) + (voff)[_i]), (PG8_LAS unsigned*)(lds + (bufoff) + ldsw + _i * 8192), 16, 0, 0); } while (0)
#define PG8_LDA(dst, b, h) do { _Pragma("unroll") for (int m = 0; m < 4; ++m) _Pragma("unroll") for (int k = 0; k < 2; ++k) dst[m][k] = *(const PG8_LAS bf16x8*)(lds + PG8_SA(b, h) + aoff + m * 2048 + k * 1024); } while (0)
#define PG8_LDB(dst, b, h) do { _Pragma("unroll") for (int n = 0; n < 2; ++n) _Pragma("unroll") for (int k = 0; k < 2; ++k) dst[n][k] = *(const PG8_LAS bf16x8*)(lds + PG8_SB(b, h) + boff + n * 2048 + k * 1024); } while (0)
#define PG8_MMA(ai, bj, At, Bt) do { __builtin_amdgcn_s_setprio(1); _Pragma("unroll") for (int m = 0; m < 4; ++m) _Pragma("unroll") for (int n = 0; n < 2; ++n) _Pragma("unroll") for (int k = 0; k < 2; ++k) \
        acc[ai][bj][m][n] = pg8_mma<I8>(Bt[n][k], At[m][k], acc[ai][bj][m][n]); __builtin_amdgcn_s_setprio(0); } while (0)
#define PG8_WAIT_V(n) asm volatile("s_waitcnt vmcnt(" #n ")" ::: "memory")
#define PG8_WAIT_L(n) asm volatile("s_waitcnt lgkmcnt(" #n ")" ::: "memory")
#define PG8_BAR __builtin_amdgcn_s_barrier()
#define PG8_SCHED __builtin_amdgcn_sched_barrier(0)
    Unit cur, nxt; int ui = 0;
    if (!S.next(0, cur)) return;
    f32x4 acc[2][2][4][2];
#pragma unroll
    for (int a = 0; a < 2; ++a)
#pragma unroll
        for (int b = 0; b < 2; ++b)
#pragma unroll
            for (int m = 0; m < 4; ++m)
#pragma unroll
                for (int n = 0; n < 2; ++n) acc[a][b][m][n] = (f32x4){0.f, 0.f, 0.f, 0.f};
    bf16x8 At[4][2], B0[2][2], B1[2][2];
    const char* cA = (const char*)g.A + (size_t)cur.pm * tstep; const char* cB = (const char*)g.Bt + (size_t)cur.pn * tstep;
    if constexpr (MID) E.load_mid(cur);
    S.a_ready(cur);
    if constexpr (SP2) {
        PG8_STAGE(PG8_SB(0, 0), cB, voffB); PG8_STAGE(PG8_SB(0, 1), cB + hstep, voffB); PG8_STAGE(PG8_SA(0, 0), cA, voffA); PG8_STAGE(PG8_SA(0, 1), cA + hstep, voffA);
        if (wr == 1) PG8_BAR;
        PG8_WAIT_V(2); PG8_BAR;
        PG8_STAGE(PG8_SB(1, 0), cB + kstep, voffB); PG8_STAGE(PG8_SA(1, 0), cA + kstep, voffA); PG8_STAGE(PG8_SB(1, 1), cB + hstep + kstep, voffB);
        PG8_WAIT_V(6); PG8_BAR;
    } else {
        PG8_STAGE(PG8_SB(0, 0), cB, voffB); PG8_STAGE(PG8_SA(0, 0), cA, voffA); PG8_STAGE(PG8_SB(0, 1), cB + hstep, voffB); PG8_STAGE(PG8_SA(0, 1), cA + hstep, voffA);
        if (wr == 1) PG8_BAR;
        PG8_WAIT_V(4); PG8_BAR;
        PG8_STAGE(PG8_SB(1, 0), cB + kstep, voffB); PG8_STAGE(PG8_SA(1, 0), cA + kstep, voffA); PG8_STAGE(PG8_SB(1, 1), cB + hstep + kstep, voffB);
        PG8_WAIT_V(6); PG8_BAR;
    }
    for (;;) {
        const bool has_next = S.next(ui + 1, nxt);
        const char* nA = has_next ? (const char*)g.A + (size_t)nxt.pm * tstep : cA; const char* nB = has_next ? (const char*)g.Bt + (size_t)nxt.pn * tstep : cB;
        for (int t = 0; t < nt; t += 2) {
            if constexpr (MID) { if (t == nt / 2) {
#pragma unroll
                for (int a = 0; a < 2; ++a)
#pragma unroll
                    for (int m = 0; m < 4; ++m)
#pragma unroll
                        for (int b = 0; b < 2; ++b)
#pragma unroll
                            for (int n = 0; n < 2; ++n) acc[a][b][m][n] = acc[a][b][m][n] * E.mid(a * 128 + wr * 64 + m * 16 + fr);
            } }
            const bool last = (t == nt - 2);
            const char* a1 = cA + (size_t)(t + 1) * kstep;
            const char* a2 = last ? nA : cA + (size_t)(t + 2) * kstep; const char* b2 = last ? nB : cB + (size_t)(t + 2) * kstep;
            const char* a3 = a2 + kstep; const char* b3 = b2 + kstep;
            if (last && has_next) S.a_ready(nxt);
            if constexpr (SP2) {
            PG8_LDB(B0, 0, 0); PG8_LDB(B1, 0, 1); PG8_SCHED; PG8_LDA(At, 0, 0); PG8_STAGE(PG8_SA(1, 1), a1 + hstep, voffA);
            PG8_WAIT_V(8); PG8_WAIT_L(0); PG8_BAR; PG8_MMA(0, 0, At, B0); PG8_MMA(0, 1, At, B1); PG8_BAR; PG8_SCHED;
            PG8_LDA(At, 0, 1); PG8_STAGE(PG8_SB(0, 0), b2, voffB); PG8_STAGE(PG8_SB(0, 1), b2 + hstep, voffB); PG8_STAGE(PG8_SA(0, 0), a2, voffA);
            PG8_WAIT_V(8); PG8_WAIT_L(0); PG8_BAR; PG8_MMA(1, 0, At, B0); PG8_MMA(1, 1, At, B1); PG8_BAR; PG8_SCHED;
            PG8_LDB(B0, 1, 0); PG8_LDB(B1, 1, 1); PG8_SCHED; PG8_LDA(At, 1, 0); PG8_STAGE(PG8_SA(0, 1), a2 + hstep, voffA);
            PG8_WAIT_V(8); PG8_WAIT_L(0); PG8_BAR; PG8_MMA(0, 0, At, B0); PG8_MMA(0, 1, At, B1); PG8_BAR; PG8_SCHED;
            PG8_LDA(At, 1, 1); PG8_STAGE(PG8_SB(1, 0), b3, voffB); PG8_STAGE(PG8_SB(1, 1), b3 + hstep, voffB); PG8_STAGE(PG8_SA(1, 0), a3, voffA);
            PG8_WAIT_V(8); PG8_WAIT_L(0); PG8_BAR; PG8_MMA(1, 0, At, B0); PG8_MMA(1, 1, At, B1); PG8_BAR; PG8_SCHED;
            } else {
            PG8_LDB(B0, 0, 0); PG8_SCHED; PG8_LDA(At, 0, 0); PG8_STAGE(PG8_SA(1, 1), a1 + hstep, voffA);
            PG8_WAIT_L(8); PG8_BAR; PG8_WAIT_L(0); PG8_MMA(0, 0, At, B0); PG8_BAR; PG8_SCHED;
            PG8_LDB(B1, 0, 1); PG8_STAGE(PG8_SB(0, 0), b2, voffB);
            PG8_BAR; PG8_WAIT_L(0); PG8_MMA(0, 1, At, B1); PG8_BAR;
            PG8_LDA(At, 0, 1); PG8_STAGE(PG8_SA(0, 0), a2, voffA);
            PG8_BAR; PG8_WAIT_L(0); PG8_MMA(1, 0, At, B0); PG8_BAR; PG8_SCHED;
            PG8_STAGE(PG8_SB(0, 1), b2 + hstep, voffB);
            PG8_WAIT_V(6); PG8_BAR; PG8_MMA(1, 1, At, B1); PG8_BAR;
            PG8_LDB(B0, 1, 0); PG8_SCHED; PG8_LDA(At, 1, 0); PG8_STAGE(PG8_SA(0, 1), a2 + hstep, voffA);
            PG8_WAIT_L(8); PG8_BAR; PG8_WAIT_L(0); PG8_MMA(0, 0, At, B0); PG8_BAR; PG8_SCHED;
            PG8_LDB(B1, 1, 1); PG8_STAGE(PG8_SB(1, 0), b3, voffB);
            PG8_BAR; PG8_WAIT_L(0); PG8_MMA(0, 1, At, B1); PG8_BAR;
            PG8_LDA(At, 1, 1); PG8_STAGE(PG8_SA(1, 0), a3, voffA);
            PG8_BAR; PG8_WAIT_L(0); PG8_MMA(1, 0, At, B0); PG8_BAR; PG8_SCHED;
            PG8_STAGE(PG8_SB(1, 1), b3 + hstep, voffB);
            PG8_WAIT_V(6); PG8_BAR; PG8_MMA(1, 1, At, B1); PG8_BAR;
            }
        }
        if constexpr (ALIGN_EPI) { if (wr == 0) PG8_BAR; }
        if constexpr (!Epi::AFTER_DRAIN) { E(acc, cur, wr, wc, fr, fq); S.done(cur); }
        if (!has_next) break;
#pragma unroll
        for (int a = 0; a < 2; ++a)
#pragma unroll
            for (int b = 0; b < 2; ++b)
#pragma unroll
                for (int m = 0; m < 4; ++m)
#pragma unroll
                    for (int n = 0; n < 2; ++n) acc[a][b][m][n] = (f32x4){0.f, 0.f, 0.f, 0.f};
        cur = nxt; cA = nA; cB = nB; ++ui;
        if constexpr (MID) E.load_mid(cur);
        if constexpr (ALIGN_EPI) { if (wr == 1) PG8_BAR; }
    }
    PG8_WAIT_V(0);
    if constexpr (!ALIGN_EPI) { if (wr == 0) PG8_BAR; }
    PG8_BAR;
    if constexpr (Epi::AFTER_DRAIN) { E.fused(acc, cur, wr, wc, fr, fq, lds, wid, lane); S.done(cur); }
#undef PG8_SA
#undef PG8_SB
#undef PG8_STAGE
#undef PG8_LDA
#undef PG8_LDB
#undef PG8_MMA
#undef PG8_WAIT_V
#undef PG8_WAIT_L
#undef PG8_BAR
#undef PG8_SCHED
}
}
#define GAS __attribute__((address_space(1)))
#define LAS __attribute__((address_space(3)))
typedef unsigned short bf16;
typedef unsigned v4u __attribute__((ext_vector_type(4)));
typedef float f32x4 __attribute__((ext_vector_type(4)));
typedef short bf16x8 __attribute__((ext_vector_type(8)));
typedef GAS unsigned gu32;
typedef GAS unsigned long long gu64;
#define RLX_AGENT __ATOMIC_RELAXED, __HIP_MEMORY_SCOPE_AGENT
#define LDS_WAIT() asm volatile("s_waitcnt lgkmcnt(0)" ::: "memory")
#define VM_WAIT() asm volatile("s_waitcnt vmcnt(0)" ::: "memory")
__device__ __forceinline__ unsigned long long rt() { return __builtin_amdgcn_s_memrealtime(); }
__device__ __forceinline__ unsigned f2bf(float f) { unsigned u = __builtin_bit_cast(unsigned, f); return (u + 0x7fffu + ((u >> 16) & 1u)) >> 16; }
__device__ __forceinline__ unsigned pk2(float lo, float hi) { return f2bf(lo) | (f2bf(hi) << 16); }

#define XB_TMO      128
#define XB_XCNT(j)  (256  + 64 * (j))
#define XB_XSUB(j)  (1280 + 64 * (j))
#define XB_XGEN(j)  (2304 + 64 * (j))
#define XB_TOP      3328
#define XB_TOPGEN   3392
#define XCD_BAR_WORDS 3456
#define XB_SPIN_CAP (1u << 18)

__device__ __forceinline__ unsigned xb_ld(unsigned* p)              { return __hip_atomic_load(p, __ATOMIC_RELAXED, __HIP_MEMORY_SCOPE_AGENT); }
__device__ __forceinline__ unsigned xb_add(unsigned* p, unsigned v) { return __hip_atomic_fetch_add(p, v, __ATOMIC_RELAXED, __HIP_MEMORY_SCOPE_AGENT); }
__device__ __forceinline__ unsigned xb_xcc_id() { return (unsigned)__builtin_amdgcn_s_getreg((3 << 11) | 20) & 0xFu; }
#define XB_SPIN(cond, bar) do { unsigned _sp = 0; while (cond) { __builtin_amdgcn_s_sleep(1); \
    if ((++_sp & 255u) == 0u) { if (xb_ld(&(bar)[XB_TMO])) break; if (_sp > XB_SPIN_CAP) { atomicAdd(&(bar)[XB_TMO], 1u); break; } } } } while (0)

struct XcdBarrier {
    unsigned* bar; unsigned x;
    volatile LAS unsigned* st;
};

__device__ __forceinline__ XcdBarrier xcd_barrier_post(unsigned* bar, volatile LAS unsigned* st) {
    XcdBarrier b; b.bar = bar; b.x = xb_xcc_id(); b.st = st;
    if (threadIdx.x == 0) (void)xb_add(&bar[XB_XCNT(b.x)], 1u);
    return b;
}
__device__ __forceinline__ void xcd_barrier_complete(unsigned* bar, unsigned x, unsigned& nloc, unsigned& nx) {
    const unsigned G = gridDim.x * gridDim.y * gridDim.z;
    unsigned sum, cnt, mine, sp = 0u;
    for (;;) {
        sum = 0u; cnt = 0u; mine = 0u;
#pragma unroll
        for (unsigned j = 0; j < 16; ++j) { const unsigned c = xb_ld(&bar[XB_XCNT(j)]); sum += c; cnt += (c > 0u) ? 1u : 0u; mine = (j == x) ? c : mine; }
        if (sum == G) break;
        __builtin_amdgcn_s_sleep(1);
        if ((++sp & 255u) == 0u) { if (xb_ld(&bar[XB_TMO])) break; if (sp > XB_SPIN_CAP) { atomicAdd(&bar[XB_TMO], 1u); break; } }
    }
    nloc = mine > 0u ? mine : 1u; nx = cnt > 0u ? cnt : 1u;
}

__device__ __forceinline__ void xcd_barrier(const XcdBarrier& b) {
    asm volatile("s_waitcnt vmcnt(0)" ::: "memory");
    __syncthreads();
    if (threadIdx.x == 0) {
        unsigned* bar = b.bar;
        __builtin_amdgcn_s_waitcnt(0);
        unsigned nloc = b.st[0], nx = b.st[1];
        if (nloc == 0u) { xcd_barrier_complete(bar, b.x, nloc, nx); b.st[0] = nloc; b.st[1] = nx; }
        const unsigned old = xb_add(&bar[XB_XSUB(b.x)], 1u);
        const unsigned gen = old / nloc;
        if (old + 1u == (gen + 1u) * nloc) {
            __builtin_amdgcn_fence(__ATOMIC_RELEASE, "agent");
            asm volatile("s_waitcnt vmcnt(0)" ::: "memory");
            const unsigned og = xb_add(&bar[XB_TOP], 1u);
            const unsigned tg = og / nx;
            if (og + 1u == (tg + 1u) * nx) xb_add(&bar[XB_TOPGEN], 1u);
            else XB_SPIN(xb_ld(&bar[XB_TOPGEN]) == tg, bar);
            __builtin_amdgcn_fence(__ATOMIC_ACQUIRE, "agent");
            xb_add(&bar[XB_XGEN(b.x)], 1u);
            asm volatile("s_waitcnt vmcnt(0)" ::: "memory");
        } else {
            XB_SPIN(xb_ld(&bar[XB_XGEN(b.x)]) == gen, bar);
            __builtin_amdgcn_fence(__ATOMIC_ACQUIRE, "agent");
            asm volatile("s_waitcnt vmcnt(0)" ::: "memory");
        }
    }
    __syncthreads();
}

#define VF16 1
#define FUSE_ROUTE 1
#ifndef XB_SPIN_CAP2
#define XB_SPIN_CAP2 1
#endif
constexpr int NWAVES = 8;
constexpr int T_TOK = 8192, DM = 4096, SEQ = 2048, NBATCH = 4;
constexpr int INW = 9216;
constexpr int C_QA = 0, C_KA = 2048, C_VA = 2560, C_QB = 3072, C_KB = 5120, C_VB = 7168;
constexpr int MEMLEN = 256, MEMW = 1024;
constexpr int NEXP = 16384, PQW = 2048;
constexpr float RMS_EPS = 1e-6f;
constexpr float LOG2E = 1.4426950408889634f;

constexpr size_t MiB = 1u << 20;
constexpr size_t WS_CTL = 0, CTL_ZERO_BYTES = 86016, WS_CM = 32768, WS_CM2 = 69632;
constexpr size_t WS_ROPE = 1 * MiB;
constexpr size_t WS_SKB = 2 * MiB;
constexpr size_t WS_WIN = 4 * MiB;
constexpr size_t WS_WOUT = 76 * MiB;
constexpr size_t WS_WMQ = 108 * MiB;
constexpr size_t WS_WMKV = 116 * MiB;
constexpr size_t WS_WMO = 132 * MiB;
constexpr size_t WS_WPQ = 140 * MiB;
constexpr size_t WS_UB = 156 * MiB;
constexpr size_t WS_VB = 284 * MiB;
constexpr size_t WS_UQ = 156 * MiB, WS_VQ = 220 * MiB;
constexpr size_t WS_SU = 3 * MiB, WS_SV = 3 * MiB + 65536;
constexpr size_t WS_SX = 3 * MiB + 131072;
constexpr size_t WS_XQ = 284 * MiB;
constexpr size_t SLICE_BYTES = (size_t)NEXP * 128;
constexpr size_t WS_XN = 412 * MiB;
constexpr size_t WS_QKV = 476 * MiB;
constexpr size_t WS_OB = 620 * MiB;
constexpr size_t WS_MEMN = 684 * MiB;
constexpr size_t WS_KVM = 692 * MiB;
constexpr size_t WS_QM = 696 * MiB;
constexpr size_t WS_OM = 712 * MiB;
constexpr size_t WS_QP = 728 * MiB;
constexpr size_t WS_IDX = 760 * MiB;
constexpr size_t WS_GATE = 764 * MiB;
constexpr size_t WS_END = 768 * MiB;
constexpr int CW_BAR = 4096;
constexpr size_t WS_SSQ1 = 131072, WS_SSQ2 = 163840, WS_SSQA = 196608, WS_SSQB = 229376, WS_SSQ0 = 262144;

constexpr int RING_BYTES = 131072;
constexpr int LDSCTL_OFF = RING_BYTES, MISC_OFF = LDSCTL_OFF + 320;
constexpr int LDS_BYTES = 147456;

typedef float f32x16 __attribute__((ext_vector_type(16)));
typedef float f32x2 __attribute__((ext_vector_type(2)));
typedef short s16x4 __attribute__((ext_vector_type(4)));
typedef __bf16 bf16x2_t __attribute__((ext_vector_type(2)));
typedef unsigned u32x2 __attribute__((ext_vector_type(2)));
#define DI __device__ __forceinline__
#define MFMA32(a, b, c) __builtin_amdgcn_mfma_f32_32x32x16_bf16((a), (b), (c), 0, 0, 0)

DI unsigned cvtpk(float lo, float hi) { f32x2 v = {lo, hi}; bf16x2_t b = __builtin_convertvector(v, bf16x2_t); return __builtin_bit_cast(unsigned, b); }
DI float bflo(unsigned u) { return __uint_as_float(u << 16); }
DI float bfhi(unsigned u) { return __uint_as_float(u & 0xffff0000u); }
DI int crow(int i, int h) { return (i & 3) + 8 * (i >> 2) + 4 * h; }
DI float wave_sum(float v) {
#pragma unroll
    for (int o = 1; o < 64; o <<= 1) v += __shfl_xor(v, o);
    return v;
}
DI float fexp2(float x) { return __builtin_amdgcn_exp2f(x); }
DI bf16x8 pack8(const f32x16& x, int s) {
    v4u p; p.x = cvtpk(x[8 * s + 0], x[8 * s + 1]); p.y = cvtpk(x[8 * s + 2], x[8 * s + 3]); p.z = cvtpk(x[8 * s + 4], x[8 * s + 5]); p.w = cvtpk(x[8 * s + 6], x[8 * s + 7]);
    return __builtin_bit_cast(bf16x8, p);
}
typedef short v4i16_t __attribute__((ext_vector_type(4)));
DI s16x4 vtr(const LAS unsigned char* p) { return __builtin_bit_cast(s16x4, __builtin_amdgcn_ds_read_tr16_b64_v4i16((LAS v4i16_t*)p)); }

DI void p0_transpose_item(const float* W, int K, int N, bf16* WT, int row_off, LAS float* scr, int item, int lane, const float* gk0 = nullptr, const float* gk1 = nullptr) {
    const int nblk = N / 32, kb = item / nblk, nb = item % nblk, k0 = 64 * kb, n0 = 32 * nb;
#pragma unroll 8
    for (int i = 0; i < 32; ++i) { const int kk = 2 * i + (lane >> 5); scr[kk * 33 + (lane & 31)] = W[(size_t)(k0 + kk) * N + n0 + (lane & 31)]; }
    LDS_WAIT(); asm volatile("" ::: "memory");
    const int c = lane & 7;
    f32x4 ga = {1.f, 1.f, 1.f, 1.f}, gb = ga;
    if (gk0) { const int kg = k0 + 8 * c; const float* gp = kg < 2048 ? gk0 + kg : gk1 + (kg - 2048); ga = *(const GAS f32x4*)gp; gb = *(const GAS f32x4*)(gp + 4); }
#pragma unroll
    for (int j = 0; j < 4; ++j) { const int n = (lane >> 3) + 8 * j; const LAS float* s = scr + (8 * c) * 33 + n;
        v4u o; o.x = cvtpk(s[0 * 33] * ga.x, s[1 * 33] * ga.y); o.y = cvtpk(s[2 * 33] * ga.z, s[3 * 33] * ga.w); o.z = cvtpk(s[4 * 33] * gb.x, s[5 * 33] * gb.y); o.w = cvtpk(s[6 * 33] * gb.z, s[7 * 33] * gb.w);
        *(GAS v4u*)(WT + (size_t)(row_off + n0 + n) * K + k0 + 8 * c) = o; }
    LDS_WAIT(); asm volatile("" ::: "memory");
}
DI void rms_row_to_bf16(const float* xrow, const float* gain, bf16* orow, int lane) {
    const GAS f32x4* xr = (const GAS f32x4*)xrow + lane;
    f32x4 v[16]; float s = 0.f;
#pragma unroll
    for (int j = 0; j < 16; ++j) { v[j] = xr[64 * j]; s += (v[j].x * v[j].x + v[j].y * v[j].y) + (v[j].z * v[j].z + v[j].w * v[j].w); }
    const float rstd = 1.0f / sqrtf(wave_sum(s) * (1.f / DM) + RMS_EPS);
    const GAS f32x4* gr = (const GAS f32x4*)gain + lane;
    GAS u32x2* o8 = (GAS u32x2*)orow + lane;
#pragma unroll
    for (int j = 0; j < 16; ++j) { const f32x4 g = gr[64 * j]; u32x2 w; w.x = cvtpk(v[j].x * rstd * g.x, v[j].y * rstd * g.y); w.y = cvtpk(v[j].z * rstd * g.z, v[j].w * rstd * g.w); o8[64 * j] = w; }
}
DI void row_to_bf16_ssq(const float* xrow, bf16* orow, float* ssq, int lane) {
    const GAS f32x4* xr = (const GAS f32x4*)xrow + lane;
    GAS u32x2* o8 = (GAS u32x2*)orow + lane; float s = 0.f;
#pragma unroll
    for (int j = 0; j < 16; ++j) { const f32x4 v = xr[64 * j]; s += (v.x * v.x + v.y * v.y) + (v.z * v.z + v.w * v.w);
        u32x2 w; w.x = cvtpk(v.x, v.y); w.y = cvtpk(v.z, v.w); o8[64 * j] = w; }
    s = wave_sum(s);
    if (lane == 0) *ssq = s;
}
DI void row_to_bf16_i8(const float* xrow, bf16* orow, unsigned char* qrow, float* rs, int lane) {
    const GAS f32x4* xr = (const GAS f32x4*)xrow + lane;
    f32x4 v[16]; float s = 0.f, am = 0.f;
#pragma unroll
    for (int j = 0; j < 16; ++j) { v[j] = xr[64 * j]; s += (v[j].x * v[j].x + v[j].y * v[j].y) + (v[j].z * v[j].z + v[j].w * v[j].w);
        am = fmaxf(am, fmaxf(fmaxf(fabsf(v[j].x), fabsf(v[j].y)), fmaxf(fabsf(v[j].z), fabsf(v[j].w)))); }
    s = wave_sum(s);
#pragma unroll
    for (int o = 1; o < 64; o <<= 1) am = fmaxf(am, __shfl_xor(am, o));
    const float inv = am > 0.f ? 127.f / am : 0.f;
    GAS u32x2* o8 = (GAS u32x2*)orow + lane; GAS unsigned* q4 = (GAS unsigned*)qrow + lane;
#pragma unroll
    for (int j = 0; j < 16; ++j) { u32x2 w; w.x = cvtpk(v[j].x, v[j].y); w.y = cvtpk(v[j].z, v[j].w); o8[64 * j] = w;
        q4[64 * j] = ((unsigned)(int)rintf(v[j].x * inv) & 0xffu) | (((unsigned)(int)rintf(v[j].y * inv) & 0xffu) << 8) | (((unsigned)(int)rintf(v[j].z * inv) & 0xffu) << 16) | (((unsigned)(int)rintf(v[j].w * inv) & 0xffu) << 24); }
    if (lane == 0) *rs = am * (1.f / 127.f) / sqrtf(s * (1.f / DM) + RMS_EPS);
}
DI void p0_colmax_item(const float* W, int N, unsigned* CM, int item, int lane, const float* gk0, const float* gk1 = nullptr) {
    const int nblk = N / 32, kb = item / nblk, nb = item % nblk, k0 = 64 * kb, n0 = 32 * nb;
    const float* gk = (gk1 && k0 >= 2048) ? gk1 - 2048 : gk0;
    float mx = 0.f;
#pragma unroll 8
    for (int i = 0; i < 32; ++i) { const int kk = k0 + 2 * i + (lane >> 5); mx = fmaxf(mx, fabsf(W[(size_t)kk * N + n0 + (lane & 31)] * gk[kk])); }
    mx = fmaxf(mx, __shfl_xor(mx, 32));
    if (lane < 32) atomicMax(CM + n0 + lane, __float_as_uint(mx));
}
DI void p0_transpose_item_i8(const float* W, int K, int N, unsigned char* WT, const unsigned* CM, LAS float* scr, int item, int lane, const float* gk0, const float* gk1 = nullptr) {
    const int nblk = N / 32, kb = item / nblk, nb = item % nblk, k0 = 64 * kb, n0 = 32 * nb;
    const float* gk = (gk1 && k0 >= 2048) ? gk1 - 2048 : gk0;
#pragma unroll 8
    for (int i = 0; i < 32; ++i) { const int kk = 2 * i + (lane >> 5); scr[kk * 33 + (lane & 31)] = W[(size_t)(k0 + kk) * N + n0 + (lane & 31)]; }
    LDS_WAIT(); asm volatile("" ::: "memory");
    const int c = lane & 7;
    const f32x4 ga = *(const GAS f32x4*)(gk + k0 + 8 * c), gb = *(const GAS f32x4*)(gk + k0 + 8 * c + 4);
#pragma unroll
    for (int j = 0; j < 4; ++j) { const int n = (lane >> 3) + 8 * j; const LAS float* sp = scr + (8 * c) * 33 + n;
        const float cm = __uint_as_float(CM[n0 + n]); const float inv = cm > 0.f ? 127.f / cm : 0.f;
        u32x2 o;
        o.x = ((unsigned)(int)rintf(sp[0 * 33] * ga.x * inv) & 0xffu) | (((unsigned)(int)rintf(sp[1 * 33] * ga.y * inv) & 0xffu) << 8) | (((unsigned)(int)rintf(sp[2 * 33] * ga.z * inv) & 0xffu) << 16) | (((unsigned)(int)rintf(sp[3 * 33] * ga.w * inv) & 0xffu) << 24);
        o.y = ((unsigned)(int)rintf(sp[4 * 33] * gb.x * inv) & 0xffu) | (((unsigned)(int)rintf(sp[5 * 33] * gb.y * inv) & 0xffu) << 8) | (((unsigned)(int)rintf(sp[6 * 33] * gb.z * inv) & 0xffu) << 16) | (((unsigned)(int)rintf(sp[7 * 33] * gb.w * inv) & 0xffu) << 24);
        *(GAS u32x2*)(WT + (size_t)(n0 + n) * K + k0 + 8 * c) = o; }
    LDS_WAIT(); asm volatile("" ::: "memory");
}
DI void mix_row_to_i8(const bf16* orow, float ssa, float ssb, unsigned char* qrow, float* rs, int lane) {
    const GAS v4u* p = (const GAS v4u*)orow + lane;
    const float ra = 1.0f / sqrtf(ssa * (1.f / 2048.f) + RMS_EPS), rb = 1.0f / sqrtf(ssb * (1.f / 2048.f) + RMS_EPS);
    float f[8][8]; float am = 0.f;
#pragma unroll
    for (int j = 0; j < 8; ++j) { const v4u v = p[64 * j]; const float rsc = j < 4 ? ra : rb;
#pragma unroll
        for (int k = 0; k < 4; ++k) { f[j][2 * k] = bflo(v[k]) * rsc; f[j][2 * k + 1] = bfhi(v[k]) * rsc; am = fmaxf(am, fmaxf(fabsf(f[j][2 * k]), fabsf(f[j][2 * k + 1]))); } }
#pragma unroll
    for (int o = 1; o < 64; o <<= 1) am = fmaxf(am, __shfl_xor(am, o));
    const float inv = am > 0.f ? 127.f / am : 0.f;
    GAS u32x2* q = (GAS u32x2*)qrow + lane;
#pragma unroll
    for (int j = 0; j < 8; ++j) { u32x2 w;
        w.x = ((unsigned)(int)rintf(f[j][0] * inv) & 0xffu) | (((unsigned)(int)rintf(f[j][1] * inv) & 0xffu) << 8) | (((unsigned)(int)rintf(f[j][2] * inv) & 0xffu) << 16) | (((unsigned)(int)rintf(f[j][3] * inv) & 0xffu) << 24);
        w.y = ((unsigned)(int)rintf(f[j][4] * inv) & 0xffu) | (((unsigned)(int)rintf(f[j][5] * inv) & 0xffu) << 8) | (((unsigned)(int)rintf(f[j][6] * inv) & 0xffu) << 16) | (((unsigned)(int)rintf(f[j][7] * inv) & 0xffu) << 24);
        q[64 * j] = w; }
    if (lane == 0) *rs = am * (1.f / 127.f);
}
DI void mix_row_norm(bf16* orow, const float* ga, const float* gb, int lane) {
    GAS v4u* p = (GAS v4u*)orow + lane;
    v4u v[8]; float sa = 0.f, sb = 0.f;
#pragma unroll
    for (int j = 0; j < 8; ++j) { v[j] = p[64 * j]; float s = 0.f;
#pragma unroll
        for (int k = 0; k < 4; ++k) { const float a = bflo(v[j][k]), b = bfhi(v[j][k]); s += a * a + b * b; }
        if (j < 4) sa += s; else sb += s; }
    const float ra = 1.0f / sqrtf(wave_sum(sa) * (1.f / 2048.f) + RMS_EPS), rb = 1.0f / sqrtf(wave_sum(sb) * (1.f / 2048.f) + RMS_EPS);
#pragma unroll
    for (int j = 0; j < 8; ++j) { const float rs = j < 4 ? ra : rb; const float* gp = (j < 4 ? ga : gb) + ((lane + 64 * (j & 3)) * 8);
        const f32x4 g0 = *(const GAS f32x4*)gp, g1 = *(const GAS f32x4*)(gp + 4); v4u w;
        w.x = cvtpk(bflo(v[j].x) * rs * g0.x, bfhi(v[j].x) * rs * g0.y); w.y = cvtpk(bflo(v[j].y) * rs * g0.z, bfhi(v[j].y) * rs * g0.w);
        w.z = cvtpk(bflo(v[j].z) * rs * g1.x, bfhi(v[j].z) * rs * g1.y); w.w = cvtpk(bflo(v[j].w) * rs * g1.z, bfhi(v[j].w) * rs * g1.w);
        p[64 * j] = w; }
}

struct EpiResF32 {
    static constexpr bool PERM = false, AFTER_DRAIN = false;
    const float* base; float* out; int ldc; float sc;
    __device__ __forceinline__ void operator()(const pg8::f32x4 (&acc)[2][2][4][2], const pg8::Unit& u, int wr, int wc, int fr, int fq) const {
        const int col0 = u.pn * 256 + wc * 32 + 4 * fq;
#pragma unroll
        for (int ai = 0; ai < 2; ++ai)
#pragma unroll
            for (int m = 0; m < 4; ++m) { const int r = ai * 128 + wr * 64 + m * 16 + fr; const size_t off = (size_t)(u.pm * 256 + r) * ldc + col0;
#pragma unroll
                for (int bj = 0; bj < 2; ++bj)
#pragma unroll
                    for (int n = 0; n < 2; ++n) { const pg8::f32x4 bs = *(const pg8::f32x4*)(base + off + bj * 128 + n * 16); *(pg8::f32x4*)(out + off + bj * 128 + n * 16) = bs + acc[ai][bj][m][n] * sc; } }
    }
};

struct EpiResNorm {
    static constexpr bool PERM = false, AFTER_DRAIN = false;
    const float* base; float* out; bf16* xn; const float* gain; float* ssq; int ldc;
    __device__ __forceinline__ void operator()(const pg8::f32x4 (&acc)[2][2][4][2], const pg8::Unit& u, int wr, int wc, int fr, int fq) const {
        const int col0 = u.pn * 256 + wc * 32 + 4 * fq;
        pg8::f32x4 gv[2][2];
#pragma unroll
        for (int bj = 0; bj < 2; ++bj)
#pragma unroll
            for (int n = 0; n < 2; ++n) gv[bj][n] = *(const pg8::f32x4*)(gain + col0 + bj * 128 + n * 16);
#pragma unroll
        for (int ai = 0; ai < 2; ++ai)
#pragma unroll
            for (int m = 0; m < 4; ++m) { const int r = u.pm * 256 + ai * 128 + wr * 64 + m * 16 + fr; const size_t off = (size_t)r * ldc + col0; float part = 0.f;
#pragma unroll
                for (int bj = 0; bj < 2; ++bj)
#pragma unroll
                    for (int n = 0; n < 2; ++n) { const pg8::f32x4 bs = *(const pg8::f32x4*)(base + off + bj * 128 + n * 16); const pg8::f32x4 v = bs + acc[ai][bj][m][n];
                        *(pg8::f32x4*)(out + off + bj * 128 + n * 16) = v; part += (v[0] * v[0] + v[1] * v[1]) + (v[2] * v[2] + v[3] * v[3]);
                        const pg8::f32x4 g = gv[bj][n]; u32x2 w; w.x = cvtpk(v[0] * g[0], v[1] * g[1]); w.y = cvtpk(v[2] * g[2], v[3] * g[3]);
                        *(u32x2*)(xn + off + bj * 128 + n * 16) = w; }
                part += __shfl_xor(part, 16); part += __shfl_xor(part, 32);
                if (fq == 0) atomicAdd(ssq + r, part); }
    }
};
struct EpiResNormMid {
    static constexpr bool PERM = false, AFTER_DRAIN = false;
    const float* base; float* out; bf16* xn; const float* gain; float* ssq; int ldc; const float* ssqa; const float* ssqb;
    LAS float* midtab;
    __device__ __forceinline__ void load_mid(const pg8::Unit& u) const {
        if (threadIdx.x < 256) { const int r = u.pm * 256 + (int)threadIdx.x;
            midtab[threadIdx.x] = sqrtf((ssqb[r] * (1.f / 2048.f) + RMS_EPS) / (ssqa[r] * (1.f / 2048.f) + RMS_EPS)); }
    }
    __device__ __forceinline__ float mid(int row_in_tile) const { return midtab[row_in_tile]; }
    __device__ __forceinline__ void operator()(const pg8::f32x4 (&acc)[2][2][4][2], const pg8::Unit& u, int wr, int wc, int fr, int fq) const {
        const int col0 = u.pn * 256 + wc * 32 + 4 * fq;
        pg8::f32x4 gv[2][2];
#pragma unroll
        for (int bj = 0; bj < 2; ++bj)
#pragma unroll
            for (int n = 0; n < 2; ++n) gv[bj][n] = *(const pg8::f32x4*)(gain + col0 + bj * 128 + n * 16);
#pragma unroll
        for (int ai = 0; ai < 2; ++ai)
#pragma unroll
            for (int m = 0; m < 4; ++m) { const int r = u.pm * 256 + ai * 128 + wr * 64 + m * 16 + fr; const size_t off = (size_t)r * ldc + col0; float part = 0.f;
                const float rsb = 1.0f / sqrtf(ssqb[r] * (1.f / 2048.f) + RMS_EPS);
#pragma unroll
                for (int bj = 0; bj < 2; ++bj)
#pragma unroll
                    for (int n = 0; n < 2; ++n) { const pg8::f32x4 bs = *(const pg8::f32x4*)(base + off + bj * 128 + n * 16); const pg8::f32x4 v = bs + acc[ai][bj][m][n] * rsb;
                        *(pg8::f32x4*)(out + off + bj * 128 + n * 16) = v; part += (v[0] * v[0] + v[1] * v[1]) + (v[2] * v[2] + v[3] * v[3]);
                        const pg8::f32x4 g = gv[bj][n]; u32x2 w; w.x = cvtpk(v[0] * g[0], v[1] * g[1]); w.y = cvtpk(v[2] * g[2], v[3] * g[3]);
                        *(u32x2*)(xn + off + bj * 128 + n * 16) = w; }
                part += __shfl_xor(part, 16); part += __shfl_xor(part, 32);
                if (fq == 0) atomicAdd(ssq + r, part); }
    }
};
struct EpiResHMid {
    static constexpr bool PERM = true, AFTER_DRAIN = false;
    bf16* H; float* ssq; int ldc; const float* ssqa; const float* ssqb; LAS float* midtab;
    __device__ __forceinline__ void load_mid(const pg8::Unit& u) const {
        if (threadIdx.x < 256) { const int r = u.pm * 256 + (int)threadIdx.x;
            midtab[threadIdx.x] = sqrtf((ssqb[r] * (1.f / 2048.f) + RMS_EPS) / (ssqa[r] * (1.f / 2048.f) + RMS_EPS)); }
    }
    __device__ __forceinline__ float mid(int row_in_tile) const { return midtab[row_in_tile]; }
    __device__ __forceinline__ void operator()(const pg8::f32x4 (&acc)[2][2][4][2], const pg8::Unit& u, int wr, int wc, int fr, int fq) const {
        const int col0 = u.pn * 256 + wc * 32 + 8 * fq;
#pragma unroll
        for (int ai = 0; ai < 2; ++ai)
#pragma unroll
            for (int m = 0; m < 4; ++m) { const int r = u.pm * 256 + ai * 128 + wr * 64 + m * 16 + fr; bf16* rowp = H + (size_t)r * ldc + col0; float part = 0.f;
                const float rsb = 1.0f / sqrtf(ssqb[r] * (1.f / 2048.f) + RMS_EPS);
#pragma unroll
                for (int bj = 0; bj < 2; ++bj) { const v4u hb = *(const v4u*)(rowp + bj * 128); float v[8];
#pragma unroll
                    for (int n = 0; n < 2; ++n)
#pragma unroll
                        for (int c = 0; c < 2; ++c) { const unsigned w2 = hb[2 * n + c]; v[4 * n + 2 * c] = bflo(w2) + acc[ai][bj][m][n][2 * c] * rsb; v[4 * n + 2 * c + 1] = bfhi(w2) + acc[ai][bj][m][n][2 * c + 1] * rsb; }
                    v4u w;
#pragma unroll
                    for (int c = 0; c < 4; ++c) { part += v[2 * c] * v[2 * c] + v[2 * c + 1] * v[2 * c + 1]; w[c] = cvtpk(v[2 * c], v[2 * c + 1]); }
                    *(v4u*)(rowp + bj * 128) = w; }
                part += __shfl_xor(part, 16); part += __shfl_xor(part, 32);
                if (fq == 0) atomicAdd(ssq + r, part); }
    }
};
struct EpiResH {
    static constexpr bool PERM = true, AFTER_DRAIN = false;
    bf16* H; float* ssq; int ldc;
    __device__ __forceinline__ void operator()(const pg8::f32x4 (&acc)[2][2][4][2], const pg8::Unit& u, int wr, int wc, int fr, int fq) const {
        const int col0 = u.pn * 256 + wc * 32 + 8 * fq;
#pragma unroll
        for (int ai = 0; ai < 2; ++ai)
#pragma unroll
            for (int m = 0; m < 4; ++m) { const int r = u.pm * 256 + ai * 128 + wr * 64 + m * 16 + fr; bf16* rowp = H + (size_t)r * ldc + col0; float part = 0.f;
#pragma unroll
                for (int bj = 0; bj < 2; ++bj) { const v4u hb = *(const v4u*)(rowp + bj * 128); float v[8];
#pragma unroll
                    for (int n = 0; n < 2; ++n)
#pragma unroll
                        for (int c = 0; c < 2; ++c) { const unsigned w2 = hb[2 * n + c]; v[4 * n + 2 * c] = bflo(w2) + acc[ai][bj][m][n][2 * c]; v[4 * n + 2 * c + 1] = bfhi(w2) + acc[ai][bj][m][n][2 * c + 1]; }
                    v4u w;
#pragma unroll
                    for (int c = 0; c < 4; ++c) { part += v[2 * c] * v[2 * c] + v[2 * c + 1] * v[2 * c + 1]; w[c] = cvtpk(v[2 * c], v[2 * c + 1]); }
                    *(v4u*)(rowp + bj * 128) = w; }
                part += __shfl_xor(part, 16); part += __shfl_xor(part, 32);
                if (fq == 0) atomicAdd(ssq + r, part); }
    }
};
struct EpiBf16I8 {
    static constexpr bool PERM = true, AFTER_DRAIN = false;
    bf16* O; int ldc; const float* rs; const unsigned* cm;
    __device__ __forceinline__ void operator()(const pg8::f32x4 (&acc)[2][2][4][2], const pg8::Unit& u, int wr, int wc, int fr, int fq) const {
        const int row0 = u.pm * 256 + wr * 64 + fr, col0 = u.pn * 256 + wc * 32 + 8 * fq;
        float cs[2][8];
#pragma unroll
        for (int bj = 0; bj < 2; ++bj) { const v4u c0 = *(const v4u*)(cm + col0 + bj * 128), c1 = *(const v4u*)(cm + col0 + bj * 128 + 4);
#pragma unroll
            for (int k = 0; k < 4; ++k) { cs[bj][k] = __uint_as_float(c0[k]) * (1.f / 127.f); cs[bj][4 + k] = __uint_as_float(c1[k]) * (1.f / 127.f); } }
#pragma unroll
        for (int ai = 0; ai < 2; ++ai)
#pragma unroll
            for (int m = 0; m < 4; ++m) { const int row = row0 + ai * 128 + m * 16; const float r1 = rs[row]; bf16* rowp = O + (size_t)row * ldc + col0;
#pragma unroll
                for (int bj = 0; bj < 2; ++bj) { float v[8];
#pragma unroll
                    for (int n = 0; n < 2; ++n)
#pragma unroll
                        for (int k = 0; k < 4; ++k) v[4 * n + k] = (float)(int)__float_as_uint(acc[ai][bj][m][n][k]) * r1 * cs[bj][4 * n + k];
                    v4u w; w.x = cvtpk(v[0], v[1]); w.y = cvtpk(v[2], v[3]); w.z = cvtpk(v[4], v[5]); w.w = cvtpk(v[6], v[7]);
                    *(v4u*)(rowp + bj * 128) = w; } }
    }
};
struct EpiResHI8 {
    static constexpr bool PERM = true, AFTER_DRAIN = false;
    bf16* H; float* ssq; int ldc; const float* rs; const unsigned* cm;
    __device__ __forceinline__ void operator()(const pg8::f32x4 (&acc)[2][2][4][2], const pg8::Unit& u, int wr, int wc, int fr, int fq) const {
        const int col0 = u.pn * 256 + wc * 32 + 8 * fq;
        float cs[2][8];
#pragma unroll
        for (int bj = 0; bj < 2; ++bj) { const v4u c0 = *(const v4u*)(cm + col0 + bj * 128), c1 = *(const v4u*)(cm + col0 + bj * 128 + 4);
#pragma unroll
            for (int k = 0; k < 4; ++k) { cs[bj][k] = __uint_as_float(c0[k]) * (1.f / 127.f); cs[bj][4 + k] = __uint_as_float(c1[k]) * (1.f / 127.f); } }
#pragma unroll
        for (int ai = 0; ai < 2; ++ai)
#pragma unroll
            for (int m = 0; m < 4; ++m) { const int r = u.pm * 256 + ai * 128 + wr * 64 + m * 16 + fr; bf16* rowp = H + (size_t)r * ldc + col0; float part = 0.f; const float r1 = rs[r];
#pragma unroll
                for (int bj = 0; bj < 2; ++bj) { const v4u hb = *(const v4u*)(rowp + bj * 128); float v[8];
#pragma unroll
                    for (int n = 0; n < 2; ++n)
#pragma unroll
                        for (int c = 0; c < 2; ++c) { const unsigned w2 = hb[2 * n + c];
                            v[4 * n + 2 * c] = bflo(w2) + (float)(int)__float_as_uint(acc[ai][bj][m][n][2 * c]) * r1 * cs[bj][4 * n + 2 * c];
                            v[4 * n + 2 * c + 1] = bfhi(w2) + (float)(int)__float_as_uint(acc[ai][bj][m][n][2 * c + 1]) * r1 * cs[bj][4 * n + 2 * c + 1]; }
                    v4u w;
#pragma unroll
                    for (int c = 0; c < 4; ++c) { part += v[2 * c] * v[2 * c] + v[2 * c + 1] * v[2 * c + 1]; w[c] = cvtpk(v[2 * c], v[2 * c + 1]); }
                    *(v4u*)(rowp + bj * 128) = w; }
                part += __shfl_xor(part, 16); part += __shfl_xor(part, 32);
                if (fq == 0) atomicAdd(ssq + r, part); }
    }
};
struct EpiBf16RowScale {
    static constexpr bool PERM = true, AFTER_DRAIN = false;
    bf16* O; int ldc; const float* ssq;
    __device__ __forceinline__ void operator()(const pg8::f32x4 (&acc)[2][2][4][2], const pg8::Unit& u, int wr, int wc, int fr, int fq) const {
        const int row0 = u.pm * 256 + wr * 64 + fr, col0 = u.pn * 256 + wc * 32 + 8 * fq;
#pragma unroll
        for (int ai = 0; ai < 2; ++ai)
#pragma unroll
            for (int m = 0; m < 4; ++m) { const int row = row0 + ai * 128 + m * 16; const float rs = 1.0f / sqrtf(ssq[row] * (1.f / DM) + RMS_EPS); bf16* rowp = O + (size_t)row * ldc + col0;
#pragma unroll
                for (int bj = 0; bj < 2; ++bj) { const pg8::f32x4 v0 = acc[ai][bj][m][0] * rs, v1 = acc[ai][bj][m][1] * rs;
                    v4u w; w.x = cvtpk(v0[0], v0[1]); w.y = cvtpk(v0[2], v0[3]); w.z = cvtpk(v1[0], v1[1]); w.w = cvtpk(v1[2], v1[3]);
                    *(v4u*)(rowp + bj * 128) = w; } }
    }
};

template <int NSTEP, int KP>
DI f32x16 qk_tile(const LAS unsigned char* Kt, const bf16x8* qf, int r, int h) {
    f32x16 s;
#pragma unroll
    for (int i = 0; i < 16; ++i) s[i] = 0.f;
    const LAS unsigned char* kp = Kt + r * KP + h * 16;
#pragma unroll
    for (int st = 0; st < NSTEP; ++st) { const bf16x8 a = *(const LAS bf16x8*)(kp + st * 32); s = MFMA32(a, qf[st], s); }
    return s;
}
template <int NDB, int VP>
DI void pv_tile(f32x16* o, const LAS unsigned char* Vt, const f32x16& p, int lane) {
    const int h = lane >> 5, q = (lane & 15) >> 2, pp = lane & 3, blk = (lane >> 4) & 1;
    const bf16x8 p0 = pack8(p, 0), p1 = pack8(p, 1);
    const LAS unsigned char* vb = Vt + (4 * h + q) * VP + blk * 32 + pp * 8;
#pragma unroll
    for (int db = 0; db < NDB; ++db) {
        const s16x4 l0 = vtr(vb + db * 64), h0 = vtr(vb + 8 * VP + db * 64), l1 = vtr(vb + 16 * VP + db * 64), h1 = vtr(vb + 24 * VP + db * 64);
        const bf16x8 v0 = __builtin_shufflevector(l0, h0, 0, 1, 2, 3, 4, 5, 6, 7), v1 = __builtin_shufflevector(l1, h1, 0, 1, 2, 3, 4, 5, 6, 7);
        o[db] = MFMA32(v0, p0, o[db]); o[db] = MFMA32(v1, p1, o[db]);
    }
}
DI float softmax_tile(f32x16& s, float& m, float& l) {
    float mx = s[0];
#pragma unroll
    for (int i = 1; i < 16; ++i) mx = fmaxf(mx, s[i]);
    mx = fmaxf(mx, __shfl_xor(mx, 32));
    const float mn = fmaxf(m, mx), alpha = fexp2(m - mn); m = mn;
    float sum = 0.f;
#pragma unroll
    for (int i = 0; i < 16; ++i) { s[i] = fexp2(s[i] - mn); sum += s[i]; }
    l = l * alpha + sum;
    return alpha;
}
DI float fmul_s(float a, float b) { float r; asm("v_mul_f32_e32 %0, %1, %2" : "=v"(r) : "v"(a), "v"(b)); return r; }
template <int NDB> DI void scale_o(f32x16* o, float alpha) {
#pragma unroll
    for (int db = 0; db < NDB; ++db)
#pragma unroll
        for (int i = 0; i < 16; ++i) o[db][i] *= alpha;
}
struct MaskNone { DI void operator()(f32x16&, int) const {} };
struct MaskSwa { int qpos, k0; int h;
    DI void operator()(f32x16& s, int st2) const {
#pragma unroll
        for (int i = 0; i < 16; ++i) { const int d = qpos - (k0 + 32 * st2 + crow(i, h)); s[i] = (d <= 128 && d >= -128) ? s[i] : -3.0e30f; } } };
struct MaskNat { const LAS float* brow; int t0;
    DI void operator()(f32x16& s, int st2) const {
        float bv[16];
#pragma unroll
        for (int i = 0; i < 16; ++i) bv[i] = brow[32 * st2 + (i & 3) + 8 * (i >> 2)];
        __builtin_amdgcn_sched_barrier(0);
#pragma unroll
        for (int i = 0; i < 16; ++i) { const int kc0 = 32 * st2 + (i & 3) + 8 * (i >> 2); s[i] = ((unsigned)(t0 + kc0) < 16u) ? s[i] + bv[i] : -3.0e30f; } } };
template <int NSTEP, int KP, int NDB, int VP, class Mask>
DI void tile64(const LAS unsigned char* Kb, const LAS unsigned char* Vb, const bf16x8* qf, f32x16* o, float& m, float& l, int lane, const Mask& mask, unsigned long long* tq = nullptr, bool domask = true) {
    const int r = lane & 31, h = lane >> 5;
#ifdef PROBE_TILE
    unsigned long long t0_ = clock64();
#define TT(i_) do { if (tq) { asm volatile("s_waitcnt vmcnt(0) lgkmcnt(0)" ::: "memory"); asm volatile("s_nop 15\n\ts_nop 15" :: "v"(s0), "v"(s1)); const unsigned long long n_ = clock64(); tq[i_] += n_ - t0_; t0_ = n_; } } while (0)
#else
#define TT(i_) do {} while (0)
#endif
    f32x16 s0, s1;
#pragma unroll
    for (int i = 0; i < 16; ++i) { s0[i] = 0.f; s1[i] = 0.f; }
    const LAS unsigned char* kp = Kb + r * KP + h * 16;
#pragma unroll
    for (int st = 0; st < NSTEP; ++st) { const bf16x8 a0 = *(const LAS bf16x8*)(kp + st * 32), a1 = *(const LAS bf16x8*)(kp + 32 * KP + st * 32);
        s0 = MFMA32(a0, qf[st], s0); s1 = MFMA32(a1, qf[st], s1); }
    TT(0);
    if (domask) { mask(s0, 0); mask(s1, 1); }
#ifdef PROBE_SPLIT
    TT(1);
#endif
    float mx0 = fmaxf(s0[0], s1[0]), mx1 = fmaxf(s0[1], s1[1]);
#pragma unroll
    for (int i = 2; i < 16; i += 2) { mx0 = fmaxf(mx0, fmaxf(s0[i], s1[i])); mx1 = fmaxf(mx1, fmaxf(s0[i + 1], s1[i + 1])); }
    float mx = fmaxf(mx0, mx1);
    { const auto sw = __builtin_amdgcn_permlane32_swap(__float_as_uint(mx), __float_as_uint(mx), false, false); mx = fmaxf(__uint_as_float(sw[0]), __uint_as_float(sw[1])); }
    const float mn = fmaxf(m, mx), alpha = fexp2(m - mn); m = mn;
    float sum0 = 0.f, sum1 = 0.f;
#pragma unroll
    for (int i = 0; i < 16; ++i) { s0[i] = fexp2(s0[i] - mn); s1[i] = fexp2(s1[i] - mn); sum0 += s0[i]; sum1 += s1[i]; }
    l = l * alpha + (sum0 + sum1);
    scale_o<NDB>(o, alpha);
#ifdef PROBE_SPLIT
    TT(2);
#else
    TT(1);
#endif
    const int q = (lane & 15) >> 2, pp = lane & 3, blk = (lane >> 4) & 1;
    const bf16x8 p00 = pack8(s0, 0), p01 = pack8(s0, 1), p10 = pack8(s1, 0), p11 = pack8(s1, 1);
    const LAS unsigned char* vb = Vb + (4 * h + q) * VP + blk * 32 + pp * 8;
#pragma unroll
    for (int db = 0; db < NDB; ++db) {
        const s16x4 a0 = vtr(vb + db * 64), a1 = vtr(vb + 8 * VP + db * 64), a2 = vtr(vb + 16 * VP + db * 64), a3 = vtr(vb + 24 * VP + db * 64);
        const s16x4 b0 = vtr(vb + 32 * VP + db * 64), b1 = vtr(vb + 40 * VP + db * 64), b2 = vtr(vb + 48 * VP + db * 64), b3 = vtr(vb + 56 * VP + db * 64);
        const bf16x8 v00 = __builtin_shufflevector(a0, a1, 0, 1, 2, 3, 4, 5, 6, 7), v01 = __builtin_shufflevector(a2, a3, 0, 1, 2, 3, 4, 5, 6, 7);
        const bf16x8 v10 = __builtin_shufflevector(b0, b1, 0, 1, 2, 3, 4, 5, 6, 7), v11 = __builtin_shufflevector(b2, b3, 0, 1, 2, 3, 4, 5, 6, 7);
        o[db] = MFMA32(v00, p00, o[db]); o[db] = MFMA32(v01, p01, o[db]); o[db] = MFMA32(v10, p10, o[db]); o[db] = MFMA32(v11, p11, o[db]);
    }
#if defined(PROBE_TILE) && !defined(PROBE_SPLIT)
    if (tq) { asm volatile("s_nop 15\n\ts_nop 15" :: "v"(o[0]), "v"(o[1]), "v"(o[2]), "v"(o[3])); const unsigned long long n_ = clock64(); tq[2] += n_ - t0_; }
#endif
#undef TT
}
template <int NDB> DI void store_o(const f32x16* o, float inv, bf16* orow, int h, float* ssq = nullptr) {
    float part = 0.f;
#pragma unroll
    for (int db = 0; db < NDB; ++db)
#pragma unroll
        for (int gp = 0; gp < 2; ++gp) {
            unsigned ax, ay, bx, by;
            { const int g = 2 * gp; const float a0 = o[db][4 * g] * inv, a1 = o[db][4 * g + 1] * inv, a2 = o[db][4 * g + 2] * inv, a3 = o[db][4 * g + 3] * inv;
              part += (a0 * a0 + a1 * a1) + (a2 * a2 + a3 * a3); ax = cvtpk(a0, a1); ay = cvtpk(a2, a3); }
            { const int g = 2 * gp + 1; const float a0 = o[db][4 * g] * inv, a1 = o[db][4 * g + 1] * inv, a2 = o[db][4 * g + 2] * inv, a3 = o[db][4 * g + 3] * inv;
              part += (a0 * a0 + a1 * a1) + (a2 * a2 + a3 * a3); bx = cvtpk(a0, a1); by = cvtpk(a2, a3); }
            const auto sx = __builtin_amdgcn_permlane32_swap(ax, bx, false, false), sy = __builtin_amdgcn_permlane32_swap(ay, by, false, false);
            v4u w; w.x = sx[0]; w.y = sy[0]; w.z = sx[1]; w.w = sy[1];
            *(GAS v4u*)(orow + 32 * db + 16 * gp + 8 * h) = w; }
    if (ssq) { part += __shfl_xor(part, 32); if (h == 0) atomicAdd(ssq, part); }
}

constexpr int KP128 = 272, VP128 = 320, KP256 = 528, VP256 = 576;
constexpr int ATT_K_OFF = 0, ATT_V_OFF = 34816, ATT_BIAS_OFF = 72704;

constexpr int A2_K = 0, A2_V = 17408, A2_BUF = 37888, A2_BIAS = 76800;
template <bool SKIPC = false> DI void swa_unit(LAS unsigned char* lds, int u, const bf16* QKV, bf16* OB, const float* sink, const float* ropec, const float* ropes, float* SSQA) {
    const int tid = threadIdx.x, lane = tid & 63, wid = __builtin_amdgcn_readfirstlane(tid >> 6), r = lane & 31, h = lane >> 5;
    const int qb = u & 31, kvh = (u >> 5) & 3, b = u >> 7;
    const int q0 = qb * 64, g = wid >> 1, sub = wid & 1, head = kvh * 4 + g;
    const int qpos = q0 + 32 * sub + r;
    const size_t tok = (size_t)b * SEQ + qpos;
    const float QS = 0.08838834764831845f * LOG2E;
    const int t_lo = qb - 2 < 0 ? 0 : qb - 2, t_hi = qb + 2 > 31 ? 31 : qb + 2;
    const int skey = tid >> 3, sc = tid & 7;
    v4u s_lo, s_hi, s_v0, s_v1; int s_kpos = 0;
#define SWA_LOAD(kt_) do { const int kpos_ = (kt_) * 64 + skey; const size_t ktok_ = (size_t)b * SEQ + kpos_; \
        const bf16* kp_ = QKV + ktok_ * INW + C_KA + kvh * 128 + 8 * sc; s_lo = *(const GAS v4u*)kp_; s_hi = *(const GAS v4u*)(kp_ + 64); \
        const bf16* vp_ = QKV + ktok_ * INW + C_VA + kvh * 128 + 8 * sc; s_v0 = *(const GAS v4u*)vp_; s_v1 = *(const GAS v4u*)(vp_ + 64); \
        s_kpos = kpos_; } while (0)
#define SWA_WRITE(buf_) do { float cc_[8], ss_[8]; _Pragma("unroll") for (int k_ = 0; k_ < 8; ++k_) { const float inv_ = fexp2(-(float)(8 * sc + k_) * (13.287712379549449f / 64.0f)); \
            const float rev_ = ((float)s_kpos * inv_) * 0.15915494309189535f; const float fr_ = rev_ - floorf(rev_); cc_[k_] = __builtin_amdgcn_cosf(fr_); ss_[k_] = __builtin_amdgcn_sinf(fr_); } \
        v4u a_, b_; _Pragma("unroll") for (int k_ = 0; k_ < 4; ++k_) { const float x1a = bflo(s_lo[k_]), x1b = bfhi(s_lo[k_]), x2a = bflo(s_hi[k_]), x2b = bfhi(s_hi[k_]); \
            a_[k_] = cvtpk(x1a * cc_[2 * k_] - x2a * ss_[2 * k_], x1b * cc_[2 * k_ + 1] - x2b * ss_[2 * k_ + 1]); \
            b_[k_] = cvtpk(x2a * cc_[2 * k_] + x1a * ss_[2 * k_], x2b * cc_[2 * k_ + 1] + x1b * ss_[2 * k_ + 1]); } \
        LAS unsigned char* bb_ = lds + (buf_) * A2_BUF; \
        *(LAS v4u*)(bb_ + A2_K + skey * KP128 + 16 * sc) = a_; *(LAS v4u*)(bb_ + A2_K + skey * KP128 + 128 + 16 * sc) = b_; \
        *(LAS v4u*)(bb_ + A2_V + skey * VP128 + 16 * sc) = s_v0; *(LAS v4u*)(bb_ + A2_V + skey * VP128 + 128 + 16 * sc) = s_v1; } while (0)
    bf16x8 qf[8];
    {
        const bf16* qp = QKV + tok * INW + C_QA + head * 128 + 8 * h;
#pragma unroll
        for (int st = 0; st < 4; ++st) {
            const v4u lo = *(const GAS v4u*)(qp + 16 * st), hi = *(const GAS v4u*)(qp + 16 * st + 64);
            const float* cp = ropec + (size_t)qpos * 64 + 16 * st + 8 * h; const float* sp = ropes + (size_t)qpos * 64 + 16 * st + 8 * h;
            const f32x4 c0 = *(const GAS f32x4*)cp, c1 = *(const GAS f32x4*)(cp + 4), s0 = *(const GAS f32x4*)sp, s1 = *(const GAS f32x4*)(sp + 4);
            float x1[8], x2[8], cc[8], ss[8];
#pragma unroll
            for (int k = 0; k < 4; ++k) { x1[2 * k] = bflo(lo[k]); x1[2 * k + 1] = bfhi(lo[k]); x2[2 * k] = bflo(hi[k]); x2[2 * k + 1] = bfhi(hi[k]); cc[k] = c0[k]; cc[4 + k] = c1[k]; ss[k] = s0[k]; ss[4 + k] = s1[k]; }
            v4u a, bq;
#pragma unroll
            for (int k = 0; k < 4; ++k) {
                a[k] = cvtpk((x1[2 * k] * cc[2 * k] - x2[2 * k] * ss[2 * k]) * QS, (x1[2 * k + 1] * cc[2 * k + 1] - x2[2 * k + 1] * ss[2 * k + 1]) * QS);
                bq[k] = cvtpk((x2[2 * k] * cc[2 * k] + x1[2 * k] * ss[2 * k]) * QS, (x2[2 * k + 1] * cc[2 * k + 1] + x1[2 * k + 1] * ss[2 * k + 1]) * QS);
            }
            qf[st] = __builtin_bit_cast(bf16x8, a); qf[st + 4] = __builtin_bit_cast(bf16x8, bq);
        }
    }
    asm volatile("" ::: "memory");
    SWA_LOAD(t_lo);
    float m = sink[head] * LOG2E, l = (h == 0) ? 1.f : 0.f;
    f32x16 o[4];
#pragma unroll
    for (int db = 0; db < 4; ++db)
#pragma unroll
        for (int i = 0; i < 16; ++i) o[db][i] = 0.f;
    __syncthreads();
    SWA_WRITE(0);
    __syncthreads();
    int buf = 0;
    for (int kt = t_lo; kt <= t_hi; ++kt) {
        if (kt < t_hi) SWA_LOAD(kt + 1);
        const LAS unsigned char* bb = lds + buf * A2_BUF;
        if (!SKIPC) { const MaskSwa mk{qpos, kt * 64, h}; tile64<8, KP128, 4, VP128>(bb + A2_K, bb + A2_V, qf, o, m, l, lane, mk, nullptr, kt <= qb - 2 || kt >= qb + 2); }
        if (kt < t_hi) SWA_WRITE(buf ^ 1);
        __syncthreads();
        buf ^= 1;
    }
#undef SWA_LOAD
#undef SWA_WRITE
    const float lt = l + __shfl_xor(l, 32);
    store_o<4>(o, 1.0f / lt, OB + tok * DM + head * 128, h, SSQA + tok);
}

#define PROBE_PTR ((unsigned char*)SSQB - WS_SSQB + 458752)
DI void nat_unit(LAS unsigned char* lds, int u, const bf16* QKV, bf16* OB, const float* relb, float* SSQB) {
    const int tid = threadIdx.x, lane = tid & 63, wid = __builtin_amdgcn_readfirstlane(tid >> 6), r = lane & 31, h = lane >> 5;
    const int rb = u & 7, head = (u >> 3) & 15, b = u >> 7;
    const int r0 = rb * 4, qrow = r0 + (wid >> 1), qcol = 32 * (wid & 1) + r;
    const size_t tok = (size_t)b * SEQ + qrow * 64 + qcol;
    const float QS = 0.08838834764831845f * LOG2E;
    int kr_lo = r0 - 4; kr_lo = kr_lo < 0 ? 0 : (kr_lo > 24 ? 24 : kr_lo);
    int kr_hi = r0 + 3 - 4; kr_hi = (kr_hi < 0 ? 0 : (kr_hi > 24 ? 24 : kr_hi)) + 7;
    int rs = qrow - 4; rs = rs < 0 ? 0 : (rs > 24 ? 24 : rs);
    int cs = qcol - 8; cs = cs < 0 ? 0 : (cs > 48 ? 48 : cs);
    const int skey = tid >> 3, sc = tid & 7;
    v4u s_k0, s_k1, s_v0, s_v1;
#define NAT_LOAD(kr_) do { const size_t ktok_ = (size_t)b * SEQ + (kr_) * 64 + skey; \
        const bf16* kp_ = QKV + ktok_ * INW + C_KB + head * 128 + 8 * sc; s_k0 = *(const GAS v4u*)kp_; s_k1 = *(const GAS v4u*)(kp_ + 64); \
        const bf16* vp_ = QKV + ktok_ * INW + C_VB + head * 128 + 8 * sc; s_v0 = *(const GAS v4u*)vp_; s_v1 = *(const GAS v4u*)(vp_ + 64); } while (0)
#define NAT_WRITE(buf_) do { LAS unsigned char* bb_ = lds + (buf_) * A2_BUF; \
        *(LAS v4u*)(bb_ + A2_K + skey * KP128 + 16 * sc) = s_k0; *(LAS v4u*)(bb_ + A2_K + skey * KP128 + 128 + 16 * sc) = s_k1; \
        *(LAS v4u*)(bb_ + A2_V + skey * VP128 + 16 * sc) = s_v0; *(LAS v4u*)(bb_ + A2_V + skey * VP128 + 128 + 16 * sc) = s_v1; } while (0)
    NAT_LOAD(kr_lo);
    bf16x8 qf[8];
    {
        const bf16* qp = QKV + tok * INW + C_QB + head * 128 + 8 * h;
#pragma unroll
        for (int st = 0; st < 8; ++st) { const v4u x = *(const GAS v4u*)(qp + 16 * st); v4u a;
#pragma unroll
            for (int k = 0; k < 4; ++k) a[k] = cvtpk(bflo(x[k]) * QS, bfhi(x[k]) * QS);
            qf[st] = __builtin_bit_cast(bf16x8, a); }
    }
    float m = -1.0e30f, l = 0.f;
    f32x16 o[4];
#pragma unroll
    for (int db = 0; db < 4; ++db)
#pragma unroll
        for (int i = 0; i < 16; ++i) o[db][i] = 0.f;
    __syncthreads();
    LAS float* bias = (LAS float*)(lds + A2_BIAS) + 64;
    if (tid < 465) bias[tid] = relb[head * 465 + tid] * LOG2E;
    NAT_WRITE(0);
    __syncthreads();
    int buf = 0;
#ifdef PROBE_TILE
    unsigned long long tq_[3] = {0, 0, 0};
#endif
#ifdef PROBE_TIMING
    unsigned long long tc_ = 0, tw_ = 0, tb_ = 0, t0_ = clock64(), tt0_ = t0_;
#define TSTAMP(acc_) do { asm volatile("s_waitcnt vmcnt(0) lgkmcnt(0)" ::: "memory"); const unsigned long long n_ = clock64(); acc_ += n_ - t0_; t0_ = n_; } while (0)
#else
#define TSTAMP(acc_) do {} while (0)
#endif
    for (int kr = kr_lo; kr <= kr_hi; ++kr) {
        if (kr < kr_hi) NAT_LOAD(kr + 1);
        if (kr >= rs && kr < rs + 8) {
            const LAS unsigned char* bb = lds + buf * A2_BUF;
            int dr = kr - qrow + 7; dr = dr < 0 ? 0 : (dr > 14 ? 14 : dr);
            int boff = 15 - qcol + 4 * h, t0 = 4 * h - cs;
            asm volatile("" : "+v"(boff), "+v"(t0));
            const LAS float* brow = bias + dr * 31 + boff;
#ifdef PROBE_TILE
            { const MaskNat mk{brow, t0}; tile64<8, KP128, 4, VP128>(bb + A2_K, bb + A2_V, qf, o, m, l, lane, mk, tq_); }
#else
            { const MaskNat mk{brow, t0}; tile64<8, KP128, 4, VP128>(bb + A2_K, bb + A2_V, qf, o, m, l, lane, mk); }
#endif
        }
#ifdef PROBE_TIMING
        { asm volatile("s_waitcnt lgkmcnt(0)" ::: "memory"); const unsigned long long n_ = clock64(); tc_ += n_ - t0_; t0_ = n_; }
        TSTAMP(tw_);
#endif
        if (kr < kr_hi) NAT_WRITE(buf ^ 1);
        __syncthreads();
        TSTAMP(tb_);
        buf ^= 1;
    }
#ifdef PROBE_TIMING
#ifdef PROBE_TILE
    if (blockIdx.x == 0 && tid == 0) { unsigned long long* pt = (unsigned long long*)PROBE_PTR; pt[0] += tq_[0]; pt[1] += tq_[1]; pt[2] += tq_[2]; pt[3] += tc_; }
#else
    if (blockIdx.x == 0 && tid == 0) { unsigned long long* pt = (unsigned long long*)PROBE_PTR; pt[0] += tc_; pt[1] += tw_; pt[2] += tb_; pt[3] += clock64() - tt0_; }
#endif
#endif
#undef TSTAMP
#undef NAT_LOAD
#undef NAT_WRITE
    const float lt = l + __shfl_xor(l, 32);
    store_o<4>(o, 1.0f / lt, OB + tok * DM + 2048 + head * 128, h, SSQB + tok);
}

DI void mem_unit(LAS unsigned char* lds, int u, const bf16* QM, const bf16* KVM, bf16* OM) {
    const int tid = threadIdx.x, lane = tid & 63, wid = __builtin_amdgcn_readfirstlane(tid >> 6), r = lane & 31, h = lane >> 5;
    const int qblk = u & 15, mh = (u >> 4) & 3, b = u >> 6;
    const int qsub = wid >> 1, dh = wid & 1;
    const size_t tok = (size_t)b * SEQ + qblk * 128 + 32 * qsub + r;
    const float QS = 0.0625f * LOG2E;
    bf16x8 qf[16];
    {
        const bf16* qp = QM + tok * MEMW + mh * 256 + 8 * h;
#pragma unroll
        for (int st = 0; st < 16; ++st) { const v4u x = *(const GAS v4u*)(qp + 16 * st); v4u a;
#pragma unroll
            for (int k = 0; k < 4; ++k) a[k] = cvtpk(bflo(x[k]) * QS, bfhi(x[k]) * QS);
            qf[st] = __builtin_bit_cast(bf16x8, a); }
    }
    float m = -1.0e30f, l = 0.f;
    f32x16 o[4];
#pragma unroll
    for (int db = 0; db < 4; ++db)
#pragma unroll
        for (int i = 0; i < 16; ++i) o[db][i] = 0.f;
    for (int kt = 0; kt < 4; ++kt) {
        __syncthreads();
#pragma unroll
        for (int it = 0; it < 4; ++it) {
            const int ch = tid + 512 * it, key = ch >> 5, c = ch & 31;
            const bf16* kp = KVM + (size_t)(b * MEMLEN + kt * 64 + key) * 2048 + mh * 256 + 8 * c;
            const v4u kv = *(const GAS v4u*)kp, vv = *(const GAS v4u*)(kp + 1024);
            *(LAS v4u*)(lds + ATT_K_OFF + key * KP256 + 16 * c) = kv; *(LAS v4u*)(lds + ATT_V_OFF + key * VP256 + 16 * c) = vv;
        }
        __syncthreads();
        { const MaskNone mk; tile64<16, KP256, 4, VP256>(lds + ATT_K_OFF, lds + ATT_V_OFF + dh * 256, qf, o, m, l, lane, mk); }
    }
    const float lt = l + __shfl_xor(l, 32);
    store_o<4>(o, 1.0f / lt, OM + tok * MEMW + mh * 256 + dh * 128, h);
}

DI unsigned f2sort(float f) { const unsigned u = __float_as_uint(f); return u ^ ((unsigned)((int)u >> 31) | 0x80000000u); }
DI float sort2f(unsigned k) { const unsigned u = (k & 0x80000000u) ? (k ^ 0x80000000u) : ~k; return __uint_as_float(u); }
constexpr int RT_SK_OFF = 0, RT_A_OFF = 69632;
struct constexpr_cand { int a, b; };
__host__ __device__ constexpr constexpr_cand cand_ab(int n) {
    int c = 0;
    for (int a = 0; a < 16; ++a) for (int b = 0; b < 16; ++b) if ((a + 1) * (b + 1) <= 16) { if (c == n) return constexpr_cand{a, b}; ++c; }
    return constexpr_cand{0, 0};
}
DI unsigned selu(int h, unsigned a, unsigned b) { asm volatile("" : "+v"(a), "+v"(b)); return h ? b : a; }
DI float self(int h, float a, float b) { asm volatile("" : "+v"(a), "+v"(b)); return h ? b : a; }
DI void ce_desc(unsigned& a, unsigned& b) { const unsigned hi = a > b ? a : b, lo = a > b ? b : a; a = hi; b = lo; }
template <int LOGN> DI void bitonic_merge_desc(unsigned (&x)[1 << LOGN]) {
#pragma unroll
    for (int lj = LOGN - 1; lj >= 0; --lj)
#pragma unroll
        for (int i = 0; i < (1 << LOGN); ++i) { const int l = i ^ (1 << lj); if (l > i) ce_desc(x[i], x[l]); }
}
DI void bitonic_sort16_desc(unsigned (&x)[16]) {
#pragma unroll
    for (int lk = 1; lk <= 4; ++lk)
#pragma unroll
        for (int lj = lk - 1; lj >= 0; --lj)
#pragma unroll
            for (int i = 0; i < 16; ++i) { const int l = i ^ (1 << lj); if (l > i) { if ((i & (1 << lk)) == 0) ce_desc(x[i], x[l]); else ce_desc(x[l], x[i]); } }
}
DI void top16_merge(unsigned (&a)[16], const unsigned (&b)[16]) {
#pragma unroll
    for (int i = 0; i < 16; ++i) a[i] = a[i] > b[15 - i] ? a[i] : b[15 - i];
    bitonic_merge_desc<4>(a);
}
DI void top16_xlane(unsigned (&a)[16]) {
    unsigned o[16];
#pragma unroll
    for (int i = 0; i < 16; ++i) o[i] = (unsigned)__shfl_xor((int)a[i], 32);
    top16_merge(a, o);
}
DI void route_unit(LAS unsigned char* lds, int u, const bf16* QP, const bf16* SKB, int* IDX, float* GATE) {
    const int tid = threadIdx.x, lane = tid & 63, wid = __builtin_amdgcn_readfirstlane(tid >> 6), r = lane & 31, h = lane >> 5;
    const int hd = u & 7, tile = u >> 3;
    const size_t tok = (size_t)tile * 256 + 32 * wid + r;
    __syncthreads();
#pragma unroll
    for (int it = 0; it < 8; ++it) { const int ch = tid + 512 * it, row = ch >> 4, c = ch & 15;
        const v4u x = *(const GAS v4u*)(SKB + ((size_t)hd * 256 + row) * 128 + 8 * c);
        *(LAS v4u*)(lds + RT_SK_OFF + row * 272 + 16 * c) = x; }
    __syncthreads();
    LAS unsigned* A = (LAS unsigned*)(lds + RT_A_OFF);
    const int tslot = wid * 32 + r;
    unsigned top[2][16];
#pragma unroll
    for (int c = 0; c < 2; ++c) {
        bf16x8 qf[8];
        const bf16* qp = QP + tok * PQW + hd * 256 + c * 128 + 8 * h;
#pragma unroll
        for (int st = 0; st < 8; ++st) qf[st] = __builtin_bit_cast(bf16x8, *(const GAS v4u*)(qp + 16 * st));
        unsigned g0[16], g1[16];
#pragma unroll
        for (int kt = 0; kt < 4; ++kt) {
            const f32x16 s = qk_tile<8, 272>(lds + RT_SK_OFF + (c * 128 + 32 * kt) * 272, qf, r, h);
            unsigned pk[16];
#pragma unroll
            for (int i = 0; i < 16; ++i) pk[i] = (f2sort(s[i]) & ~0x7Fu) | (unsigned)(127 - (32 * kt + crow(i, h)));
            bitonic_sort16_desc(pk);
            if (kt == 0) {
#pragma unroll
                for (int i = 0; i < 16; ++i) g0[i] = pk[i];
            } else if (kt == 1) { top16_merge(g0, pk); }
            else if (kt == 2) {
#pragma unroll
                for (int i = 0; i < 16; ++i) g1[i] = pk[i];
            } else { top16_merge(g1, pk); }
        }
        top16_merge(g0, g1);
        top16_xlane(g0);
#pragma unroll
        for (int i = 0; i < 16; ++i) { top[c][i] = g0[i]; if (h == 0) A[(c * 16 + i) * 256 + tslot] = g0[i]; }
    }
    float v1[16], v2[16];
#pragma unroll
    for (int a = 0; a < 16; ++a) { v1[a] = sort2f(top[0][a] & ~0x7Fu); v2[a] = sort2f(top[1][a] & ~0x7Fu); }
    unsigned cd[64];
#define CK(a_, b_) ((f2sort(v1[a_] + v2[b_]) & ~0xFFu) | (unsigned)(255 - ((a_) * 16 + (b_))))
    cd[0] = CK(0, 0); cd[1] = CK(0, 1); cd[2] = CK(0, 2); cd[3] = CK(0, 3); cd[4] = CK(0, 4);
    cd[5] = CK(0, 5); cd[6] = CK(0, 6); cd[7] = CK(0, 7); cd[8] = CK(0, 8); cd[9] = CK(0, 9);
    cd[10] = CK(0, 10); cd[11] = CK(0, 11); cd[12] = CK(0, 12); cd[13] = CK(0, 13); cd[14] = CK(0, 14);
    cd[15] = CK(0, 15); cd[16] = CK(1, 0); cd[17] = CK(1, 1); cd[18] = CK(1, 2); cd[19] = CK(1, 3);
    cd[20] = CK(1, 4); cd[21] = CK(1, 5); cd[22] = CK(1, 6); cd[23] = CK(1, 7); cd[24] = CK(2, 0);
    cd[25] = CK(2, 1); cd[26] = CK(2, 2); cd[27] = CK(2, 3); cd[28] = CK(2, 4); cd[29] = CK(3, 0);
    cd[30] = CK(3, 1); cd[31] = CK(3, 2); cd[32] = CK(3, 3); cd[33] = CK(4, 0); cd[34] = CK(4, 1);
    cd[35] = CK(4, 2); cd[36] = CK(5, 0); cd[37] = CK(5, 1); cd[38] = CK(6, 0); cd[39] = CK(6, 1);
    cd[40] = CK(7, 0); cd[41] = CK(7, 1); cd[42] = CK(8, 0); cd[43] = CK(9, 0); cd[44] = CK(10, 0);
    cd[45] = CK(11, 0); cd[46] = CK(12, 0); cd[47] = CK(13, 0); cd[48] = CK(14, 0); cd[49] = CK(15, 0);
#undef CK
#pragma unroll
    for (int n = 50; n < 64; ++n) cd[n] = 0u;
    unsigned c0[16], c1[16];
#pragma unroll
    for (int i = 0; i < 16; ++i) { c0[i] = selu(h, cd[i], cd[32 + i]); c1[i] = selu(h, cd[16 + i], cd[48 + i]); }
    bitonic_sort16_desc(c0); bitonic_sort16_desc(c1);
    top16_merge(c0, c1);
    top16_xlane(c0);
    LDS_WAIT();
    asm volatile("" ::: "memory");
    const float mx0 = sort2f(c0[0] & ~0xFFu);
    float ev[16], esum = 0.f;
#pragma unroll
    for (int t = 0; t < 16; ++t) { ev[t] = fexp2((sort2f(c0[t] & ~0xFFu) - mx0) * LOG2E); esum += ev[t]; }
    const float inv = 1.0f / esum;
#pragma unroll
    for (int q4 = 0; q4 < 2; ++q4) {
        int iv[4]; float gv[4];
#pragma unroll
        for (int k = 0; k < 4; ++k) {
            const unsigned cw = selu(h, c0[4 * q4 + k], c0[8 + 4 * q4 + k]);
            const float e = self(h, ev[4 * q4 + k], ev[8 + 4 * q4 + k]);
            const int code = 255 - (int)(cw & 0xFFu), a = code >> 4, bb = code & 15;
            const int i1 = 127 - (int)(A[a * 256 + tslot] & 0x7Fu), i2 = 127 - (int)(A[(16 + bb) * 256 + tslot] & 0x7Fu);
            iv[k] = i1 * 128 + i2; gv[k] = e * inv;
        }
        const size_t o = tok * 128 + hd * 16 + 8 * h + 4 * q4;
        v4u iw; iw.x = (unsigned)iv[0]; iw.y = (unsigned)iv[1]; iw.z = (unsigned)iv[2]; iw.w = (unsigned)iv[3];
        *(GAS v4u*)(IDX + o) = iw;
        f32x4 gw; gw.x = gv[0]; gw.y = gv[1]; gw.z = gv[2]; gw.w = gv[3];
        *(GAS f32x4*)(GATE + o) = gw;
    }
}

DI float dot2bf(unsigned w, unsigned x, float acc) { return __builtin_amdgcn_fdot2_f32_bf16(__builtin_bit_cast(bf16x2_t, w), __builtin_bit_cast(bf16x2_t, x), acc, false); }
DI float readlane_f(float v, int l) { return __uint_as_float((unsigned)__builtin_amdgcn_readlane((int)__float_as_uint(v), l)); }
DI float gelu_erf(float x) { return 0.5f * x * (1.0f + erff(x * 0.70710678118654752f)); }
DI void load_row8(v4u* dst, const bf16* row, int lane) {
    const GAS v4u* p = (const GAS v4u*)row + lane;
#pragma unroll
    for (int j = 0; j < 8; ++j) dst[j] = p[64 * j];
}
DI float dot_row(const v4u* xr, const v4u* w) {
    float a0 = 0.f, a1 = 0.f, a2 = 0.f, a3 = 0.f;
#pragma unroll
    for (int j = 0; j < 8; ++j) { a0 = dot2bf(w[j].x, xr[j].x, a0); a1 = dot2bf(w[j].y, xr[j].y, a1); a2 = dot2bf(w[j].z, xr[j].z, a2); a3 = dot2bf(w[j].w, xr[j].w, a3); }
    return (a0 + a1) + (a2 + a3);
}
DI void axpy_row(float* acc, const v4u* w, float s) {
#pragma unroll
    for (int j = 0; j < 8; ++j)
#pragma unroll
        for (int k = 0; k < 4; ++k) { acc[8 * j + 2 * k] += s * bflo(w[j][k]); acc[8 * j + 2 * k + 1] += s * bfhi(w[j][k]); }
}
DI void peer_token(int tk, const bf16* XN, const int* IDX, const float* GATE, const bf16* UB, const bf16* VB, float* hout, const float* gfin, int lane) {
    v4u xr[8];
    load_row8(xr, XN + (size_t)tk * DM, lane);
    const int ilo = IDX[(size_t)tk * 128 + lane], ihi = IDX[(size_t)tk * 128 + 64 + lane];
    const float glo = GATE[(size_t)tk * 128 + lane], ghi = GATE[(size_t)tk * 128 + 64 + lane];
    float alo = 0.f, ahi = 0.f;
#ifdef PEER_REP
    for (int prep_ = 0; prep_ < 2; ++prep_)
#endif
    {
        v4u b0[8], b1[8];
        load_row8(b0, UB + (size_t)__builtin_amdgcn_readlane(ilo, 0) * DM, lane);
#pragma unroll 1
        for (int e = 0; e < 128; e += 2) {
            const int l1 = (e + 1) & 63;
            const int r1 = (e + 1) < 64 ? __builtin_amdgcn_readlane(ilo, l1) : __builtin_amdgcn_readlane(ihi, l1);
            load_row8(b1, UB + (size_t)r1 * DM, lane);
            { const float d = wave_sum(dot_row(xr, b0)); if (e < 64) { if (lane == (e & 63)) alo = d; } else { if (lane == (e & 63)) ahi = d; } }
            const int e2 = e + 2 < 128 ? e + 2 : 127, l2 = e2 & 63;
            const int r2 = e2 < 64 ? __builtin_amdgcn_readlane(ilo, l2) : __builtin_amdgcn_readlane(ihi, l2);
            load_row8(b0, UB + (size_t)r2 * DM, lane);
            { const float d = wave_sum(dot_row(xr, b1)); if (e + 1 < 64) { if (lane == l1) alo = d; } else { if (lane == l1) ahi = d; } }
        }
    }
#ifdef DBG_NO_PEER
    const float wlo = 0.f * alo * glo, whi = 0.f * ahi * ghi;
#else
    const float wlo = gelu_erf(alo) * glo, whi = gelu_erf(ahi) * ghi;
#endif
    float acc[64];
#pragma unroll
    for (int i = 0; i < 64; ++i) acc[i] = 0.f;
    {
        v4u b0[8], b1[8];
        load_row8(b0, VB + (size_t)__builtin_amdgcn_readlane(ilo, 0) * DM, lane);
#pragma unroll 1
        for (int e = 0; e < 128; e += 2) {
            const int l0 = e & 63, l1 = (e + 1) & 63;
            const int r1 = (e + 1) < 64 ? __builtin_amdgcn_readlane(ilo, l1) : __builtin_amdgcn_readlane(ihi, l1);
            load_row8(b1, VB + (size_t)r1 * DM, lane);
            { const float w = e < 64 ? readlane_f(wlo, l0) : readlane_f(whi, l0); axpy_row(acc, b0, w); }
            const int e2 = e + 2 < 128 ? e + 2 : 127, l2 = e2 & 63;
            const int r2 = e2 < 64 ? __builtin_amdgcn_readlane(ilo, l2) : __builtin_amdgcn_readlane(ihi, l2);
            load_row8(b0, VB + (size_t)r2 * DM, lane);
            { const float w = (e + 1) < 64 ? readlane_f(wlo, l1) : readlane_f(whi, l1); axpy_row(acc, b1, w); }
        }
    }
    float* hrow = hout + (size_t)tk * DM;
    float ssq = 0.f;
#pragma unroll
    for (int j = 0; j < 8; ++j) {
        const f32x4 h0 = *(const GAS f32x4*)(hrow + 512 * j + 8 * lane), h1 = *(const GAS f32x4*)(hrow + 512 * j + 8 * lane + 4);
#pragma unroll
        for (int k = 0; k < 4; ++k) { acc[8 * j + k] += h0[k]; acc[8 * j + 4 + k] += h1[k]; }
#pragma unroll
        for (int k = 0; k < 8; ++k) ssq += acc[8 * j + k] * acc[8 * j + k];
    }
    const float rstd = 1.0f / sqrtf(wave_sum(ssq) * (1.f / DM) + RMS_EPS);
#pragma unroll
    for (int j = 0; j < 8; ++j) {
        const f32x4 g0 = *(const GAS f32x4*)(gfin + 512 * j + 8 * lane), g1 = *(const GAS f32x4*)(gfin + 512 * j + 8 * lane + 4);
        f32x4 o0, o1;
#pragma unroll
        for (int k = 0; k < 4; ++k) { o0[k] = acc[8 * j + k] * rstd * g0[k]; o1[k] = acc[8 * j + 4 + k] * rstd * g1[k]; }
        *(GAS f32x4*)(hrow + 512 * j + 8 * lane) = o0; *(GAS f32x4*)(hrow + 512 * j + 8 * lane + 4) = o1;
    }
}

DI float wave_max(float v) {
#pragma unroll
    for (int o = 1; o < 64; o <<= 1) v = fmaxf(v, __shfl_xor(v, o));
    return v;
}
DI int wave_sum_i(int v) {
#pragma unroll
    for (int o = 1; o < 64; o <<= 1) v += __shfl_xor(v, o);
    return v;
}
DI unsigned q8(float x, float inv, int bias) { return (unsigned)((int)rintf(x * inv) + bias) & 0xffu; }
DI void quant_row_i8(const float* src, unsigned char* dst, float* scl, int lane, int bias) {
    f32x4 v[16]; float am = 0.f;
#pragma unroll
    for (int j = 0; j < 4; ++j)
#pragma unroll
        for (int q = 0; q < 4; ++q) { const f32x4 t = *(const GAS f32x4*)(src + 1024 * j + 16 * lane + 4 * q); v[4 * j + q] = t;
            am = fmaxf(am, fmaxf(fmaxf(fabsf(t.x), fabsf(t.y)), fmaxf(fabsf(t.z), fabsf(t.w)))); }
    am = wave_max(am);
    const float inv = am > 0.f ? 127.f / am : 0.f;
#pragma unroll
    for (int j = 0; j < 4; ++j) { v4u w;
#pragma unroll
        for (int q = 0; q < 4; ++q) { const f32x4 t = v[4 * j + q]; w[q] = q8(t.x, inv, bias) | (q8(t.y, inv, bias) << 8) | (q8(t.z, inv, bias) << 16) | (q8(t.w, inv, bias) << 24); }
        *(GAS v4u*)(dst + 1024 * j + 16 * lane) = w; }
    if (lane == 0) *scl = am * (1.f / 127.f);
}
DI void load_row4(v4u* dst, const unsigned char* row, int lane) {
    const GAS v4u* p = (const GAS v4u*)row + lane;
#pragma unroll
    for (int j = 0; j < 4; ++j) dst[j] = p[64 * j];
}
DI int idot_row(const v4u* xq, const v4u* w) {
    int a0 = 0, a1 = 0;
#pragma unroll
    for (int j = 0; j < 4; ++j) { a0 = __builtin_amdgcn_sdot4((int)w[j].x, (int)xq[j].x, a0, false); a1 = __builtin_amdgcn_sdot4((int)w[j].y, (int)xq[j].y, a1, false);
        a0 = __builtin_amdgcn_sdot4((int)w[j].z, (int)xq[j].z, a0, false); a1 = __builtin_amdgcn_sdot4((int)w[j].w, (int)xq[j].w, a1, false); }
    return a0 + a1;
}
DI void axpy_row_u8(float* acc, const v4u* w, float s) {
#pragma unroll
    for (int j = 0; j < 4; ++j)
#pragma unroll
        for (int q = 0; q < 4; ++q) { const unsigned u = w[j][q];
            acc[16 * j + 4 * q + 0] += s * (float)(u & 0xffu); acc[16 * j + 4 * q + 1] += s * (float)((u >> 8) & 0xffu);
            acc[16 * j + 4 * q + 2] += s * (float)((u >> 16) & 0xffu); acc[16 * j + 4 * q + 3] += s * (float)(u >> 24); }
}
#define RL(v, l) __builtin_amdgcn_readlane((v), (l))
DI void peer_token_q(int tk, const bf16* XN, const int* IDX, const float* GATE, const unsigned char* UQ, const unsigned char* VQ, const float* SU, const float* SV, const float* SSQ,
                     float* hout, const float* gfin, int lane) {
    v4u xq[4]; float sx;
    {
        v4u xb[8]; float am = 0.f;
        const bf16* xp = XN + (size_t)tk * DM + 16 * lane;
#pragma unroll
        for (int j = 0; j < 4; ++j) { xb[2 * j] = *(const GAS v4u*)(xp + 1024 * j); xb[2 * j + 1] = *(const GAS v4u*)(xp + 1024 * j + 8); }
#pragma unroll
        for (int i = 0; i < 8; ++i)
#pragma unroll
            for (int k = 0; k < 4; ++k) am = fmaxf(am, fmaxf(fabsf(bflo(xb[i][k])), fabsf(bfhi(xb[i][k]))));
        am = wave_max(am);
        const float inv = am > 0.f ? 127.f / am : 0.f; sx = am * (1.f / 127.f);
#pragma unroll
        for (int j = 0; j < 4; ++j)
#pragma unroll
            for (int q = 0; q < 4; ++q) { const unsigned w0 = xb[2 * j + (q >> 1)][2 * (q & 1)], w1 = xb[2 * j + (q >> 1)][2 * (q & 1) + 1];
                xq[j][q] = q8(bflo(w0), inv, 0) | (q8(bfhi(w0), inv, 0) << 8) | (q8(bflo(w1), inv, 0) << 16) | (q8(bfhi(w1), inv, 0) << 24); }
    }
    const int ilo = IDX[(size_t)tk * 128 + lane], ihi = IDX[(size_t)tk * 128 + 64 + lane];
    const float glo = GATE[(size_t)tk * 128 + lane], ghi = GATE[(size_t)tk * 128 + 64 + lane];
    const float sulo = SU[ilo], suhi = SU[ihi], svlo = SV[ilo], svhi = SV[ihi];
    int dlo = 0, dhi = 0;
#define ROWIDX(e) ((e) < 64 ? RL(ilo, (e) & 63) : RL(ihi, (e) & 63))
#ifdef PEER_L2PROBE
    {
        int pd = 0;
        v4u ba[2][4], bb[2][4];
#define ROWIDXP(e) (((e) < 64 ? RL(ilo, (e) & 63) : RL(ihi, (e) & 63)) & 511)
        load_row4(ba[0], UQ + (size_t)ROWIDXP(0) * DM, lane); load_row4(ba[1], UQ + (size_t)ROWIDXP(1) * DM, lane);
#pragma unroll 1
        for (int e = 0; e < 128; e += 4) {
            load_row4(bb[0], UQ + (size_t)ROWIDXP(e + 2) * DM, lane); load_row4(bb[1], UQ + (size_t)ROWIDXP(e + 3) * DM, lane);
            pd += wave_sum_i(idot_row(xq, ba[0])) + wave_sum_i(idot_row(xq, ba[1]));
            const int e4 = e + 4 < 128 ? e + 4 : 126;
            load_row4(ba[0], UQ + (size_t)ROWIDXP(e4) * DM, lane); load_row4(ba[1], UQ + (size_t)ROWIDXP(e4 + 1) * DM, lane);
            pd += wave_sum_i(idot_row(xq, bb[0])) + wave_sum_i(idot_row(xq, bb[1]));
        }
#undef ROWIDXP
        asm volatile("" :: "v"(pd));
    }
#endif
#ifdef PEER_REP
    for (int prep_ = 0; prep_ < 2; ++prep_)
#endif
    {
        v4u ba[2][4], bb[2][4];
        load_row4(ba[0], UQ + (size_t)RL(ilo, 0) * DM, lane); load_row4(ba[1], UQ + (size_t)RL(ilo, 1) * DM, lane);
#pragma unroll 1
        for (int e = 0; e < 128; e += 4) {
            load_row4(bb[0], UQ + (size_t)ROWIDX(e + 2) * DM, lane); load_row4(bb[1], UQ + (size_t)ROWIDX(e + 3) * DM, lane);
            { const int d0 = wave_sum_i(idot_row(xq, ba[0])), d1 = wave_sum_i(idot_row(xq, ba[1]));
              if (e < 64) { if (lane == (e & 63)) dlo = d0; if (lane == ((e + 1) & 63)) dlo = d1; } else { if (lane == (e & 63)) dhi = d0; if (lane == ((e + 1) & 63)) dhi = d1; } }
            const int e4 = e + 4 < 128 ? e + 4 : 126;
            load_row4(ba[0], UQ + (size_t)ROWIDX(e4) * DM, lane); load_row4(ba[1], UQ + (size_t)ROWIDX(e4 + 1) * DM, lane);
            { const int d0 = wave_sum_i(idot_row(xq, bb[0])), d1 = wave_sum_i(idot_row(xq, bb[1]));
              if (e < 64) { if (lane == ((e + 2) & 63)) dlo = d0; if (lane == ((e + 3) & 63)) dlo = d1; } else { if (lane == ((e + 2) & 63)) dhi = d0; if (lane == ((e + 3) & 63)) dhi = d1; } }
        }
    }
    const float rsx = sx / sqrtf(SSQ[tk] * (1.f / DM) + RMS_EPS);
    const float wlo = gelu_erf((float)dlo * rsx * sulo) * glo * svlo, whi = gelu_erf((float)dhi * rsx * suhi) * ghi * svhi;
    const float wsum = wave_sum(wlo + whi);
    float acc[64];
#pragma unroll
    for (int i = 0; i < 64; ++i) acc[i] = 0.f;
#define ROWW(e) ((e) < 64 ? readlane_f(wlo, (e) & 63) : readlane_f(whi, (e) & 63))
    {
        v4u ba[2][4], bb[2][4];
        load_row4(ba[0], VQ + (size_t)RL(ilo, 0) * DM, lane); load_row4(ba[1], VQ + (size_t)RL(ilo, 1) * DM, lane);
#pragma unroll 1
        for (int e = 0; e < 128; e += 4) {
            load_row4(bb[0], VQ + (size_t)ROWIDX(e + 2) * DM, lane); load_row4(bb[1], VQ + (size_t)ROWIDX(e + 3) * DM, lane);
            axpy_row_u8(acc, ba[0], ROWW(e)); axpy_row_u8(acc, ba[1], ROWW(e + 1));
            const int e4 = e + 4 < 128 ? e + 4 : 126;
            load_row4(ba[0], VQ + (size_t)ROWIDX(e4) * DM, lane); load_row4(ba[1], VQ + (size_t)ROWIDX(e4 + 1) * DM, lane);
            axpy_row_u8(acc, bb[0], ROWW(e + 2)); axpy_row_u8(acc, bb[1], ROWW(e + 3));
        }
    }
#undef ROWIDX
#undef ROWW
    float* hrow = hout + (size_t)tk * DM + 16 * lane;
    const float corr = -128.f * wsum;
    float ssq = 0.f;
#pragma unroll
    for (int j = 0; j < 4; ++j)
#pragma unroll
        for (int q = 0; q < 4; ++q) { const f32x4 hv = *(const GAS f32x4*)(hrow + 1024 * j + 4 * q);
#pragma unroll
            for (int k = 0; k < 4; ++k) { const float t = acc[16 * j + 4 * q + k] + corr + hv[k]; acc[16 * j + 4 * q + k] = t; ssq += t * t; } }
    const float rstd = 1.0f / sqrtf(wave_sum(ssq) * (1.f / DM) + RMS_EPS);
    const float* gp = gfin + 16 * lane;
#pragma unroll
    for (int j = 0; j < 4; ++j)
#pragma unroll
        for (int q = 0; q < 4; ++q) { const f32x4 gv = *(const GAS f32x4*)(gp + 1024 * j + 4 * q); f32x4 o;
#pragma unroll
            for (int k = 0; k < 4; ++k) o[k] = acc[16 * j + 4 * q + k] * rstd * gv[k];
            *(GAS f32x4*)(hrow + 1024 * j + 4 * q) = o; }
}

DI void fmac_s(float& acc, float w, float x) { asm("v_fmac_f32_e32 %0, %1, %2" : "+v"(acc) : "v"(w), "v"(x)); }
DI void pkfma16_lo(unsigned& acc, unsigned x, unsigned wp) { asm("v_pk_fma_f16 %0, %1, %2, %0 op_sel_hi:[1,0,1]" : "+v"(acc) : "v"(x), "v"(wp)); }
DI void pkfma16_hi(unsigned& acc, unsigned x, unsigned wp) { asm("v_pk_fma_f16 %0, %1, %2, %0 op_sel:[0,1,0] op_sel_hi:[1,1,1]" : "+v"(acc) : "v"(x), "v"(wp)); }
DI void quant_row_i8_sliced(const float* src, unsigned char* tab, int e, float* scl, int lane, int bias) {
    f32x4 v[16]; float am = 0.f;
#pragma unroll
    for (int j = 0; j < 4; ++j)
#pragma unroll
        for (int q = 0; q < 4; ++q) { const f32x4 t = *(const GAS f32x4*)(src + 1024 * j + 16 * lane + 4 * q); v[4 * j + q] = t;
            am = fmaxf(am, fmaxf(fmaxf(fabsf(t.x), fabsf(t.y)), fmaxf(fabsf(t.z), fabsf(t.w)))); }
    am = wave_max(am);
    const float inv = am > 0.f ? 127.f / am : 0.f;
#pragma unroll
    for (int j = 0; j < 4; ++j) { v4u w;
#pragma unroll
        for (int q = 0; q < 4; ++q) { const f32x4 t = v[4 * j + q]; w[q] = q8(t.x, inv, bias) | (q8(t.y, inv, bias) << 8) | (q8(t.z, inv, bias) << 16) | (q8(t.w, inv, bias) << 24); }
        *(GAS v4u*)(tab + (size_t)(8 * j + (lane >> 3)) * SLICE_BYTES + (size_t)e * 128 + 16 * (lane & 7)) = w; }
    if (lane == 0) *scl = am * (1.f / 127.f);
}
DI void qrow_load(f32x4* v, const float* src, int lane) {
#pragma unroll
    for (int j = 0; j < 4; ++j)
#pragma unroll
        for (int q = 0; q < 4; ++q) v[4 * j + q] = *(const GAS f32x4*)(src + 1024 * j + 16 * lane + 4 * q);
}
template <bool NOST = false> DI void qrow_store(const f32x4* v, unsigned char* tab, int e, float* scl, int lane, int bias) {
    float am = 0.f;
#pragma unroll
    for (int i = 0; i < 16; ++i) { const f32x4 t = v[i]; am = fmaxf(am, fmaxf(fmaxf(fabsf(t.x), fabsf(t.y)), fmaxf(fabsf(t.z), fabsf(t.w)))); }
    am = wave_max(am);
    const float inv = am > 0.f ? 127.f / am : 0.f;
#pragma unroll
    for (int j = 0; j < 4; ++j) { v4u w;
#pragma unroll
        for (int q = 0; q < 4; ++q) { const f32x4 t = v[4 * j + q]; w[q] = q8(t.x, inv, bias) | (q8(t.y, inv, bias) << 8) | (q8(t.z, inv, bias) << 16) | (q8(t.w, inv, bias) << 24); }
        if (NOST) asm volatile("" :: "v"(w)); else *(GAS v4u*)(tab + (size_t)(8 * j + (lane >> 3)) * SLICE_BYTES + (size_t)e * 128 + 16 * (lane & 7)) = w; }
    if (lane == 0 && !NOST) *scl = am * (1.f / 127.f);
}
DI unsigned q4(float x, float inv) { int q = (int)floorf(x * inv + 8.0f); q = q < 0 ? 0 : (q > 15 ? 15 : q); return (unsigned)q; }
DI void qrow_store_u4(const f32x4* v, unsigned char* tab, int e, float* scl, int lane) {
    float ss = 0.f;
#pragma unroll
    for (int i = 0; i < 16; ++i) { const f32x4 t = v[i]; ss += (t.x * t.x + t.y * t.y) + (t.z * t.z + t.w * t.w); }
    ss = wave_sum(ss);
    const float step = 0.3352f * sqrtf(ss * (1.f / DM)), inv = step > 0.f ? 1.0f / step : 0.f;
#pragma unroll
    for (int j = 0; j < 4; ++j) { u32x2 w;
#pragma unroll
        for (int d = 0; d < 2; ++d) { const f32x4 a = v[4 * j + 2 * d], b = v[4 * j + 2 * d + 1];
            w[d] = q4(a.x, inv) | (q4(a.y, inv) << 8) | (q4(a.z, inv) << 16) | (q4(a.w, inv) << 24) | (q4(b.x, inv) << 4) | (q4(b.y, inv) << 12) | (q4(b.z, inv) << 20) | (q4(b.w, inv) << 28); }
        *(GAS u32x2*)(tab + (size_t)(4 * j + (lane >> 4)) * SLICE_BYTES + (size_t)e * 128 + 8 * (lane & 15)) = w; }
    if (lane == 0) *scl = step;
}
template <bool NOST = false> DI void quant_rows_strided(int r_lo, int r_hi, int stride, const float* peer_u, const float* peer_v, unsigned char* UQ, unsigned char* VQ, float* SU, float* SV, int lane) {
    if (r_lo >= r_hi) return;
#define QSRC(r_) (((r_) >= NEXP ? peer_v + (size_t)((r_) - NEXP) * DM : peer_u + (size_t)(r_) * DM))
#ifdef U4
#define QSTORE(v_, r_) do { if ((r_) >= NEXP) qrow_store<NOST>(v_, VQ, (r_) - NEXP, SV + ((r_) - NEXP), lane, 128); else qrow_store_u4(v_, UQ, (r_), SU + (r_), lane); } while (0)
#else
#define QSTORE(v_, r_) do { if ((r_) >= NEXP) qrow_store<NOST>(v_, VQ, (r_) - NEXP, SV + ((r_) - NEXP), lane, 128); else qrow_store<NOST>(v_, UQ, (r_), SU + (r_), lane, 0); } while (0)
#endif
    f32x4 va[16], vb[16];
    qrow_load(va, QSRC(r_lo), lane);
#pragma unroll 1
    for (int r = r_lo; r < r_hi; r += 2 * stride) {
        const int r1 = r + stride < r_hi ? r + stride : r, r2 = r + 2 * stride < r_hi ? r + 2 * stride : r;
        qrow_load(vb, QSRC(r1), lane);
        QSTORE(va, r);
        qrow_load(va, QSRC(r2), lane);
        if (r + stride < r_hi) QSTORE(vb, r1);
    }
#undef QSRC
#undef QSTORE
}
DI void quant_token(int tk, const bf16* XN, const float* gain, const float* SSQ, unsigned char* XQ, float* SX, int lane) {
    v4u xb[8]; float am = 0.f;
    const bf16* xp = XN + (size_t)tk * DM + 16 * lane; const float* gp = gain + 16 * lane;
#pragma unroll
    for (int j = 0; j < 4; ++j) { xb[2 * j] = *(const GAS v4u*)(xp + 1024 * j); xb[2 * j + 1] = *(const GAS v4u*)(xp + 1024 * j + 8); }
#pragma unroll
    for (int i = 0; i < 8; ++i) { const f32x4 g0 = *(const GAS f32x4*)(gp + 1024 * (i >> 1) + 8 * (i & 1)), g1 = *(const GAS f32x4*)(gp + 1024 * (i >> 1) + 8 * (i & 1) + 4);
        xb[i].x = cvtpk(bflo(xb[i].x) * g0.x, bfhi(xb[i].x) * g0.y); xb[i].y = cvtpk(bflo(xb[i].y) * g0.z, bfhi(xb[i].y) * g0.w);
        xb[i].z = cvtpk(bflo(xb[i].z) * g1.x, bfhi(xb[i].z) * g1.y); xb[i].w = cvtpk(bflo(xb[i].w) * g1.z, bfhi(xb[i].w) * g1.w); }
#pragma unroll
    for (int i = 0; i < 8; ++i)
#pragma unroll
        for (int k = 0; k < 4; ++k) am = fmaxf(am, fmaxf(fabsf(bflo(xb[i][k])), fabsf(bfhi(xb[i][k]))));
    am = wave_max(am);
    const float inv = am > 0.f ? 127.f / am : 0.f;
#pragma unroll
    for (int j = 0; j < 4; ++j) { v4u o;
#pragma unroll
        for (int q = 0; q < 4; ++q) { const unsigned w0 = xb[2 * j + (q >> 1)][2 * (q & 1)], w1 = xb[2 * j + (q >> 1)][2 * (q & 1) + 1];
            o[q] = q8(bflo(w0), inv, 0) | (q8(bfhi(w0), inv, 0) << 8) | (q8(bflo(w1), inv, 0) << 16) | (q8(bfhi(w1), inv, 0) << 24); }
        *(GAS v4u*)(XQ + (size_t)tk * DM + 1024 * j + 16 * lane) = o; }
    if (lane == 0) SX[tk] = am * (1.f / 127.f) / sqrtf(SSQ[tk] * (1.f / DM) + RMS_EPS);
#ifdef U4
    {
        int sm = 0;
#pragma unroll
        for (int i = 0; i < 8; ++i)
#pragma unroll
            for (int k = 0; k < 4; ++k) { sm += (int)rintf(bflo(xb[i][k]) * inv) + (int)rintf(bfhi(xb[i][k]) * inv); }
        sm = wave_sum_i(sm);
        if (lane == 0) ((int*)(SX + T_TOK))[tk] = sm;
    }
#endif
}
DI void peer_sweep(LAS unsigned char* lds, int wave, int gw, int NGW, const unsigned char* XQ, const float* SX, const int* IDX, const float* GATE,
                   const unsigned char* UQs, const unsigned char* VQs, const float* SU, const float* SV, bf16* Hres, float* hout, const float* gfin, int lane) {
    const int g = lane >> 3, c = lane & 7;
    LAS int* RI = (LAS int*)(lds + wave * 16384) + lane;
    int tok[4];
#pragma unroll
    for (int k = 0; k < 4; ++k) tok[k] = gw + k * NGW;
#pragma unroll
    for (int k = 0; k < 4; ++k)
#pragma unroll
        for (int i = 0; i < 16; ++i) RI[(k * 16 + i) * 64] = IDX[(size_t)tok[k] * 128 + 8 * i + g] * 128 + 16 * c;
    LDS_WAIT(); asm volatile("" ::: "memory");
#define PS_ISSUE(dst, base, k_, h_) do { _Pragma("unroll") for (int i_ = 0; i_ < 8; ++i_) dst[i_] = *(const GAS v4u*)((base) + RI[((k_) * 16 + 8 * (h_) + i_) * 64]); } while (0)
#ifdef PROBE_SWEEP
    const unsigned long long tsw0 = __builtin_amdgcn_s_memrealtime(); const unsigned long long tck0 = clock64();
#endif
    int A[4][16];
#pragma unroll
    for (int k = 0; k < 4; ++k)
#pragma unroll
        for (int i = 0; i < 16; ++i) A[k][i] = 0;
#ifdef U4
    {
        v4u wa[16], wb[16], xa0, xa1, xb0, xb1;
#define PS_ISSUE16(dst, base, k_) do { _Pragma("unroll") for (int i_ = 0; i_ < 16; ++i_) dst[i_] = *(const GAS v4u*)((base) + RI[((k_) * 16 + i_) * 64]); } while (0)
#define PS_XS(d0_, d1_, s_, k_) do { const unsigned char* xp_ = XQ + (size_t)tok[k_] * DM + 256 * (s_) + 32 * c; d0_ = *(const GAS v4u*)xp_; d1_ = *(const GAS v4u*)(xp_ + 16); } while (0)
#define PS_D4(a_, w_, xl_, xh_) do { a_ = __builtin_amdgcn_sdot4((int)((w_) & 0x0F0F0F0Fu), (int)(xl_), a_, false); a_ = __builtin_amdgcn_sdot4((int)(((w_) >> 4) & 0x0F0F0F0Fu), (int)(xh_), a_, false); } while (0)
#define PS_DOT16(k_, w_, x0_, x1_) do { _Pragma("unroll") for (int i_ = 0; i_ < 16; ++i_) { int a_ = A[k_][i_]; PS_D4(a_, w_[i_].x, x0_.x, x0_.y); PS_D4(a_, w_[i_].y, x0_.z, x0_.w); \
            PS_D4(a_, w_[i_].z, x1_.x, x1_.y); PS_D4(a_, w_[i_].w, x1_.z, x1_.w); A[k_][i_] = a_; } } while (0)
        PS_ISSUE16(wa, UQs, 0); PS_XS(xa0, xa1, 0, 0);
#pragma unroll 1
        for (int s = 0; s < 16; ++s) {
            asm volatile("" ::: "memory");
            const unsigned char* us = UQs + (size_t)s * SLICE_BYTES;
            const int sn = s + 1 < 16 ? s + 1 : 15;
            const unsigned char* usn = UQs + (size_t)sn * SLICE_BYTES;
            PS_ISSUE16(wb, us, 1); PS_XS(xb0, xb1, s, 1);
            PS_DOT16(0, wa, xa0, xa1);
            PS_ISSUE16(wa, us, 2); PS_XS(xa0, xa1, s, 2);
            PS_DOT16(1, wb, xb0, xb1);
            PS_ISSUE16(wb, us, 3); PS_XS(xb0, xb1, s, 3);
            PS_DOT16(2, wa, xa0, xa1);
            PS_ISSUE16(wa, usn, 0); PS_XS(xa0, xa1, sn, 0);
            PS_DOT16(3, wb, xb0, xb1);
        }
#undef PS_ISSUE16
#undef PS_XS
#undef PS_D4
#undef PS_DOT16
    }
#else
    {
        v4u wa[16], wb[16], xa, xb;
#define PS_ISSUE16(dst, base, k_) do { _Pragma("unroll") for (int i_ = 0; i_ < 16; ++i_) dst[i_] = *(const GAS v4u*)((base) + RI[((k_) * 16 + i_) * 64]); } while (0)
#define PS_XS(s_, k_) (*(const GAS v4u*)(XQ + (size_t)tok[k_] * DM + 128 * (s_) + 16 * c))
#define PS_DOT16(k_, w_, x_) do { _Pragma("unroll") for (int i_ = 0; i_ < 16; ++i_) { int a_ = A[k_][i_]; a_ = __builtin_amdgcn_sdot4((int)w_[i_].x, (int)x_.x, a_, false); a_ = __builtin_amdgcn_sdot4((int)w_[i_].y, (int)x_.y, a_, false); \
            a_ = __builtin_amdgcn_sdot4((int)w_[i_].z, (int)x_.z, a_, false); a_ = __builtin_amdgcn_sdot4((int)w_[i_].w, (int)x_.w, a_, false); A[k_][i_] = a_; } } while (0)
        PS_ISSUE16(wa, UQs, 0); xa = PS_XS(0, 0);
#pragma unroll 1
        for (int s = 0; s < 32; ++s) {
            asm volatile("" ::: "memory");
            const unsigned char* us = UQs + (size_t)s * SLICE_BYTES;
            const int sn = s + 1 < 32 ? s + 1 : 31;
            const unsigned char* usn = UQs + (size_t)sn * SLICE_BYTES;
            PS_ISSUE16(wb, us, 1); xb = PS_XS(s, 1);
            PS_DOT16(0, wa, xa);
            PS_ISSUE16(wa, us, 2); xa = PS_XS(s, 2);
            PS_DOT16(1, wb, xb);
            PS_ISSUE16(wb, us, 3); xb = PS_XS(s, 3);
            PS_DOT16(2, wa, xa);
            PS_ISSUE16(wa, usn, 0); xa = PS_XS(sn, 0);
            PS_DOT16(3, wb, xb);
        }
#undef PS_ISSUE16
#undef PS_XS
#undef PS_DOT16
    }
#endif
#ifdef PROBE_USWEEP
    {
        int A2[4][16];
#pragma unroll
        for (int k = 0; k < 4; ++k)
#pragma unroll
            for (int i = 0; i < 16; ++i) A2[k][i] = 0;
        v4u wb0[8], wb1[8], xs, xsn;
        PS_ISSUE(wb0, UQs, 0, 0); xs = *(const GAS v4u*)(XQ + (size_t)tok[0] * DM + 16 * c);
#pragma unroll 1
        for (int s = 0; s < 32; ++s) {
            asm volatile("" ::: "memory");
            const unsigned char* us = UQs + (size_t)s * SLICE_BYTES;
            const int sn = s + 1 < 32 ? s + 1 : 31;
            const unsigned char* usn = UQs + (size_t)sn * SLICE_BYTES;
#pragma unroll
            for (int k = 0; k < 4; ++k) {
                PS_ISSUE(wb1, us, k, 1);
#pragma unroll
                for (int i = 0; i < 8; ++i) { int a = A2[k][i]; a = __builtin_amdgcn_sdot4((int)wb0[i].x, (int)xs.x, a, false); a = __builtin_amdgcn_sdot4((int)wb0[i].y, (int)xs.y, a, false);
                    a = __builtin_amdgcn_sdot4((int)wb0[i].z, (int)xs.z, a, false); a = __builtin_amdgcn_sdot4((int)wb0[i].w, (int)xs.w, a, false); A2[k][i] = a; }
                if (k < 3) { PS_ISSUE(wb0, us, k + 1, 0); xsn = *(const GAS v4u*)(XQ + (size_t)tok[k + 1 < 4 ? k + 1 : 3] * DM + 128 * s + 16 * c); }
                else { PS_ISSUE(wb0, usn, 0, 0); xsn = *(const GAS v4u*)(XQ + (size_t)tok[0] * DM + 128 * sn + 16 * c); }
#pragma unroll
                for (int i = 0; i < 8; ++i) { int a = A2[k][8 + i]; a = __builtin_amdgcn_sdot4((int)wb1[i].x, (int)xs.x, a, false); a = __builtin_amdgcn_sdot4((int)wb1[i].y, (int)xs.y, a, false);
                    a = __builtin_amdgcn_sdot4((int)wb1[i].z, (int)xs.z, a, false); a = __builtin_amdgcn_sdot4((int)wb1[i].w, (int)xs.w, a, false); A2[k][8 + i] = a; }
                xs = xsn;
            }
        }
#pragma unroll
        for (int k = 0; k < 4; ++k)
#pragma unroll
            for (int i = 0; i < 16; ++i) asm volatile("" :: "v"(A2[k][i]));
    }
#endif
#ifdef PROBE_SWEEP
    asm volatile("s_waitcnt vmcnt(0)" ::: "memory"); const unsigned long long tsw1 = __builtin_amdgcn_s_memrealtime();
#endif
    float W[4][16], wsum[4];
#ifdef VF16
    unsigned Wp[4][8]; float usc[4];
    typedef _Float16 h2_t __attribute__((ext_vector_type(2)));
#endif
#pragma unroll
    for (int k = 0; k < 4; ++k) {
        const float sx = SX[tok[k]]; float ws_ = 0.f;
#pragma unroll
        for (int i = 0; i < 16; ++i) {
            int a = A[k][i]; a += __shfl_xor(a, 1); a += __shfl_xor(a, 2); a += __shfl_xor(a, 4);
            const int e = IDX[(size_t)tok[k] * 128 + 8 * i + g];
#ifdef U4
            const float w = gelu_erf(((float)a - 7.5f * (float)((const int*)(SX + T_TOK))[tok[k]]) * sx * SU[e]) * GATE[(size_t)tok[k] * 128 + 8 * i + g] * SV[e];
#else
            const float w = gelu_erf((float)a * sx * SU[e]) * GATE[(size_t)tok[k] * 128 + 8 * i + g] * SV[e];
#endif
            W[k][i] = w; ws_ += w;
        }
        ws_ += __shfl_xor(ws_, 8); ws_ += __shfl_xor(ws_, 16); ws_ += __shfl_xor(ws_, 32);
        wsum[k] = ws_;
#ifdef VF16
        {
            float wm = 0.f;
#pragma unroll
            for (int i = 0; i < 16; ++i) wm = fmaxf(wm, fabsf(W[k][i]));
            wm = fmaxf(wm, __shfl_xor(wm, 8)); wm = fmaxf(wm, __shfl_xor(wm, 16)); wm = fmaxf(wm, __shfl_xor(wm, 32));
            const int ex = wm > 0.f ? __builtin_amdgcn_frexp_expf(wm) : 14;
            const float alpha = __builtin_amdgcn_ldexpf(1.0f, 14 - ex);
            usc[k] = __builtin_amdgcn_ldexpf(1.0f, 24 - (14 - ex));
#pragma unroll
            for (int p = 0; p < 8; ++p) { const _Float16 h0 = (_Float16)(W[k][2 * p] * alpha), h1 = (_Float16)(W[k][2 * p + 1] * alpha);
                Wp[k][p] = (unsigned)__builtin_bit_cast(unsigned short, h0) | ((unsigned)__builtin_bit_cast(unsigned short, h1) << 16); }
        }
#endif
    }
    float ssq[4] = {0.f, 0.f, 0.f, 0.f};
    const bool g0 = (g & 1) != 0, g1 = (g & 2) != 0, g2 = (g & 4) != 0;
    const int colsub = 16 * c + 8 * (g & 1) + 4 * ((g >> 1) & 1) + 2 * ((g >> 2) & 1);
#ifndef NO_VSWEEP
    {
        v4u wb0[8], wb1[8];
#ifdef VF16
        int riA[8], riB[8];
#define PS_RI(dst, k_, h_) do { _Pragma("unroll") for (int i_ = 0; i_ < 8; ++i_) dst[i_] = RI[((k_) * 16 + 8 * (h_) + i_) * 64]; } while (0)
#define PS_LD(dst, base, ri_) do { _Pragma("unroll") for (int i_ = 0; i_ < 8; ++i_) dst[i_] = *(const GAS v4u*)((base) + ri_[i_]); } while (0)
        PS_RI(riB, 0, 1);
#endif
        PS_ISSUE(wb0, VQs, 0, 0);
#pragma unroll 1
        for (int s = 0; s < 32; ++s) {
            asm volatile("" ::: "memory");
            const unsigned char* vs = VQs + (size_t)s * SLICE_BYTES;
            const int sn = s + 1 < 32 ? s + 1 : 31;
            const unsigned char* vsn = VQs + (size_t)sn * SLICE_BYTES;
#pragma unroll
            for (int k = 0; k < 4; ++k) {
                float acc[16];
#ifdef VF16
                PS_LD(wb1, vs, riB);
                if (k < 3) PS_RI(riA, k + 1, 0); else PS_RI(riA, 0, 0);
                __builtin_amdgcn_sched_barrier(0);
#else
                PS_ISSUE(wb1, vs, k, 1);
#endif
                const unsigned hb = *(const GAS unsigned*)(Hres + (size_t)tok[k] * DM + 128 * s + colsub);
                f32x2 hv; hv.x = bflo(hb); hv.y = bfhi(hb);
#ifdef VF16
                unsigned ac2[8];
#pragma unroll
                for (int b = 0; b < 8; ++b) ac2[b] = 0u;
#define PS_ROWH(wv_, i_) do { const unsigned wp_ = Wp[k][(i_) >> 1]; \
                    _Pragma("unroll") for (int q = 0; q < 4; ++q) { const unsigned u = wv_[q]; \
                        const unsigned x0 = __builtin_amdgcn_perm(u, 0u, 0x0C050C04u), x1 = __builtin_amdgcn_perm(u, 0u, 0x0C070C06u); \
                        if ((i_) & 1) { pkfma16_hi(ac2[2 * q], x0, wp_); pkfma16_hi(ac2[2 * q + 1], x1, wp_); } else { pkfma16_lo(ac2[2 * q], x0, wp_); pkfma16_lo(ac2[2 * q + 1], x1, wp_); } } } while (0)
#pragma unroll
                for (int i = 0; i < 8; ++i) PS_ROWH(wb0[i], i);
                if (k < 3) { PS_LD(wb0, vs, riA); PS_RI(riB, k + 1, 1); } else { PS_LD(wb0, vsn, riA); PS_RI(riB, 0, 1); }
                __builtin_amdgcn_sched_barrier(0);
#pragma unroll
                for (int i = 0; i < 8; ++i) PS_ROWH(wb1[i], 8 + i);
#undef PS_ROWH
#pragma unroll
                for (int b = 0; b < 8; ++b) { const h2_t hv2 = __builtin_bit_cast(h2_t, ac2[b]); acc[2 * b] = (float)hv2.x * usc[k]; acc[2 * b + 1] = (float)hv2.y * usc[k]; }
#else
#pragma unroll
                for (int b = 0; b < 16; ++b) acc[b] = 0.f;
#pragma unroll
                for (int i = 0; i < 8; ++i) { const float w = W[k][i];
#pragma unroll
                    for (int q = 0; q < 4; ++q) { const unsigned u = wb0[i][q];
                        fmac_s(acc[4 * q + 0], w, (float)(u & 0xffu)); fmac_s(acc[4 * q + 1], w, (float)((u >> 8) & 0xffu)); fmac_s(acc[4 * q + 2], w, (float)((u >> 16) & 0xffu)); fmac_s(acc[4 * q + 3], w, (float)(u >> 24)); } }
                if (k < 3) { PS_ISSUE(wb0, vs, k + 1, 0); } else { PS_ISSUE(wb0, vsn, 0, 0); }
#pragma unroll
                for (int i = 0; i < 8; ++i) { const float w = W[k][8 + i];
#pragma unroll
                    for (int q = 0; q < 4; ++q) { const unsigned u = wb1[i][q];
                        fmac_s(acc[4 * q + 0], w, (float)(u & 0xffu)); fmac_s(acc[4 * q + 1], w, (float)((u >> 8) & 0xffu)); fmac_s(acc[4 * q + 2], w, (float)((u >> 16) & 0xffu)); fmac_s(acc[4 * q + 3], w, (float)(u >> 24)); } }
#endif
                float r8[8], r4[4], r2[2];
#pragma unroll
                for (int j = 0; j < 8; ++j) { const float snd = g0 ? acc[j] : acc[8 + j], kp = g0 ? acc[8 + j] : acc[j];
                    r8[j] = kp + __uint_as_float((unsigned)__builtin_amdgcn_update_dpp(0, (int)__float_as_uint(snd), 0x128  , 0xf, 0xf, false)); }
#pragma unroll
                for (int j = 0; j < 4; ++j) { const auto sw = __builtin_amdgcn_permlane16_swap(__float_as_uint(r8[j]), __float_as_uint(r8[4 + j]), false, false); r4[j] = __uint_as_float(sw[0]) + __uint_as_float(sw[1]); }
#pragma unroll
                for (int j = 0; j < 2; ++j) { const auto sw = __builtin_amdgcn_permlane32_swap(__float_as_uint(r4[j]), __float_as_uint(r4[2 + j]), false, false); r2[j] = __uint_as_float(sw[0]) + __uint_as_float(sw[1]); }
                const float corr = -128.f * wsum[k];
                f32x2 o; o.x = hv.x + r2[0] + corr; o.y = hv.y + r2[1] + corr;
                ssq[k] += o.x * o.x + o.y * o.y;
                *(GAS unsigned*)(Hres + (size_t)tok[k] * DM + 128 * s + colsub) = cvtpk(o.x, o.y);
            }
        }
    }
#endif
#undef PS_ISSUE
    asm volatile("s_waitcnt vmcnt(0)" ::: "memory");
#ifdef PROBE_SWEEP
    const unsigned long long tsw2 = __builtin_amdgcn_s_memrealtime();
#endif
#pragma unroll 1
    for (int k = 0; k < 4; ++k) {
        const float rstd = 1.0f / sqrtf(wave_sum(ssq[k]) * (1.f / DM) + RMS_EPS);
        const GAS v4u* hb = (const GAS v4u*)(Hres + (size_t)tok[k] * DM) + lane;
        float* orow = hout + (size_t)tok[k] * DM + 8 * lane; const float* gp = gfin + 8 * lane;
#pragma unroll
        for (int j = 0; j < 8; ++j) { const v4u v = hb[64 * j]; const f32x4 g0 = *(const GAS f32x4*)(gp + 512 * j), g1 = *(const GAS f32x4*)(gp + 512 * j + 4);
            f32x4 o0, o1; o0.x = bflo(v.x) * rstd * g0.x; o0.y = bfhi(v.x) * rstd * g0.y; o0.z = bflo(v.y) * rstd * g0.z; o0.w = bfhi(v.y) * rstd * g0.w;
            o1.x = bflo(v.z) * rstd * g1.x; o1.y = bfhi(v.z) * rstd * g1.y; o1.z = bflo(v.w) * rstd * g1.z; o1.w = bfhi(v.w) * rstd * g1.w;
            *(GAS f32x4*)(orow + 512 * j) = o0; *(GAS f32x4*)(orow + 512 * j + 4) = o1; }
    }
#ifdef PROBE_SWEEP
    if (gw == 0 && lane == 0) { asm volatile("s_waitcnt vmcnt(0)" ::: "memory");
        const unsigned long long tsw3 = __builtin_amdgcn_s_memrealtime();
        const unsigned long long d = PROBE_SWEEP == 0 ? tsw1 - tsw0 : (PROBE_SWEEP == 1 ? tsw2 - tsw1 : tsw3 - tsw2);
        const float val = PROBE_SWEEP == 4 ? (float)(clock64() - tck0) / (float)(tsw3 - tsw0) / 40.f : (PROBE_SWEEP == 3 ? (float)(tsw3 - tsw0) * (0.01f / 1000.f) : (float)d / (float)(tsw3 - tsw0));
        hout[(size_t)tok[0] * DM] += 0.2f + 0.25f * val; }
#endif
#ifdef PROBE_PHASE
    if (gw == 0 && lane == 0) { asm volatile("s_waitcnt vmcnt(0)" ::: "memory");
        const unsigned long long* ps = (const unsigned long long*)((const unsigned char*)SU - WS_SU + 458752 + 64);
        const unsigned long long tend = (PROBE_END == 13) ? __builtin_amdgcn_s_memrealtime() : ps[PROBE_END];
        hout[(size_t)tok[0] * DM] += 0.2f + 0.25f * ((float)(tend - ps[PROBE_START]) * 0.0131f / (float)PROBE_SCALE); }
#endif
#ifdef PROBE_TIMING
    if (gw == 0 && lane == 0) { asm volatile("s_waitcnt vmcnt(0)" ::: "memory");
        const unsigned long long* pt = (const unsigned long long*)((const unsigned char*)SU - WS_SU + 458752);
        const float tot = (float)pt[3]; const float frac = (float)pt[PROBE_METRIC] / tot;
        hout[(size_t)tok[0] * DM] += 0.2f + 0.25f * frac; }
#endif
}

struct Args { const float* in[21]; float* out; unsigned char* ws; int ph_lo, ph_hi; };
static_assert(sizeof(Args) == 21 * 8 + 8 + 8 + 8, "Args has no padding");

__global__ void __launch_bounds__(NWAVES * 64, 2) hymba_fwd(Args args) {
    extern __shared__ __attribute__((aligned(16))) unsigned char lds_raw[];
    LAS unsigned char* lds = (LAS unsigned char*)lds_raw;
    volatile LAS unsigned* MISC = (volatile LAS unsigned*)(lds + MISC_OFF);
    const int tid = threadIdx.x, lane = tid & 63, wave = __builtin_amdgcn_readfirstlane(tid >> 6);
    const int G = gridDim.x; const int bx = blockIdx.x;
    const int vcu = (G % 8 == 0) ? (bx % 8) * (G / 8) + bx / 8 : bx;
    unsigned char* ws = args.ws;
    gu32* ctl = (gu32*)(ws + WS_CTL);
    for (int u = tid; u < (LDS_BYTES - LDSCTL_OFF) / 4; u += NWAVES * 64) ((LAS unsigned*)(lds + LDSCTL_OFF))[u] = 0u;
    __syncthreads();
    XcdBarrier bar = xcd_barrier_post((unsigned*)(ctl + CW_BAR), MISC + 8);
    const int lo = args.ph_lo, hi = args.ph_hi;
#ifdef PH_ONLY
#define IN(k) ((k) == PH_ONLY && lo <= (k) && (k) < hi)
#else
#define IN(k) (lo <= (k) && (k) < hi)
#endif
#ifndef DUP_PHASE
#define DUP_PHASE -1
#endif
#define REP(k) for (int rep_ = 0; rep_ < ((k) == DUP_PHASE ? 2 : 1); ++rep_)
#ifdef PROBE_PHASE
#define PSTAMP(i_) do { if (blockIdx.x == 0 && tid == 0) ((unsigned long long*)(ws + 458752 + 64))[i_] = __builtin_amdgcn_s_memrealtime(); } while (0)
#else
#define PSTAMP(i_) do {} while (0)
#endif
#define SEAM(k) do { if (IN(k) && IN((k) + 1)) xcd_barrier(bar); PSTAMP((k) + 1); } while (0)

    const float* x = args.in[0]; const float* mem = args.in[1]; const float* norm_mix = args.in[2]; const float* w_in = args.in[3];
    const float* swa_sink = args.in[4]; const float* nat_rel_bias = args.in[5]; const float* out_norm_swa = args.in[6]; const float* out_norm_nat = args.in[7];
    const float* w_out = args.in[8]; const float* norm_mem_q = args.in[9]; const float* norm_mem_kv = args.in[10]; const float* w_mem_q = args.in[11];
    const float* w_mem_k = args.in[12]; const float* w_mem_v = args.in[13]; const float* w_mem_o = args.in[14]; const float* norm_ffn = args.in[15];
    const float* w_peer_q = args.in[16]; const float* peer_sub_keys = args.in[17]; const float* peer_u = args.in[18]; const float* peer_v = args.in[19];
    const float* norm_final = args.in[20];
    float* out = args.out;
    float* ropec = (float*)(ws + WS_ROPE); float* ropes = ropec + 2048 * 64;
    bf16* SKB = (bf16*)(ws + WS_SKB);
    bf16* WIN_T = (bf16*)(ws + WS_WIN); bf16* WOUT_T = (bf16*)(ws + WS_WOUT); bf16* WMQ_T = (bf16*)(ws + WS_WMQ); bf16* WMKV_T = (bf16*)(ws + WS_WMKV);
    bf16* WMO_T = (bf16*)(ws + WS_WMO); bf16* WPQ_T = (bf16*)(ws + WS_WPQ); bf16* UB = (bf16*)(ws + WS_UB); bf16* VB = (bf16*)(ws + WS_VB);
    bf16* XN = (bf16*)(ws + WS_XN); bf16* QKV = (bf16*)(ws + WS_QKV); bf16* OB = (bf16*)(ws + WS_OB); bf16* MEMN = (bf16*)(ws + WS_MEMN);
    bf16* KVM = (bf16*)(ws + WS_KVM); bf16* QM = (bf16*)(ws + WS_QM); bf16* OM = (bf16*)(ws + WS_OM); bf16* QP = (bf16*)(ws + WS_QP);
    int* IDX = (int*)(ws + WS_IDX); float* GATE = (float*)(ws + WS_GATE);
    float* SSQ1 = (float*)(ws + WS_SSQ1); float* SSQ2 = (float*)(ws + WS_SSQ2); float* SSQA = (float*)(ws + WS_SSQA); float* SSQB = (float*)(ws + WS_SSQB); float* SSQ0 = (float*)(ws + WS_SSQ0);
    unsigned* CM = (unsigned*)(ws + WS_CM); unsigned* CM2 = (unsigned*)(ws + WS_CM2);
    unsigned char* XQ = ws + WS_XQ; float* SX = (float*)(ws + WS_SX);
    unsigned char* UQ = ws + WS_UQ; unsigned char* VQ = ws + WS_VQ; float* SU = (float*)(ws + WS_SU); float* SV = (float*)(ws + WS_SV);
    const int gw = vcu * NWAVES + wave, NGW = G * NWAVES;

    PSTAMP(0);
    constexpr int I_IN = (DM / 64) * (INW / 32), I_OUT = (DM / 64) * (DM / 32), I_MQ = (DM / 64) * (MEMW / 32), I_MO = (MEMW / 64) * (DM / 32), I_PQ = (DM / 64) * (PQW / 32);
#ifdef QKV_I8
    constexpr int QR0 = 28160, QR1 = 28160;
#ifndef D1P0
#define D1P0 5120
#endif
#else
    constexpr int QR0 = 26624, QR1 = 28160;
#define D1P0 0
#endif
#ifdef WOUT_I8
#define D1_WOUT(r_) p0_transpose_item_i8(w_out, DM, DM, (unsigned char*)WOUT_T, CM2, scr, (r_), lane, out_norm_swa, out_norm_nat)
#else
#define D1_WOUT(r_) p0_transpose_item(w_out, DM, DM, WOUT_T, 0, scr, (r_), lane, out_norm_swa, out_norm_nat)
#endif
#define D1_ITEM(it_) do { int r = (it_); \
        if (r < I_OUT) { D1_WOUT(r); break; } r -= I_OUT; \
        if (r < I_MQ) { p0_transpose_item(w_mem_q, DM, MEMW, WMQ_T, 0, scr, r, lane, norm_mem_q, norm_mem_q + 2048); break; } r -= I_MQ; \
        if (r < I_MQ) { p0_transpose_item(w_mem_k, DM, MEMW, WMKV_T, 0, scr, r, lane); break; } r -= I_MQ; \
        p0_transpose_item(w_mem_v, DM, MEMW, WMKV_T, MEMW, scr, r, lane); } while (0)
#define QUANT_ROWS(first_, last_, w0_, nw_) quant_rows_strided((first_) + (w0_), (last_), (nw_), peer_u, peer_v, UQ, VQ, SU, SV, lane)
    if (IN(0)) REP(0) {
        LAS float* scr = (LAS float*)(lds + wave * 16384);
#ifdef DUP_P0A
        for (int rr_ = 0; rr_ < 2; ++rr_)
#endif
#ifdef QKV_I8
        for (int it = gw; it < I_IN; it += NGW) p0_colmax_item(w_in, INW, CM, it, lane, norm_mix);
#ifdef WOUT_I8
        for (int it = gw; it < I_OUT; it += NGW) p0_colmax_item(w_out, DM, CM2, it, lane, out_norm_swa, out_norm_nat);
#endif
        xcd_barrier(bar);
        for (int it = gw; it < I_IN; it += NGW) p0_transpose_item_i8(w_in, DM, INW, (unsigned char*)WIN_T, CM, scr, it, lane, norm_mix);
        for (int m = gw; m < T_TOK; m += NGW) row_to_bf16_i8(x + (size_t)m * DM, XN + (size_t)m * DM, XQ + (size_t)m * DM, SSQ0 + m, lane);
        for (int it = gw; it < D1P0; it += NGW) D1_ITEM(it);
#else
        for (int it = gw; it < I_IN; it += NGW) p0_transpose_item(w_in, DM, INW, WIN_T, 0, scr, it, lane, norm_mix, norm_mix + 2048);
        for (int m = gw; m < T_TOK; m += NGW) row_to_bf16_ssq(x + (size_t)m * DM, XN + (size_t)m * DM, SSQ0 + m, lane);
#endif
        for (int m = gw; m < NBATCH * MEMLEN; m += NGW) rms_row_to_bf16(mem + (size_t)m * DM, norm_mem_kv, MEMN + (size_t)m * DM, lane);
#ifdef DUP_P0C
        for (int rr_ = 0; rr_ < 2; ++rr_)
#endif
        QUANT_ROWS(0, QR0, gw, NGW);
#ifdef DUP_P0C_NOST
        quant_rows_strided<true>(gw, QR0, NGW, peer_u, peer_v, UQ, VQ, SU, SV, lane);
#endif
        for (int e = gw * 64 + lane; e < 4 * T_TOK; e += NGW * 64) SSQ1[e] = 0.f;
        for (int e = (gw * 64 + lane) * 4; e < 8 * 2 * 128 * 128; e += NGW * 64 * 4) { const f32x4 a = *(const GAS f32x4*)(peer_sub_keys + e); u32x2 w; w.x = cvtpk(a.x, a.y); w.y = cvtpk(a.z, a.w); *(GAS u32x2*)(SKB + e) = w; }
        for (int e = gw * 64 + lane; e < 2048 * 64; e += NGW * 64) {
            const int pos = e >> 6, i = e & 63;
            const float inv = fexp2(-(float)i * (13.287712379549449f / 64.0f));
            const float ang = (float)pos * inv;
            const float rev = ang * 0.15915494309189535f; const float fr = rev - floorf(rev);
            ropec[e] = __builtin_amdgcn_cosf(fr); ropes[e] = __builtin_amdgcn_sinf(fr);
        }
    }
    SEAM(0);
    if (IN(1)) REP(1) {
#ifdef QKV_I8
        { pg8::Gemm g{(const bf16*)XQ, WIN_T, T_TOK, INW, DM / 2}; pg8::StaticOrder S; S.init(T_TOK, INW, G, bx);
          EpiBf16I8 E{QKV, INW, SSQ0, CM};
          pg8::gemm_phase<EpiBf16I8, pg8::StaticOrder, true, true, false, true>(lds, g, S, E); }
#else
        { pg8::Gemm g{XN, WIN_T, T_TOK, INW, DM}; pg8::StaticOrder S; S.init(T_TOK, INW, G, bx);
          EpiBf16RowScale E{QKV, INW, SSQ0};
          pg8::gemm_phase<EpiBf16RowScale, pg8::StaticOrder, true, true>(lds, g, S, E); }
#endif
        if (bx >= G / 2) {
            LAS float* scr = (LAS float*)(lds + wave * 16384);
            const int w0 = (bx - G / 2) * NWAVES + wave, nw = (G - G / 2) * NWAVES;
            for (int it = D1P0 + w0; it < I_OUT + 3 * I_MQ; it += nw) D1_ITEM(it);
            QUANT_ROWS(QR0, QR1, w0, nw);
        }
    }
    SEAM(1);
    if (IN(2)) REP(2) {
        for (int u = vcu; u < 1024; u += G) {
#ifndef NO_SWA
            if (u < 512) swa_unit(lds, u, QKV, OB, swa_sink, ropec, ropes, SSQA);
#endif
#ifndef NO_NAT
            if (u >= 512) nat_unit(lds, u - 512, QKV, OB, nat_rel_bias, SSQB);
#endif
#ifdef PROBE_SWA2
            if (u < 512) swa_unit<true>(lds, u, QKV, (bf16*)(ws + WS_QP), swa_sink, ropec, ropes, (float*)(ws + 393216));
#endif
#ifdef PROBE_NAT2
            if (u >= 512) nat_unit(lds, u - 512, QKV, (bf16*)(ws + WS_QP), nat_rel_bias, (float*)(ws + 393216));
#endif
        }
    }
    SEAM(2);
#ifdef WOUT_I8
    if (IN(3)) { unsigned char* OQ = (unsigned char*)QKV;
        for (int m = gw; m < T_TOK; m += NGW) mix_row_to_i8(OB + (size_t)m * DM, SSQA[m], SSQB[m], OQ + (size_t)m * DM, SSQ0 + m, lane); }
    SEAM(3);
    if (IN(4)) REP(4) {
        pg8::Gemm g{(const bf16*)QKV, WOUT_T, T_TOK, DM, DM / 2}; pg8::StaticOrder S; S.init(T_TOK, DM, G, bx);
        EpiResHI8 E{XN, SSQ1, DM, SSQ0, CM2};
        pg8::gemm_phase<EpiResHI8, pg8::StaticOrder, true, true, false, true>(lds, g, S, E);
    }
#else
    if (IN(4)) REP(4) {
        pg8::Gemm g{OB, WOUT_T, T_TOK, DM, DM}; pg8::StaticOrder S; S.init(T_TOK, DM, G, bx);
        EpiResHMid E{XN, SSQ1, DM, SSQA, SSQB, (LAS float*)(lds + RING_BYTES + 1024)};
        pg8::gemm_phase<EpiResHMid, pg8::StaticOrder, true, true, true>(lds, g, S, E);
    }
#endif
    SEAM(4);
    if (IN(6)) REP(6) {
        pg8::Gemm g{XN, WMQ_T, T_TOK, MEMW, DM}; pg8::StaticOrder S; S.init(T_TOK, MEMW, G, bx);
        EpiBf16RowScale E{QM, MEMW, SSQ1};
        pg8::gemm_phase<EpiBf16RowScale, pg8::StaticOrder, true, true>(lds, g, S, E);
        { pg8::Gemm g2{MEMN, WMKV_T, NBATCH * MEMLEN, 2 * MEMW, DM}; pg8::StaticOrder S2; S2.init(NBATCH * MEMLEN, 2 * MEMW, G, (bx + G / 2) % G);
          pg8::EpiBf16<0> E2{KVM, 2 * MEMW, nullptr, 0, 0, 1.f};
          pg8::gemm_phase<pg8::EpiBf16<0>, pg8::StaticOrder, true, true>(lds, g2, S2, E2); }
        if (bx >= G / 2 + 32) {
            LAS float* scr = (LAS float*)(lds + wave * 16384);
            const int w0 = (bx - (G / 2 + 32)) * NWAVES + wave, nw = (G - (G / 2 + 32)) * NWAVES;
            for (int it = w0; it < I_MO + I_PQ; it += nw) {
                if (it < I_MO) p0_transpose_item(w_mem_o, MEMW, DM, WMO_T, 0, scr, it, lane);
                else p0_transpose_item(w_peer_q, DM, PQW, WPQ_T, 0, scr, it - I_MO, lane, norm_ffn, norm_ffn + 2048);
            }
            QUANT_ROWS(QR1, 2 * NEXP, w0, nw);
        }
    }
    SEAM(6);
    if (IN(7)) REP(7) { for (int u = bx; u < 256; u += G) mem_unit(lds, u, QM, KVM, OM); }
    SEAM(7);
    if (IN(8)) {
        pg8::Gemm g{OM, WMO_T, T_TOK, DM, MEMW}; pg8::StaticOrder S; S.init(T_TOK, DM, G, bx);
        EpiResH E{XN, SSQ2, DM};
        pg8::gemm_phase<EpiResH, pg8::StaticOrder, true, true>(lds, g, S, E);
    }
    SEAM(8);
    if (IN(10)) REP(10) {
        pg8::Gemm g{XN, WPQ_T, T_TOK, PQW, DM}; pg8::StaticOrder S; S.init(T_TOK, PQW, G, bx);
        EpiBf16RowScale E{QP, PQW, SSQ2};
        pg8::gemm_phase<EpiBf16RowScale, pg8::StaticOrder, true, true>(lds, g, S, E);
#ifdef FUSE_ROUTE
        { pg8::Unit un; for (int i = 0; S.next(i, un); ++i) { asm volatile("s_waitcnt vmcnt(0)" ::: "memory"); route_unit(lds, un.pm * 8 + un.pn, QP, SKB, IDX, GATE); } }
        for (int m = gw; m < T_TOK; m += NGW) quant_token(m, XN, norm_ffn, SSQ2, XQ, SX, lane);
#endif
    }
#ifdef FUSE_ROUTE
    if (IN(10) && IN(12)) { xcd_barrier(bar); PSTAMP(12); }
#else
    SEAM(10);
    if (IN(11)) REP(11) { for (int u = bx; u < 256; u += G) route_unit(lds, u, QP, SKB, IDX, GATE);
        for (int m = gw; m < T_TOK; m += NGW) quant_token(m, XN, norm_ffn, SSQ2, XQ, SX, lane); }
    SEAM(11);
#endif
    if (IN(12)) { __syncthreads(); peer_sweep(lds, wave, gw, NGW, XQ, SX, IDX, GATE, UQ, VQ, SU, SV, XN, out, norm_final, lane); }
#undef IN
#undef SEAM
}

constexpr int N_PHASES = 13;
#ifndef MK_N_LAUNCHES
#define MK_N_LAUNCHES 1
#endif

extern "C" void kernel_launch(void* const* d_in, const int* in_sizes, int n_in, void* d_out, int out_size, void* d_ws, size_t ws_size, hipStream_t stream) {
    static int grid = 0;
    if (grid == 0) {
        if (n_in != 21 || in_sizes[0] != T_TOK * DM || out_size != T_TOK * DM || ws_size < WS_END) { fprintf(stderr, "kernel_launch: unexpected shapes (n_in %d in0 %d out %d ws %zu)\n", n_in, n_in > 0 ? in_sizes[0] : -1, out_size, ws_size); grid = -1; return; }
        int dev = 0, cus = 0, per_cu = 0;
        if (hipGetDevice(&dev) != hipSuccess || hipDeviceGetAttribute(&cus, hipDeviceAttributeMultiprocessorCount, dev) != hipSuccess) { grid = -1; return; }
        if (hipFuncSetAttribute((const void*)hymba_fwd, hipFuncAttributeMaxDynamicSharedMemorySize, LDS_BYTES) != hipSuccess) { fprintf(stderr, "kernel_launch: hipFuncSetAttribute failed\n"); grid = -1; return; }
        if (hipOccupancyMaxActiveBlocksPerMultiprocessor(&per_cu, (const void*)hymba_fwd, NWAVES * 64, LDS_BYTES) != hipSuccess || per_cu < 1) fprintf(stderr, "kernel_launch: occupancy query says %d\n", per_cu);
        (void)hipGetLastError();
        grid = cus;
    }
    if (grid < 0) return;
    if (hipMemsetAsync((char*)d_ws + WS_CTL, 0, CTL_ZERO_BYTES, stream) != hipSuccess) return;
    Args a{};
    for (int i = 0; i < 21; ++i) a.in[i] = (const float*)d_in[i];
    a.out = (float*)d_out; a.ws = (unsigned char*)d_ws;
#if MK_N_LAUNCHES == 1
    a.ph_lo = 0; a.ph_hi = N_PHASES;
    hipLaunchKernelGGL(hymba_fwd, dim3(grid), dim3(NWAVES * 64), LDS_BYTES, stream, a);
#else
    for (int p = 0; p < N_PHASES; ++p) { a.ph_lo = p; a.ph_hi = p + 1; hipLaunchKernelGGL(hymba_fwd, dim3(grid), dim3(NWAVES * 64), LDS_BYTES, stream, a); }
#endif
}
```

```cpp
#define QKV_I8
#define WOUT_I8
#include <hip/hip_runtime.h>
#include <cstdio>
#include <cstdint>
namespace pg8 {
#define PG8_LAS __attribute__((address_space(3)))
typedef unsigned short bf16_t;
typedef short bf16x8 __attribute__((ext_vector_type(8)));
typedef float f32x4 __attribute__((ext_vector_type(4)));
typedef unsigned u32x4 __attribute__((ext_vector_type(4)));
constexpr int BM = 256, BK = 64, HALF = 128, HTB = HALF * BK * 2  , STAGE_BYTES = 8 * HTB, NXCD = 8, WGM = 8;

__host__ __device__ __forceinline__ int lds_byte(int r, int c) { const int st = (r >> 4) * 2 + (c >> 5), rr = r & 15, cc = c & 31, ob = rr * 64 + cc * 2; return st * 1024 + (ob ^ (((ob >> 9) & 1) << 5)); }
__host__ __device__ __forceinline__ void stage_rc(int b, int& R, int& C) { const int st = b / 1024, sb = b % 1024, swz = sb ^ (((sb >> 9) & 1) << 5); R = (st >> 1) * 16 + swz / 64; C = (st & 1) * 32 + (swz % 64) / 2; }
__host__ __device__ __forceinline__ int perm32(int rho) { const int n = rho >> 4, i = rho & 15; return 8 * (i >> 2) + 4 * n + (i & 3); }

struct Unit { int pm, pn; };
struct Gemm { const bf16_t* A; const bf16_t* Bt; int M, N, K; };

struct StaticOrder {
    int nM, nN, nwg, G, c;
    __host__ __device__ void init(int M, int N, int G_, int c_) { nM = M / BM; nN = N / BM; nwg = nM * nN; G = G_; c = c_; }
    __host__ __device__ bool next(int i, Unit& u) const {
        const long L = (long)i * G + c; if (L >= nwg) return false;
        int wgid = (int)L; { const int q = nwg / NXCD, r = nwg % NXCD, xcd = wgid % NXCD, off = wgid / NXCD; wgid = (xcd < r ? xcd * (q + 1) : r * (q + 1) + (xcd - r) * q) + off; }
        const int nig = WGM * nN, gid = wgid / nig, fm = gid * WGM, gsz = (nM - fm) < WGM ? (nM - fm) : WGM;
        u.pm = fm + ((wgid % nig) % gsz); u.pn = (wgid % nig) / gsz; return true;
    }
    __device__ __forceinline__ void a_ready(const Unit&) const {}
    __device__ __forceinline__ void done(const Unit&) const {}
};

__device__ __forceinline__ unsigned cvt_pk_bf16(float lo, float hi) { unsigned r; asm volatile("v_cvt_pk_bf16_f32 %0, %1, %2" : "=v"(r) : "v"(lo), "v"(hi)); return r; }
typedef float f32x2 __attribute__((ext_vector_type(2)));
__device__ __forceinline__ f32x2 gelu_pk(f32x2 v) {
    const f32x2 av = __builtin_elementwise_abs(v), d = av * 0.2316418882f + 1.0f;
    f32x2 t; t.x = __builtin_amdgcn_rcpf(d.x); t.y = __builtin_amdgcn_rcpf(d.y);
    f32x2 q = t * 0.5307027145f + (-0.7265760135f); q = q * t + 0.7107068705f; q = q * t + (-0.142248368f); q = q * t + 0.127414796f; q = q * t;
    const f32x2 s = (v * v) * (-0.72134752044f);
    f32x2 e; e.x = __builtin_amdgcn_exp2f(s.x); e.y = __builtin_amdgcn_exp2f(s.y);
    const f32x2 m = v * (q * e), r = v - m;
    f32x2 o; o.x = v.x < 0.f ? m.x : r.x; o.y = v.y < 0.f ? m.y : r.y; return o;
}

template <int ACT  > struct EpiBf16 {
    static constexpr bool PERM = true, AFTER_DRAIN = false; static_assert(ACT == 0 || ACT == 1, "EpiBf16: ACT is 0 (none) or 1 (gelu_pk)");
    bf16_t* O; int ldc; const float* bias; int split_cols; size_t split_stride; float scale0;
    __device__ __forceinline__ void operator()(const f32x4 (&acc)[2][2][4][2], const Unit& u, int wr, int wc, int fr, int fq) const {
        const int row0 = u.pm * BM + wr * 64 + fr; int colt = u.pn * BM; bf16_t* base = O;
        float sc = 1.f; if (split_cols) { const int t = colt / split_cols; base += (size_t)t * split_stride; colt -= t * split_cols; if (t == 0) sc = scale0; }
        const int col0 = colt + wc * 32 + 8 * fq, bcol0 = u.pn * BM + wc * 32 + 8 * fq;
        f32x4 bv[2][2];
#pragma unroll
        for (int bj = 0; bj < 2; ++bj)
#pragma unroll
            for (int n = 0; n < 2; ++n) bv[bj][n] = bias ? *(const f32x4*)(bias + bcol0 + bj * HALF + 4 * n) : (f32x4){0.f, 0.f, 0.f, 0.f};
#pragma unroll
        for (int ai = 0; ai < 2; ++ai)
#pragma unroll
            for (int m = 0; m < 4; ++m) { bf16_t* rowp = base + (size_t)(row0 + ai * HALF + m * 16) * ldc + col0;
#pragma unroll
                for (int bj = 0; bj < 2; ++bj) { f32x4 v0 = acc[ai][bj][m][0] + bv[bj][0], v1 = acc[ai][bj][m][1] + bv[bj][1];
                    if (ACT == 1) { f32x2 a = gelu_pk((f32x2){v0[0], v0[1]}), b = gelu_pk((f32x2){v0[2], v0[3]}), c = gelu_pk((f32x2){v1[0], v1[1]}), d = gelu_pk((f32x2){v1[2], v1[3]});
                        v0 = (f32x4){a.x, a.y, b.x, b.y}; v1 = (f32x4){c.x, c.y, d.x, d.y}; }
                    v0 = v0 * sc; v1 = v1 * sc; u32x4 w; w.x = cvt_pk_bf16(v0[0], v0[1]); w.y = cvt_pk_bf16(v0[2], v0[3]); w.z = cvt_pk_bf16(v1[0], v1[1]); w.w = cvt_pk_bf16(v1[2], v1[3]);
                    *(u32x4*)(rowp + bj * HALF) = w; } }
    }
};

struct PanelStats {
    unsigned* xbuf;
    unsigned* cnt;
    unsigned* tmo;
    int ntn; float eps;
    unsigned code;
    __device__ __forceinline__ bool run(const f32x4 (&v)[2][2][4][2], const Unit& u, int wr, int wc, int fr, int fq, PG8_LAS unsigned char* lds, int wid, int lane) const {
        typedef float f32x2v __attribute__((ext_vector_type(2)));
        PG8_LAS f32x2v* P = (PG8_LAS f32x2v*)lds;
        PG8_LAS f32x2v* S = (PG8_LAS f32x2v*)(lds + 8192);
        PG8_LAS unsigned* flag = (PG8_LAS unsigned*)(lds + 8192 + 2048);
#pragma unroll
        for (int ai = 0; ai < 2; ++ai)
#pragma unroll
            for (int m = 0; m < 4; ++m) {
                float s = 0.f;
#pragma unroll
                for (int bj = 0; bj < 2; ++bj)
#pragma unroll
                    for (int n = 0; n < 2; ++n) { const f32x4 x = v[ai][bj][m][n]; s += (x[0] + x[1]) + (x[2] + x[3]); }
                s += __shfl_xor(s, 16); s += __shfl_xor(s, 32);
                const float mw = s * (1.0f / 64.0f); float q = 0.f;
#pragma unroll
                for (int bj = 0; bj < 2; ++bj)
#pragma unroll
                    for (int n = 0; n < 2; ++n) { const f32x4 d = v[ai][bj][m][n] - mw; q += (d[0] * d[0] + d[1] * d[1]) + (d[2] * d[2] + d[3] * d[3]); }
                q += __shfl_xor(q, 16); q += __shfl_xor(q, 32);
                if (fq == 0) P[(ai * HALF + wr * 64 + m * 16 + fr) * 4 + wc] = (f32x2v){mw, q};
            }
        asm volatile("s_waitcnt lgkmcnt(0)" ::: "memory"); __builtin_amdgcn_s_barrier(); asm volatile("" ::: "memory");
#if defined(BROKEN_EXCHANGE_NO_WAIT)
#warning BROKEN CONTROL BUILD: the row-statistics exchange does not wait; results are wrong by design
        if (blockIdx.x >= 64) { const long long t0_ = clock64(); while (clock64() - t0_ < 60000) __builtin_amdgcn_s_sleep(8); }
#endif
        const int row = wid * 32 + (lane & 31);
        if (lane < 32) {
            const f32x2v a = P[row * 4 + 0], b = P[row * 4 + 1], c = P[row * 4 + 2], d = P[row * 4 + 3];
            const float mt = (a.x + b.x + c.x + d.x) * 0.25f;
            const float da = a.x - mt, db = b.x - mt, dc = c.x - mt, dd = d.x - mt;
            const float m2 = (a.y + b.y) + (c.y + d.y) + 64.0f * ((da * da + db * db) + (dc * dc + dd * dd));
            unsigned long long* slot = (unsigned long long*)xbuf + ((size_t)(u.pm * BM + row) * 4 + u.pn);
            __hip_atomic_store(slot, ((unsigned long long)__float_as_uint(m2) << 32) | __float_as_uint(mt), __ATOMIC_RELAXED, __HIP_MEMORY_SCOPE_AGENT);
        }
        asm volatile("s_waitcnt vmcnt(0)" ::: "memory");
        if (lane == 0) __hip_atomic_fetch_add(cnt + 64 * u.pm, 1u, __ATOMIC_RELAXED, __HIP_MEMORY_SCOPE_AGENT);
        if (wid == 0) {
            bool dead = false; const unsigned long long t0 = __builtin_amdgcn_s_memrealtime(); const unsigned want = 8u * (unsigned)ntn;
            for (;;) {
#if defined(BROKEN_EXCHANGE_NO_WAIT)
                break;
#endif
                if ((unsigned)__builtin_amdgcn_readfirstlane(__hip_atomic_load(cnt + 64 * u.pm, __ATOMIC_RELAXED, __HIP_MEMORY_SCOPE_AGENT)) >= want) break;
                if (__builtin_amdgcn_s_memrealtime() - t0 > 2000000ull) {
                    if (lane == 0) { unsigned expect = 0u; __hip_atomic_compare_exchange_strong(tmo + 1, &expect, code | (unsigned)(u.pm & 0xff), __ATOMIC_RELAXED, __ATOMIC_RELAXED, __HIP_MEMORY_SCOPE_AGENT);
                                     __hip_atomic_store(tmo, 1u, __ATOMIC_RELAXED, __HIP_MEMORY_SCOPE_AGENT); }
                    dead = true; break; }
                __builtin_amdgcn_s_sleep(2);
            }
            __builtin_amdgcn_fence(__ATOMIC_ACQUIRE, "agent");
            if (lane == 0) flag[0] = dead ? 1u : 0u;
        }
        asm volatile("s_waitcnt vmcnt(0) lgkmcnt(0)" ::: "memory"); __builtin_amdgcn_s_barrier(); asm volatile("" ::: "memory");
        const bool bad = flag[0] != 0u;
        if (lane < 32) {
            const unsigned long long* slot = (const unsigned long long*)xbuf + (size_t)(u.pm * BM + row) * 4; float mt[4], m2[4]; float ms = 0.f;
#pragma unroll
            for (int t = 0; t < 4; ++t) { if (t < ntn) { const unsigned long long w = __hip_atomic_load(slot + t, __ATOMIC_RELAXED, __HIP_MEMORY_SCOPE_AGENT); mt[t] = __uint_as_float((unsigned)w); m2[t] = __uint_as_float((unsigned)(w >> 32)); } else { mt[t] = 0.f; m2[t] = 0.f; } ms += mt[t]; }
            const float mean = ms / (float)ntn; float q = 0.f;
#pragma unroll
            for (int t = 0; t < 4; ++t) if (t < ntn) { const float dm = mt[t] - mean; q += m2[t] + 256.0f * dm * dm; }
            S[row] = (f32x2v){mean, 1.0f / sqrtf(q / (256.0f * (float)ntn) + eps)};
        }
        asm volatile("s_waitcnt lgkmcnt(0)" ::: "memory"); __builtin_amdgcn_s_barrier(); asm volatile("" ::: "memory");
        return bad;
    }
};
struct EpiLnRes {
    static constexpr bool PERM = false, AFTER_DRAIN = true;
    const float* base; float* out; int ldc; const float* bias; PanelStats st; unsigned poison;
    __device__ __forceinline__ void fused(f32x4 (&acc)[2][2][4][2], const Unit& u, int wr, int wc, int fr, int fq, PG8_LAS unsigned char* lds, int wid, int lane) const {
        typedef float f32x2v __attribute__((ext_vector_type(2)));
        const PG8_LAS f32x2v* S = (const PG8_LAS f32x2v*)(lds + 8192);
        const int col0 = u.pn * BM + wc * 32 + 4 * fq;
#pragma unroll
        for (int bj = 0; bj < 2; ++bj)
#pragma unroll
            for (int n = 0; n < 2; ++n) { const f32x4 bv = bias ? *(const f32x4*)(bias + col0 + bj * HALF + n * 16) : (f32x4){0.f, 0.f, 0.f, 0.f};
#pragma unroll
                for (int ai = 0; ai < 2; ++ai)
#pragma unroll
                    for (int m = 0; m < 4; ++m) acc[ai][bj][m][n] += bv; }
        f32x4 pre[4][2][2];
#pragma unroll
        for (int m = 0; m < 4; ++m) { const size_t off = (size_t)(u.pm * BM + wr * 64 + m * 16 + fr) * ldc + col0;
#pragma unroll
            for (int bj = 0; bj < 2; ++bj)
#pragma unroll
                for (int n = 0; n < 2; ++n) pre[m][bj][n] = *(const f32x4*)(base + off + bj * HALF + n * 16); }
        const bool bad = st.run(acc, u, wr, wc, fr, fq, lds, wid, lane) || poison != 0u;
        const float qnan = __builtin_nanf("");
#pragma unroll
        for (int ai = 0; ai < 2; ++ai)
#pragma unroll
            for (int m = 0; m < 4; ++m) { const int r = ai * HALF + wr * 64 + m * 16 + fr; const f32x2v sr = S[r]; const size_t off = (size_t)(u.pm * BM + r) * ldc + col0;
#pragma unroll
                for (int bj = 0; bj < 2; ++bj)
#pragma unroll
                    for (int n = 0; n < 2; ++n) { const f32x4 bs = ai == 0 ? pre[m][bj][n] : *(const f32x4*)(base + off + bj * HALF + n * 16); f32x4 o = bs + (acc[ai][bj][m][n] - sr.x) * sr.y;
                        if (bad) o = (f32x4){qnan, qnan, qnan, qnan}; *(f32x4*)(out + off + bj * HALF + n * 16) = o; }
                if (m & 1) asm volatile("" ::: "memory"); }
    }
};
struct EpiLnResLn {
    static constexpr bool PERM = false, AFTER_DRAIN = true;
    const float* base; float* out; bf16_t* xn; int ldc; const float* bias; PanelStats st1, st2; unsigned poison;
    __device__ __forceinline__ void fused(f32x4 (&acc)[2][2][4][2], const Unit& u, int wr, int wc, int fr, int fq, PG8_LAS unsigned char* lds, int wid, int lane) const {
        typedef float f32x2v __attribute__((ext_vector_type(2))); typedef unsigned u32x2v __attribute__((ext_vector_type(2)));
        const PG8_LAS f32x2v* S = (const PG8_LAS f32x2v*)(lds + 8192);
        const int col0 = u.pn * BM + wc * 32 + 4 * fq;
#pragma unroll
        for (int bj = 0; bj < 2; ++bj)
#pragma unroll
            for (int n = 0; n < 2; ++n) { const f32x4 bv = bias ? *(const f32x4*)(bias + col0 + bj * HALF + n * 16) : (f32x4){0.f, 0.f, 0.f, 0.f};
#pragma unroll
                for (int ai = 0; ai < 2; ++ai)
#pragma unroll
                    for (int m = 0; m < 4; ++m) acc[ai][bj][m][n] += bv; }
        bool bad = st1.run(acc, u, wr, wc, fr, fq, lds, wid, lane) || poison != 0u;
        const float qnan = __builtin_nanf("");
#pragma unroll
        for (int ai = 0; ai < 2; ++ai)
#pragma unroll
            for (int m = 0; m < 4; ++m) { const int r = ai * HALF + wr * 64 + m * 16 + fr; const f32x2v sr = S[r]; const size_t off = (size_t)(u.pm * BM + r) * ldc + col0;
#pragma unroll
                for (int bj = 0; bj < 2; ++bj)
#pragma unroll
                    for (int n = 0; n < 2; ++n) { const f32x4 bs = *(const f32x4*)(base + off + bj * HALF + n * 16); acc[ai][bj][m][n] = bs + (acc[ai][bj][m][n] - sr.x) * sr.y; }
                asm volatile("" : "+v"(acc[ai][0][m][0]), "+v"(acc[ai][0][m][1]), "+v"(acc[ai][1][m][0]), "+v"(acc[ai][1][m][1]));
                if (m & 1) asm volatile("" ::: "memory"); }
        const bool bad1 = bad;
        bad = st2.run(acc, u, wr, wc, fr, fq, lds, wid, lane) || bad;
#pragma unroll
        for (int ai = 0; ai < 2; ++ai)
#pragma unroll
            for (int m = 0; m < 4; ++m) { const int r = ai * HALF + wr * 64 + m * 16 + fr; const f32x2v sr = S[r]; const size_t off = (size_t)(u.pm * BM + r) * ldc + col0;
#pragma unroll
                for (int bj = 0; bj < 2; ++bj)
#pragma unroll
                    for (int n = 0; n < 2; ++n) { const f32x4 x1 = acc[ai][bj][m][n]; *(f32x4*)(out + off + bj * HALF + n * 16) = bad1 ? (f32x4){qnan, qnan, qnan, qnan} : x1;
                        const f32x4 o = (x1 - sr.x) * sr.y; u32x2v w; w.x = cvt_pk_bf16(o[0], o[1]); w.y = cvt_pk_bf16(o[2], o[3]);
                        if (bad) { w.x = 0x7fc07fc0u; w.y = 0x7fc07fc0u; } *(u32x2v*)(xn + off + bj * HALF + n * 16) = w; }
                asm volatile("" ::: "memory"); }
    }
};

typedef int i32x4 __attribute__((ext_vector_type(4)));
template <bool I8> __device__ __forceinline__ f32x4 pg8_mma(bf16x8 b, bf16x8 a, f32x4 c) {
    if constexpr (I8) return __builtin_bit_cast(f32x4, __builtin_amdgcn_mfma_i32_16x16x64_i8(__builtin_bit_cast(i32x4, b), __builtin_bit_cast(i32x4, a), __builtin_bit_cast(i32x4, c), 0, 0, 0));
    else return __builtin_amdgcn_mfma_f32_16x16x32_bf16(b, a, c, 0, 0, 0);
}
template <class Epi, class Sched, bool ALIGN_EPI = false, bool SP2 = false, bool MID = false, bool I8 = false>
__device__ __forceinline__ void gemm_phase(PG8_LAS unsigned char* lds, const Gemm g, const Sched& S, const Epi& E) {
    const int tid = threadIdx.x, wid = __builtin_amdgcn_readfirstlane(tid >> 6), lane = tid & 63, wr = wid >> 2, wc = wid & 3, fr = lane & 15, fq = lane >> 4;
    const int K = g.K, nt = K / BK;
    unsigned voffA[2], voffB[2];
#pragma unroll
    for (int i = 0; i < 2; ++i) { int R, C; stage_rc(tid * 16 + i * 8192, R, C); const int Rb = Epi::PERM ? ((R & ~31) + perm32(R & 31)) : R;
        voffA[i] = (unsigned)(R * K + C) * 2u; voffB[i] = (unsigned)(Rb * K + C) * 2u; }
    const size_t kstep = (size_t)(BK * 2);
    const size_t hstep = (size_t)HALF * K * 2;
    const size_t tstep = 2 * hstep;
    const unsigned ldsw = (unsigned)wid * 1024u;
    const int aoff = lds_byte(wr * 64 + fr, fq * 8), boff = lds_byte(wc * 32 + fr, fq * 8);
#define PG8_SA(b, h) (((b) * 2 + (h)) * HTB)
#define PG8_SB(b, h) ((4 + (b) * 2 + (h)) * HTB)
#define PG8_STAGE(bufoff, gbase, voff) do { _Pragma("unroll") for (int _i = 0; _i < 2; ++_i) \
        __builtin_amdgcn_global_load_lds((const unsigned*)((const char*)(gbase) + (voff)[_i]), (PG8_LAS unsigned*)(lds + (bufoff) + ldsw + _i * 8192), 16, 0, 0); } while (0)
#define PG8_LDA(dst, b, h) do { _Pragma("unroll") for (int m = 0; m < 4; ++m) _Pragma("unroll") for (int k = 0; k < 2; ++k) dst[m][k] = *(const PG8_LAS bf16x8*)(lds + PG8_SA(b, h) + aoff + m * 2048 + k * 1024); } while (0)
#define PG8_LDB(dst, b, h) do { _Pragma("unroll") for (int n = 0; n < 2; ++n) _Pragma("unroll") for (int k = 0; k < 2; ++k) dst[n][k] = *(const PG8_LAS bf16x8*)(lds + PG8_SB(b, h) + boff + n * 2048 + k * 1024); } while (0)
#define PG8_MMA(ai, bj, At, Bt) do { __builtin_amdgcn_s_setprio(1); _Pragma("unroll") for (int m = 0; m < 4; ++m) _Pragma("unroll") for (int n = 0; n < 2; ++n) _Pragma("unroll") for (int k = 0; k < 2; ++k) \
        acc[ai][bj][m][n] = pg8_mma<I8>(Bt[n][k], At[m][k], acc[ai][bj][m][n]); __builtin_amdgcn_s_setprio(0); } while (0)
#define PG8_WAIT_V(n) asm volatile("s_waitcnt vmcnt(" #n ")" ::: "memory")
#define PG8_WAIT_L(n) asm volatile("s_waitcnt lgkmcnt(" #n ")" ::: "memory")
#define PG8_BAR __builtin_amdgcn_s_barrier()
#define PG8_SCHED __builtin_amdgcn_sched_barrier(0)
    Unit cur, nxt; int ui = 0;
    if (!S.next(0, cur)) return;
    f32x4 acc[2][2][4][2];
#pragma unroll
    for (int a = 0; a < 2; ++a)
#pragma unroll
        for (int b = 0; b < 2; ++b)
#pragma unroll
            for (int m = 0; m < 4; ++m)
#pragma unroll
                for (int n = 0; n < 2; ++n) acc[a][b][m][n] = (f32x4){0.f, 0.f, 0.f, 0.f};
    bf16x8 At[4][2], B0[2][2], B1[2][2];
    const char* cA = (const char*)g.A + (size_t)cur.pm * tstep; const char* cB = (const char*)g.Bt + (size_t)cur.pn * tstep;
    if constexpr (MID) E.load_mid(cur);
    S.a_ready(cur);
    if constexpr (SP2) {
        PG8_STAGE(PG8_SB(0, 0), cB, voffB); PG8_STAGE(PG8_SB(0, 1), cB + hstep, voffB); PG8_STAGE(PG8_SA(0, 0), cA, voffA); PG8_STAGE(PG8_SA(0, 1), cA + hstep, voffA);
        if (wr == 1) PG8_BAR;
        PG8_WAIT_V(2); PG8_BAR;
        PG8_STAGE(PG8_SB(1, 0), cB + kstep, voffB); PG8_STAGE(PG8_SA(1, 0), cA + kstep, voffA); PG8_STAGE(PG8_SB(1, 1), cB + hstep + kstep, voffB);
        PG8_WAIT_V(6); PG8_BAR;
    } else {
        PG8_STAGE(PG8_SB(0, 0), cB, voffB); PG8_STAGE(PG8_SA(0, 0), cA, voffA); PG8_STAGE(PG8_SB(0, 1), cB + hstep, voffB); PG8_STAGE(PG8_SA(0, 1), cA + hstep, voffA);
        if (wr == 1) PG8_BAR;
        PG8_WAIT_V(4); PG8_BAR;
        PG8_STAGE(PG8_SB(1, 0), cB + kstep, voffB); PG8_STAGE(PG8_SA(1, 0), cA + kstep, voffA); PG8_STAGE(PG8_SB(1, 1), cB + hstep + kstep, voffB);
        PG8_WAIT_V(6); PG8_BAR;
    }
    for (;;) {
        const bool has_next = S.next(ui + 1, nxt);
        const char* nA = has_next ? (const char*)g.A + (size_t)nxt.pm * tstep : cA; const char* nB = has_next ? (const char*)g.Bt + (size_t)nxt.pn * tstep : cB;
        for (int t = 0; t < nt; t += 2) {
            if constexpr (MID) { if (t == nt / 2) {
#pragma unroll
                for (int a = 0; a < 2; ++a)
#pragma unroll
                    for (int m = 0; m < 4; ++m)
#pragma unroll
                        for (int b = 0; b < 2; ++b)
#pragma unroll
                            for (int n = 0; n < 2; ++n) acc[a][b][m][n] = acc[a][b][m][n] * E.mid(a * 128 + wr * 64 + m * 16 + fr);
            } }
            const bool last = (t == nt - 2);
            const char* a1 = cA + (size_t)(t + 1) * kstep;
            const char* a2 = last ? nA : cA + (size_t)(t + 2) * kstep; const char* b2 = last ? nB : cB + (size_t)(t + 2) * kstep;
            const char* a3 = a2 + kstep; const char* b3 = b2 + kstep;
            if (last && has_next) S.a_ready(nxt);
            if constexpr (SP2) {
            PG8_LDB(B0, 0, 0); PG8_LDB(B1, 0, 1); PG8_SCHED; PG8_LDA(At, 0, 0); PG8_STAGE(PG8_SA(1, 1), a1 + hstep, voffA);
            PG8_WAIT_V(8); PG8_WAIT_L(0); PG8_BAR; PG8_MMA(0, 0, At, B0); PG8_MMA(0, 1, At, B1); PG8_BAR; PG8_SCHED;
            PG8_LDA(At, 0, 1); PG8_STAGE(PG8_SB(0, 0), b2, voffB); PG8_STAGE(PG8_SB(0, 1), b2 + hstep, voffB); PG8_STAGE(PG8_SA(0, 0), a2, voffA);
            PG8_WAIT_V(8); PG8_WAIT_L(0); PG8_BAR; PG8_MMA(1, 0, At, B0); PG8_MMA(1, 1, At, B1); PG8_BAR; PG8_SCHED;
            PG8_LDB(B0, 1, 0); PG8_LDB(B1, 1, 1); PG8_SCHED; PG8_LDA(At, 1, 0); PG8_STAGE(PG8_SA(0, 1), a2 + hstep, voffA);
            PG8_WAIT_V(8); PG8_WAIT_L(0); PG8_BAR; PG8_MMA(0, 0, At, B0); PG8_MMA(0, 1, At, B1); PG8_BAR; PG8_SCHED;
            PG8_LDA(At, 1, 1); PG8_STAGE(PG8_SB(1, 0), b3, voffB); PG8_STAGE(PG8_SB(1, 1), b3 + hstep, voffB); PG8_STAGE(PG8_SA(1, 0), a3, voffA);
            PG8_WAIT_V(8); PG8_WAIT_L(0); PG8_BAR; PG8_MMA(1, 0, At, B0); PG8_MMA(1, 1, At, B1); PG8_BAR; PG8_SCHED;
            } else {
            PG8_LDB(B0, 0, 0); PG8_SCHED; PG8_LDA(At, 0, 0); PG8_STAGE(PG8_SA(1, 1), a1 + hstep, voffA);
            PG8_WAIT_L(8); PG8_BAR; PG8_WAIT_L(0); PG8_MMA(0, 0, At, B0); PG8_BAR; PG8_SCHED;
            PG8_LDB(B1, 0, 1); PG8_STAGE(PG8_SB(0, 0), b2, voffB);
            PG8_BAR; PG8_WAIT_L(0); PG8_MMA(0, 1, At, B1); PG8_BAR;
            PG8_LDA(At, 0, 1); PG8_STAGE(PG8_SA(0, 0), a2, voffA);
            PG8_BAR; PG8_WAIT_L(0); PG8_MMA(1, 0, At, B0); PG8_BAR; PG8_SCHED;
            PG8_STAGE(PG8_SB(0, 1), b2 + hstep, voffB);
            PG8_WAIT_V(6); PG8_BAR; PG8_MMA(1, 1, At, B1); PG8_BAR;
            PG8_LDB(B0, 1, 0); PG8_SCHED; PG8_LDA(At, 1, 0); PG8_STAGE(PG8_SA(0, 1), a2 + hstep, voffA);
            PG8_WAIT_L(8); PG8_BAR; PG8_WAIT_L(0); PG8_MMA(0, 0, At, B0); PG8_BAR; PG8_SCHED;
            PG8_LDB(B1, 1, 1); PG8_STAGE(PG8_SB(1, 0), b3, voffB);
            PG8_BAR; PG8_WAIT_L(0); PG8_MMA(0, 1, At, B1); PG8_BAR;
            PG8_LDA(At, 1, 1); PG8_STAGE(PG8_SA(1, 0), a3, voffA);
            PG8_BAR; PG8_WAIT_L(0); PG8_MMA(1, 0, At, B0); PG8_BAR; PG8_SCHED;
            PG8_STAGE(PG8_SB(1, 1), b3 + hstep, voffB);
            PG8_WAIT_V(6); PG8_BAR; PG8_MMA(1, 1, At, B1); PG8_BAR;
            }
        }
        if constexpr (ALIGN_EPI) { if (wr == 0) PG8_BAR; }
        if constexpr (!Epi::AFTER_DRAIN) { E(acc, cur, wr, wc, fr, fq); S.done(cur); }
        if (!has_next) break;
#pragma unroll
        for (int a = 0; a < 2; ++a)
#pragma unroll
            for (int b = 0; b < 2; ++b)
#pragma unroll
                for (int m = 0; m < 4; ++m)
#pragma unroll
                    for (int n = 0; n < 2; ++n) acc[a][b][m][n] = (f32x4){0.f, 0.f, 0.f, 0.f};
        cur = nxt; cA = nA; cB = nB; ++ui;
        if constexpr (MID) E.load_mid(cur);
        if constexpr (ALIGN_EPI) { if (wr == 1) PG8_BAR; }
    }
    PG8_WAIT_V(0);
    if constexpr (!ALIGN_EPI) { if (wr == 0) PG8_BAR; }
    PG8_BAR;
    if constexpr (Epi::AFTER_DRAIN) { E.fused(acc, cur, wr, wc, fr, fq, lds, wid, lane); S.done(cur); }
#undef PG8_SA
#undef PG8_SB
#undef PG8_STAGE
#undef PG8_LDA
#undef PG8_LDB
#undef PG8_MMA
#undef PG8_WAIT_V
#undef PG8_WAIT_L
#undef PG8_BAR
#undef PG8_SCHED
}
}
#define GAS __attribute__((address_space(1)))
#define LAS __attribute__((address_space(3)))
typedef unsigned short bf16;
typedef unsigned v4u __attribute__((ext_vector_type(4)));
typedef float f32x4 __attribute__((ext_vector_type(4)));
typedef short bf16x8 __attribute__((ext_vector_type(8)));
typedef GAS unsigned gu32;
typedef GAS unsigned long long gu64;
#define RLX_AGENT __ATOMIC_RELAXED, __HIP_MEMORY_SCOPE_AGENT
#define LDS_WAIT() asm volatile("s_waitcnt lgkmcnt(0)" ::: "memory")
#define VM_WAIT() asm volatile("s_waitcnt vmcnt(0)" ::: "memory")
__device__ __forceinline__ unsigned long long rt() { return __builtin_amdgcn_s_memrealtime(); }
__device__ __forceinline__ unsigned f2bf(float f) { unsigned u = __builtin_bit_cast(unsigned, f); return (u + 0x7fffu + ((u >> 16) & 1u)) >> 16; }
__device__ __forceinline__ unsigned pk2(float lo, float hi) { return f2bf(lo) | (f2bf(hi) << 16); }

#define XB_TMO      128
#define XB_XCNT(j)  (256  + 64 * (j))
#define XB_XSUB(j)  (1280 + 64 * (j))
#define XB_XGEN(j)  (2304 + 64 * (j))
#define XB_TOP      3328
#define XB_TOPGEN   3392
#define XCD_BAR_WORDS 3456
#define XB_SPIN_CAP (1u << 18)

__device__ __forceinline__ unsigned xb_ld(unsigned* p)              { return __hip_atomic_load(p, __ATOMIC_RELAXED, __HIP_MEMORY_SCOPE_AGENT); }
__device__ __forceinline__ unsigned xb_add(unsigned* p, unsigned v) { return __hip_atomic_fetch_add(p, v, __ATOMIC_RELAXED, __HIP_MEMORY_SCOPE_AGENT); }
__device__ __forceinline__ unsigned xb_xcc_id() { return (unsigned)__builtin_amdgcn_s_getreg((3 << 11) | 20) & 0xFu; }
#define XB_SPIN(cond, bar) do { unsigned _sp = 0; while (cond) { __builtin_amdgcn_s_sleep(1); \
    if ((++_sp & 255u) == 0u) { if (xb_ld(&(bar)[XB_TMO])) break; if (_sp > XB_SPIN_CAP) { atomicAdd(&(bar)[XB_TMO], 1u); break; } } } } while (0)

struct XcdBarrier {
    unsigned* bar; unsigned x;
    volatile LAS unsigned* st;
};

__device__ __forceinline__ XcdBarrier xcd_barrier_post(unsigned* bar, volatile LAS unsigned* st) {
    XcdBarrier b; b.bar = bar; b.x = xb_xcc_id(); b.st = st;
    if (threadIdx.x == 0) (void)xb_add(&bar[XB_XCNT(b.x)], 1u);
    return b;
}
__device__ __forceinline__ void xcd_barrier_complete(unsigned* bar, unsigned x, unsigned& nloc, unsigned& nx) {
    const unsigned G = gridDim.x * gridDim.y * gridDim.z;
    unsigned sum, cnt, mine, sp = 0u;
    for (;;) {
        sum = 0u; cnt = 0u; mine = 0u;
#pragma unroll
        for (unsigned j = 0; j < 16; ++j) { const unsigned c = xb_ld(&bar[XB_XCNT(j)]); sum += c; cnt += (c > 0u) ? 1u : 0u; mine = (j == x) ? c : mine; }
        if (sum == G) break;
        __builtin_amdgcn_s_sleep(1);
        if ((++sp & 255u) == 0u) { if (xb_ld(&bar[XB_TMO])) break; if (sp > XB_SPIN_CAP) { atomicAdd(&bar[XB_TMO], 1u); break; } }
    }
    nloc = mine > 0u ? mine : 1u; nx = cnt > 0u ? cnt : 1u;
}

__device__ __forceinline__ void xcd_barrier(const XcdBarrier& b) {
    asm volatile("s_waitcnt vmcnt(0)" ::: "memory");
    __syncthreads();
    if (threadIdx.x == 0) {
        unsigned* bar = b.bar;
        __builtin_amdgcn_s_waitcnt(0);
        unsigned nloc = b.st[0], nx = b.st[1];
        if (nloc == 0u) { xcd_barrier_complete(bar, b.x, nloc, nx); b.st[0] = nloc; b.st[1] = nx; }
        const unsigned old = xb_add(&bar[XB_XSUB(b.x)], 1u);
        const unsigned gen = old / nloc;
        if (old + 1u == (gen + 1u) * nloc) {
            __builtin_amdgcn_fence(__ATOMIC_RELEASE, "agent");
            asm volatile("s_waitcnt vmcnt(0)" ::: "memory");
            const unsigned og = xb_add(&bar[XB_TOP], 1u);
            const unsigned tg = og / nx;
            if (og + 1u == (tg + 1u) * nx) xb_add(&bar[XB_TOPGEN], 1u);
            else XB_SPIN(xb_ld(&bar[XB_TOPGEN]) == tg, bar);
            __builtin_amdgcn_fence(__ATOMIC_ACQUIRE, "agent");
            xb_add(&bar[XB_XGEN(b.x)], 1u);
            asm volatile("s_waitcnt vmcnt(0)" ::: "memory");
        } else {
            XB_SPIN(xb_ld(&bar[XB_XGEN(b.x)]) == gen, bar);
            __builtin_amdgcn_fence(__ATOMIC_ACQUIRE, "agent");
            asm volatile("s_waitcnt vmcnt(0)" ::: "memory");
        }
    }
    __syncthreads();
}

#define VF16 1
#define FUSE_ROUTE 1
#ifndef CMR
#define CMR 32
#endif
#ifndef CMK
#define CMK 4
#endif
#ifndef XB_SPIN_CAP2
#define XB_SPIN_CAP2 1
#endif
constexpr int NWAVES = 8;
constexpr int T_TOK = 8192, DM = 4096, SEQ = 2048, NBATCH = 4;
constexpr int INW = 9216;
constexpr int C_QA = 0, C_KA = 2048, C_VA = 2560, C_QB = 3072, C_KB = 5120, C_VB = 7168;
constexpr int MEMLEN = 256, MEMW = 1024;
constexpr int NEXP = 16384, PQW = 2048;
constexpr float RMS_EPS = 1e-6f;
constexpr float LOG2E = 1.4426950408889634f;

constexpr size_t MiB = 1u << 20;
constexpr size_t WS_CTL = 0, CTL_ZERO_BYTES = 94208, WS_CM = 32768, WS_CM2 = 69632, WS_CM3 = 86016;
constexpr size_t WS_ROPE = 1 * MiB;
constexpr size_t WS_SKB = 2 * MiB;
constexpr size_t WS_WIN = 4 * MiB;
constexpr size_t WS_WOUT = 76 * MiB;
constexpr size_t WS_WMQ = 108 * MiB;
constexpr size_t WS_WMKV = 116 * MiB;
constexpr size_t WS_WMO = 132 * MiB;
constexpr size_t WS_WPQ = 140 * MiB;
constexpr size_t WS_UB = 156 * MiB;
constexpr size_t WS_VB = 284 * MiB;
constexpr size_t WS_UQ = 156 * MiB, WS_VQ = 220 * MiB;
constexpr size_t WS_SU = 3 * MiB, WS_SV = 3 * MiB + 65536;
constexpr size_t WS_SX = 3 * MiB + 131072;
constexpr size_t WS_XQ = 284 * MiB;
constexpr size_t SLICE_BYTES = (size_t)NEXP * 128;
constexpr size_t WS_XN = 412 * MiB;
constexpr size_t WS_QKV = 476 * MiB;
constexpr size_t WS_OB = 620 * MiB;
constexpr size_t WS_MEMN = 684 * MiB;
constexpr size_t WS_KVM = 692 * MiB;
constexpr size_t WS_QM = 696 * MiB;
constexpr size_t WS_OM = 712 * MiB;
constexpr size_t WS_QP = 728 * MiB;
constexpr size_t WS_IDX = 760 * MiB;
constexpr size_t WS_GATE = 764 * MiB;
constexpr size_t WS_END = 768 * MiB;
constexpr int CW_BAR = 4096;
constexpr size_t WS_SSQ1 = 131072, WS_SSQ2 = 163840, WS_SSQA = 196608, WS_SSQB = 229376, WS_SSQ0 = 262144;

constexpr int RING_BYTES = 131072;
constexpr int LDSCTL_OFF = RING_BYTES, MISC_OFF = LDSCTL_OFF + 320;
constexpr int LDS_BYTES = 147456;

typedef float f32x16 __attribute__((ext_vector_type(16)));
typedef float f32x2 __attribute__((ext_vector_type(2)));
typedef short s16x4 __attribute__((ext_vector_type(4)));
typedef __bf16 bf16x2_t __attribute__((ext_vector_type(2)));
typedef unsigned u32x2 __attribute__((ext_vector_type(2)));
#define DI __device__ __forceinline__
#define MFMA32(a, b, c) __builtin_amdgcn_mfma_f32_32x32x16_bf16((a), (b), (c), 0, 0, 0)

DI unsigned cvtpk(float lo, float hi) { f32x2 v = {lo, hi}; bf16x2_t b = __builtin_convertvector(v, bf16x2_t); return __builtin_bit_cast(unsigned, b); }
DI float bflo(unsigned u) { return __uint_as_float(u << 16); }
DI float bfhi(unsigned u) { return __uint_as_float(u & 0xffff0000u); }
DI int crow(int i, int h) { return (i & 3) + 8 * (i >> 2) + 4 * h; }
DI float wave_sum(float v) {
#pragma unroll
    for (int o = 1; o < 64; o <<= 1) v += __shfl_xor(v, o);
    return v;
}
DI float fexp2(float x) { return __builtin_amdgcn_exp2f(x); }
DI bf16x8 pack8(const f32x16& x, int s) {
    v4u p; p.x = cvtpk(x[8 * s + 0], x[8 * s + 1]); p.y = cvtpk(x[8 * s + 2], x[8 * s + 3]); p.z = cvtpk(x[8 * s + 4], x[8 * s + 5]); p.w = cvtpk(x[8 * s + 6], x[8 * s + 7]);
    return __builtin_bit_cast(bf16x8, p);
}
typedef short v4i16_t __attribute__((ext_vector_type(4)));
DI s16x4 vtr(const LAS unsigned char* p) { return __builtin_bit_cast(s16x4, __builtin_amdgcn_ds_read_tr16_b64_v4i16((LAS v4i16_t*)p)); }

DI void p0_transpose_item(const float* W, int K, int N, bf16* WT, int row_off, LAS float* scr, int item, int lane, const float* gk0 = nullptr, const float* gk1 = nullptr) {
    const int nblk = N / 32, kb = item / nblk, nb = item % nblk, k0 = 64 * kb, n0 = 32 * nb;
#pragma unroll 8
    for (int i = 0; i < 32; ++i) { const int kk = 2 * i + (lane >> 5); scr[kk * 33 + (lane & 31)] = W[(size_t)(k0 + kk) * N + n0 + (lane & 31)]; }
    LDS_WAIT(); asm volatile("" ::: "memory");
    const int c = lane & 7;
    f32x4 ga = {1.f, 1.f, 1.f, 1.f}, gb = ga;
    if (gk0) { const int kg = k0 + 8 * c; const float* gp = kg < 2048 ? gk0 + kg : gk1 + (kg - 2048); ga = *(const GAS f32x4*)gp; gb = *(const GAS f32x4*)(gp + 4); }
#pragma unroll
    for (int j = 0; j < 4; ++j) { const int n = (lane >> 3) + 8 * j; const LAS float* s = scr + (8 * c) * 33 + n;
        v4u o; o.x = cvtpk(s[0 * 33] * ga.x, s[1 * 33] * ga.y); o.y = cvtpk(s[2 * 33] * ga.z, s[3 * 33] * ga.w); o.z = cvtpk(s[4 * 33] * gb.x, s[5 * 33] * gb.y); o.w = cvtpk(s[6 * 33] * gb.z, s[7 * 33] * gb.w);
        *(GAS v4u*)(WT + (size_t)(row_off + n0 + n) * K + k0 + 8 * c) = o; }
    LDS_WAIT(); asm volatile("" ::: "memory");
}
DI void rms_row_to_bf16(const float* xrow, const float* gain, bf16* orow, int lane) {
    const GAS f32x4* xr = (const GAS f32x4*)xrow + lane;
    f32x4 v[16]; float s = 0.f;
#pragma unroll
    for (int j = 0; j < 16; ++j) { v[j] = xr[64 * j]; s += (v[j].x * v[j].x + v[j].y * v[j].y) + (v[j].z * v[j].z + v[j].w * v[j].w); }
    const float rstd = 1.0f / sqrtf(wave_sum(s) * (1.f / DM) + RMS_EPS);
    const GAS f32x4* gr = (const GAS f32x4*)gain + lane;
    GAS u32x2* o8 = (GAS u32x2*)orow + lane;
#pragma unroll
    for (int j = 0; j < 16; ++j) { const f32x4 g = gr[64 * j]; u32x2 w; w.x = cvtpk(v[j].x * rstd * g.x, v[j].y * rstd * g.y); w.y = cvtpk(v[j].z * rstd * g.z, v[j].w * rstd * g.w); o8[64 * j] = w; }
}
DI void row_to_bf16_ssq(const float* xrow, bf16* orow, float* ssq, int lane) {
    const GAS f32x4* xr = (const GAS f32x4*)xrow + lane;
    GAS u32x2* o8 = (GAS u32x2*)orow + lane; float s = 0.f;
#pragma unroll
    for (int j = 0; j < 16; ++j) { const f32x4 v = xr[64 * j]; s += (v.x * v.x + v.y * v.y) + (v.z * v.z + v.w * v.w);
        u32x2 w; w.x = cvtpk(v.x, v.y); w.y = cvtpk(v.z, v.w); o8[64 * j] = w; }
    s = wave_sum(s);
    if (lane == 0) *ssq = s;
}
DI void row_to_bf16_i8(const float* xrow, bf16* orow, unsigned char* qrow, float* rs, int lane) {
    const GAS f32x4* xr = (const GAS f32x4*)xrow + lane;
    f32x4 v[16]; float s = 0.f, am = 0.f;
#pragma unroll
    for (int j = 0; j < 16; ++j) { v[j] = xr[64 * j]; s += (v[j].x * v[j].x + v[j].y * v[j].y) + (v[j].z * v[j].z + v[j].w * v[j].w);
        am = fmaxf(am, fmaxf(fmaxf(fabsf(v[j].x), fabsf(v[j].y)), fmaxf(fabsf(v[j].z), fabsf(v[j].w)))); }
    s = wave_sum(s);
#pragma unroll
    for (int o = 1; o < 64; o <<= 1) am = fmaxf(am, __shfl_xor(am, o));
    const float inv = am > 0.f ? 127.f / am : 0.f;
    GAS u32x2* o8 = (GAS u32x2*)orow + lane; GAS unsigned* q4 = (GAS unsigned*)qrow + lane;
#pragma unroll
    for (int j = 0; j < 16; ++j) { u32x2 w; w.x = cvtpk(v[j].x, v[j].y); w.y = cvtpk(v[j].z, v[j].w); o8[64 * j] = w;
        q4[64 * j] = ((unsigned)(int)rintf(v[j].x * inv) & 0xffu) | (((unsigned)(int)rintf(v[j].y * inv) & 0xffu) << 8) | (((unsigned)(int)rintf(v[j].z * inv) & 0xffu) << 16) | (((unsigned)(int)rintf(v[j].w * inv) & 0xffu) << 24); }
    if (lane == 0) *rs = am * (1.f / 127.f) / sqrtf(s * (1.f / DM) + RMS_EPS);
}
DI void p0_colmax_item(const float* W, int N, unsigned* CM, int item, int lane, const float* gk0, const float* gk1 = nullptr) {
    const int nblk = N / 32, kr = item / nblk, nb = item % nblk, n0 = 32 * nb;
    float mx = 0.f;
    for (int kb = kr * CMK; kb < kr * CMK + CMK; ++kb) { const int k0 = 64 * kb;
        const float* gk = (gk1 && k0 >= 2048) ? gk1 - 2048 : gk0;
        if (!gk0) {
#pragma unroll 16
            for (int i = 0; i < 32; ++i) { const int kk = k0 + 2 * i + (lane >> 5); mx = fmaxf(mx, fabsf(W[(size_t)kk * N + n0 + (lane & 31)])); }
        } else
#pragma unroll 16
        for (int i = 0; i < 32; ++i) { const int kk = k0 + 2 * i + (lane >> 5); mx = fmaxf(mx, fabsf(W[(size_t)kk * N + n0 + (lane & 31)] * gk[kk])); }
    }
    mx = fmaxf(mx, __shfl_xor(mx, 32));
    if (lane < 32) atomicMax(CM + n0 + lane, __float_as_uint(mx));
}
DI void p0_colmax_rows(const float* W, int N, unsigned* CM, int item, int lane, const float* gk0, const float* gk1 = nullptr) {
    const int nch = N / 256, kb = item / nch, ch = item % nch, k0 = CMR * kb, n0 = 256 * ch + 4 * lane;
    const float* gk = (gk1 && k0 >= 2048) ? gk1 - 2048 : gk0;
    float m0 = 0.f, m1 = 0.f, m2 = 0.f, m3 = 0.f;
    const float* wp = W + (size_t)k0 * N + n0;
#pragma unroll 16
    for (int i = 0; i < CMR; ++i) { const f32x4 w = *(const GAS f32x4*)(wp + (size_t)i * N); const float g = gk0 ? gk[k0 + i] : 1.f;
        m0 = fmaxf(m0, fabsf(w.x * g)); m1 = fmaxf(m1, fabsf(w.y * g)); m2 = fmaxf(m2, fabsf(w.z * g)); m3 = fmaxf(m3, fabsf(w.w * g)); }
    atomicMax(CM + n0, __float_as_uint(m0)); atomicMax(CM + n0 + 1, __float_as_uint(m1)); atomicMax(CM + n0 + 2, __float_as_uint(m2)); atomicMax(CM + n0 + 3, __float_as_uint(m3));
}
DI void p0_transpose_item_i8(const float* W, int K, int N, unsigned char* WT, const unsigned* CM, LAS float* scr, int item, int lane, const float* gk0, const float* gk1 = nullptr) {
    const int nblk = N / 32, kb = item / nblk, nb = item % nblk, k0 = 64 * kb, n0 = 32 * nb;
    const float* gk = (gk1 && k0 >= 2048) ? gk1 - 2048 : gk0;
#pragma unroll 8
    for (int i = 0; i < 32; ++i) { const int kk = 2 * i + (lane >> 5); scr[kk * 33 + (lane & 31)] = W[(size_t)(k0 + kk) * N + n0 + (lane & 31)]; }
    LDS_WAIT(); asm volatile("" ::: "memory");
    const int c = lane & 7;
    f32x4 ga = {1.f, 1.f, 1.f, 1.f}, gb = {1.f, 1.f, 1.f, 1.f};
    if (gk0) { ga = *(const GAS f32x4*)(gk + k0 + 8 * c); gb = *(const GAS f32x4*)(gk + k0 + 8 * c + 4); }
#pragma unroll
    for (int j = 0; j < 4; ++j) { const int n = (lane >> 3) + 8 * j; const LAS float* sp = scr + (8 * c) * 33 + n;
        const float cm = __uint_as_float(CM[n0 + n]); const float inv = cm > 0.f ? 127.f / cm : 0.f;
        u32x2 o;
        o.x = ((unsigned)(int)rintf(sp[0 * 33] * ga.x * inv) & 0xffu) | (((unsigned)(int)rintf(sp[1 * 33] * ga.y * inv) & 0xffu) << 8) | (((unsigned)(int)rintf(sp[2 * 33] * ga.z * inv) & 0xffu) << 16) | (((unsigned)(int)rintf(sp[3 * 33] * ga.w * inv) & 0xffu) << 24);
        o.y = ((unsigned)(int)rintf(sp[4 * 33] * gb.x * inv) & 0xffu) | (((unsigned)(int)rintf(sp[5 * 33] * gb.y * inv) & 0xffu) << 8) | (((unsigned)(int)rintf(sp[6 * 33] * gb.z * inv) & 0xffu) << 16) | (((unsigned)(int)rintf(sp[7 * 33] * gb.w * inv) & 0xffu) << 24);
        *(GAS u32x2*)(WT + (size_t)(n0 + n) * K + k0 + 8 * c) = o; }
    LDS_WAIT(); asm volatile("" ::: "memory");
}
DI void mix_row_to_i8(const bf16* orow, float ssa, float ssb, unsigned char* qrow, float* rs, int lane) {
    const GAS v4u* p = (const GAS v4u*)orow + lane;
    const float ra = 1.0f / sqrtf(ssa * (1.f / 2048.f) + RMS_EPS), rb = 1.0f / sqrtf(ssb * (1.f / 2048.f) + RMS_EPS);
    float f[8][8]; float am = 0.f;
#pragma unroll
    for (int j = 0; j < 8; ++j) { const v4u v = p[64 * j]; const float rsc = j < 4 ? ra : rb;
#pragma unroll
        for (int k = 0; k < 4; ++k) { f[j][2 * k] = bflo(v[k]) * rsc; f[j][2 * k + 1] = bfhi(v[k]) * rsc; am = fmaxf(am, fmaxf(fabsf(f[j][2 * k]), fabsf(f[j][2 * k + 1]))); } }
#pragma unroll
    for (int o = 1; o < 64; o <<= 1) am = fmaxf(am, __shfl_xor(am, o));
    const float inv = am > 0.f ? 127.f / am : 0.f;
    GAS u32x2* q = (GAS u32x2*)qrow + lane;
#pragma unroll
    for (int j = 0; j < 8; ++j) { u32x2 w;
        w.x = ((unsigned)(int)rintf(f[j][0] * inv) & 0xffu) | (((unsigned)(int)rintf(f[j][1] * inv) & 0xffu) << 8) | (((unsigned)(int)rintf(f[j][2] * inv) & 0xffu) << 16) | (((unsigned)(int)rintf(f[j][3] * inv) & 0xffu) << 24);
        w.y = ((unsigned)(int)rintf(f[j][4] * inv) & 0xffu) | (((unsigned)(int)rintf(f[j][5] * inv) & 0xffu) << 8) | (((unsigned)(int)rintf(f[j][6] * inv) & 0xffu) << 16) | (((unsigned)(int)rintf(f[j][7] * inv) & 0xffu) << 24);
        q[64 * j] = w; }
    if (lane == 0) *rs = am * (1.f / 127.f);
}
DI void mix_row_norm(bf16* orow, const float* ga, const float* gb, int lane) {
    GAS v4u* p = (GAS v4u*)orow + lane;
    v4u v[8]; float sa = 0.f, sb = 0.f;
#pragma unroll
    for (int j = 0; j < 8; ++j) { v[j] = p[64 * j]; float s = 0.f;
#pragma unroll
        for (int k = 0; k < 4; ++k) { const float a = bflo(v[j][k]), b = bfhi(v[j][k]); s += a * a + b * b; }
        if (j < 4) sa += s; else sb += s; }
    const float ra = 1.0f / sqrtf(wave_sum(sa) * (1.f / 2048.f) + RMS_EPS), rb = 1.0f / sqrtf(wave_sum(sb) * (1.f / 2048.f) + RMS_EPS);
#pragma unroll
    for (int j = 0; j < 8; ++j) { const float rs = j < 4 ? ra : rb; const float* gp = (j < 4 ? ga : gb) + ((lane + 64 * (j & 3)) * 8);
        const f32x4 g0 = *(const GAS f32x4*)gp, g1 = *(const GAS f32x4*)(gp + 4); v4u w;
        w.x = cvtpk(bflo(v[j].x) * rs * g0.x, bfhi(v[j].x) * rs * g0.y); w.y = cvtpk(bflo(v[j].y) * rs * g0.z, bfhi(v[j].y) * rs * g0.w);
        w.z = cvtpk(bflo(v[j].z) * rs * g1.x, bfhi(v[j].z) * rs * g1.y); w.w = cvtpk(bflo(v[j].w) * rs * g1.z, bfhi(v[j].w) * rs * g1.w);
        p[64 * j] = w; }
}

struct EpiResF32 {
    static constexpr bool PERM = false, AFTER_DRAIN = false;
    const float* base; float* out; int ldc; float sc;
    __device__ __forceinline__ void operator()(const pg8::f32x4 (&acc)[2][2][4][2], const pg8::Unit& u, int wr, int wc, int fr, int fq) const {
        const int col0 = u.pn * 256 + wc * 32 + 4 * fq;
#pragma unroll
        for (int ai = 0; ai < 2; ++ai)
#pragma unroll
            for (int m = 0; m < 4; ++m) { const int r = ai * 128 + wr * 64 + m * 16 + fr; const size_t off = (size_t)(u.pm * 256 + r) * ldc + col0;
#pragma unroll
                for (int bj = 0; bj < 2; ++bj)
#pragma unroll
                    for (int n = 0; n < 2; ++n) { const pg8::f32x4 bs = *(const pg8::f32x4*)(base + off + bj * 128 + n * 16); *(pg8::f32x4*)(out + off + bj * 128 + n * 16) = bs + acc[ai][bj][m][n] * sc; } }
    }
};

struct EpiResNorm {
    static constexpr bool PERM = false, AFTER_DRAIN = false;
    const float* base; float* out; bf16* xn; const float* gain; float* ssq; int ldc;
    __device__ __forceinline__ void operator()(const pg8::f32x4 (&acc)[2][2][4][2], const pg8::Unit& u, int wr, int wc, int fr, int fq) const {
        const int col0 = u.pn * 256 + wc * 32 + 4 * fq;
        pg8::f32x4 gv[2][2];
#pragma unroll
        for (int bj = 0; bj < 2; ++bj)
#pragma unroll
            for (int n = 0; n < 2; ++n) gv[bj][n] = *(const pg8::f32x4*)(gain + col0 + bj * 128 + n * 16);
#pragma unroll
        for (int ai = 0; ai < 2; ++ai)
#pragma unroll
            for (int m = 0; m < 4; ++m) { const int r = u.pm * 256 + ai * 128 + wr * 64 + m * 16 + fr; const size_t off = (size_t)r * ldc + col0; float part = 0.f;
#pragma unroll
                for (int bj = 0; bj < 2; ++bj)
#pragma unroll
                    for (int n = 0; n < 2; ++n) { const pg8::f32x4 bs = *(const pg8::f32x4*)(base + off + bj * 128 + n * 16); const pg8::f32x4 v = bs + acc[ai][bj][m][n];
                        *(pg8::f32x4*)(out + off + bj * 128 + n * 16) = v; part += (v[0] * v[0] + v[1] * v[1]) + (v[2] * v[2] + v[3] * v[3]);
                        const pg8::f32x4 g = gv[bj][n]; u32x2 w; w.x = cvtpk(v[0] * g[0], v[1] * g[1]); w.y = cvtpk(v[2] * g[2], v[3] * g[3]);
                        *(u32x2*)(xn + off + bj * 128 + n * 16) = w; }
                part += __shfl_xor(part, 16); part += __shfl_xor(part, 32);
                if (fq == 0) atomicAdd(ssq + r, part); }
    }
};
struct EpiResNormMid {
    static constexpr bool PERM = false, AFTER_DRAIN = false;
    const float* base; float* out; bf16* xn; const float* gain; float* ssq; int ldc; const float* ssqa; const float* ssqb;
    LAS float* midtab;
    __device__ __forceinline__ void load_mid(const pg8::Unit& u) const {
        if (threadIdx.x < 256) { const int r = u.pm * 256 + (int)threadIdx.x;
            midtab[threadIdx.x] = sqrtf((ssqb[r] * (1.f / 2048.f) + RMS_EPS) / (ssqa[r] * (1.f / 2048.f) + RMS_EPS)); }
    }
    __device__ __forceinline__ float mid(int row_in_tile) const { return midtab[row_in_tile]; }
    __device__ __forceinline__ void operator()(const pg8::f32x4 (&acc)[2][2][4][2], const pg8::Unit& u, int wr, int wc, int fr, int fq) const {
        const int col0 = u.pn * 256 + wc * 32 + 4 * fq;
        pg8::f32x4 gv[2][2];
#pragma unroll
        for (int bj = 0; bj < 2; ++bj)
#pragma unroll
            for (int n = 0; n < 2; ++n) gv[bj][n] = *(const pg8::f32x4*)(gain + col0 + bj * 128 + n * 16);
#pragma unroll
        for (int ai = 0; ai < 2; ++ai)
#pragma unroll
            for (int m = 0; m < 4; ++m) { const int r = u.pm * 256 + ai * 128 + wr * 64 + m * 16 + fr; const size_t off = (size_t)r * ldc + col0; float part = 0.f;
                const float rsb = 1.0f / sqrtf(ssqb[r] * (1.f / 2048.f) + RMS_EPS);
#pragma unroll
                for (int bj = 0; bj < 2; ++bj)
#pragma unroll
                    for (int n = 0; n < 2; ++n) { const pg8::f32x4 bs = *(const pg8::f32x4*)(base + off + bj * 128 + n * 16); const pg8::f32x4 v = bs + acc[ai][bj][m][n] * rsb;
                        *(pg8::f32x4*)(out + off + bj * 128 + n * 16) = v; part += (v[0] * v[0] + v[1] * v[1]) + (v[2] * v[2] + v[3] * v[3]);
                        const pg8::f32x4 g = gv[bj][n]; u32x2 w; w.x = cvtpk(v[0] * g[0], v[1] * g[1]); w.y = cvtpk(v[2] * g[2], v[3] * g[3]);
                        *(u32x2*)(xn + off + bj * 128 + n * 16) = w; }
                part += __shfl_xor(part, 16); part += __shfl_xor(part, 32);
                if (fq == 0) atomicAdd(ssq + r, part); }
    }
};
struct EpiResHMid {
    static constexpr bool PERM = true, AFTER_DRAIN = false;
    bf16* H; float* ssq; int ldc; const float* ssqa; const float* ssqb; LAS float* midtab;
    __device__ __forceinline__ void load_mid(const pg8::Unit& u) const {
        if (threadIdx.x < 256) { const int r = u.pm * 256 + (int)threadIdx.x;
            midtab[threadIdx.x] = sqrtf((ssqb[r] * (1.f / 2048.f) + RMS_EPS) / (ssqa[r] * (1.f / 2048.f) + RMS_EPS)); }
    }
    __device__ __forceinline__ float mid(int row_in_tile) const { return midtab[row_in_tile]; }
    __device__ __forceinline__ void operator()(const pg8::f32x4 (&acc)[2][2][4][2], const pg8::Unit& u, int wr, int wc, int fr, int fq) const {
        const int col0 = u.pn * 256 + wc * 32 + 8 * fq;
#pragma unroll
        for (int ai = 0; ai < 2; ++ai)
#pragma unroll
            for (int m = 0; m < 4; ++m) { const int r = u.pm * 256 + ai * 128 + wr * 64 + m * 16 + fr; bf16* rowp = H + (size_t)r * ldc + col0; float part = 0.f;
                const float rsb = 1.0f / sqrtf(ssqb[r] * (1.f / 2048.f) + RMS_EPS);
#pragma unroll
                for (int bj = 0; bj < 2; ++bj) { const v4u hb = *(const v4u*)(rowp + bj * 128); float v[8];
#pragma unroll
                    for (int n = 0; n < 2; ++n)
#pragma unroll
                        for (int c = 0; c < 2; ++c) { const unsigned w2 = hb[2 * n + c]; v[4 * n + 2 * c] = bflo(w2) + acc[ai][bj][m][n][2 * c] * rsb; v[4 * n + 2 * c + 1] = bfhi(w2) + acc[ai][bj][m][n][2 * c + 1] * rsb; }
                    v4u w;
#pragma unroll
                    for (int c = 0; c < 4; ++c) { part += v[2 * c] * v[2 * c] + v[2 * c + 1] * v[2 * c + 1]; w[c] = cvtpk(v[2 * c], v[2 * c + 1]); }
                    *(v4u*)(rowp + bj * 128) = w; }
                part += __shfl_xor(part, 16); part += __shfl_xor(part, 32);
                if (fq == 0) atomicAdd(ssq + r, part); }
    }
};
struct EpiResH {
    static constexpr bool PERM = true, AFTER_DRAIN = false;
    bf16* H; float* ssq; int ldc;
    __device__ __forceinline__ void operator()(const pg8::f32x4 (&acc)[2][2][4][2], const pg8::Unit& u, int wr, int wc, int fr, int fq) const {
        const int col0 = u.pn * 256 + wc * 32 + 8 * fq;
#pragma unroll
        for (int ai = 0; ai < 2; ++ai)
#pragma unroll
            for (int m = 0; m < 4; ++m) { const int r = u.pm * 256 + ai * 128 + wr * 64 + m * 16 + fr; bf16* rowp = H + (size_t)r * ldc + col0; float part = 0.f;
#pragma unroll
                for (int bj = 0; bj < 2; ++bj) { const v4u hb = *(const v4u*)(rowp + bj * 128); float v[8];
#pragma unroll
                    for (int n = 0; n < 2; ++n)
#pragma unroll
                        for (int c = 0; c < 2; ++c) { const unsigned w2 = hb[2 * n + c]; v[4 * n + 2 * c] = bflo(w2) + acc[ai][bj][m][n][2 * c]; v[4 * n + 2 * c + 1] = bfhi(w2) + acc[ai][bj][m][n][2 * c + 1]; }
                    v4u w;
#pragma unroll
                    for (int c = 0; c < 4; ++c) { part += v[2 * c] * v[2 * c] + v[2 * c + 1] * v[2 * c + 1]; w[c] = cvtpk(v[2 * c], v[2 * c + 1]); }
                    *(v4u*)(rowp + bj * 128) = w; }
                part += __shfl_xor(part, 16); part += __shfl_xor(part, 32);
                if (fq == 0) atomicAdd(ssq + r, part); }
    }
};
struct EpiBf16I8 {
    static constexpr bool PERM = true, AFTER_DRAIN = false;
    bf16* O; int ldc; const float* rs; const unsigned* cm;
    __device__ __forceinline__ void operator()(const pg8::f32x4 (&acc)[2][2][4][2], const pg8::Unit& u, int wr, int wc, int fr, int fq) const {
        const int row0 = u.pm * 256 + wr * 64 + fr, col0 = u.pn * 256 + wc * 32 + 8 * fq;
        float cs[2][8];
#pragma unroll
        for (int bj = 0; bj < 2; ++bj) { const v4u c0 = *(const v4u*)(cm + col0 + bj * 128), c1 = *(const v4u*)(cm + col0 + bj * 128 + 4);
#pragma unroll
            for (int k = 0; k < 4; ++k) { cs[bj][k] = __uint_as_float(c0[k]) * (1.f / 127.f); cs[bj][4 + k] = __uint_as_float(c1[k]) * (1.f / 127.f); } }
#pragma unroll
        for (int ai = 0; ai < 2; ++ai)
#pragma unroll
            for (int m = 0; m < 4; ++m) { const int row = row0 + ai * 128 + m * 16; const float r1 = rs[row]; bf16* rowp = O + (size_t)row * ldc + col0;
#pragma unroll
                for (int bj = 0; bj < 2; ++bj) { float v[8];
#pragma unroll
                    for (int n = 0; n < 2; ++n)
#pragma unroll
                        for (int k = 0; k < 4; ++k) v[4 * n + k] = (float)(int)__float_as_uint(acc[ai][bj][m][n][k]) * r1 * cs[bj][4 * n + k];
                    v4u w; w.x = cvtpk(v[0], v[1]); w.y = cvtpk(v[2], v[3]); w.z = cvtpk(v[4], v[5]); w.w = cvtpk(v[6], v[7]);
                    *(v4u*)(rowp + bj * 128) = w; } }
    }
};
struct EpiResHI8 {
    static constexpr bool PERM = true, AFTER_DRAIN = false;
    bf16* H; float* ssq; int ldc; const float* rs; const unsigned* cm;
    __device__ __forceinline__ void operator()(const pg8::f32x4 (&acc)[2][2][4][2], const pg8::Unit& u, int wr, int wc, int fr, int fq) const {
        const int col0 = u.pn * 256 + wc * 32 + 8 * fq;
        float cs[2][8];
#pragma unroll
        for (int bj = 0; bj < 2; ++bj) { const v4u c0 = *(const v4u*)(cm + col0 + bj * 128), c1 = *(const v4u*)(cm + col0 + bj * 128 + 4);
#pragma unroll
            for (int k = 0; k < 4; ++k) { cs[bj][k] = __uint_as_float(c0[k]) * (1.f / 127.f); cs[bj][4 + k] = __uint_as_float(c1[k]) * (1.f / 127.f); } }
#pragma unroll
        for (int ai = 0; ai < 2; ++ai)
#pragma unroll
            for (int m = 0; m < 4; ++m) { const int r = u.pm * 256 + ai * 128 + wr * 64 + m * 16 + fr; bf16* rowp = H + (size_t)r * ldc + col0; float part = 0.f; const float r1 = rs[r];
#pragma unroll
                for (int bj = 0; bj < 2; ++bj) { const v4u hb = *(const v4u*)(rowp + bj * 128); float v[8];
#pragma unroll
                    for (int n = 0; n < 2; ++n)
#pragma unroll
                        for (int c = 0; c < 2; ++c) { const unsigned w2 = hb[2 * n + c];
                            v[4 * n + 2 * c] = bflo(w2) + (float)(int)__float_as_uint(acc[ai][bj][m][n][2 * c]) * r1 * cs[bj][4 * n + 2 * c];
                            v[4 * n + 2 * c + 1] = bfhi(w2) + (float)(int)__float_as_uint(acc[ai][bj][m][n][2 * c + 1]) * r1 * cs[bj][4 * n + 2 * c + 1]; }
                    v4u w;
#pragma unroll
                    for (int c = 0; c < 4; ++c) { part += v[2 * c] * v[2 * c] + v[2 * c + 1] * v[2 * c + 1]; w[c] = cvtpk(v[2 * c], v[2 * c + 1]); }
                    *(v4u*)(rowp + bj * 128) = w; }
                part += __shfl_xor(part, 16); part += __shfl_xor(part, 32);
                if (fq == 0) atomicAdd(ssq + r, part); }
    }
};
struct EpiBf16RowScale {
    static constexpr bool PERM = true, AFTER_DRAIN = false;
    bf16* O; int ldc; const float* ssq;
    __device__ __forceinline__ void operator()(const pg8::f32x4 (&acc)[2][2][4][2], const pg8::Unit& u, int wr, int wc, int fr, int fq) const {
        const int row0 = u.pm * 256 + wr * 64 + fr, col0 = u.pn * 256 + wc * 32 + 8 * fq;
#pragma unroll
        for (int ai = 0; ai < 2; ++ai)
#pragma unroll
            for (int m = 0; m < 4; ++m) { const int row = row0 + ai * 128 + m * 16; const float rs = 1.0f / sqrtf(ssq[row] * (1.f / DM) + RMS_EPS); bf16* rowp = O + (size_t)row * ldc + col0;
#pragma unroll
                for (int bj = 0; bj < 2; ++bj) { const pg8::f32x4 v0 = acc[ai][bj][m][0] * rs, v1 = acc[ai][bj][m][1] * rs;
                    v4u w; w.x = cvtpk(v0[0], v0[1]); w.y = cvtpk(v0[2], v0[3]); w.z = cvtpk(v1[0], v1[1]); w.w = cvtpk(v1[2], v1[3]);
                    *(v4u*)(rowp + bj * 128) = w; } }
    }
};

template <int NSTEP, int KP>
DI f32x16 qk_tile(const LAS unsigned char* Kt, const bf16x8* qf, int r, int h) {
    f32x16 s;
#pragma unroll
    for (int i = 0; i < 16; ++i) s[i] = 0.f;
    const LAS unsigned char* kp = Kt + r * KP + h * 16;
#pragma unroll
    for (int st = 0; st < NSTEP; ++st) { const bf16x8 a = *(const LAS bf16x8*)(kp + st * 32); s = MFMA32(a, qf[st], s); }
    return s;
}
template <int NDB, int VP>
DI void pv_tile(f32x16* o, const LAS unsigned char* Vt, const f32x16& p, int lane) {
    const int h = lane >> 5, q = (lane & 15) >> 2, pp = lane & 3, blk = (lane >> 4) & 1;
    const bf16x8 p0 = pack8(p, 0), p1 = pack8(p, 1);
    const LAS unsigned char* vb = Vt + (4 * h + q) * VP + blk * 32 + pp * 8;
#pragma unroll
    for (int db = 0; db < NDB; ++db) {
        const s16x4 l0 = vtr(vb + db * 64), h0 = vtr(vb + 8 * VP + db * 64), l1 = vtr(vb + 16 * VP + db * 64), h1 = vtr(vb + 24 * VP + db * 64);
        const bf16x8 v0 = __builtin_shufflevector(l0, h0, 0, 1, 2, 3, 4, 5, 6, 7), v1 = __builtin_shufflevector(l1, h1, 0, 1, 2, 3, 4, 5, 6, 7);
        o[db] = MFMA32(v0, p0, o[db]); o[db] = MFMA32(v1, p1, o[db]);
    }
}
DI float softmax_tile(f32x16& s, float& m, float& l) {
    float mx = s[0];
#pragma unroll
    for (int i = 1; i < 16; ++i) mx = fmaxf(mx, s[i]);
    mx = fmaxf(mx, __shfl_xor(mx, 32));
    const float mn = fmaxf(m, mx), alpha = fexp2(m - mn); m = mn;
    float sum = 0.f;
#pragma unroll
    for (int i = 0; i < 16; ++i) { s[i] = fexp2(s[i] - mn); sum += s[i]; }
    l = l * alpha + sum;
    return alpha;
}
DI float fmul_s(float a, float b) { float r; asm("v_mul_f32_e32 %0, %1, %2" : "=v"(r) : "v"(a), "v"(b)); return r; }
template <int NDB> DI void scale_o(f32x16* o, float alpha) {
#pragma unroll
    for (int db = 0; db < NDB; ++db)
#pragma unroll
        for (int i = 0; i < 16; ++i) o[db][i] *= alpha;
}
struct MaskNone { DI void operator()(f32x16&, int) const {} };
struct MaskSwa { int qpos, k0; int h;
    DI void operator()(f32x16& s, int st2) const {
#pragma unroll
        for (int i = 0; i < 16; ++i) { const int d = qpos - (k0 + 32 * st2 + crow(i, h)); s[i] = (d <= 128 && d >= -128) ? s[i] : -3.0e30f; } } };
struct MaskNat { const LAS float* brow; int t0;
    DI void operator()(f32x16& s, int st2) const {
        float bv[16];
#pragma unroll
        for (int i = 0; i < 16; ++i) bv[i] = brow[32 * st2 + (i & 3) + 8 * (i >> 2)];
        __builtin_amdgcn_sched_barrier(0);
#pragma unroll
        for (int i = 0; i < 16; ++i) { const int kc0 = 32 * st2 + (i & 3) + 8 * (i >> 2); s[i] = ((unsigned)(t0 + kc0) < 16u) ? s[i] + bv[i] : -3.0e30f; } } };
template <int NSTEP, int KP, int NDB, int VP, class Mask>
DI void tile64(const LAS unsigned char* Kb, const LAS unsigned char* Vb, const bf16x8* qf, f32x16* o, float& m, float& l, int lane, const Mask& mask, unsigned long long* tq = nullptr, bool domask = true) {
    const int r = lane & 31, h = lane >> 5;
#ifdef PROBE_TILE
    unsigned long long t0_ = clock64();
#define TT(i_) do { if (tq) { asm volatile("s_waitcnt vmcnt(0) lgkmcnt(0)" ::: "memory"); asm volatile("s_nop 15\n\ts_nop 15" :: "v"(s0), "v"(s1)); const unsigned long long n_ = clock64(); tq[i_] += n_ - t0_; t0_ = n_; } } while (0)
#else
#define TT(i_) do {} while (0)
#endif
    f32x16 s0, s1;
#pragma unroll
    for (int i = 0; i < 16; ++i) { s0[i] = 0.f; s1[i] = 0.f; }
    const LAS unsigned char* kp = Kb + r * KP + h * 16;
#pragma unroll
    for (int st = 0; st < NSTEP; ++st) { const bf16x8 a0 = *(const LAS bf16x8*)(kp + st * 32), a1 = *(const LAS bf16x8*)(kp + 32 * KP + st * 32);
        s0 = MFMA32(a0, qf[st], s0); s1 = MFMA32(a1, qf[st], s1); }
    TT(0);
    if (domask) { mask(s0, 0); mask(s1, 1); }
#ifdef PROBE_SPLIT
    TT(1);
#endif
    float mx0 = fmaxf(s0[0], s1[0]), mx1 = fmaxf(s0[1], s1[1]);
#pragma unroll
    for (int i = 2; i < 16; i += 2) { mx0 = fmaxf(mx0, fmaxf(s0[i], s1[i])); mx1 = fmaxf(mx1, fmaxf(s0[i + 1], s1[i + 1])); }
    float mx = fmaxf(mx0, mx1);
    { const auto sw = __builtin_amdgcn_permlane32_swap(__float_as_uint(mx), __float_as_uint(mx), false, false); mx = fmaxf(__uint_as_float(sw[0]), __uint_as_float(sw[1])); }
    const float mn = fmaxf(m, mx), alpha = fexp2(m - mn); m = mn;
    float sum0 = 0.f, sum1 = 0.f;
#pragma unroll
    for (int i = 0; i < 16; ++i) { s0[i] = fexp2(s0[i] - mn); s1[i] = fexp2(s1[i] - mn); sum0 += s0[i]; sum1 += s1[i]; }
    l = l * alpha + (sum0 + sum1);
    scale_o<NDB>(o, alpha);
#ifdef PROBE_SPLIT
    TT(2);
#else
    TT(1);
#endif
    const int q = (lane & 15) >> 2, pp = lane & 3, blk = (lane >> 4) & 1;
    const bf16x8 p00 = pack8(s0, 0), p01 = pack8(s0, 1), p10 = pack8(s1, 0), p11 = pack8(s1, 1);
    const LAS unsigned char* vb = Vb + (4 * h + q) * VP + blk * 32 + pp * 8;
#pragma unroll
    for (int db = 0; db < NDB; ++db) {
        const s16x4 a0 = vtr(vb + db * 64), a1 = vtr(vb + 8 * VP + db * 64), a2 = vtr(vb + 16 * VP + db * 64), a3 = vtr(vb + 24 * VP + db * 64);
        const s16x4 b0 = vtr(vb + 32 * VP + db * 64), b1 = vtr(vb + 40 * VP + db * 64), b2 = vtr(vb + 48 * VP + db * 64), b3 = vtr(vb + 56 * VP + db * 64);
        const bf16x8 v00 = __builtin_shufflevector(a0, a1, 0, 1, 2, 3, 4, 5, 6, 7), v01 = __builtin_shufflevector(a2, a3, 0, 1, 2, 3, 4, 5, 6, 7);
        const bf16x8 v10 = __builtin_shufflevector(b0, b1, 0, 1, 2, 3, 4, 5, 6, 7), v11 = __builtin_shufflevector(b2, b3, 0, 1, 2, 3, 4, 5, 6, 7);
        o[db] = MFMA32(v00, p00, o[db]); o[db] = MFMA32(v01, p01, o[db]); o[db] = MFMA32(v10, p10, o[db]); o[db] = MFMA32(v11, p11, o[db]);
    }
#if defined(PROBE_TILE) && !defined(PROBE_SPLIT)
    if (tq) { asm volatile("s_nop 15\n\ts_nop 15" :: "v"(o[0]), "v"(o[1]), "v"(o[2]), "v"(o[3])); const unsigned long long n_ = clock64(); tq[2] += n_ - t0_; }
#endif
#undef TT
}
template <int NDB> DI void store_o(const f32x16* o, float inv, bf16* orow, int h, float* ssq = nullptr) {
    float part = 0.f;
#pragma unroll
    for (int db = 0; db < NDB; ++db)
#pragma unroll
        for (int gp = 0; gp < 2; ++gp) {
            unsigned ax, ay, bx, by;
            { const int g = 2 * gp; const float a0 = o[db][4 * g] * inv, a1 = o[db][4 * g + 1] * inv, a2 = o[db][4 * g + 2] * inv, a3 = o[db][4 * g + 3] * inv;
              part += (a0 * a0 + a1 * a1) + (a2 * a2 + a3 * a3); ax = cvtpk(a0, a1); ay = cvtpk(a2, a3); }
            { const int g = 2 * gp + 1; const float a0 = o[db][4 * g] * inv, a1 = o[db][4 * g + 1] * inv, a2 = o[db][4 * g + 2] * inv, a3 = o[db][4 * g + 3] * inv;
              part += (a0 * a0 + a1 * a1) + (a2 * a2 + a3 * a3); bx = cvtpk(a0, a1); by = cvtpk(a2, a3); }
            const auto sx = __builtin_amdgcn_permlane32_swap(ax, bx, false, false), sy = __builtin_amdgcn_permlane32_swap(ay, by, false, false);
            v4u w; w.x = sx[0]; w.y = sy[0]; w.z = sx[1]; w.w = sy[1];
            *(GAS v4u*)(orow + 32 * db + 16 * gp + 8 * h) = w; }
    if (ssq) { part += __shfl_xor(part, 32); if (h == 0) atomicAdd(ssq, part); }
}

constexpr int KP128 = 272, VP128 = 320, KP256 = 528, VP256 = 576;
constexpr int ATT_K_OFF = 0, ATT_V_OFF = 34816, ATT_BIAS_OFF = 72704;

constexpr int A2_K = 0, A2_V = 17408, A2_BUF = 37888, A2_BIAS = 76800;
template <bool SKIPC = false> DI void swa_unit(LAS unsigned char* lds, int u, const bf16* QKV, bf16* OB, const float* sink, const float* ropec, const float* ropes, float* SSQA) {
    const int tid = threadIdx.x, lane = tid & 63, wid = __builtin_amdgcn_readfirstlane(tid >> 6), r = lane & 31, h = lane >> 5;
    const int qb = u & 31, kvh = (u >> 5) & 3, b = u >> 7;
    const int q0 = qb * 64, g = wid >> 1, sub = wid & 1, head = kvh * 4 + g;
    const int qpos = q0 + 32 * sub + r;
    const size_t tok = (size_t)b * SEQ + qpos;
    const float QS = 0.08838834764831845f * LOG2E;
    const int t_lo = qb - 2 < 0 ? 0 : qb - 2, t_hi = qb + 2 > 31 ? 31 : qb + 2;
    const int skey = tid >> 3, sc = tid & 7;
    v4u s_lo, s_hi, s_v0, s_v1; int s_kpos = 0;
#define SWA_LOAD(kt_) do { const int kpos_ = (kt_) * 64 + skey; const size_t ktok_ = (size_t)b * SEQ + kpos_; \
        const bf16* kp_ = QKV + ktok_ * INW + C_KA + kvh * 128 + 8 * sc; s_lo = *(const GAS v4u*)kp_; s_hi = *(const GAS v4u*)(kp_ + 64); \
        const bf16* vp_ = QKV + ktok_ * INW + C_VA + kvh * 128 + 8 * sc; s_v0 = *(const GAS v4u*)vp_; s_v1 = *(const GAS v4u*)(vp_ + 64); \
        s_kpos = kpos_; } while (0)
#define SWA_WRITE(buf_) do { float cc_[8], ss_[8]; _Pragma("unroll") for (int k_ = 0; k_ < 8; ++k_) { const float inv_ = fexp2(-(float)(8 * sc + k_) * (13.287712379549449f / 64.0f)); \
            const float rev_ = ((float)s_kpos * inv_) * 0.15915494309189535f; const float fr_ = rev_ - floorf(rev_); cc_[k_] = __builtin_amdgcn_cosf(fr_); ss_[k_] = __builtin_amdgcn_sinf(fr_); } \
        v4u a_, b_; _Pragma("unroll") for (int k_ = 0; k_ < 4; ++k_) { const float x1a = bflo(s_lo[k_]), x1b = bfhi(s_lo[k_]), x2a = bflo(s_hi[k_]), x2b = bfhi(s_hi[k_]); \
            a_[k_] = cvtpk(x1a * cc_[2 * k_] - x2a * ss_[2 * k_], x1b * cc_[2 * k_ + 1] - x2b * ss_[2 * k_ + 1]); \
            b_[k_] = cvtpk(x2a * cc_[2 * k_] + x1a * ss_[2 * k_], x2b * cc_[2 * k_ + 1] + x1b * ss_[2 * k_ + 1]); } \
        LAS unsigned char* bb_ = lds + (buf_) * A2_BUF; \
        *(LAS v4u*)(bb_ + A2_K + skey * KP128 + 16 * sc) = a_; *(LAS v4u*)(bb_ + A2_K + skey * KP128 + 128 + 16 * sc) = b_; \
        *(LAS v4u*)(bb_ + A2_V + skey * VP128 + 16 * sc) = s_v0; *(LAS v4u*)(bb_ + A2_V + skey * VP128 + 128 + 16 * sc) = s_v1; } while (0)
    bf16x8 qf[8];
    {
        const bf16* qp = QKV + tok * INW + C_QA + head * 128 + 8 * h;
#pragma unroll
        for (int st = 0; st < 4; ++st) {
            const v4u lo = *(const GAS v4u*)(qp + 16 * st), hi = *(const GAS v4u*)(qp + 16 * st + 64);
            const float* cp = ropec + (size_t)qpos * 64 + 16 * st + 8 * h; const float* sp = ropes + (size_t)qpos * 64 + 16 * st + 8 * h;
            const f32x4 c0 = *(const GAS f32x4*)cp, c1 = *(const GAS f32x4*)(cp + 4), s0 = *(const GAS f32x4*)sp, s1 = *(const GAS f32x4*)(sp + 4);
            float x1[8], x2[8], cc[8], ss[8];
#pragma unroll
            for (int k = 0; k < 4; ++k) { x1[2 * k] = bflo(lo[k]); x1[2 * k + 1] = bfhi(lo[k]); x2[2 * k] = bflo(hi[k]); x2[2 * k + 1] = bfhi(hi[k]); cc[k] = c0[k]; cc[4 + k] = c1[k]; ss[k] = s0[k]; ss[4 + k] = s1[k]; }
            v4u a, bq;
#pragma unroll
            for (int k = 0; k < 4; ++k) {
                a[k] = cvtpk((x1[2 * k] * cc[2 * k] - x2[2 * k] * ss[2 * k]) * QS, (x1[2 * k + 1] * cc[2 * k + 1] - x2[2 * k + 1] * ss[2 * k + 1]) * QS);
                bq[k] = cvtpk((x2[2 * k] * cc[2 * k] + x1[2 * k] * ss[2 * k]) * QS, (x2[2 * k + 1] * cc[2 * k + 1] + x1[2 * k + 1] * ss[2 * k + 1]) * QS);
            }
            qf[st] = __builtin_bit_cast(bf16x8, a); qf[st + 4] = __builtin_bit_cast(bf16x8, bq);
        }
    }
    asm volatile("" ::: "memory");
    SWA_LOAD(t_lo);
    float m = sink[head] * LOG2E, l = (h == 0) ? 1.f : 0.f;
    f32x16 o[4];
#pragma unroll
    for (int db = 0; db < 4; ++db)
#pragma unroll
        for (int i = 0; i < 16; ++i) o[db][i] = 0.f;
    __syncthreads();
    SWA_WRITE(0);
    __syncthreads();
    int buf = 0;
    for (int kt = t_lo; kt <= t_hi; ++kt) {
        if (kt < t_hi) SWA_LOAD(kt + 1);
        const LAS unsigned char* bb = lds + buf * A2_BUF;
        if (!SKIPC) { const MaskSwa mk{qpos, kt * 64, h}; tile64<8, KP128, 4, VP128>(bb + A2_K, bb + A2_V, qf, o, m, l, lane, mk, nullptr, kt <= qb - 2 || kt >= qb + 2); }
        if (kt < t_hi) SWA_WRITE(buf ^ 1);
        __syncthreads();
        buf ^= 1;
    }
#undef SWA_LOAD
#undef SWA_WRITE
    const float lt = l + __shfl_xor(l, 32);
    store_o<4>(o, 1.0f / lt, OB + tok * DM + head * 128, h, SSQA + tok);
}

#define PROBE_PTR ((unsigned char*)SSQB - WS_SSQB + 458752)
DI void nat_unit(LAS unsigned char* lds, int u, const bf16* QKV, bf16* OB, const float* relb, float* SSQB) {
    const int tid = threadIdx.x, lane = tid & 63, wid = __builtin_amdgcn_readfirstlane(tid >> 6), r = lane & 31, h = lane >> 5;
    const int rb = u & 7, head = (u >> 3) & 15, b = u >> 7;
    const int r0 = rb * 4, qrow = r0 + (wid >> 1), qcol = 32 * (wid & 1) + r;
    const size_t tok = (size_t)b * SEQ + qrow * 64 + qcol;
    const float QS = 0.08838834764831845f * LOG2E;
    int kr_lo = r0 - 4; kr_lo = kr_lo < 0 ? 0 : (kr_lo > 24 ? 24 : kr_lo);
    int kr_hi = r0 + 3 - 4; kr_hi = (kr_hi < 0 ? 0 : (kr_hi > 24 ? 24 : kr_hi)) + 7;
    int rs = qrow - 4; rs = rs < 0 ? 0 : (rs > 24 ? 24 : rs);
    int cs = qcol - 8; cs = cs < 0 ? 0 : (cs > 48 ? 48 : cs);
    const int skey = tid >> 3, sc = tid & 7;
    v4u s_k0, s_k1, s_v0, s_v1;
#define NAT_LOAD(kr_) do { const size_t ktok_ = (size_t)b * SEQ + (kr_) * 64 + skey; \
        const bf16* kp_ = QKV + ktok_ * INW + C_KB + head * 128 + 8 * sc; s_k0 = *(const GAS v4u*)kp_; s_k1 = *(const GAS v4u*)(kp_ + 64); \
        const bf16* vp_ = QKV + ktok_ * INW + C_VB + head * 128 + 8 * sc; s_v0 = *(const GAS v4u*)vp_; s_v1 = *(const GAS v4u*)(vp_ + 64); } while (0)
#define NAT_WRITE(buf_) do { LAS unsigned char* bb_ = lds + (buf_) * A2_BUF; \
        *(LAS v4u*)(bb_ + A2_K + skey * KP128 + 16 * sc) = s_k0; *(LAS v4u*)(bb_ + A2_K + skey * KP128 + 128 + 16 * sc) = s_k1; \
        *(LAS v4u*)(bb_ + A2_V + skey * VP128 + 16 * sc) = s_v0; *(LAS v4u*)(bb_ + A2_V + skey * VP128 + 128 + 16 * sc) = s_v1; } while (0)
    NAT_LOAD(kr_lo);
    bf16x8 qf[8];
    {
        const bf16* qp = QKV + tok * INW + C_QB + head * 128 + 8 * h;
#pragma unroll
        for (int st = 0; st < 8; ++st) { const v4u x = *(const GAS v4u*)(qp + 16 * st); v4u a;
#pragma unroll
            for (int k = 0; k < 4; ++k) a[k] = cvtpk(bflo(x[k]) * QS, bfhi(x[k]) * QS);
            qf[st] = __builtin_bit_cast(bf16x8, a); }
    }
    float m = -1.0e30f, l = 0.f;
    f32x16 o[4];
#pragma unroll
    for (int db = 0; db < 4; ++db)
#pragma unroll
        for (int i = 0; i < 16; ++i) o[db][i] = 0.f;
    __syncthreads();
    LAS float* bias = (LAS float*)(lds + A2_BIAS) + 64;
    if (tid < 465) bias[tid] = relb[head * 465 + tid] * LOG2E;
    NAT_WRITE(0);
    __syncthreads();
    int buf = 0;
#ifdef PROBE_TILE
    unsigned long long tq_[3] = {0, 0, 0};
#endif
#ifdef PROBE_TIMING
    unsigned long long tc_ = 0, tw_ = 0, tb_ = 0, t0_ = clock64(), tt0_ = t0_;
#define TSTAMP(acc_) do { asm volatile("s_waitcnt vmcnt(0) lgkmcnt(0)" ::: "memory"); const unsigned long long n_ = clock64(); acc_ += n_ - t0_; t0_ = n_; } while (0)
#else
#define TSTAMP(acc_) do {} while (0)
#endif
    for (int kr = kr_lo; kr <= kr_hi; ++kr) {
        if (kr < kr_hi) NAT_LOAD(kr + 1);
        if (kr >= rs && kr < rs + 8) {
            const LAS unsigned char* bb = lds + buf * A2_BUF;
            int dr = kr - qrow + 7; dr = dr < 0 ? 0 : (dr > 14 ? 14 : dr);
            int boff = 15 - qcol + 4 * h, t0 = 4 * h - cs;
            asm volatile("" : "+v"(boff), "+v"(t0));
            const LAS float* brow = bias + dr * 31 + boff;
#ifdef PROBE_TILE
            { const MaskNat mk{brow, t0}; tile64<8, KP128, 4, VP128>(bb + A2_K, bb + A2_V, qf, o, m, l, lane, mk, tq_); }
#else
            { const MaskNat mk{brow, t0}; tile64<8, KP128, 4, VP128>(bb + A2_K, bb + A2_V, qf, o, m, l, lane, mk); }
#endif
        }
#ifdef PROBE_TIMING
        { asm volatile("s_waitcnt lgkmcnt(0)" ::: "memory"); const unsigned long long n_ = clock64(); tc_ += n_ - t0_; t0_ = n_; }
        TSTAMP(tw_);
#endif
        if (kr < kr_hi) NAT_WRITE(buf ^ 1);
        __syncthreads();
        TSTAMP(tb_);
        buf ^= 1;
    }
#ifdef PROBE_TIMING
#ifdef PROBE_TILE
    if (blockIdx.x == 0 && tid == 0) { unsigned long long* pt = (unsigned long long*)PROBE_PTR; pt[0] += tq_[0]; pt[1] += tq_[1]; pt[2] += tq_[2]; pt[3] += tc_; }
#else
    if (blockIdx.x == 0 && tid == 0) { unsigned long long* pt = (unsigned long long*)PROBE_PTR; pt[0] += tc_; pt[1] += tw_; pt[2] += tb_; pt[3] += clock64() - tt0_; }
#endif
#endif
#undef TSTAMP
#undef NAT_LOAD
#undef NAT_WRITE
    const float lt = l + __shfl_xor(l, 32);
    store_o<4>(o, 1.0f / lt, OB + tok * DM + 2048 + head * 128, h, SSQB + tok);
}

DI void mem_unit(LAS unsigned char* lds, int u, const bf16* QM, const bf16* KVM, bf16* OM) {
    const int tid = threadIdx.x, lane = tid & 63, wid = __builtin_amdgcn_readfirstlane(tid >> 6), r = lane & 31, h = lane >> 5;
    const int qblk = u & 15, mh = (u >> 4) & 3, b = u >> 6;
    const int qsub = wid >> 1, dh = wid & 1;
    const size_t tok = (size_t)b * SEQ + qblk * 128 + 32 * qsub + r;
    const float QS = 0.0625f * LOG2E;
    bf16x8 qf[16];
    {
        const bf16* qp = QM + tok * MEMW + mh * 256 + 8 * h;
#pragma unroll
        for (int st = 0; st < 16; ++st) { const v4u x = *(const GAS v4u*)(qp + 16 * st); v4u a;
#pragma unroll
            for (int k = 0; k < 4; ++k) a[k] = cvtpk(bflo(x[k]) * QS, bfhi(x[k]) * QS);
            qf[st] = __builtin_bit_cast(bf16x8, a); }
    }
    float m = -1.0e30f, l = 0.f;
    f32x16 o[4];
#pragma unroll
    for (int db = 0; db < 4; ++db)
#pragma unroll
        for (int i = 0; i < 16; ++i) o[db][i] = 0.f;
    for (int kt = 0; kt < 4; ++kt) {
        __syncthreads();
#pragma unroll
        for (int it = 0; it < 4; ++it) {
            const int ch = tid + 512 * it, key = ch >> 5, c = ch & 31;
            const bf16* kp = KVM + (size_t)(b * MEMLEN + kt * 64 + key) * 2048 + mh * 256 + 8 * c;
            const v4u kv = *(const GAS v4u*)kp, vv = *(const GAS v4u*)(kp + 1024);
            *(LAS v4u*)(lds + ATT_K_OFF + key * KP256 + 16 * c) = kv; *(LAS v4u*)(lds + ATT_V_OFF + key * VP256 + 16 * c) = vv;
        }
        __syncthreads();
        { const MaskNone mk; tile64<16, KP256, 4, VP256>(lds + ATT_K_OFF, lds + ATT_V_OFF + dh * 256, qf, o, m, l, lane, mk); }
    }
    const float lt = l + __shfl_xor(l, 32);
    store_o<4>(o, 1.0f / lt, OM + tok * MEMW + mh * 256 + dh * 128, h);
}

DI unsigned f2sort(float f) { const unsigned u = __float_as_uint(f); return u ^ ((unsigned)((int)u >> 31) | 0x80000000u); }
DI float sort2f(unsigned k) { const unsigned u = (k & 0x80000000u) ? (k ^ 0x80000000u) : ~k; return __uint_as_float(u); }
constexpr int RT_SK_OFF = 0, RT_A_OFF = 69632;
struct constexpr_cand { int a, b; };
__host__ __device__ constexpr constexpr_cand cand_ab(int n) {
    int c = 0;
    for (int a = 0; a < 16; ++a) for (int b = 0; b < 16; ++b) if ((a + 1) * (b + 1) <= 16) { if (c == n) return constexpr_cand{a, b}; ++c; }
    return constexpr_cand{0, 0};
}
DI unsigned selu(int h, unsigned a, unsigned b) { asm volatile("" : "+v"(a), "+v"(b)); return h ? b : a; }
DI float self(int h, float a, float b) { asm volatile("" : "+v"(a), "+v"(b)); return h ? b : a; }
DI void ce_desc(unsigned& a, unsigned& b) { const unsigned hi = a > b ? a : b, lo = a > b ? b : a; a = hi; b = lo; }
template <int LOGN> DI void bitonic_merge_desc(unsigned (&x)[1 << LOGN]) {
#pragma unroll
    for (int lj = LOGN - 1; lj >= 0; --lj)
#pragma unroll
        for (int i = 0; i < (1 << LOGN); ++i) { const int l = i ^ (1 << lj); if (l > i) ce_desc(x[i], x[l]); }
}
DI void bitonic_sort16_desc(unsigned (&x)[16]) {
#pragma unroll
    for (int lk = 1; lk <= 4; ++lk)
#pragma unroll
        for (int lj = lk - 1; lj >= 0; --lj)
#pragma unroll
            for (int i = 0; i < 16; ++i) { const int l = i ^ (1 << lj); if (l > i) { if ((i & (1 << lk)) == 0) ce_desc(x[i], x[l]); else ce_desc(x[l], x[i]); } }
}
DI void top16_merge(unsigned (&a)[16], const unsigned (&b)[16]) {
#pragma unroll
    for (int i = 0; i < 16; ++i) a[i] = a[i] > b[15 - i] ? a[i] : b[15 - i];
    bitonic_merge_desc<4>(a);
}
DI void top16_xlane(unsigned (&a)[16]) {
    unsigned o[16];
#pragma unroll
    for (int i = 0; i < 16; ++i) o[i] = (unsigned)__shfl_xor((int)a[i], 32);
    top16_merge(a, o);
}
DI void route_unit(LAS unsigned char* lds, int u, const bf16* QP, const bf16* SKB, int* IDX, float* GATE) {
    const int tid = threadIdx.x, lane = tid & 63, wid = __builtin_amdgcn_readfirstlane(tid >> 6), r = lane & 31, h = lane >> 5;
    const int hd = u & 7, tile = u >> 3;
    const size_t tok = (size_t)tile * 256 + 32 * wid + r;
    __syncthreads();
#pragma unroll
    for (int it = 0; it < 8; ++it) { const int ch = tid + 512 * it, row = ch >> 4, c = ch & 15;
        const v4u x = *(const GAS v4u*)(SKB + ((size_t)hd * 256 + row) * 128 + 8 * c);
        *(LAS v4u*)(lds + RT_SK_OFF + row * 272 + 16 * c) = x; }
    __syncthreads();
    LAS unsigned* A = (LAS unsigned*)(lds + RT_A_OFF);
    const int tslot = wid * 32 + r;
    unsigned top[2][16];
#pragma unroll
    for (int c = 0; c < 2; ++c) {
        bf16x8 qf[8];
        const bf16* qp = QP + tok * PQW + hd * 256 + c * 128 + 8 * h;
#pragma unroll
        for (int st = 0; st < 8; ++st) qf[st] = __builtin_bit_cast(bf16x8, *(const GAS v4u*)(qp + 16 * st));
        unsigned g0[16], g1[16];
#pragma unroll
        for (int kt = 0; kt < 4; ++kt) {
            const f32x16 s = qk_tile<8, 272>(lds + RT_SK_OFF + (c * 128 + 32 * kt) * 272, qf, r, h);
            unsigned pk[16];
#pragma unroll
            for (int i = 0; i < 16; ++i) pk[i] = (f2sort(s[i]) & ~0x7Fu) | (unsigned)(127 - (32 * kt + crow(i, h)));
            bitonic_sort16_desc(pk);
            if (kt == 0) {
#pragma unroll
                for (int i = 0; i < 16; ++i) g0[i] = pk[i];
            } else if (kt == 1) { top16_merge(g0, pk); }
            else if (kt == 2) {
#pragma unroll
                for (int i = 0; i < 16; ++i) g1[i] = pk[i];
            } else { top16_merge(g1, pk); }
        }
        top16_merge(g0, g1);
        top16_xlane(g0);
#pragma unroll
        for (int i = 0; i < 16; ++i) { top[c][i] = g0[i]; if (h == 0) A[(c * 16 + i) * 256 + tslot] = g0[i]; }
    }
    float v1[16], v2[16];
#pragma unroll
    for (int a = 0; a < 16; ++a) { v1[a] = sort2f(top[0][a] & ~0x7Fu); v2[a] = sort2f(top[1][a] & ~0x7Fu); }
    unsigned cd[64];
#define CK(a_, b_) ((f2sort(v1[a_] + v2[b_]) & ~0xFFu) | (unsigned)(255 - ((a_) * 16 + (b_))))
    cd[0] = CK(0, 0); cd[1] = CK(0, 1); cd[2] = CK(0, 2); cd[3] = CK(0, 3); cd[4] = CK(0, 4);
    cd[5] = CK(0, 5); cd[6] = CK(0, 6); cd[7] = CK(0, 7); cd[8] = CK(0, 8); cd[9] = CK(0, 9);
    cd[10] = CK(0, 10); cd[11] = CK(0, 11); cd[12] = CK(0, 12); cd[13] = CK(0, 13); cd[14] = CK(0, 14);
    cd[15] = CK(0, 15); cd[16] = CK(1, 0); cd[17] = CK(1, 1); cd[18] = CK(1, 2); cd[19] = CK(1, 3);
    cd[20] = CK(1, 4); cd[21] = CK(1, 5); cd[22] = CK(1, 6); cd[23] = CK(1, 7); cd[24] = CK(2, 0);
    cd[25] = CK(2, 1); cd[26] = CK(2, 2); cd[27] = CK(2, 3); cd[28] = CK(2, 4); cd[29] = CK(3, 0);
    cd[30] = CK(3, 1); cd[31] = CK(3, 2); cd[32] = CK(3, 3); cd[33] = CK(4, 0); cd[34] = CK(4, 1);
    cd[35] = CK(4, 2); cd[36] = CK(5, 0); cd[37] = CK(5, 1); cd[38] = CK(6, 0); cd[39] = CK(6, 1);
    cd[40] = CK(7, 0); cd[41] = CK(7, 1); cd[42] = CK(8, 0); cd[43] = CK(9, 0); cd[44] = CK(10, 0);
    cd[45] = CK(11, 0); cd[46] = CK(12, 0); cd[47] = CK(13, 0); cd[48] = CK(14, 0); cd[49] = CK(15, 0);
#undef CK
#pragma unroll
    for (int n = 50; n < 64; ++n) cd[n] = 0u;
    unsigned c0[16], c1[16];
#pragma unroll
    for (int i = 0; i < 16; ++i) { c0[i] = selu(h, cd[i], cd[32 + i]); c1[i] = selu(h, cd[16 + i], cd[48 + i]); }
    bitonic_sort16_desc(c0); bitonic_sort16_desc(c1);
    top16_merge(c0, c1);
    top16_xlane(c0);
    LDS_WAIT();
    asm volatile("" ::: "memory");
    const float mx0 = sort2f(c0[0] & ~0xFFu);
    float ev[16], esum = 0.f;
#pragma unroll
    for (int t = 0; t < 16; ++t) { ev[t] = fexp2((sort2f(c0[t] & ~0xFFu) - mx0) * LOG2E); esum += ev[t]; }
    const float inv = 1.0f / esum;
#pragma unroll
    for (int q4 = 0; q4 < 2; ++q4) {
        int iv[4]; float gv[4];
#pragma unroll
        for (int k = 0; k < 4; ++k) {
            const unsigned cw = selu(h, c0[4 * q4 + k], c0[8 + 4 * q4 + k]);
            const float e = self(h, ev[4 * q4 + k], ev[8 + 4 * q4 + k]);
            const int code = 255 - (int)(cw & 0xFFu), a = code >> 4, bb = code & 15;
            const int i1 = 127 - (int)(A[a * 256 + tslot] & 0x7Fu), i2 = 127 - (int)(A[(16 + bb) * 256 + tslot] & 0x7Fu);
            iv[k] = i1 * 128 + i2; gv[k] = e * inv;
        }
        const size_t o = tok * 128 + hd * 16 + 8 * h + 4 * q4;
        v4u iw; iw.x = (unsigned)iv[0]; iw.y = (unsigned)iv[1]; iw.z = (unsigned)iv[2]; iw.w = (unsigned)iv[3];
        *(GAS v4u*)(IDX + o) = iw;
        f32x4 gw; gw.x = gv[0]; gw.y = gv[1]; gw.z = gv[2]; gw.w = gv[3];
        *(GAS f32x4*)(GATE + o) = gw;
    }
}

DI float dot2bf(unsigned w, unsigned x, float acc) { return __builtin_amdgcn_fdot2_f32_bf16(__builtin_bit_cast(bf16x2_t, w), __builtin_bit_cast(bf16x2_t, x), acc, false); }
DI float readlane_f(float v, int l) { return __uint_as_float((unsigned)__builtin_amdgcn_readlane((int)__float_as_uint(v), l)); }
DI float gelu_erf(float x) { return 0.5f * x * (1.0f + erff(x * 0.70710678118654752f)); }
DI void load_row8(v4u* dst, const bf16* row, int lane) {
    const GAS v4u* p = (const GAS v4u*)row + lane;
#pragma unroll
    for (int j = 0; j < 8; ++j) dst[j] = p[64 * j];
}
DI float dot_row(const v4u* xr, const v4u* w) {
    float a0 = 0.f, a1 = 0.f, a2 = 0.f, a3 = 0.f;
#pragma unroll
    for (int j = 0; j < 8; ++j) { a0 = dot2bf(w[j].x, xr[j].x, a0); a1 = dot2bf(w[j].y, xr[j].y, a1); a2 = dot2bf(w[j].z, xr[j].z, a2); a3 = dot2bf(w[j].w, xr[j].w, a3); }
    return (a0 + a1) + (a2 + a3);
}
DI void axpy_row(float* acc, const v4u* w, float s) {
#pragma unroll
    for (int j = 0; j < 8; ++j)
#pragma unroll
        for (int k = 0; k < 4; ++k) { acc[8 * j + 2 * k] += s * bflo(w[j][k]); acc[8 * j + 2 * k + 1] += s * bfhi(w[j][k]); }
}
DI void peer_token(int tk, const bf16* XN, const int* IDX, const float* GATE, const bf16* UB, const bf16* VB, float* hout, const float* gfin, int lane) {
    v4u xr[8];
    load_row8(xr, XN + (size_t)tk * DM, lane);
    const int ilo = IDX[(size_t)tk * 128 + lane], ihi = IDX[(size_t)tk * 128 + 64 + lane];
    const float glo = GATE[(size_t)tk * 128 + lane], ghi = GATE[(size_t)tk * 128 + 64 + lane];
    float alo = 0.f, ahi = 0.f;
#ifdef PEER_REP
    for (int prep_ = 0; prep_ < 2; ++prep_)
#endif
    {
        v4u b0[8], b1[8];
        load_row8(b0, UB + (size_t)__builtin_amdgcn_readlane(ilo, 0) * DM, lane);
#pragma unroll 1
        for (int e = 0; e < 128; e += 2) {
            const int l1 = (e + 1) & 63;
            const int r1 = (e + 1) < 64 ? __builtin_amdgcn_readlane(ilo, l1) : __builtin_amdgcn_readlane(ihi, l1);
            load_row8(b1, UB + (size_t)r1 * DM, lane);
            { const float d = wave_sum(dot_row(xr, b0)); if (e < 64) { if (lane == (e & 63)) alo = d; } else { if (lane == (e & 63)) ahi = d; } }
            const int e2 = e + 2 < 128 ? e + 2 : 127, l2 = e2 & 63;
            const int r2 = e2 < 64 ? __builtin_amdgcn_readlane(ilo, l2) : __builtin_amdgcn_readlane(ihi, l2);
            load_row8(b0, UB + (size_t)r2 * DM, lane);
            { const float d = wave_sum(dot_row(xr, b1)); if (e + 1 < 64) { if (lane == l1) alo = d; } else { if (lane == l1) ahi = d; } }
        }
    }
#ifdef DBG_NO_PEER
    const float wlo = 0.f * alo * glo, whi = 0.f * ahi * ghi;
#else
    const float wlo = gelu_erf(alo) * glo, whi = gelu_erf(ahi) * ghi;
#endif
    float acc[64];
#pragma unroll
    for (int i = 0; i < 64; ++i) acc[i] = 0.f;
    {
        v4u b0[8], b1[8];
        load_row8(b0, VB + (size_t)__builtin_amdgcn_readlane(ilo, 0) * DM, lane);
#pragma unroll 1
        for (int e = 0; e < 128; e += 2) {
            const int l0 = e & 63, l1 = (e + 1) & 63;
            const int r1 = (e + 1) < 64 ? __builtin_amdgcn_readlane(ilo, l1) : __builtin_amdgcn_readlane(ihi, l1);
            load_row8(b1, VB + (size_t)r1 * DM, lane);
            { const float w = e < 64 ? readlane_f(wlo, l0) : readlane_f(whi, l0); axpy_row(acc, b0, w); }
            const int e2 = e + 2 < 128 ? e + 2 : 127, l2 = e2 & 63;
            const int r2 = e2 < 64 ? __builtin_amdgcn_readlane(ilo, l2) : __builtin_amdgcn_readlane(ihi, l2);
            load_row8(b0, VB + (size_t)r2 * DM, lane);
            { const float w = (e + 1) < 64 ? readlane_f(wlo, l1) : readlane_f(whi, l1); axpy_row(acc, b1, w); }
        }
    }
    float* hrow = hout + (size_t)tk * DM;
    float ssq = 0.f;
#pragma unroll
    for (int j = 0; j < 8; ++j) {
        const f32x4 h0 = *(const GAS f32x4*)(hrow + 512 * j + 8 * lane), h1 = *(const GAS f32x4*)(hrow + 512 * j + 8 * lane + 4);
#pragma unroll
        for (int k = 0; k < 4; ++k) { acc[8 * j + k] += h0[k]; acc[8 * j + 4 + k] += h1[k]; }
#pragma unroll
        for (int k = 0; k < 8; ++k) ssq += acc[8 * j + k] * acc[8 * j + k];
    }
    const float rstd = 1.0f / sqrtf(wave_sum(ssq) * (1.f / DM) + RMS_EPS);
#pragma unroll
    for (int j = 0; j < 8; ++j) {
        const f32x4 g0 = *(const GAS f32x4*)(gfin + 512 * j + 8 * lane), g1 = *(const GAS f32x4*)(gfin + 512 * j + 8 * lane + 4);
        f32x4 o0, o1;
#pragma unroll
        for (int k = 0; k < 4; ++k) { o0[k] = acc[8 * j + k] * rstd * g0[k]; o1[k] = acc[8 * j + 4 + k] * rstd * g1[k]; }
        *(GAS f32x4*)(hrow + 512 * j + 8 * lane) = o0; *(GAS f32x4*)(hrow + 512 * j + 8 * lane + 4) = o1;
    }
}

DI float wave_max(float v) {
#pragma unroll
    for (int o = 1; o < 64; o <<= 1) v = fmaxf(v, __shfl_xor(v, o));
    return v;
}
DI int wave_sum_i(int v) {
#pragma unroll
    for (int o = 1; o < 64; o <<= 1) v += __shfl_xor(v, o);
    return v;
}
DI unsigned q8(float x, float inv, int bias) { return (unsigned)((int)rintf(x * inv) + bias) & 0xffu; }
DI void quant_row_i8(const float* src, unsigned char* dst, float* scl, int lane, int bias) {
    f32x4 v[16]; float am = 0.f;
#pragma unroll
    for (int j = 0; j < 4; ++j)
#pragma unroll
        for (int q = 0; q < 4; ++q) { const f32x4 t = *(const GAS f32x4*)(src + 1024 * j + 16 * lane + 4 * q); v[4 * j + q] = t;
            am = fmaxf(am, fmaxf(fmaxf(fabsf(t.x), fabsf(t.y)), fmaxf(fabsf(t.z), fabsf(t.w)))); }
    am = wave_max(am);
    const float inv = am > 0.f ? 127.f / am : 0.f;
#pragma unroll
    for (int j = 0; j < 4; ++j) { v4u w;
#pragma unroll
        for (int q = 0; q < 4; ++q) { const f32x4 t = v[4 * j + q]; w[q] = q8(t.x, inv, bias) | (q8(t.y, inv, bias) << 8) | (q8(t.z, inv, bias) << 16) | (q8(t.w, inv, bias) << 24); }
        *(GAS v4u*)(dst + 1024 * j + 16 * lane) = w; }
    if (lane == 0) *scl = am * (1.f / 127.f);
}
DI void load_row4(v4u* dst, const unsigned char* row, int lane) {
    const GAS v4u* p = (const GAS v4u*)row + lane;
#pragma unroll
    for (int j = 0; j < 4; ++j) dst[j] = p[64 * j];
}
DI int idot_row(const v4u* xq, const v4u* w) {
    int a0 = 0, a1 = 0;
#pragma unroll
    for (int j = 0; j < 4; ++j) { a0 = __builtin_amdgcn_sdot4((int)w[j].x, (int)xq[j].x, a0, false); a1 = __builtin_amdgcn_sdot4((int)w[j].y, (int)xq[j].y, a1, false);
        a0 = __builtin_amdgcn_sdot4((int)w[j].z, (int)xq[j].z, a0, false); a1 = __builtin_amdgcn_sdot4((int)w[j].w, (int)xq[j].w, a1, false); }
    return a0 + a1;
}
DI void axpy_row_u8(float* acc, const v4u* w, float s) {
#pragma unroll
    for (int j = 0; j < 4; ++j)
#pragma unroll
        for (int q = 0; q < 4; ++q) { const unsigned u = w[j][q];
            acc[16 * j + 4 * q + 0] += s * (float)(u & 0xffu); acc[16 * j + 4 * q + 1] += s * (float)((u >> 8) & 0xffu);
            acc[16 * j + 4 * q + 2] += s * (float)((u >> 16) & 0xffu); acc[16 * j + 4 * q + 3] += s * (float)(u >> 24); }
}
#define RL(v, l) __builtin_amdgcn_readlane((v), (l))
DI void peer_token_q(int tk, const bf16* XN, const int* IDX, const float* GATE, const unsigned char* UQ, const unsigned char* VQ, const float* SU, const float* SV, const float* SSQ,
                     float* hout, const float* gfin, int lane) {
    v4u xq[4]; float sx;
    {
        v4u xb[8]; float am = 0.f;
        const bf16* xp = XN + (size_t)tk * DM + 16 * lane;
#pragma unroll
        for (int j = 0; j < 4; ++j) { xb[2 * j] = *(const GAS v4u*)(xp + 1024 * j); xb[2 * j + 1] = *(const GAS v4u*)(xp + 1024 * j + 8); }
#pragma unroll
        for (int i = 0; i < 8; ++i)
#pragma unroll
            for (int k = 0; k < 4; ++k) am = fmaxf(am, fmaxf(fabsf(bflo(xb[i][k])), fabsf(bfhi(xb[i][k]))));
        am = wave_max(am);
        const float inv = am > 0.f ? 127.f / am : 0.f; sx = am * (1.f / 127.f);
#pragma unroll
        for (int j = 0; j < 4; ++j)
#pragma unroll
            for (int q = 0; q < 4; ++q) { const unsigned w0 = xb[2 * j + (q >> 1)][2 * (q & 1)], w1 = xb[2 * j + (q >> 1)][2 * (q & 1) + 1];
                xq[j][q] = q8(bflo(w0), inv, 0) | (q8(bfhi(w0), inv, 0) << 8) | (q8(bflo(w1), inv, 0) << 16) | (q8(bfhi(w1), inv, 0) << 24); }
    }
    const int ilo = IDX[(size_t)tk * 128 + lane], ihi = IDX[(size_t)tk * 128 + 64 + lane];
    const float glo = GATE[(size_t)tk * 128 + lane], ghi = GATE[(size_t)tk * 128 + 64 + lane];
    const float sulo = SU[ilo], suhi = SU[ihi], svlo = SV[ilo], svhi = SV[ihi];
    int dlo = 0, dhi = 0;
#define ROWIDX(e) ((e) < 64 ? RL(ilo, (e) & 63) : RL(ihi, (e) & 63))
#ifdef PEER_L2PROBE
    {
        int pd = 0;
        v4u ba[2][4], bb[2][4];
#define ROWIDXP(e) (((e) < 64 ? RL(ilo, (e) & 63) : RL(ihi, (e) & 63)) & 511)
        load_row4(ba[0], UQ + (size_t)ROWIDXP(0) * DM, lane); load_row4(ba[1], UQ + (size_t)ROWIDXP(1) * DM, lane);
#pragma unroll 1
        for (int e = 0; e < 128; e += 4) {
            load_row4(bb[0], UQ + (size_t)ROWIDXP(e + 2) * DM, lane); load_row4(bb[1], UQ + (size_t)ROWIDXP(e + 3) * DM, lane);
            pd += wave_sum_i(idot_row(xq, ba[0])) + wave_sum_i(idot_row(xq, ba[1]));
            const int e4 = e + 4 < 128 ? e + 4 : 126;
            load_row4(ba[0], UQ + (size_t)ROWIDXP(e4) * DM, lane); load_row4(ba[1], UQ + (size_t)ROWIDXP(e4 + 1) * DM, lane);
            pd += wave_sum_i(idot_row(xq, bb[0])) + wave_sum_i(idot_row(xq, bb[1]));
        }
#undef ROWIDXP
        asm volatile("" :: "v"(pd));
    }
#endif
#ifdef PEER_REP
    for (int prep_ = 0; prep_ < 2; ++prep_)
#endif
    {
        v4u ba[2][4], bb[2][4];
        load_row4(ba[0], UQ + (size_t)RL(ilo, 0) * DM, lane); load_row4(ba[1], UQ + (size_t)RL(ilo, 1) * DM, lane);
#pragma unroll 1
        for (int e = 0; e < 128; e += 4) {
            load_row4(bb[0], UQ + (size_t)ROWIDX(e + 2) * DM, lane); load_row4(bb[1], UQ + (size_t)ROWIDX(e + 3) * DM, lane);
            { const int d0 = wave_sum_i(idot_row(xq, ba[0])), d1 = wave_sum_i(idot_row(xq, ba[1]));
              if (e < 64) { if (lane == (e & 63)) dlo = d0; if (lane == ((e + 1) & 63)) dlo = d1; } else { if (lane == (e & 63)) dhi = d0; if (lane == ((e + 1) & 63)) dhi = d1; } }
            const int e4 = e + 4 < 128 ? e + 4 : 126;
            load_row4(ba[0], UQ + (size_t)ROWIDX(e4) * DM, lane); load_row4(ba[1], UQ + (size_t)ROWIDX(e4 + 1) * DM, lane);
            { const int d0 = wave_sum_i(idot_row(xq, bb[0])), d1 = wave_sum_i(idot_row(xq, bb[1]));
              if (e < 64) { if (lane == ((e + 2) & 63)) dlo = d0; if (lane == ((e + 3) & 63)) dlo = d1; } else { if (lane == ((e + 2) & 63)) dhi = d0; if (lane == ((e + 3) & 63)) dhi = d1; } }
        }
    }
    const float rsx = sx / sqrtf(SSQ[tk] * (1.f / DM) + RMS_EPS);
    const float wlo = gelu_erf((float)dlo * rsx * sulo) * glo * svlo, whi = gelu_erf((float)dhi * rsx * suhi) * ghi * svhi;
    const float wsum = wave_sum(wlo + whi);
    float acc[64];
#pragma unroll
    for (int i = 0; i < 64; ++i) acc[i] = 0.f;
#define ROWW(e) ((e) < 64 ? readlane_f(wlo, (e) & 63) : readlane_f(whi, (e) & 63))
    {
        v4u ba[2][4], bb[2][4];
        load_row4(ba[0], VQ + (size_t)RL(ilo, 0) * DM, lane); load_row4(ba[1], VQ + (size_t)RL(ilo, 1) * DM, lane);
#pragma unroll 1
        for (int e = 0; e < 128; e += 4) {
            load_row4(bb[0], VQ + (size_t)ROWIDX(e + 2) * DM, lane); load_row4(bb[1], VQ + (size_t)ROWIDX(e + 3) * DM, lane);
            axpy_row_u8(acc, ba[0], ROWW(e)); axpy_row_u8(acc, ba[1], ROWW(e + 1));
            const int e4 = e + 4 < 128 ? e + 4 : 126;
            load_row4(ba[0], VQ + (size_t)ROWIDX(e4) * DM, lane); load_row4(ba[1], VQ + (size_t)ROWIDX(e4 + 1) * DM, lane);
            axpy_row_u8(acc, bb[0], ROWW(e + 2)); axpy_row_u8(acc, bb[1], ROWW(e + 3));
        }
    }
#undef ROWIDX
#undef ROWW
    float* hrow = hout + (size_t)tk * DM + 16 * lane;
    const float corr = -128.f * wsum;
    float ssq = 0.f;
#pragma unroll
    for (int j = 0; j < 4; ++j)
#pragma unroll
        for (int q = 0; q < 4; ++q) { const f32x4 hv = *(const GAS f32x4*)(hrow + 1024 * j + 4 * q);
#pragma unroll
            for (int k = 0; k < 4; ++k) { const float t = acc[16 * j + 4 * q + k] + corr + hv[k]; acc[16 * j + 4 * q + k] = t; ssq += t * t; } }
    const float rstd = 1.0f / sqrtf(wave_sum(ssq) * (1.f / DM) + RMS_EPS);
    const float* gp = gfin + 16 * lane;
#pragma unroll
    for (int j = 0; j < 4; ++j)
#pragma unroll
        for (int q = 0; q < 4; ++q) { const f32x4 gv = *(const GAS f32x4*)(gp + 1024 * j + 4 * q); f32x4 o;
#pragma unroll
            for (int k = 0; k < 4; ++k) o[k] = acc[16 * j + 4 * q + k] * rstd * gv[k];
            *(GAS f32x4*)(hrow + 1024 * j + 4 * q) = o; }
}

DI void fmac_s(float& acc, float w, float x) { asm("v_fmac_f32_e32 %0, %1, %2" : "+v"(acc) : "v"(w), "v"(x)); }
DI void pkfma16_lo(unsigned& acc, unsigned x, unsigned wp) { asm("v_pk_fma_f16 %0, %1, %2, %0 op_sel_hi:[1,0,1]" : "+v"(acc) : "v"(x), "v"(wp)); }
DI void pkfma16_hi(unsigned& acc, unsigned x, unsigned wp) { asm("v_pk_fma_f16 %0, %1, %2, %0 op_sel:[0,1,0] op_sel_hi:[1,1,1]" : "+v"(acc) : "v"(x), "v"(wp)); }
DI void quant_row_i8_sliced(const float* src, unsigned char* tab, int e, float* scl, int lane, int bias) {
    f32x4 v[16]; float am = 0.f;
#pragma unroll
    for (int j = 0; j < 4; ++j)
#pragma unroll
        for (int q = 0; q < 4; ++q) { const f32x4 t = *(const GAS f32x4*)(src + 1024 * j + 16 * lane + 4 * q); v[4 * j + q] = t;
            am = fmaxf(am, fmaxf(fmaxf(fabsf(t.x), fabsf(t.y)), fmaxf(fabsf(t.z), fabsf(t.w)))); }
    am = wave_max(am);
    const float inv = am > 0.f ? 127.f / am : 0.f;
#pragma unroll
    for (int j = 0; j < 4; ++j) { v4u w;
#pragma unroll
        for (int q = 0; q < 4; ++q) { const f32x4 t = v[4 * j + q]; w[q] = q8(t.x, inv, bias) | (q8(t.y, inv, bias) << 8) | (q8(t.z, inv, bias) << 16) | (q8(t.w, inv, bias) << 24); }
        *(GAS v4u*)(tab + (size_t)(8 * j + (lane >> 3)) * SLICE_BYTES + (size_t)e * 128 + 16 * (lane & 7)) = w; }
    if (lane == 0) *scl = am * (1.f / 127.f);
}
DI void qrow_load(f32x4* v, const float* src, int lane) {
#pragma unroll
    for (int j = 0; j < 4; ++j)
#pragma unroll
        for (int q = 0; q < 4; ++q) v[4 * j + q] = *(const GAS f32x4*)(src + 1024 * j + 16 * lane + 4 * q);
}
template <bool NOST = false> DI void qrow_store(const f32x4* v, unsigned char* tab, int e, float* scl, int lane, int bias) {
    float am = 0.f;
#pragma unroll
    for (int i = 0; i < 16; ++i) { const f32x4 t = v[i]; am = fmaxf(am, fmaxf(fmaxf(fabsf(t.x), fabsf(t.y)), fmaxf(fabsf(t.z), fabsf(t.w)))); }
    am = wave_max(am);
    const float inv = am > 0.f ? 127.f / am : 0.f;
#pragma unroll
    for (int j = 0; j < 4; ++j) { v4u w;
#pragma unroll
        for (int q = 0; q < 4; ++q) { const f32x4 t = v[4 * j + q]; w[q] = q8(t.x, inv, bias) | (q8(t.y, inv, bias) << 8) | (q8(t.z, inv, bias) << 16) | (q8(t.w, inv, bias) << 24); }
        if (NOST) asm volatile("" :: "v"(w)); else *(GAS v4u*)(tab + (size_t)(8 * j + (lane >> 3)) * SLICE_BYTES + (size_t)e * 128 + 16 * (lane & 7)) = w; }
    if (lane == 0 && !NOST) *scl = am * (1.f / 127.f);
}
DI unsigned q4(float x, float inv) { int q = (int)floorf(x * inv + 8.0f); q = q < 0 ? 0 : (q > 15 ? 15 : q); return (unsigned)q; }
DI void qrow_store_u4(const f32x4* v, unsigned char* tab, int e, float* scl, int lane) {
    float ss = 0.f;
#pragma unroll
    for (int i = 0; i < 16; ++i) { const f32x4 t = v[i]; ss += (t.x * t.x + t.y * t.y) + (t.z * t.z + t.w * t.w); }
    ss = wave_sum(ss);
    const float step = 0.3352f * sqrtf(ss * (1.f / DM)), inv = step > 0.f ? 1.0f / step : 0.f;
#pragma unroll
    for (int j = 0; j < 4; ++j) { u32x2 w;
#pragma unroll
        for (int d = 0; d < 2; ++d) { const f32x4 a = v[4 * j + 2 * d], b = v[4 * j + 2 * d + 1];
            w[d] = q4(a.x, inv) | (q4(a.y, inv) << 8) | (q4(a.z, inv) << 16) | (q4(a.w, inv) << 24) | (q4(b.x, inv) << 4) | (q4(b.y, inv) << 12) | (q4(b.z, inv) << 20) | (q4(b.w, inv) << 28); }
        *(GAS u32x2*)(tab + (size_t)(4 * j + (lane >> 4)) * SLICE_BYTES + (size_t)e * 128 + 8 * (lane & 15)) = w; }
    if (lane == 0) *scl = step;
}
template <bool NOST = false> DI void quant_rows_strided(int r_lo, int r_hi, int stride, const float* peer_u, const float* peer_v, unsigned char* UQ, unsigned char* VQ, float* SU, float* SV, int lane) {
    if (r_lo >= r_hi) return;
#define QSRC(r_) (((r_) >= NEXP ? peer_v + (size_t)((r_) - NEXP) * DM : peer_u + (size_t)(r_) * DM))
#ifdef U4
#define QSTORE(v_, r_) do { if ((r_) >= NEXP) qrow_store<NOST>(v_, VQ, (r_) - NEXP, SV + ((r_) - NEXP), lane, 128); else qrow_store_u4(v_, UQ, (r_), SU + (r_), lane); } while (0)
#else
#define QSTORE(v_, r_) do { if ((r_) >= NEXP) qrow_store<NOST>(v_, VQ, (r_) - NEXP, SV + ((r_) - NEXP), lane, 128); else qrow_store<NOST>(v_, UQ, (r_), SU + (r_), lane, 0); } while (0)
#endif
    f32x4 va[16], vb[16];
    qrow_load(va, QSRC(r_lo), lane);
#pragma unroll 1
    for (int r = r_lo; r < r_hi; r += 2 * stride) {
        const int r1 = r + stride < r_hi ? r + stride : r, r2 = r + 2 * stride < r_hi ? r + 2 * stride : r;
        qrow_load(vb, QSRC(r1), lane);
        QSTORE(va, r);
        qrow_load(va, QSRC(r2), lane);
        if (r + stride < r_hi) QSTORE(vb, r1);
    }
#undef QSRC
#undef QSTORE
}
DI void quant_token(int tk, const bf16* XN, const float* gain, const float* SSQ, unsigned char* XQ, float* SX, int lane) {
    v4u xb[8]; float am = 0.f;
    const bf16* xp = XN + (size_t)tk * DM + 16 * lane; const float* gp = gain + 16 * lane;
#pragma unroll
    for (int j = 0; j < 4; ++j) { xb[2 * j] = *(const GAS v4u*)(xp + 1024 * j); xb[2 * j + 1] = *(const GAS v4u*)(xp + 1024 * j + 8); }
#pragma unroll
    for (int i = 0; i < 8; ++i) { const f32x4 g0 = *(const GAS f32x4*)(gp + 1024 * (i >> 1) + 8 * (i & 1)), g1 = *(const GAS f32x4*)(gp + 1024 * (i >> 1) + 8 * (i & 1) + 4);
        xb[i].x = cvtpk(bflo(xb[i].x) * g0.x, bfhi(xb[i].x) * g0.y); xb[i].y = cvtpk(bflo(xb[i].y) * g0.z, bfhi(xb[i].y) * g0.w);
        xb[i].z = cvtpk(bflo(xb[i].z) * g1.x, bfhi(xb[i].z) * g1.y); xb[i].w = cvtpk(bflo(xb[i].w) * g1.z, bfhi(xb[i].w) * g1.w); }
#pragma unroll
    for (int i = 0; i < 8; ++i)
#pragma unroll
        for (int k = 0; k < 4; ++k) am = fmaxf(am, fmaxf(fabsf(bflo(xb[i][k])), fabsf(bfhi(xb[i][k]))));
    am = wave_max(am);
    const float inv = am > 0.f ? 127.f / am : 0.f;
#pragma unroll
    for (int j = 0; j < 4; ++j) { v4u o;
#pragma unroll
        for (int q = 0; q < 4; ++q) { const unsigned w0 = xb[2 * j + (q >> 1)][2 * (q & 1)], w1 = xb[2 * j + (q >> 1)][2 * (q & 1) + 1];
            o[q] = q8(bflo(w0), inv, 0) | (q8(bfhi(w0), inv, 0) << 8) | (q8(bflo(w1), inv, 0) << 16) | (q8(bfhi(w1), inv, 0) << 24); }
        *(GAS v4u*)(XQ + (size_t)tk * DM + 1024 * j + 16 * lane) = o; }
    if (lane == 0) SX[tk] = am * (1.f / 127.f) / sqrtf(SSQ[tk] * (1.f / DM) + RMS_EPS);
#ifdef U4
    {
        int sm = 0;
#pragma unroll
        for (int i = 0; i < 8; ++i)
#pragma unroll
            for (int k = 0; k < 4; ++k) { sm += (int)rintf(bflo(xb[i][k]) * inv) + (int)rintf(bfhi(xb[i][k]) * inv); }
        sm = wave_sum_i(sm);
        if (lane == 0) ((int*)(SX + T_TOK))[tk] = sm;
    }
#endif
}
DI void peer_sweep(LAS unsigned char* lds, int wave, int gw, int NGW, const unsigned char* XQ, const float* SX, const int* IDX, const float* GATE,
                   const unsigned char* UQs, const unsigned char* VQs, const float* SU, const float* SV, bf16* Hres, float* hout, const float* gfin, int lane) {
    const int g = lane >> 3, c = lane & 7;
    LAS int* RI = (LAS int*)(lds + wave * 16384) + lane;
    int tok[4];
#pragma unroll
    for (int k = 0; k < 4; ++k) tok[k] = gw + k * NGW;
#pragma unroll
    for (int k = 0; k < 4; ++k)
#pragma unroll
        for (int i = 0; i < 16; ++i) RI[(k * 16 + i) * 64] = IDX[(size_t)tok[k] * 128 + 8 * i + g] * 128 + 16 * c;
    LDS_WAIT(); asm volatile("" ::: "memory");
#define PS_ISSUE(dst, base, k_, h_) do { _Pragma("unroll") for (int i_ = 0; i_ < 8; ++i_) dst[i_] = *(const GAS v4u*)((base) + RI[((k_) * 16 + 8 * (h_) + i_) * 64]); } while (0)
#ifdef PROBE_SWEEP
    const unsigned long long tsw0 = __builtin_amdgcn_s_memrealtime(); const unsigned long long tck0 = clock64();
#endif
    int A[4][16];
#pragma unroll
    for (int k = 0; k < 4; ++k)
#pragma unroll
        for (int i = 0; i < 16; ++i) A[k][i] = 0;
#ifdef U4
    {
        v4u wa[16], wb[16], xa0, xa1, xb0, xb1;
#define PS_ISSUE16(dst, base, k_) do { _Pragma("unroll") for (int i_ = 0; i_ < 16; ++i_) dst[i_] = *(const GAS v4u*)((base) + RI[((k_) * 16 + i_) * 64]); } while (0)
#define PS_XS(d0_, d1_, s_, k_) do { const unsigned char* xp_ = XQ + (size_t)tok[k_] * DM + 256 * (s_) + 32 * c; d0_ = *(const GAS v4u*)xp_; d1_ = *(const GAS v4u*)(xp_ + 16); } while (0)
#define PS_D4(a_, w_, xl_, xh_) do { a_ = __builtin_amdgcn_sdot4((int)((w_) & 0x0F0F0F0Fu), (int)(xl_), a_, false); a_ = __builtin_amdgcn_sdot4((int)(((w_) >> 4) & 0x0F0F0F0Fu), (int)(xh_), a_, false); } while (0)
#define PS_DOT16(k_, w_, x0_, x1_) do { _Pragma("unroll") for (int i_ = 0; i_ < 16; ++i_) { int a_ = A[k_][i_]; PS_D4(a_, w_[i_].x, x0_.x, x0_.y); PS_D4(a_, w_[i_].y, x0_.z, x0_.w); \
            PS_D4(a_, w_[i_].z, x1_.x, x1_.y); PS_D4(a_, w_[i_].w, x1_.z, x1_.w); A[k_][i_] = a_; } } while (0)
        PS_ISSUE16(wa, UQs, 0); PS_XS(xa0, xa1, 0, 0);
#pragma unroll 1
        for (int s = 0; s < 16; ++s) {
            asm volatile("" ::: "memory");
            const unsigned char* us = UQs + (size_t)s * SLICE_BYTES;
            const int sn = s + 1 < 16 ? s + 1 : 15;
            const unsigned char* usn = UQs + (size_t)sn * SLICE_BYTES;
            PS_ISSUE16(wb, us, 1); PS_XS(xb0, xb1, s, 1);
            PS_DOT16(0, wa, xa0, xa1);
            PS_ISSUE16(wa, us, 2); PS_XS(xa0, xa1, s, 2);
            PS_DOT16(1, wb, xb0, xb1);
            PS_ISSUE16(wb, us, 3); PS_XS(xb0, xb1, s, 3);
            PS_DOT16(2, wa, xa0, xa1);
            PS_ISSUE16(wa, usn, 0); PS_XS(xa0, xa1, sn, 0);
            PS_DOT16(3, wb, xb0, xb1);
        }
#undef PS_ISSUE16
#undef PS_XS
#undef PS_D4
#undef PS_DOT16
    }
#else
    {
        v4u wa[16], wb[16], xa, xb;
#define PS_ISSUE16(dst, base, k_) do { _Pragma("unroll") for (int i_ = 0; i_ < 16; ++i_) dst[i_] = *(const GAS v4u*)((base) + RI[((k_) * 16 + i_) * 64]); } while (0)
#define PS_XS(s_, k_) (*(const GAS v4u*)(XQ + (size_t)tok[k_] * DM + 128 * (s_) + 16 * c))
#define PS_DOT16(k_, w_, x_) do { _Pragma("unroll") for (int i_ = 0; i_ < 16; ++i_) { int a_ = A[k_][i_]; a_ = __builtin_amdgcn_sdot4((int)w_[i_].x, (int)x_.x, a_, false); a_ = __builtin_amdgcn_sdot4((int)w_[i_].y, (int)x_.y, a_, false); \
            a_ = __builtin_amdgcn_sdot4((int)w_[i_].z, (int)x_.z, a_, false); a_ = __builtin_amdgcn_sdot4((int)w_[i_].w, (int)x_.w, a_, false); A[k_][i_] = a_; } } while (0)
        PS_ISSUE16(wa, UQs, 0); xa = PS_XS(0, 0);
#pragma unroll 1
        for (int s = 0; s < 32; ++s) {
            asm volatile("" ::: "memory");
            const unsigned char* us = UQs + (size_t)s * SLICE_BYTES;
            const int sn = s + 1 < 32 ? s + 1 : 31;
            const unsigned char* usn = UQs + (size_t)sn * SLICE_BYTES;
            PS_ISSUE16(wb, us, 1); xb = PS_XS(s, 1);
            PS_DOT16(0, wa, xa);
            PS_ISSUE16(wa, us, 2); xa = PS_XS(s, 2);
            PS_DOT16(1, wb, xb);
            PS_ISSUE16(wb, us, 3); xb = PS_XS(s, 3);
            PS_DOT16(2, wa, xa);
            PS_ISSUE16(wa, usn, 0); xa = PS_XS(sn, 0);
            PS_DOT16(3, wb, xb);
        }
#undef PS_ISSUE16
#undef PS_XS
#undef PS_DOT16
    }
#endif
#ifdef PROBE_USWEEP
    {
        int A2[4][16];
#pragma unroll
        for (int k = 0; k < 4; ++k)
#pragma unroll
            for (int i = 0; i < 16; ++i) A2[k][i] = 0;
        v4u wb0[8], wb1[8], xs, xsn;
        PS_ISSUE(wb0, UQs, 0, 0); xs = *(const GAS v4u*)(XQ + (size_t)tok[0] * DM + 16 * c);
#pragma unroll 1
        for (int s = 0; s < 32; ++s) {
            asm volatile("" ::: "memory");
            const unsigned char* us = UQs + (size_t)s * SLICE_BYTES;
            const int sn = s + 1 < 32 ? s + 1 : 31;
            const unsigned char* usn = UQs + (size_t)sn * SLICE_BYTES;
#pragma unroll
            for (int k = 0; k < 4; ++k) {
                PS_ISSUE(wb1, us, k, 1);
#pragma unroll
                for (int i = 0; i < 8; ++i) { int a = A2[k][i]; a = __builtin_amdgcn_sdot4((int)wb0[i].x, (int)xs.x, a, false); a = __builtin_amdgcn_sdot4((int)wb0[i].y, (int)xs.y, a, false);
                    a = __builtin_amdgcn_sdot4((int)wb0[i].z, (int)xs.z, a, false); a = __builtin_amdgcn_sdot4((int)wb0[i].w, (int)xs.w, a, false); A2[k][i] = a; }
                if (k < 3) { PS_ISSUE(wb0, us, k + 1, 0); xsn = *(const GAS v4u*)(XQ + (size_t)tok[k + 1 < 4 ? k + 1 : 3] * DM + 128 * s + 16 * c); }
                else { PS_ISSUE(wb0, usn, 0, 0); xsn = *(const GAS v4u*)(XQ + (size_t)tok[0] * DM + 128 * sn + 16 * c); }
#pragma unroll
                for (int i = 0; i < 8; ++i) { int a = A2[k][8 + i]; a = __builtin_amdgcn_sdot4((int)wb1[i].x, (int)xs.x, a, false); a = __builtin_amdgcn_sdot4((int)wb1[i].y, (int)xs.y, a, false);
                    a = __builtin_amdgcn_sdot4((int)wb1[i].z, (int)xs.z, a, false); a = __builtin_amdgcn_sdot4((int)wb1[i].w, (int)xs.w, a, false); A2[k][8 + i] = a; }
                xs = xsn;
            }
        }
#pragma unroll
        for (int k = 0; k < 4; ++k)
#pragma unroll
            for (int i = 0; i < 16; ++i) asm volatile("" :: "v"(A2[k][i]));
    }
#endif
#ifdef PROBE_SWEEP
    asm volatile("s_waitcnt vmcnt(0)" ::: "memory"); const unsigned long long tsw1 = __builtin_amdgcn_s_memrealtime();
#endif
    float W[4][16], wsum[4];
#ifdef VF16
    unsigned Wp[4][8]; float usc[4];
    typedef _Float16 h2_t __attribute__((ext_vector_type(2)));
#endif
#pragma unroll
    for (int k = 0; k < 4; ++k) {
        const float sx = SX[tok[k]]; float ws_ = 0.f;
#pragma unroll
        for (int i = 0; i < 16; ++i) {
            int a = A[k][i]; a += __shfl_xor(a, 1); a += __shfl_xor(a, 2); a += __shfl_xor(a, 4);
            const int e = IDX[(size_t)tok[k] * 128 + 8 * i + g];
#ifdef U4
            const float w = gelu_erf(((float)a - 7.5f * (float)((const int*)(SX + T_TOK))[tok[k]]) * sx * SU[e]) * GATE[(size_t)tok[k] * 128 + 8 * i + g] * SV[e];
#else
            const float w = gelu_erf((float)a * sx * SU[e]) * GATE[(size_t)tok[k] * 128 + 8 * i + g] * SV[e];
#endif
            W[k][i] = w; ws_ += w;
        }
        ws_ += __shfl_xor(ws_, 8); ws_ += __shfl_xor(ws_, 16); ws_ += __shfl_xor(ws_, 32);
        wsum[k] = ws_;
#ifdef VF16
        {
            float wm = 0.f;
#pragma unroll
            for (int i = 0; i < 16; ++i) wm = fmaxf(wm, fabsf(W[k][i]));
            wm = fmaxf(wm, __shfl_xor(wm, 8)); wm = fmaxf(wm, __shfl_xor(wm, 16)); wm = fmaxf(wm, __shfl_xor(wm, 32));
            const int ex = wm > 0.f ? __builtin_amdgcn_frexp_expf(wm) : 14;
            const float alpha = __builtin_amdgcn_ldexpf(1.0f, 14 - ex);
            usc[k] = __builtin_amdgcn_ldexpf(1.0f, 24 - (14 - ex));
#pragma unroll
            for (int p = 0; p < 8; ++p) { const _Float16 h0 = (_Float16)(W[k][2 * p] * alpha), h1 = (_Float16)(W[k][2 * p + 1] * alpha);
                Wp[k][p] = (unsigned)__builtin_bit_cast(unsigned short, h0) | ((unsigned)__builtin_bit_cast(unsigned short, h1) << 16); }
        }
#endif
    }
    float ssq[4] = {0.f, 0.f, 0.f, 0.f};
    const bool g0 = (g & 1) != 0, g1 = (g & 2) != 0, g2 = (g & 4) != 0;
    const int colsub = 16 * c + 8 * (g & 1) + 4 * ((g >> 1) & 1) + 2 * ((g >> 2) & 1);
#ifndef NO_VSWEEP
    {
        v4u wb0[8], wb1[8];
#ifdef VF16
        int riA[8], riB[8];
#define PS_RI(dst, k_, h_) do { _Pragma("unroll") for (int i_ = 0; i_ < 8; ++i_) dst[i_] = RI[((k_) * 16 + 8 * (h_) + i_) * 64]; } while (0)
#define PS_LD(dst, base, ri_) do { _Pragma("unroll") for (int i_ = 0; i_ < 8; ++i_) dst[i_] = *(const GAS v4u*)((base) + ri_[i_]); } while (0)
        PS_RI(riB, 0, 1);
#endif
        PS_ISSUE(wb0, VQs, 0, 0);
#pragma unroll 1
        for (int s = 0; s < 32; ++s) {
            asm volatile("" ::: "memory");
            const unsigned char* vs = VQs + (size_t)s * SLICE_BYTES;
            const int sn = s + 1 < 32 ? s + 1 : 31;
            const unsigned char* vsn = VQs + (size_t)sn * SLICE_BYTES;
#pragma unroll
            for (int k = 0; k < 4; ++k) {
                float acc[16];
#ifdef VF16
                PS_LD(wb1, vs, riB);
                if (k < 3) PS_RI(riA, k + 1, 0); else PS_RI(riA, 0, 0);
                __builtin_amdgcn_sched_barrier(0);
#else
                PS_ISSUE(wb1, vs, k, 1);
#endif
                const unsigned hb = *(const GAS unsigned*)(Hres + (size_t)tok[k] * DM + 128 * s + colsub);
                f32x2 hv; hv.x = bflo(hb); hv.y = bfhi(hb);
#ifdef VF16
                unsigned ac2[8];
#pragma unroll
                for (int b = 0; b < 8; ++b) ac2[b] = 0u;
#define PS_ROWH(wv_, i_) do { const unsigned wp_ = Wp[k][(i_) >> 1]; \
                    _Pragma("unroll") for (int q = 0; q < 4; ++q) { const unsigned u = wv_[q]; \
                        const unsigned x0 = __builtin_amdgcn_perm(u, 0u, 0x0C050C04u), x1 = __builtin_amdgcn_perm(u, 0u, 0x0C070C06u); \
                        if ((i_) & 1) { pkfma16_hi(ac2[2 * q], x0, wp_); pkfma16_hi(ac2[2 * q + 1], x1, wp_); } else { pkfma16_lo(ac2[2 * q], x0, wp_); pkfma16_lo(ac2[2 * q + 1], x1, wp_); } } } while (0)
#pragma unroll
                for (int i = 0; i < 8; ++i) PS_ROWH(wb0[i], i);
                if (k < 3) { PS_LD(wb0, vs, riA); PS_RI(riB, k + 1, 1); } else { PS_LD(wb0, vsn, riA); PS_RI(riB, 0, 1); }
                __builtin_amdgcn_sched_barrier(0);
#pragma unroll
                for (int i = 0; i < 8; ++i) PS_ROWH(wb1[i], 8 + i);
#undef PS_ROWH
#pragma unroll
                for (int b = 0; b < 8; ++b) { const h2_t hv2 = __builtin_bit_cast(h2_t, ac2[b]); acc[2 * b] = (float)hv2.x * usc[k]; acc[2 * b + 1] = (float)hv2.y * usc[k]; }
#else
#pragma unroll
                for (int b = 0; b < 16; ++b) acc[b] = 0.f;
#pragma unroll
                for (int i = 0; i < 8; ++i) { const float w = W[k][i];
#pragma unroll
                    for (int q = 0; q < 4; ++q) { const unsigned u = wb0[i][q];
                        fmac_s(acc[4 * q + 0], w, (float)(u & 0xffu)); fmac_s(acc[4 * q + 1], w, (float)((u >> 8) & 0xffu)); fmac_s(acc[4 * q + 2], w, (float)((u >> 16) & 0xffu)); fmac_s(acc[4 * q + 3], w, (float)(u >> 24)); } }
                if (k < 3) { PS_ISSUE(wb0, vs, k + 1, 0); } else { PS_ISSUE(wb0, vsn, 0, 0); }
#pragma unroll
                for (int i = 0; i < 8; ++i) { const float w = W[k][8 + i];
#pragma unroll
                    for (int q = 0; q < 4; ++q) { const unsigned u = wb1[i][q];
                        fmac_s(acc[4 * q + 0], w, (float)(u & 0xffu)); fmac_s(acc[4 * q + 1], w, (float)((u >> 8) & 0xffu)); fmac_s(acc[4 * q + 2], w, (float)((u >> 16) & 0xffu)); fmac_s(acc[4 * q + 3], w, (float)(u >> 24)); } }
#endif
                float r8[8], r4[4], r2[2];
#pragma unroll
                for (int j = 0; j < 8; ++j) { const float snd = g0 ? acc[j] : acc[8 + j], kp = g0 ? acc[8 + j] : acc[j];
                    r8[j] = kp + __uint_as_float((unsigned)__builtin_amdgcn_update_dpp(0, (int)__float_as_uint(snd), 0x128  , 0xf, 0xf, false)); }
#pragma unroll
                for (int j = 0; j < 4; ++j) { const auto sw = __builtin_amdgcn_permlane16_swap(__float_as_uint(r8[j]), __float_as_uint(r8[4 + j]), false, false); r4[j] = __uint_as_float(sw[0]) + __uint_as_float(sw[1]); }
#pragma unroll
                for (int j = 0; j < 2; ++j) { const auto sw = __builtin_amdgcn_permlane32_swap(__float_as_uint(r4[j]), __float_as_uint(r4[2 + j]), false, false); r2[j] = __uint_as_float(sw[0]) + __uint_as_float(sw[1]); }
                const float corr = -128.f * wsum[k];
                f32x2 o; o.x = hv.x + r2[0] + corr; o.y = hv.y + r2[1] + corr;
                ssq[k] += o.x * o.x + o.y * o.y;
                *(GAS unsigned*)(Hres + (size_t)tok[k] * DM + 128 * s + colsub) = cvtpk(o.x, o.y);
            }
        }
    }
#endif
#undef PS_ISSUE
    asm volatile("s_waitcnt vmcnt(0)" ::: "memory");
#ifdef PROBE_SWEEP
    const unsigned long long tsw2 = __builtin_amdgcn_s_memrealtime();
#endif
#pragma unroll 1
    for (int k = 0; k < 4; ++k) {
        const float rstd = 1.0f / sqrtf(wave_sum(ssq[k]) * (1.f / DM) + RMS_EPS);
        const GAS v4u* hb = (const GAS v4u*)(Hres + (size_t)tok[k] * DM) + lane;
        float* orow = hout + (size_t)tok[k] * DM + 8 * lane; const float* gp = gfin + 8 * lane;
#pragma unroll
        for (int j = 0; j < 8; ++j) { const v4u v = hb[64 * j]; const f32x4 g0 = *(const GAS f32x4*)(gp + 512 * j), g1 = *(const GAS f32x4*)(gp + 512 * j + 4);
            f32x4 o0, o1; o0.x = bflo(v.x) * rstd * g0.x; o0.y = bfhi(v.x) * rstd * g0.y; o0.z = bflo(v.y) * rstd * g0.z; o0.w = bfhi(v.y) * rstd * g0.w;
            o1.x = bflo(v.z) * rstd * g1.x; o1.y = bfhi(v.z) * rstd * g1.y; o1.z = bflo(v.w) * rstd * g1.z; o1.w = bfhi(v.w) * rstd * g1.w;
            *(GAS f32x4*)(orow + 512 * j) = o0; *(GAS f32x4*)(orow + 512 * j + 4) = o1; }
    }
#ifdef PROBE_SWEEP
    if (gw == 0 && lane == 0) { asm volatile("s_waitcnt vmcnt(0)" ::: "memory");
        const unsigned long long tsw3 = __builtin_amdgcn_s_memrealtime();
        const unsigned long long d = PROBE_SWEEP == 0 ? tsw1 - tsw0 : (PROBE_SWEEP == 1 ? tsw2 - tsw1 : tsw3 - tsw2);
        const float val = PROBE_SWEEP == 4 ? (float)(clock64() - tck0) / (float)(tsw3 - tsw0) / 40.f : (PROBE_SWEEP == 3 ? (float)(tsw3 - tsw0) * (0.01f / 1000.f) : (float)d / (float)(tsw3 - tsw0));
        hout[(size_t)tok[0] * DM] += 0.2f + 0.25f * val; }
#endif
#ifdef PROBE_PHASE
    if (gw == 0 && lane == 0) { asm volatile("s_waitcnt vmcnt(0)" ::: "memory");
        const unsigned long long* ps = (const unsigned long long*)((const unsigned char*)SU - WS_SU + 458752 + 64);
        const unsigned long long tend = (PROBE_END == 13) ? __builtin_amdgcn_s_memrealtime() : ps[PROBE_END];
        hout[(size_t)tok[0] * DM] += 0.2f + 0.25f * ((float)(tend - ps[PROBE_START]) * 0.0131f / (float)PROBE_SCALE); }
#endif
#ifdef PROBE_TIMING
    if (gw == 0 && lane == 0) { asm volatile("s_waitcnt vmcnt(0)" ::: "memory");
        const unsigned long long* pt = (const unsigned long long*)((const unsigned char*)SU - WS_SU + 458752);
        const float tot = (float)pt[3]; const float frac = (float)pt[PROBE_METRIC] / tot;
        hout[(size_t)tok[0] * DM] += 0.2f + 0.25f * frac; }
#endif
}

struct Args { const float* in[21]; float* out; unsigned char* ws; int ph_lo, ph_hi; };
static_assert(sizeof(Args) == 21 * 8 + 8 + 8 + 8, "Args has no padding");

__global__ void __launch_bounds__(NWAVES * 64, 2) hymba_fwd(Args args) {
    extern __shared__ __attribute__((aligned(16))) unsigned char lds_raw[];
    LAS unsigned char* lds = (LAS unsigned char*)lds_raw;
    volatile LAS unsigned* MISC = (volatile LAS unsigned*)(lds + MISC_OFF);
    const int tid = threadIdx.x, lane = tid & 63, wave = __builtin_amdgcn_readfirstlane(tid >> 6);
    const int G = gridDim.x; const int bx = blockIdx.x;
    const int vcu = (G % 8 == 0) ? (bx % 8) * (G / 8) + bx / 8 : bx;
    unsigned char* ws = args.ws;
    gu32* ctl = (gu32*)(ws + WS_CTL);
    for (int u = tid; u < (LDS_BYTES - LDSCTL_OFF) / 4; u += NWAVES * 64) ((LAS unsigned*)(lds + LDSCTL_OFF))[u] = 0u;
    __syncthreads();
    XcdBarrier bar = xcd_barrier_post((unsigned*)(ctl + CW_BAR), MISC + 8);
    const int lo = args.ph_lo, hi = args.ph_hi;
#ifdef PH_ONLY
#define IN(k) ((k) == PH_ONLY && lo <= (k) && (k) < hi)
#else
#define IN(k) (lo <= (k) && (k) < hi)
#endif
#ifndef DUP_PHASE
#define DUP_PHASE -1
#endif
#define REP(k) for (int rep_ = 0; rep_ < ((k) == DUP_PHASE ? 2 : 1); ++rep_)
#ifdef PROBE_PHASE
#define PSTAMP(i_) do { if (blockIdx.x == 0 && tid == 0) ((unsigned long long*)(ws + 458752 + 64))[i_] = __builtin_amdgcn_s_memrealtime(); } while (0)
#else
#define PSTAMP(i_) do {} while (0)
#endif
#define SEAM(k) do { if (IN(k) && IN((k) + 1)) xcd_barrier(bar); PSTAMP((k) + 1); } while (0)

    const float* x = args.in[0]; const float* mem = args.in[1]; const float* norm_mix = args.in[2]; const float* w_in = args.in[3];
    const float* swa_sink = args.in[4]; const float* nat_rel_bias = args.in[5]; const float* out_norm_swa = args.in[6]; const float* out_norm_nat = args.in[7];
    const float* w_out = args.in[8]; const float* norm_mem_q = args.in[9]; const float* norm_mem_kv = args.in[10]; const float* w_mem_q = args.in[11];
    const float* w_mem_k = args.in[12]; const float* w_mem_v = args.in[13]; const float* w_mem_o = args.in[14]; const float* norm_ffn = args.in[15];
    const float* w_peer_q = args.in[16]; const float* peer_sub_keys = args.in[17]; const float* peer_u = args.in[18]; const float* peer_v = args.in[19];
    const float* norm_final = args.in[20];
    float* out = args.out;
    float* ropec = (float*)(ws + WS_ROPE); float* ropes = ropec + 2048 * 64;
    bf16* SKB = (bf16*)(ws + WS_SKB);
    bf16* WIN_T = (bf16*)(ws + WS_WIN); bf16* WOUT_T = (bf16*)(ws + WS_WOUT); bf16* WMQ_T = (bf16*)(ws + WS_WMQ); bf16* WMKV_T = (bf16*)(ws + WS_WMKV);
    bf16* WMO_T = (bf16*)(ws + WS_WMO); bf16* WPQ_T = (bf16*)(ws + WS_WPQ); bf16* UB = (bf16*)(ws + WS_UB); bf16* VB = (bf16*)(ws + WS_VB);
    bf16* XN = (bf16*)(ws + WS_XN); bf16* QKV = (bf16*)(ws + WS_QKV); bf16* OB = (bf16*)(ws + WS_OB); bf16* MEMN = (bf16*)(ws + WS_MEMN);
    bf16* KVM = (bf16*)(ws + WS_KVM); bf16* QM = (bf16*)(ws + WS_QM); bf16* OM = (bf16*)(ws + WS_OM); bf16* QP = (bf16*)(ws + WS_QP);
    int* IDX = (int*)(ws + WS_IDX); float* GATE = (float*)(ws + WS_GATE);
    float* SSQ1 = (float*)(ws + WS_SSQ1); float* SSQ2 = (float*)(ws + WS_SSQ2); float* SSQA = (float*)(ws + WS_SSQA); float* SSQB = (float*)(ws + WS_SSQB); float* SSQ0 = (float*)(ws + WS_SSQ0);
    unsigned* CM = (unsigned*)(ws + WS_CM); unsigned* CM2 = (unsigned*)(ws + WS_CM2); unsigned* CM3 = (unsigned*)(ws + WS_CM3);
    unsigned char* XQ = ws + WS_XQ; float* SX = (float*)(ws + WS_SX);
    unsigned char* UQ = ws + WS_UQ; unsigned char* VQ = ws + WS_VQ; float* SU = (float*)(ws + WS_SU); float* SV = (float*)(ws + WS_SV);
    const int gw = vcu * NWAVES + wave, NGW = G * NWAVES;

    PSTAMP(0);
    constexpr int I_IN = (DM / 64) * (INW / 32), I_OUT = (DM / 64) * (DM / 32), I_MQ = (DM / 64) * (MEMW / 32), I_MO = (MEMW / 64) * (DM / 32), I_PQ = (DM / 64) * (PQW / 32);
#ifdef QKV_I8
    constexpr int QR0 = 28160, QR1 = 28160;
#ifndef D1P0
#define D1P0 5120
#endif
#else
    constexpr int QR0 = 26624, QR1 = 28160;
#define D1P0 0
#endif
#ifdef WOUT_I8
#define D1_WOUT(r_) p0_transpose_item_i8(w_out, DM, DM, (unsigned char*)WOUT_T, CM2, scr, (r_), lane, out_norm_swa, out_norm_nat)
#else
#define D1_WOUT(r_) p0_transpose_item(w_out, DM, DM, WOUT_T, 0, scr, (r_), lane, out_norm_swa, out_norm_nat)
#endif
#define D1_ITEM(it_) do { int r = (it_); \
        if (r < I_OUT) { D1_WOUT(r); break; } r -= I_OUT; \
        if (r < I_MQ) { p0_transpose_item(w_mem_q, DM, MEMW, WMQ_T, 0, scr, r, lane, norm_mem_q, norm_mem_q + 2048); break; } r -= I_MQ; \
        if (r < I_MQ) { p0_transpose_item(w_mem_k, DM, MEMW, WMKV_T, 0, scr, r, lane); break; } r -= I_MQ; \
        p0_transpose_item(w_mem_v, DM, MEMW, WMKV_T, MEMW, scr, r, lane); } while (0)
#define QUANT_ROWS(first_, last_, w0_, nw_) quant_rows_strided((first_) + (w0_), (last_), (nw_), peer_u, peer_v, UQ, VQ, SU, SV, lane)
    if (IN(0)) REP(0) {
        LAS float* scr = (LAS float*)(lds + wave * 16384);
#ifdef DUP_P0A
        for (int rr_ = 0; rr_ < 2; ++rr_)
#endif
#ifdef QKV_I8
        { constexpr int C_IN = (DM / CMR) * (INW / 256), C_OUT = (DM / CMR) * (DM / 256), C_PQ = (DM / CMR) * (PQW / 256);
#if defined(PQ_I8)
          constexpr int C_ALL = C_IN + C_OUT + C_PQ;
#elif defined(WOUT_I8)
          constexpr int C_ALL = C_IN + C_OUT;
#else
          constexpr int C_ALL = C_IN;
#endif
          for (int it = gw; it < C_ALL; it += NGW) {
              if (it < C_IN) p0_colmax_rows(w_in, INW, CM, it, lane, norm_mix);
              else if (it < C_IN + C_OUT) p0_colmax_rows(w_out, DM, CM2, it - C_IN, lane, out_norm_swa, out_norm_nat);
              else p0_colmax_rows(w_peer_q, PQW, CM3, it - C_IN - C_OUT, lane, nullptr);
          } }
#if 0
#ifdef WOUT_I8
        for (int it = gw; it < I_OUT / CMK; it += NGW) p0_colmax_item(w_out, DM, CM2, it, lane, out_norm_swa, out_norm_nat);
#endif
#ifdef PQ_I8
        for (int it = gw; it < I_PQ / CMK; it += NGW) p0_colmax_item(w_peer_q, PQW, CM3, it, lane, nullptr);
#endif
#endif
        PSTAMP(14);
        xcd_barrier(bar);
        PSTAMP(15);
        for (int it = gw; it < I_IN; it += NGW) p0_transpose_item_i8(w_in, DM, INW, (unsigned char*)WIN_T, CM, scr, it, lane, norm_mix);
        PSTAMP(16);
        for (int m = gw; m < T_TOK; m += NGW) row_to_bf16_i8(x + (size_t)m * DM, XN + (size_t)m * DM, XQ + (size_t)m * DM, SSQ0 + m, lane);
        PSTAMP(17);
        for (int it = gw; it < D1P0; it += NGW) D1_ITEM(it);
        PSTAMP(18);
#else
        for (int it = gw; it < I_IN; it += NGW) p0_transpose_item(w_in, DM, INW, WIN_T, 0, scr, it, lane, norm_mix, norm_mix + 2048);
        for (int m = gw; m < T_TOK; m += NGW) row_to_bf16_ssq(x + (size_t)m * DM, XN + (size_t)m * DM, SSQ0 + m, lane);
#endif
        for (int m = gw; m < NBATCH * MEMLEN; m += NGW) rms_row_to_bf16(mem + (size_t)m * DM, norm_mem_kv, MEMN + (size_t)m * DM, lane);
#ifdef DUP_P0C
        for (int rr_ = 0; rr_ < 2; ++rr_)
#endif
        QUANT_ROWS(0, QR0, gw, NGW);
        PSTAMP(19);
#ifdef DUP_P0C_NOST
        quant_rows_strided<true>(gw, QR0, NGW, peer_u, peer_v, UQ, VQ, SU, SV, lane);
#endif
        for (int e = gw * 64 + lane; e < 4 * T_TOK; e += NGW * 64) SSQ1[e] = 0.f;
        for (int e = (gw * 64 + lane) * 4; e < 8 * 2 * 128 * 128; e += NGW * 64 * 4) { const f32x4 a = *(const GAS f32x4*)(peer_sub_keys + e); u32x2 w; w.x = cvtpk(a.x, a.y); w.y = cvtpk(a.z, a.w); *(GAS u32x2*)(SKB + e) = w; }
        for (int e = gw * 64 + lane; e < 2048 * 64; e += NGW * 64) {
            const int pos = e >> 6, i = e & 63;
            const float inv = fexp2(-(float)i * (13.287712379549449f / 64.0f));
            const float ang = (float)pos * inv;
            const float rev = ang * 0.15915494309189535f; const float fr = rev - floorf(rev);
            ropec[e] = __builtin_amdgcn_cosf(fr); ropes[e] = __builtin_amdgcn_sinf(fr);
        }
    }
    SEAM(0);
    if (IN(1)) REP(1) {
#ifdef QKV_I8
        { pg8::Gemm g{(const bf16*)XQ, WIN_T, T_TOK, INW, DM / 2}; pg8::StaticOrder S; S.init(T_TOK, INW, G, bx);
          EpiBf16I8 E{QKV, INW, SSQ0, CM};
          pg8::gemm_phase<EpiBf16I8, pg8::StaticOrder, true, true, false, true>(lds, g, S, E); }
#else
        { pg8::Gemm g{XN, WIN_T, T_TOK, INW, DM}; pg8::StaticOrder S; S.init(T_TOK, INW, G, bx);
          EpiBf16RowScale E{QKV, INW, SSQ0};
          pg8::gemm_phase<EpiBf16RowScale, pg8::StaticOrder, true, true>(lds, g, S, E); }
#endif
        if (bx >= G / 2) {
            LAS float* scr = (LAS float*)(lds + wave * 16384);
            const int w0 = (bx - G / 2) * NWAVES + wave, nw = (G - G / 2) * NWAVES;
            for (int it = D1P0 + w0; it < I_OUT + 3 * I_MQ; it += nw) D1_ITEM(it);
            QUANT_ROWS(QR0, QR1, w0, nw);
        }
    }
    SEAM(1);
    if (IN(2)) REP(2) {
        for (int u = vcu; u < 1024; u += G) {
#ifndef NO_SWA
            if (u < 512) swa_unit(lds, u, QKV, OB, swa_sink, ropec, ropes, SSQA);
#endif
#ifndef NO_NAT
            if (u >= 512) nat_unit(lds, u - 512, QKV, OB, nat_rel_bias, SSQB);
#endif
#ifdef PROBE_SWA2
            if (u < 512) swa_unit<true>(lds, u, QKV, (bf16*)(ws + WS_QP), swa_sink, ropec, ropes, (float*)(ws + 393216));
#endif
#ifdef PROBE_NAT2
            if (u >= 512) nat_unit(lds, u - 512, QKV, (bf16*)(ws + WS_QP), nat_rel_bias, (float*)(ws + 393216));
#endif
        }
    }
    SEAM(2);
#ifdef WOUT_I8
    if (IN(3)) { unsigned char* OQ = (unsigned char*)QKV;
        for (int m = gw; m < T_TOK; m += NGW) mix_row_to_i8(OB + (size_t)m * DM, SSQA[m], SSQB[m], OQ + (size_t)m * DM, SSQ0 + m, lane); }
    SEAM(3);
    if (IN(4)) REP(4) {
        pg8::Gemm g{(const bf16*)QKV, WOUT_T, T_TOK, DM, DM / 2}; pg8::StaticOrder S; S.init(T_TOK, DM, G, bx);
        EpiResHI8 E{XN, SSQ1, DM, SSQ0, CM2};
        pg8::gemm_phase<EpiResHI8, pg8::StaticOrder, true, true, false, true>(lds, g, S, E);
    }
#else
    if (IN(4)) REP(4) {
        pg8::Gemm g{OB, WOUT_T, T_TOK, DM, DM}; pg8::StaticOrder S; S.init(T_TOK, DM, G, bx);
        EpiResHMid E{XN, SSQ1, DM, SSQA, SSQB, (LAS float*)(lds + RING_BYTES + 1024)};
        pg8::gemm_phase<EpiResHMid, pg8::StaticOrder, true, true, true>(lds, g, S, E);
    }
#endif
    SEAM(4);
    if (IN(6)) REP(6) {
        pg8::Gemm g{XN, WMQ_T, T_TOK, MEMW, DM}; pg8::StaticOrder S; S.init(T_TOK, MEMW, G, bx);
        EpiBf16RowScale E{QM, MEMW, SSQ1};
        pg8::gemm_phase<EpiBf16RowScale, pg8::StaticOrder, true, true>(lds, g, S, E);
        { pg8::Gemm g2{MEMN, WMKV_T, NBATCH * MEMLEN, 2 * MEMW, DM}; pg8::StaticOrder S2; S2.init(NBATCH * MEMLEN, 2 * MEMW, G, (bx + G / 2) % G);
          pg8::EpiBf16<0> E2{KVM, 2 * MEMW, nullptr, 0, 0, 1.f};
          pg8::gemm_phase<pg8::EpiBf16<0>, pg8::StaticOrder, true, true>(lds, g2, S2, E2); }
        if (bx >= G / 2 + 32) {
            LAS float* scr = (LAS float*)(lds + wave * 16384);
            const int w0 = (bx - (G / 2 + 32)) * NWAVES + wave, nw = (G - (G / 2 + 32)) * NWAVES;
            for (int it = w0; it < I_MO + I_PQ; it += nw) {
                if (it < I_MO) p0_transpose_item(w_mem_o, MEMW, DM, WMO_T, 0, scr, it, lane);
#ifdef PQ_I8
                else p0_transpose_item_i8(w_peer_q, DM, PQW, (unsigned char*)WPQ_T, CM3, scr, it - I_MO, lane, nullptr);
#else
                else p0_transpose_item(w_peer_q, DM, PQW, WPQ_T, 0, scr, it - I_MO, lane, norm_ffn, norm_ffn + 2048);
#endif
            }
            QUANT_ROWS(QR1, 2 * NEXP, w0, nw);
        }
    }
    SEAM(6);
    if (IN(7)) REP(7) { for (int u = bx; u < 256; u += G) mem_unit(lds, u, QM, KVM, OM); }
    SEAM(7);
    if (IN(8)) {
        pg8::Gemm g{OM, WMO_T, T_TOK, DM, MEMW}; pg8::StaticOrder S; S.init(T_TOK, DM, G, bx);
        EpiResH E{XN, SSQ2, DM};
        pg8::gemm_phase<EpiResH, pg8::StaticOrder, true, true>(lds, g, S, E);
    }
    SEAM(8);
#ifdef PQ_I8
    if (IN(9)) { for (int m = gw; m < T_TOK; m += NGW) quant_token(m, XN, norm_ffn, SSQ2, XQ, SX, lane); }
    SEAM(9);
#endif
    if (IN(10)) REP(10) {
#ifdef PQ_I8
        pg8::Gemm g{(const bf16*)XQ, WPQ_T, T_TOK, PQW, DM / 2}; pg8::StaticOrder S; S.init(T_TOK, PQW, G, bx);
        EpiBf16I8 E{QP, PQW, SX, CM3};
        pg8::gemm_phase<EpiBf16I8, pg8::StaticOrder, true, true, false, true>(lds, g, S, E);
#else
        pg8::Gemm g{XN, WPQ_T, T_TOK, PQW, DM}; pg8::StaticOrder S; S.init(T_TOK, PQW, G, bx);
        EpiBf16RowScale E{QP, PQW, SSQ2};
        pg8::gemm_phase<EpiBf16RowScale, pg8::StaticOrder, true, true>(lds, g, S, E);
#endif
#ifdef FUSE_ROUTE
        { pg8::Unit un; for (int i = 0; S.next(i, un); ++i) { asm volatile("s_waitcnt vmcnt(0)" ::: "memory"); route_unit(lds, un.pm * 8 + un.pn, QP, SKB, IDX, GATE); } }
#ifndef PQ_I8
        for (int m = gw; m < T_TOK; m += NGW) quant_token(m, XN, norm_ffn, SSQ2, XQ, SX, lane);
#endif
#endif
    }
#ifdef FUSE_ROUTE
    if (IN(10) && IN(12)) { xcd_barrier(bar); PSTAMP(12); }
#else
    SEAM(10);
    if (IN(11)) REP(11) { for (int u = bx; u < 256; u += G) route_unit(lds, u, QP, SKB, IDX, GATE);
        for (int m = gw; m < T_TOK; m += NGW) quant_token(m, XN, norm_ffn, SSQ2, XQ, SX, lane); }
    SEAM(11);
#endif
    if (IN(12)) { __syncthreads(); peer_sweep(lds, wave, gw, NGW, XQ, SX, IDX, GATE, UQ, VQ, SU, SV, XN, out, norm_final, lane); }
#undef IN
#undef SEAM
}

constexpr int N_PHASES = 13;
#ifndef MK_N_LAUNCHES
#define MK_N_LAUNCHES 1
#endif

extern "C" void kernel_launch(void* const* d_in, const int* in_sizes, int n_in, void* d_out, int out_size, void* d_ws, size_t ws_size, hipStream_t stream) {
    static int grid = 0;
    if (grid == 0) {
        if (n_in != 21 || in_sizes[0] != T_TOK * DM || out_size != T_TOK * DM || ws_size < WS_END) { fprintf(stderr, "kernel_launch: unexpected shapes (n_in %d in0 %d out %d ws %zu)\n", n_in, n_in > 0 ? in_sizes[0] : -1, out_size, ws_size); grid = -1; return; }
        int dev = 0, cus = 0, per_cu = 0;
        if (hipGetDevice(&dev) != hipSuccess || hipDeviceGetAttribute(&cus, hipDeviceAttributeMultiprocessorCount, dev) != hipSuccess) { grid = -1; return; }
        if (hipFuncSetAttribute((const void*)hymba_fwd, hipFuncAttributeMaxDynamicSharedMemorySize, LDS_BYTES) != hipSuccess) { fprintf(stderr, "kernel_launch: hipFuncSetAttribute failed\n"); grid = -1; return; }
        if (hipOccupancyMaxActiveBlocksPerMultiprocessor(&per_cu, (const void*)hymba_fwd, NWAVES * 64, LDS_BYTES) != hipSuccess || per_cu < 1) fprintf(stderr, "kernel_launch: occupancy query says %d\n", per_cu);
        (void)hipGetLastError();
        grid = cus;
    }
    if (grid < 0) return;
    if (hipMemsetAsync((char*)d_ws + WS_CTL, 0, CTL_ZERO_BYTES, stream) != hipSuccess) return;
    Args a{};
    for (int i = 0; i < 21; ++i) a.in[i] = (const float*)d_in[i];
    a.out = (float*)d_out; a.ws = (unsigned char*)d_ws;
#if MK_N_LAUNCHES == 1
    a.ph_lo = 0; a.ph_hi = N_PHASES;
    hipLaunchKernelGGL(hymba_fwd, dim3(grid), dim3(NWAVES * 64), LDS_BYTES, stream, a);
#else
    for (int p = 0; p < N_PHASES; ++p) { a.ph_lo = p; a.ph_hi = p + 1; hipLaunchKernelGGL(hymba_fwd, dim3(grid), dim3(NWAVES * 64), LDS_BYTES, stream, a); }
#endif
}
```

```cpp
#include <hip/hip_runtime.h>
#include <cstdio>
#include <cstdint>
namespace pg8 {
#define PG8_LAS __attribute__((address_space(3)))
typedef unsigned short bf16_t;
typedef short bf16x8 __attribute__((ext_vector_type(8)));
typedef float f32x4 __attribute__((ext_vector_type(4)));
typedef unsigned u32x4 __attribute__((ext_vector_type(4)));
constexpr int BM = 256, BK = 64, HALF = 128, HTB = HALF * BK * 2  , STAGE_BYTES = 8 * HTB, NXCD = 8, WGM = 8;

__host__ __device__ __forceinline__ int lds_byte(int r, int c) { const int st = (r >> 4) * 2 + (c >> 5), rr = r & 15, cc = c & 31, ob = rr * 64 + cc * 2; return st * 1024 + (ob ^ (((ob >> 9) & 1) << 5)); }
__host__ __device__ __forceinline__ void stage_rc(int b, int& R, int& C) { const int st = b / 1024, sb = b % 1024, swz = sb ^ (((sb >> 9) & 1) << 5); R = (st >> 1) * 16 + swz / 64; C = (st & 1) * 32 + (swz % 64) / 2; }
__host__ __device__ __forceinline__ int perm32(int rho) { const int n = rho >> 4, i = rho & 15; return 8 * (i >> 2) + 4 * n + (i & 3); }

struct Unit { int pm, pn; };
struct Gemm { const bf16_t* A; const bf16_t* Bt; int M, N, K; };

struct StaticOrder {
    int nM, nN, nwg, G, c;
    __host__ __device__ void init(int M, int N, int G_, int c_) { nM = M / BM; nN = N / BM; nwg = nM * nN; G = G_; c = c_; }
    __host__ __device__ bool next(int i, Unit& u) const {
        const long L = (long)i * G + c; if (L >= nwg) return false;
        int wgid = (int)L; { const int q = nwg / NXCD, r = nwg % NXCD, xcd = wgid % NXCD, off = wgid / NXCD; wgid = (xcd < r ? xcd * (q + 1) : r * (q + 1) + (xcd - r) * q) + off; }
        const int nig = WGM * nN, gid = wgid / nig, fm = gid * WGM, gsz = (nM - fm) < WGM ? (nM - fm) : WGM;
        u.pm = fm + ((wgid % nig) % gsz); u.pn = (wgid % nig) / gsz; return true;
    }
    __device__ __forceinline__ void a_ready(const Unit&) const {}
    __device__ __forceinline__ void done(const Unit&) const {}
};

__device__ __forceinline__ unsigned cvt_pk_bf16(float lo, float hi) { unsigned r; asm volatile("v_cvt_pk_bf16_f32 %0, %1, %2" : "=v"(r) : "v"(lo), "v"(hi)); return r; }
typedef float f32x2 __attribute__((ext_vector_type(2)));
__device__ __forceinline__ f32x2 gelu_pk(f32x2 v) {
    const f32x2 av = __builtin_elementwise_abs(v), d = av * 0.2316418882f + 1.0f;
    f32x2 t; t.x = __builtin_amdgcn_rcpf(d.x); t.y = __builtin_amdgcn_rcpf(d.y);
    f32x2 q = t * 0.5307027145f + (-0.7265760135f); q = q * t + 0.7107068705f; q = q * t + (-0.142248368f); q = q * t + 0.127414796f; q = q * t;
    const f32x2 s = (v * v) * (-0.72134752044f);
    f32x2 e; e.x = __builtin_amdgcn_exp2f(s.x); e.y = __builtin_amdgcn_exp2f(s.y);
    const f32x2 m = v * (q * e), r = v - m;
    f32x2 o; o.x = v.x < 0.f ? m.x : r.x; o.y = v.y < 0.f ? m.y : r.y; return o;
}

template <int ACT  > struct EpiBf16 {
    static constexpr bool PERM = true, AFTER_DRAIN = false; static_assert(ACT == 0 || ACT == 1, "EpiBf16: ACT is 0 (none) or 1 (gelu_pk)");
    bf16_t* O; int ldc; const float* bias; int split_cols; size_t split_stride; float scale0;
    __device__ __forceinline__ void operator()(const f32x4 (&acc)[2][2][4][2], const Unit& u, int wr, int wc, int fr, int fq) const {
        const int row0 = u.pm * BM + wr * 64 + fr; int colt = u.pn * BM; bf16_t* base = O;
        float sc = 1.f; if (split_cols) { const int t = colt / split_cols; base += (size_t)t * split_stride; colt -= t * split_cols; if (t == 0) sc = scale0; }
        const int col0 = colt + wc * 32 + 8 * fq, bcol0 = u.pn * BM + wc * 32 + 8 * fq;
        f32x4 bv[2][2];
#pragma unroll
        for (int bj = 0; bj < 2; ++bj)
#pragma unroll
            for (int n = 0; n < 2; ++n) bv[bj][n] = bias ? *(const f32x4*)(bias + bcol0 + bj * HALF + 4 * n) : (f32x4){0.f, 0.f, 0.f, 0.f};
#pragma unroll
        for (int ai = 0; ai < 2; ++ai)
#pragma unroll
            for (int m = 0; m < 4; ++m) { bf16_t* rowp = base + (size_t)(row0 + ai * HALF + m * 16) * ldc + col0;
#pragma unroll
                for (int bj = 0; bj < 2; ++bj) { f32x4 v0 = acc[ai][bj][m][0] + bv[bj][0], v1 = acc[ai][bj][m][1] + bv[bj][1];
                    if (ACT == 1) { f32x2 a = gelu_pk((f32x2){v0[0], v0[1]}), b = gelu_pk((f32x2){v0[2], v0[3]}), c = gelu_pk((f32x2){v1[0], v1[1]}), d = gelu_pk((f32x2){v1[2], v1[3]});
                        v0 = (f32x4){a.x, a.y, b.x, b.y}; v1 = (f32x4){c.x, c.y, d.x, d.y}; }
                    v0 = v0 * sc; v1 = v1 * sc; u32x4 w; w.x = cvt_pk_bf16(v0[0], v0[1]); w.y = cvt_pk_bf16(v0[2], v0[3]); w.z = cvt_pk_bf16(v1[0], v1[1]); w.w = cvt_pk_bf16(v1[2], v1[3]);
                    *(u32x4*)(rowp + bj * HALF) = w; } }
    }
};

struct PanelStats {
    unsigned* xbuf;
    unsigned* cnt;
    unsigned* tmo;
    int ntn; float eps;
    unsigned code;
    __device__ __forceinline__ bool run(const f32x4 (&v)[2][2][4][2], const Unit& u, int wr, int wc, int fr, int fq, PG8_LAS unsigned char* lds, int wid, int lane) const {
        typedef float f32x2v __attribute__((ext_vector_type(2)));
        PG8_LAS f32x2v* P = (PG8_LAS f32x2v*)lds;
        PG8_LAS f32x2v* S = (PG8_LAS f32x2v*)(lds + 8192);
        PG8_LAS unsigned* flag = (PG8_LAS unsigned*)(lds + 8192 + 2048);
#pragma unroll
        for (int ai = 0; ai < 2; ++ai)
#pragma unroll
            for (int m = 0; m < 4; ++m) {
                float s = 0.f;
#pragma unroll
                for (int bj = 0; bj < 2; ++bj)
#pragma unroll
                    for (int n = 0; n < 2; ++n) { const f32x4 x = v[ai][bj][m][n]; s += (x[0] + x[1]) + (x[2] + x[3]); }
                s += __shfl_xor(s, 16); s += __shfl_xor(s, 32);
                const float mw = s * (1.0f / 64.0f); float q = 0.f;
#pragma unroll
                for (int bj = 0; bj < 2; ++bj)
#pragma unroll
                    for (int n = 0; n < 2; ++n) { const f32x4 d = v[ai][bj][m][n] - mw; q += (d[0] * d[0] + d[1] * d[1]) + (d[2] * d[2] + d[3] * d[3]); }
                q += __shfl_xor(q, 16); q += __shfl_xor(q, 32);
                if (fq == 0) P[(ai * HALF + wr * 64 + m * 16 + fr) * 4 + wc] = (f32x2v){mw, q};
            }
        asm volatile("s_waitcnt lgkmcnt(0)" ::: "memory"); __builtin_amdgcn_s_barrier(); asm volatile("" ::: "memory");
#if defined(BROKEN_EXCHANGE_NO_WAIT)
#warning BROKEN CONTROL BUILD: the row-statistics exchange does not wait; results are wrong by design
        if (blockIdx.x >= 64) { const long long t0_ = clock64(); while (clock64() - t0_ < 60000) __builtin_amdgcn_s_sleep(8); }
#endif
        const int row = wid * 32 + (lane & 31);
        if (lane < 32) {
            const f32x2v a = P[row * 4 + 0], b = P[row * 4 + 1], c = P[row * 4 + 2], d = P[row * 4 + 3];
            const float mt = (a.x + b.x + c.x + d.x) * 0.25f;
            const float da = a.x - mt, db = b.x - mt, dc = c.x - mt, dd = d.x - mt;
            const float m2 = (a.y + b.y) + (c.y + d.y) + 64.0f * ((da * da + db * db) + (dc * dc + dd * dd));
            unsigned long long* slot = (unsigned long long*)xbuf + ((size_t)(u.pm * BM + row) * 4 + u.pn);
            __hip_atomic_store(slot, ((unsigned long long)__float_as_uint(m2) << 32) | __float_as_uint(mt), __ATOMIC_RELAXED, __HIP_MEMORY_SCOPE_AGENT);
        }
        asm volatile("s_waitcnt vmcnt(0)" ::: "memory");
        if (lane == 0) __hip_atomic_fetch_add(cnt + 64 * u.pm, 1u, __ATOMIC_RELAXED, __HIP_MEMORY_SCOPE_AGENT);
        if (wid == 0) {
            bool dead = false; const unsigned long long t0 = __builtin_amdgcn_s_memrealtime(); const unsigned want = 8u * (unsigned)ntn;
            for (;;) {
#if defined(BROKEN_EXCHANGE_NO_WAIT)
                break;
#endif
                if ((unsigned)__builtin_amdgcn_readfirstlane(__hip_atomic_load(cnt + 64 * u.pm, __ATOMIC_RELAXED, __HIP_MEMORY_SCOPE_AGENT)) >= want) break;
                if (__builtin_amdgcn_s_memrealtime() - t0 > 2000000ull) {
                    if (lane == 0) { unsigned expect = 0u; __hip_atomic_compare_exchange_strong(tmo + 1, &expect, code | (unsigned)(u.pm & 0xff), __ATOMIC_RELAXED, __ATOMIC_RELAXED, __HIP_MEMORY_SCOPE_AGENT);
                                     __hip_atomic_store(tmo, 1u, __ATOMIC_RELAXED, __HIP_MEMORY_SCOPE_AGENT); }
                    dead = true; break; }
                __builtin_amdgcn_s_sleep(2);
            }
            __builtin_amdgcn_fence(__ATOMIC_ACQUIRE, "agent");
            if (lane == 0) flag[0] = dead ? 1u : 0u;
        }
        asm volatile("s_waitcnt vmcnt(0) lgkmcnt(0)" ::: "memory"); __builtin_amdgcn_s_barrier(); asm volatile("" ::: "memory");
        const bool bad = flag[0] != 0u;
        if (lane < 32) {
            const unsigned long long* slot = (const unsigned long long*)xbuf + (size_t)(u.pm * BM + row) * 4; float mt[4], m2[4]; float ms = 0.f;
#pragma unroll
            for (int t = 0; t < 4; ++t) { if (t < ntn) { const unsigned long long w = __hip_atomic_load(slot + t, __ATOMIC_RELAXED, __HIP_MEMORY_SCOPE_AGENT); mt[t] = __uint_as_float((unsigned)w); m2[t] = __uint_as_float((unsigned)(w >> 32)); } else { mt[t] = 0.f; m2[t] = 0.f; } ms += mt[t]; }
            const float mean = ms / (float)ntn; float q = 0.f;
#pragma unroll
            for (int t = 0; t < 4; ++t) if (t < ntn) { const float dm = mt[t] - mean; q += m2[t] + 256.0f * dm * dm; }
            S[row] = (f32x2v){mean, 1.0f / sqrtf(q / (256.0f * (float)ntn) + eps)};
        }
        asm volatile("s_waitcnt lgkmcnt(0)" ::: "memory"); __builtin_amdgcn_s_barrier(); asm volatile("" ::: "memory");
        return bad;
    }
};
struct EpiLnRes {
    static constexpr bool PERM = false, AFTER_DRAIN = true;
    const float* base; float* out; int ldc; const float* bias; PanelStats st; unsigned poison;
    __device__ __forceinline__ void fused(f32x4 (&acc)[2][2][4][2], const Unit& u, int wr, int wc, int fr, int fq, PG8_LAS unsigned char* lds, int wid, int lane) const {
        typedef float f32x2v __attribute__((ext_vector_type(2)));
        const PG8_LAS f32x2v* S = (const PG8_LAS f32x2v*)(lds + 8192);
        const int col0 = u.pn * BM + wc * 32 + 4 * fq;
#pragma unroll
        for (int bj = 0; bj < 2; ++bj)
#pragma unroll
            for (int n = 0; n < 2; ++n) { const f32x4 bv = bias ? *(const f32x4*)(bias + col0 + bj * HALF + n * 16) : (f32x4){0.f, 0.f, 0.f, 0.f};
#pragma unroll
                for (int ai = 0; ai < 2; ++ai)
#pragma unroll
                    for (int m = 0; m < 4; ++m) acc[ai][bj][m][n] += bv; }
        f32x4 pre[4][2][2];
#pragma unroll
        for (int m = 0; m < 4; ++m) { const size_t off = (size_t)(u.pm * BM + wr * 64 + m * 16 + fr) * ldc + col0;
#pragma unroll
            for (int bj = 0; bj < 2; ++bj)
#pragma unroll
                for (int n = 0; n < 2; ++n) pre[m][bj][n] = *(const f32x4*)(base + off + bj * HALF + n * 16); }
        const bool bad = st.run(acc, u, wr, wc, fr, fq, lds, wid, lane) || poison != 0u;
        const float qnan = __builtin_nanf("");
#pragma unroll
        for (int ai = 0; ai < 2; ++ai)
#pragma unroll
            for (int m = 0; m < 4; ++m) { const int r = ai * HALF + wr * 64 + m * 16 + fr; const f32x2v sr = S[r]; const size_t off = (size_t)(u.pm * BM + r) * ldc + col0;
#pragma unroll
                for (int bj = 0; bj < 2; ++bj)
#pragma unroll
                    for (int n = 0; n < 2; ++n) { const f32x4 bs = ai == 0 ? pre[m][bj][n] : *(const f32x4*)(base + off + bj * HALF + n * 16); f32x4 o = bs + (acc[ai][bj][m][n] - sr.x) * sr.y;
                        if (bad) o = (f32x4){qnan, qnan, qnan, qnan}; *(f32x4*)(out + off + bj * HALF + n * 16) = o; }
                if (m & 1) asm volatile("" ::: "memory"); }
    }
};
struct EpiLnResLn {
    static constexpr bool PERM = false, AFTER_DRAIN = true;
    const float* base; float* out; bf16_t* xn; int ldc; const float* bias; PanelStats st1, st2; unsigned poison;
    __device__ __forceinline__ void fused(f32x4 (&acc)[2][2][4][2], const Unit& u, int wr, int wc, int fr, int fq, PG8_LAS unsigned char* lds, int wid, int lane) const {
        typedef float f32x2v __attribute__((ext_vector_type(2))); typedef unsigned u32x2v __attribute__((ext_vector_type(2)));
        const PG8_LAS f32x2v* S = (const PG8_LAS f32x2v*)(lds + 8192);
        const int col0 = u.pn * BM + wc * 32 + 4 * fq;
#pragma unroll
        for (int bj = 0; bj < 2; ++bj)
#pragma unroll
            for (int n = 0; n < 2; ++n) { const f32x4 bv = bias ? *(const f32x4*)(bias + col0 + bj * HALF + n * 16) : (f32x4){0.f, 0.f, 0.f, 0.f};
#pragma unroll
                for (int ai = 0; ai < 2; ++ai)
#pragma unroll
                    for (int m = 0; m < 4; ++m) acc[ai][bj][m][n] += bv; }
        bool bad = st1.run(acc, u, wr, wc, fr, fq, lds, wid, lane) || poison != 0u;
        const float qnan = __builtin_nanf("");
#pragma unroll
        for (int ai = 0; ai < 2; ++ai)
#pragma unroll
            for (int m = 0; m < 4; ++m) { const int r = ai * HALF + wr * 64 + m * 16 + fr; const f32x2v sr = S[r]; const size_t off = (size_t)(u.pm * BM + r) * ldc + col0;
#pragma unroll
                for (int bj = 0; bj < 2; ++bj)
#pragma unroll
                    for (int n = 0; n < 2; ++n) { const f32x4 bs = *(const f32x4*)(base + off + bj * HALF + n * 16); acc[ai][bj][m][n] = bs + (acc[ai][bj][m][n] - sr.x) * sr.y; }
                asm volatile("" : "+v"(acc[ai][0][m][0]), "+v"(acc[ai][0][m][1]), "+v"(acc[ai][1][m][0]), "+v"(acc[ai][1][m][1]));
                if (m & 1) asm volatile("" ::: "memory"); }
        const bool bad1 = bad;
        bad = st2.run(acc, u, wr, wc, fr, fq, lds, wid, lane) || bad;
#pragma unroll
        for (int ai = 0; ai < 2; ++ai)
#pragma unroll
            for (int m = 0; m < 4; ++m) { const int r = ai * HALF + wr * 64 + m * 16 + fr; const f32x2v sr = S[r]; const size_t off = (size_t)(u.pm * BM + r) * ldc + col0;
#pragma unroll
                for (int bj = 0; bj < 2; ++bj)
#pragma unroll
                    for (int n = 0; n < 2; ++n) { const f32x4 x1 = acc[ai][bj][m][n]; *(f32x4*)(out + off + bj * HALF + n * 16) = bad1 ? (f32x4){qnan, qnan, qnan, qnan} : x1;
                        const f32x4 o = (x1 - sr.x) * sr.y; u32x2v w; w.x = cvt_pk_bf16(o[0], o[1]); w.y = cvt_pk_bf16(o[2], o[3]);
                        if (bad) { w.x = 0x7fc07fc0u; w.y = 0x7fc07fc0u; } *(u32x2v*)(xn + off + bj * HALF + n * 16) = w; }
                asm volatile("" ::: "memory"); }
    }
};

typedef int i32x4 __attribute__((ext_vector_type(4)));
template <bool I8> __device__ __forceinline__ f32x4 pg8_mma(bf16x8 b, bf16x8 a, f32x4 c) {
    if constexpr (I8) return __builtin_bit_cast(f32x4, __builtin_amdgcn_mfma_i32_16x16x64_i8(__builtin_bit_cast(i32x4, b), __builtin_bit_cast(i32x4, a), __builtin_bit_cast(i32x4, c), 0, 0, 0));
    else return __builtin_amdgcn_mfma_f32_16x16x32_bf16(b, a, c, 0, 0, 0);
}
template <class Epi, class Sched, bool ALIGN_EPI = false, bool SP2 = false, bool MID = false, bool I8 = false>
__device__ __forceinline__ void gemm_phase(PG8_LAS unsigned char* lds, const Gemm g, const Sched& S, const Epi& E) {
    const int tid = threadIdx.x, wid = __builtin_amdgcn_readfirstlane(tid >> 6), lane = tid & 63, wr = wid >> 2, wc = wid & 3, fr = lane & 15, fq = lane >> 4;
    const int K = g.K, nt = K / BK;
    unsigned voffA[2], voffB[2];
#pragma unroll
    for (int i = 0; i < 2; ++i) { int R, C; stage_rc(tid * 16 + i * 8192, R, C); const int Rb = Epi::PERM ? ((R & ~31) + perm32(R & 31)) : R;
        voffA[i] = (unsigned)(R * K + C) * 2u; voffB[i] = (unsigned)(Rb * K + C) * 2u; }
    const size_t kstep = (size_t)(BK * 2);
#ifdef KROT
    const size_t kmask = (size_t)K * 2 - 1, krot = MID ? 0 : (size_t)((blockIdx.x & 7) * (nt / 8)) * kstep;
#define PG8_KT(base_, x_) ((base_) + ((((size_t)(x_)) * kstep + krot) & kmask))
#else
    const size_t krot = 0;
#define PG8_KT(base_, x_) ((base_) + (size_t)(x_) * kstep)
#endif
    const size_t hstep = (size_t)HALF * K * 2;
    const size_t tstep = 2 * hstep;
    const unsigned ldsw = (unsigned)wid * 1024u;
    const int aoff = lds_byte(wr * 64 + fr, fq * 8), boff = lds_byte(wc * 32 + fr, fq * 8);
#define PG8_SA(b, h) (((b) * 2 + (h)) * HTB)
#define PG8_SB(b, h) ((4 + (b) * 2 + (h)) * HTB)
#define PG8_STAGE(bufoff, gbase, voff) do { _Pragma("unroll") for (int _i = 0; _i < 2; ++_i) \
        __builtin_amdgcn_global_load_lds((const unsigned*)((const char*)(gbase) + (voff)[_i]), (PG8_LAS unsigned*)(lds + (bufoff) + ldsw + _i * 8192), 16, 0, 0); } while (0)
#define PG8_LDA(dst, b, h) do { _Pragma("unroll") for (int m = 0; m < 4; ++m) _Pragma("unroll") for (int k = 0; k < 2; ++k) dst[m][k] = *(const PG8_LAS bf16x8*)(lds + PG8_SA(b, h) + aoff + m * 2048 + k * 1024); } while (0)
#define PG8_LDB(dst, b, h) do { _Pragma("unroll") for (int n = 0; n < 2; ++n) _Pragma("unroll") for (int k = 0; k < 2; ++k) dst[n][k] = *(const PG8_LAS bf16x8*)(lds + PG8_SB(b, h) + boff + n * 2048 + k * 1024); } while (0)
#define PG8_MMA(ai, bj, At, Bt) do { __builtin_amdgcn_s_setprio(1); _Pragma("unroll") for (int m = 0; m < 4; ++m) _Pragma("unroll") for (int n = 0; n < 2; ++n) _Pragma("unroll") for (int k = 0; k < 2; ++k) \
        acc[ai][bj][m][n] = pg8_mma<I8>(Bt[n][k], At[m][k], acc[ai][bj][m][n]); __builtin_amdgcn_s_setprio(0); } while (0)
#define PG8_WAIT_V(n) asm volatile("s_waitcnt vmcnt(" #n ")" ::: "memory")
#define PG8_WAIT_L(n) asm volatile("s_waitcnt lgkmcnt(" #n ")" ::: "memory")
#define PG8_BAR __builtin_amdgcn_s_barrier()
#define PG8_SCHED __builtin_amdgcn_sched_barrier(0)
    Unit cur, nxt; int ui = 0;
    if (!S.next(0, cur)) return;
    f32x4 acc[2][2][4][2];
#pragma unroll
    for (int a = 0; a < 2; ++a)
#pragma unroll
        for (int b = 0; b < 2; ++b)
#pragma unroll
            for (int m = 0; m < 4; ++m)
#pragma unroll
                for (int n = 0; n < 2; ++n) acc[a][b][m][n] = (f32x4){0.f, 0.f, 0.f, 0.f};
    bf16x8 At[4][2], B0[2][2], B1[2][2];
    const char* cA = (const char*)g.A + (size_t)cur.pm * tstep; const char* cB = (const char*)g.Bt + (size_t)cur.pn * tstep;
    if constexpr (MID) E.load_mid(cur);
    S.a_ready(cur);
    if constexpr (SP2) {
        PG8_STAGE(PG8_SB(0, 0), cB + krot, voffB); PG8_STAGE(PG8_SB(0, 1), cB + krot + hstep, voffB); PG8_STAGE(PG8_SA(0, 0), cA + krot, voffA); PG8_STAGE(PG8_SA(0, 1), cA + krot + hstep, voffA);
        if (wr == 1) PG8_BAR;
        PG8_WAIT_V(2); PG8_BAR;
        PG8_STAGE(PG8_SB(1, 0), cB + krot + kstep, voffB); PG8_STAGE(PG8_SA(1, 0), cA + krot + kstep, voffA); PG8_STAGE(PG8_SB(1, 1), cB + krot + hstep + kstep, voffB);
        PG8_WAIT_V(6); PG8_BAR;
    } else {
        PG8_STAGE(PG8_SB(0, 0), cB + krot, voffB); PG8_STAGE(PG8_SA(0, 0), cA + krot, voffA); PG8_STAGE(PG8_SB(0, 1), cB + krot + hstep, voffB); PG8_STAGE(PG8_SA(0, 1), cA + krot + hstep, voffA);
        if (wr == 1) PG8_BAR;
        PG8_WAIT_V(4); PG8_BAR;
        PG8_STAGE(PG8_SB(1, 0), cB + krot + kstep, voffB); PG8_STAGE(PG8_SA(1, 0), cA + krot + kstep, voffA); PG8_STAGE(PG8_SB(1, 1), cB + krot + hstep + kstep, voffB);
        PG8_WAIT_V(6); PG8_BAR;
    }
    for (;;) {
        const bool has_next = S.next(ui + 1, nxt);
        const char* nA = has_next ? (const char*)g.A + (size_t)nxt.pm * tstep : cA; const char* nB = has_next ? (const char*)g.Bt + (size_t)nxt.pn * tstep : cB;
        for (int t = 0; t < nt; t += 2) {
            if constexpr (MID) { if (t == nt / 2) {
#pragma unroll
                for (int a = 0; a < 2; ++a)
#pragma unroll
                    for (int m = 0; m < 4; ++m)
#pragma unroll
                        for (int b = 0; b < 2; ++b)
#pragma unroll
                            for (int n = 0; n < 2; ++n) acc[a][b][m][n] = acc[a][b][m][n] * E.mid(a * 128 + wr * 64 + m * 16 + fr);
            } }
            const bool last = (t == nt - 2);
            const char* a1 = PG8_KT(cA, t + 1);
            const char* a2 = last ? nA + krot : PG8_KT(cA, t + 2); const char* b2 = last ? nB + krot : PG8_KT(cB, t + 2);
            const char* a3 = a2 + kstep; const char* b3 = b2 + kstep;
            if (last && has_next) S.a_ready(nxt);
            if constexpr (SP2) {
            PG8_LDB(B0, 0, 0); PG8_LDB(B1, 0, 1); PG8_SCHED; PG8_LDA(At, 0, 0); PG8_STAGE(PG8_SA(1, 1), a1 + hstep, voffA);
            PG8_WAIT_V(8); PG8_WAIT_L(0); PG8_BAR; PG8_MMA(0, 0, At, B0); PG8_MMA(0, 1, At, B1); PG8_BAR; PG8_SCHED;
            PG8_LDA(At, 0, 1); PG8_STAGE(PG8_SB(0, 0), b2, voffB); PG8_STAGE(PG8_SB(0, 1), b2 + hstep, voffB); PG8_STAGE(PG8_SA(0, 0), a2, voffA);
            PG8_WAIT_V(8); PG8_WAIT_L(0); PG8_BAR; PG8_MMA(1, 0, At, B0); PG8_MMA(1, 1, At, B1); PG8_BAR; PG8_SCHED;
            PG8_LDB(B0, 1, 0); PG8_LDB(B1, 1, 1); PG8_SCHED; PG8_LDA(At, 1, 0); PG8_STAGE(PG8_SA(0, 1), a2 + hstep, voffA);
            PG8_WAIT_V(8); PG8_WAIT_L(0); PG8_BAR; PG8_MMA(0, 0, At, B0); PG8_MMA(0, 1, At, B1); PG8_BAR; PG8_SCHED;
            PG8_LDA(At, 1, 1); PG8_STAGE(PG8_SB(1, 0), b3, voffB); PG8_STAGE(PG8_SB(1, 1), b3 + hstep, voffB); PG8_STAGE(PG8_SA(1, 0), a3, voffA);
            PG8_WAIT_V(8); PG8_WAIT_L(0); PG8_BAR; PG8_MMA(1, 0, At, B0); PG8_MMA(1, 1, At, B1); PG8_BAR; PG8_SCHED;
            } else {
            PG8_LDB(B0, 0, 0); PG8_SCHED; PG8_LDA(At, 0, 0); PG8_STAGE(PG8_SA(1, 1), a1 + hstep, voffA);
            PG8_WAIT_L(8); PG8_BAR; PG8_WAIT_L(0); PG8_MMA(0, 0, At, B0); PG8_BAR; PG8_SCHED;
            PG8_LDB(B1, 0, 1); PG8_STAGE(PG8_SB(0, 0), b2, voffB);
            PG8_BAR; PG8_WAIT_L(0); PG8_MMA(0, 1, At, B1); PG8_BAR;
            PG8_LDA(At, 0, 1); PG8_STAGE(PG8_SA(0, 0), a2, voffA);
            PG8_BAR; PG8_WAIT_L(0); PG8_MMA(1, 0, At, B0); PG8_BAR; PG8_SCHED;
            PG8_STAGE(PG8_SB(0, 1), b2 + hstep, voffB);
            PG8_WAIT_V(6); PG8_BAR; PG8_MMA(1, 1, At, B1); PG8_BAR;
            PG8_LDB(B0, 1, 0); PG8_SCHED; PG8_LDA(At, 1, 0); PG8_STAGE(PG8_SA(0, 1), a2 + hstep, voffA);
            PG8_WAIT_L(8); PG8_BAR; PG8_WAIT_L(0); PG8_MMA(0, 0, At, B0); PG8_BAR; PG8_SCHED;
            PG8_LDB(B1, 1, 1); PG8_STAGE(PG8_SB(1, 0), b3, voffB);
            PG8_BAR; PG8_WAIT_L(0); PG8_MMA(0, 1, At, B1); PG8_BAR;
            PG8_LDA(At, 1, 1); PG8_STAGE(PG8_SA(1, 0), a3, voffA);
            PG8_BAR; PG8_WAIT_L(0); PG8_MMA(1, 0, At, B0); PG8_BAR; PG8_SCHED;
            PG8_STAGE(PG8_SB(1, 1), b3 + hstep, voffB);
            PG8_WAIT_V(6); PG8_BAR; PG8_MMA(1, 1, At, B1); PG8_BAR;
            }
        }
        if constexpr (ALIGN_EPI) { if (wr == 0) PG8_BAR; }
        if constexpr (!Epi::AFTER_DRAIN) { E(acc, cur, wr, wc, fr, fq); S.done(cur); }
        if (!has_next) break;
#pragma unroll
        for (int a = 0; a < 2; ++a)
#pragma unroll
            for (int b = 0; b < 2; ++b)
#pragma unroll
                for (int m = 0; m < 4; ++m)
#pragma unroll
                    for (int n = 0; n < 2; ++n) acc[a][b][m][n] = (f32x4){0.f, 0.f, 0.f, 0.f};
        cur = nxt; cA = nA; cB = nB; ++ui;
        if constexpr (MID) E.load_mid(cur);
        if constexpr (ALIGN_EPI) { if (wr == 1) PG8_BAR; }
    }
    PG8_WAIT_V(0);
    if constexpr (!ALIGN_EPI) { if (wr == 0) PG8_BAR; }
    PG8_BAR;
    if constexpr (Epi::AFTER_DRAIN) { E.fused(acc, cur, wr, wc, fr, fq, lds, wid, lane); S.done(cur); }
#undef PG8_KT
#undef PG8_SA
#undef PG8_SB
#undef PG8_STAGE
#undef PG8_LDA
#undef PG8_LDB
#undef PG8_MMA
#undef PG8_WAIT_V
#undef PG8_WAIT_L
#undef PG8_BAR
#undef PG8_SCHED
}
}
#define GAS __attribute__((address_space(1)))
#define LAS __attribute__((address_space(3)))
typedef unsigned short bf16;
typedef unsigned v4u __attribute__((ext_vector_type(4)));
typedef float f32x4 __attribute__((ext_vector_type(4)));
typedef short bf16x8 __attribute__((ext_vector_type(8)));
typedef GAS unsigned gu32;
typedef GAS unsigned long long gu64;
#define RLX_AGENT __ATOMIC_RELAXED, __HIP_MEMORY_SCOPE_AGENT
#define LDS_WAIT() asm volatile("s_waitcnt lgkmcnt(0)" ::: "memory")
#define VM_WAIT() asm volatile("s_waitcnt vmcnt(0)" ::: "memory")
__device__ __forceinline__ unsigned long long rt() { return __builtin_amdgcn_s_memrealtime(); }
__device__ __forceinline__ unsigned f2bf(float f) { unsigned u = __builtin_bit_cast(unsigned, f); return (u + 0x7fffu + ((u >> 16) & 1u)) >> 16; }
__device__ __forceinline__ unsigned pk2(float lo, float hi) { return f2bf(lo) | (f2bf(hi) << 16); }

#define XB_TMO      128
#define XB_XCNT(j)  (256  + 64 * (j))
#define XB_XSUB(j)  (1280 + 64 * (j))
#define XB_XGEN(j)  (2304 + 64 * (j))
#define XB_TOP      3328
#define XB_TOPGEN   3392
#define XCD_BAR_WORDS 3456
#define XB_SPIN_CAP (1u << 18)

__device__ __forceinline__ unsigned xb_ld(unsigned* p)              { return __hip_atomic_load(p, __ATOMIC_RELAXED, __HIP_MEMORY_SCOPE_AGENT); }
__device__ __forceinline__ unsigned xb_add(unsigned* p, unsigned v) { return __hip_atomic_fetch_add(p, v, __ATOMIC_RELAXED, __HIP_MEMORY_SCOPE_AGENT); }
__device__ __forceinline__ unsigned xb_xcc_id() { return (unsigned)__builtin_amdgcn_s_getreg((3 << 11) | 20) & 0xFu; }
#define XB_SPIN(cond, bar) do { unsigned _sp = 0; while (cond) { __builtin_amdgcn_s_sleep(1); \
    if ((++_sp & 255u) == 0u) { if (xb_ld(&(bar)[XB_TMO])) break; if (_sp > XB_SPIN_CAP) { atomicAdd(&(bar)[XB_TMO], 1u); break; } } } } while (0)

struct XcdBarrier {
    unsigned* bar; unsigned x;
    volatile LAS unsigned* st;
};

__device__ __forceinline__ XcdBarrier xcd_barrier_post(unsigned* bar, volatile LAS unsigned* st) {
    XcdBarrier b; b.bar = bar; b.x = xb_xcc_id(); b.st = st;
    if (threadIdx.x == 0) (void)xb_add(&bar[XB_XCNT(b.x)], 1u);
    return b;
}
__device__ __forceinline__ void xcd_barrier_complete(unsigned* bar, unsigned x, unsigned& nloc, unsigned& nx) {
    const unsigned G = gridDim.x * gridDim.y * gridDim.z;
    unsigned sum, cnt, mine, sp = 0u;
    for (;;) {
        sum = 0u; cnt = 0u; mine = 0u;
#pragma unroll
        for (unsigned j = 0; j < 16; ++j) { const unsigned c = xb_ld(&bar[XB_XCNT(j)]); sum += c; cnt += (c > 0u) ? 1u : 0u; mine = (j == x) ? c : mine; }
        if (sum == G) break;
        __builtin_amdgcn_s_sleep(1);
        if ((++sp & 255u) == 0u) { if (xb_ld(&bar[XB_TMO])) break; if (sp > XB_SPIN_CAP) { atomicAdd(&bar[XB_TMO], 1u); break; } }
    }
    nloc = mine > 0u ? mine : 1u; nx = cnt > 0u ? cnt : 1u;
}

__device__ __forceinline__ void xcd_barrier(const XcdBarrier& b) {
    asm volatile("s_waitcnt vmcnt(0)" ::: "memory");
    __syncthreads();
    if (threadIdx.x == 0) {
        unsigned* bar = b.bar;
        __builtin_amdgcn_s_waitcnt(0);
        unsigned nloc = b.st[0], nx = b.st[1];
        if (nloc == 0u) { xcd_barrier_complete(bar, b.x, nloc, nx); b.st[0] = nloc; b.st[1] = nx; }
        const unsigned old = xb_add(&bar[XB_XSUB(b.x)], 1u);
        const unsigned gen = old / nloc;
        if (old + 1u == (gen + 1u) * nloc) {
            __builtin_amdgcn_fence(__ATOMIC_RELEASE, "agent");
            asm volatile("s_waitcnt vmcnt(0)" ::: "memory");
            const unsigned og = xb_add(&bar[XB_TOP], 1u);
            const unsigned tg = og / nx;
            if (og + 1u == (tg + 1u) * nx) xb_add(&bar[XB_TOPGEN], 1u);
            else XB_SPIN(xb_ld(&bar[XB_TOPGEN]) == tg, bar);
            __builtin_amdgcn_fence(__ATOMIC_ACQUIRE, "agent");
            xb_add(&bar[XB_XGEN(b.x)], 1u);
            asm volatile("s_waitcnt vmcnt(0)" ::: "memory");
        } else {
            XB_SPIN(xb_ld(&bar[XB_XGEN(b.x)]) == gen, bar);
            __builtin_amdgcn_fence(__ATOMIC_ACQUIRE, "agent");
            asm volatile("s_waitcnt vmcnt(0)" ::: "memory");
        }
    }
    __syncthreads();
}

#define VF16 1
#define FUSE_ROUTE 1
#ifndef BF16_GEMMS
#define QKV_I8 1
#define WOUT_I8 1
#define WGTR 1
#ifndef NO_XDIRECT
#define XDIRECT 1
#endif
#define QLDS 1
#define U4 1
#define VDOT4 1
#define SROT 1
#define V4 1
#endif
#ifndef CMR
#define CMR 32
#endif
#ifndef CMK
#define CMK 4
#endif
#ifndef XB_SPIN_CAP2
#define XB_SPIN_CAP2 1
#endif
constexpr int NWAVES = 8;
constexpr int T_TOK = 8192, DM = 4096, SEQ = 2048, NBATCH = 4;
constexpr int INW = 9216;
constexpr int C_QA = 0, C_KA = 2048, C_VA = 2560, C_QB = 3072, C_KB = 5120, C_VB = 7168;
constexpr int MEMLEN = 256, MEMW = 1024;
constexpr int NEXP = 16384, PQW = 2048;
constexpr float RMS_EPS = 1e-6f;
constexpr float LOG2E = 1.4426950408889634f;

constexpr size_t MiB = 1u << 20;
constexpr size_t WS_CTL = 0, CTL_ZERO_BYTES = 94208, WS_CM = 32768, WS_CM2 = 69632, WS_CM3 = 86016;
constexpr size_t WS_ROPE = 1 * MiB;
constexpr size_t WS_SKB = 2 * MiB;
constexpr size_t WS_WIN = 4 * MiB;
constexpr size_t WS_WOUT = 76 * MiB;
constexpr size_t WS_WMQ = 108 * MiB;
constexpr size_t WS_WMKV = 116 * MiB;
constexpr size_t WS_WMO = 132 * MiB;
constexpr size_t WS_WPQ = 140 * MiB;
constexpr size_t WS_UB = 156 * MiB;
constexpr size_t WS_VB = 284 * MiB;
#ifdef SLICE_PAD
constexpr size_t WS_UQ = 156 * MiB, WS_VQ = 222 * MiB;
#else
constexpr size_t WS_UQ = 156 * MiB, WS_VQ = 220 * MiB;
#endif
constexpr size_t WS_SU = 3 * MiB, WS_SV = 3 * MiB + 65536;
constexpr size_t WS_SX = 3 * MiB + 131072;
#ifdef SLICE_PAD
constexpr size_t WS_XQ = 288 * MiB;
#else
constexpr size_t WS_XQ = 284 * MiB;
#endif
#ifdef SLICE_PAD
constexpr size_t SLICE_BYTES = (size_t)NEXP * 128 + SLICE_PAD;
#else
constexpr size_t SLICE_BYTES = (size_t)NEXP * 128;
#endif
constexpr size_t WS_XN = 412 * MiB;
constexpr size_t WS_QKV = 476 * MiB;
constexpr size_t WS_OB = 620 * MiB;
constexpr size_t WS_MEMN = 684 * MiB;
constexpr size_t WS_KVM = 692 * MiB;
constexpr size_t WS_QM = 696 * MiB;
constexpr size_t WS_OM = 712 * MiB;
constexpr size_t WS_QP = 728 * MiB;
constexpr size_t WS_IDX = 760 * MiB;
constexpr size_t WS_GATE = 764 * MiB;
constexpr size_t WS_END = 768 * MiB;
constexpr int CW_BAR = 4096;
constexpr size_t WS_SSQ1 = 131072, WS_SSQ2 = 163840, WS_SSQA = 196608, WS_SSQB = 229376, WS_SSQ0 = 262144;

constexpr int RING_BYTES = 131072;
constexpr int LDSCTL_OFF = RING_BYTES, MISC_OFF = LDSCTL_OFF + 320;
constexpr int LDS_BYTES = 147456;

typedef float f32x16 __attribute__((ext_vector_type(16)));
typedef float f32x2 __attribute__((ext_vector_type(2)));
typedef short s16x4 __attribute__((ext_vector_type(4)));
typedef __bf16 bf16x2_t __attribute__((ext_vector_type(2)));
typedef unsigned u32x2 __attribute__((ext_vector_type(2)));
#define DI __device__ __forceinline__
#define MFMA32(a, b, c) __builtin_amdgcn_mfma_f32_32x32x16_bf16((a), (b), (c), 0, 0, 0)

DI unsigned cvtpk(float lo, float hi) { f32x2 v = {lo, hi}; bf16x2_t b = __builtin_convertvector(v, bf16x2_t); return __builtin_bit_cast(unsigned, b); }
DI float bflo(unsigned u) { return __uint_as_float(u << 16); }
DI float bfhi(unsigned u) { return __uint_as_float(u & 0xffff0000u); }
DI int crow(int i, int h) { return (i & 3) + 8 * (i >> 2) + 4 * h; }
DI float wave_sum(float v) {
#pragma unroll
    for (int o = 1; o < 64; o <<= 1) v += __shfl_xor(v, o);
    return v;
}
DI float fexp2(float x) { return __builtin_amdgcn_exp2f(x); }
DI bf16x8 pack8(const f32x16& x, int s) {
    v4u p; p.x = cvtpk(x[8 * s + 0], x[8 * s + 1]); p.y = cvtpk(x[8 * s + 2], x[8 * s + 3]); p.z = cvtpk(x[8 * s + 4], x[8 * s + 5]); p.w = cvtpk(x[8 * s + 6], x[8 * s + 7]);
    return __builtin_bit_cast(bf16x8, p);
}
typedef short v4i16_t __attribute__((ext_vector_type(4)));
DI s16x4 vtr(const LAS unsigned char* p) { return __builtin_bit_cast(s16x4, __builtin_amdgcn_ds_read_tr16_b64_v4i16((LAS v4i16_t*)p)); }

DI void p0_transpose_item(const float* W, int K, int N, bf16* WT, int row_off, LAS float* scr, int item, int lane, const float* gk0 = nullptr, const float* gk1 = nullptr) {
    const int nblk = N / 32, kb = item / nblk, nb = item % nblk, k0 = 64 * kb, n0 = 32 * nb;
#pragma unroll 8
    for (int i = 0; i < 32; ++i) { const int kk = 2 * i + (lane >> 5); scr[kk * 33 + (lane & 31)] = W[(size_t)(k0 + kk) * N + n0 + (lane & 31)]; }
    LDS_WAIT(); asm volatile("" ::: "memory");
    const int c = lane & 7;
    f32x4 ga = {1.f, 1.f, 1.f, 1.f}, gb = ga;
    if (gk0) { const int kg = k0 + 8 * c; const float* gp = kg < 2048 ? gk0 + kg : gk1 + (kg - 2048); ga = *(const GAS f32x4*)gp; gb = *(const GAS f32x4*)(gp + 4); }
#pragma unroll
    for (int j = 0; j < 4; ++j) { const int n = (lane >> 3) + 8 * j; const LAS float* s = scr + (8 * c) * 33 + n;
        v4u o; o.x = cvtpk(s[0 * 33] * ga.x, s[1 * 33] * ga.y); o.y = cvtpk(s[2 * 33] * ga.z, s[3 * 33] * ga.w); o.z = cvtpk(s[4 * 33] * gb.x, s[5 * 33] * gb.y); o.w = cvtpk(s[6 * 33] * gb.z, s[7 * 33] * gb.w);
        *(GAS v4u*)(WT + (size_t)(row_off + n0 + n) * K + k0 + 8 * c) = o; }
    LDS_WAIT(); asm volatile("" ::: "memory");
}
struct WgTrDesc { const float* W; bf16* WT; const float* g; int K, N, row_off, item; };
#define WGTR_ISSUE(t_) do { const int nch_ = (t_).N >> 8, kb_ = (t_).item / nch_, cb_ = (t_).item - kb_ * nch_; \
        const float* p_ = (t_).W + (size_t)(64 * kb_ + 8 * wave) * (t_).N + 256 * cb_ + lane; \
        _Pragma("unroll") for (int i_ = 0; i_ < 8; ++i_) { _Pragma("unroll") for (int q_ = 0; q_ < 4; ++q_) v[4 * i_ + q_] = p_[(size_t)i_ * (t_).N + 64 * q_]; } } while (0)
template <class Dec> DI void wgtr_run(LAS float* scr, int g0, int g1, int gstride, Dec dec, int wave, int lane) {
    __syncthreads();
    if (g0 >= g1) return;
    float v[32];
    WgTrDesc d = dec(g0);
    WGTR_ISSUE(d);
    for (int g = g0; g < g1; g += gstride) {
        const int nch = d.N >> 8, kb = d.item / nch, cb = d.item - kb * nch, k0 = 64 * kb, n0 = 256 * cb;
#pragma unroll
        for (int i = 0; i < 8; ++i) { const int r = 8 * wave + i; const float gg = d.g ? d.g[k0 + r] : 1.f;
#pragma unroll
            for (int q = 0; q < 4; ++q) scr[r * 257 + 64 * q + lane] = v[4 * i + q] * gg; }
        __syncthreads();
        WgTrDesc dn = d;
        if (g + gstride < g1) { dn = dec(g + gstride); WGTR_ISSUE(dn); }
        const int kc = lane & 7;
#pragma unroll
        for (int j = 0; j < 4; ++j) { const int col = 32 * wave + 8 * j + (lane >> 3); const LAS float* sp = scr + (8 * kc) * 257 + col;
            v4u o; o.x = cvtpk(sp[0 * 257], sp[1 * 257]); o.y = cvtpk(sp[2 * 257], sp[3 * 257]); o.z = cvtpk(sp[4 * 257], sp[5 * 257]); o.w = cvtpk(sp[6 * 257], sp[7 * 257]);
            *(GAS v4u*)(d.WT + (size_t)(d.row_off + n0 + col) * d.K + k0 + 8 * kc) = o; }
        __syncthreads();
        d = dn;
    }
}
DI void rms_row_to_bf16(const float* xrow, const float* gain, bf16* orow, int lane) {
    const GAS f32x4* xr = (const GAS f32x4*)xrow + lane;
    f32x4 v[16]; float s = 0.f;
#pragma unroll
    for (int j = 0; j < 16; ++j) { v[j] = xr[64 * j]; s += (v[j].x * v[j].x + v[j].y * v[j].y) + (v[j].z * v[j].z + v[j].w * v[j].w); }
    const float rstd = 1.0f / sqrtf(wave_sum(s) * (1.f / DM) + RMS_EPS);
    const GAS f32x4* gr = (const GAS f32x4*)gain + lane;
    GAS u32x2* o8 = (GAS u32x2*)orow + lane;
#pragma unroll
    for (int j = 0; j < 16; ++j) { const f32x4 g = gr[64 * j]; u32x2 w; w.x = cvtpk(v[j].x * rstd * g.x, v[j].y * rstd * g.y); w.y = cvtpk(v[j].z * rstd * g.z, v[j].w * rstd * g.w); o8[64 * j] = w; }
}
DI void row_to_bf16_ssq(const float* xrow, bf16* orow, float* ssq, int lane) {
    const GAS f32x4* xr = (const GAS f32x4*)xrow + lane;
    GAS u32x2* o8 = (GAS u32x2*)orow + lane; float s = 0.f;
#pragma unroll
    for (int j = 0; j < 16; ++j) { const f32x4 v = xr[64 * j]; s += (v.x * v.x + v.y * v.y) + (v.z * v.z + v.w * v.w);
        u32x2 w; w.x = cvtpk(v.x, v.y); w.y = cvtpk(v.z, v.w); o8[64 * j] = w; }
    s = wave_sum(s);
    if (lane == 0) *ssq = s;
}
DI void row_to_bf16_i8(const float* xrow, bf16* orow, unsigned char* qrow, float* rs, int lane) {
    const GAS f32x4* xr = (const GAS f32x4*)xrow + lane;
    f32x4 v[16]; float s = 0.f, am = 0.f;
#pragma unroll
    for (int j = 0; j < 16; ++j) { v[j] = xr[64 * j]; s += (v[j].x * v[j].x + v[j].y * v[j].y) + (v[j].z * v[j].z + v[j].w * v[j].w);
        am = fmaxf(am, fmaxf(fmaxf(fabsf(v[j].x), fabsf(v[j].y)), fmaxf(fabsf(v[j].z), fabsf(v[j].w)))); }
    s = wave_sum(s);
#pragma unroll
    for (int o = 1; o < 64; o <<= 1) am = fmaxf(am, __shfl_xor(am, o));
    const float inv = am > 0.f ? 127.f / am : 0.f;
    GAS u32x2* o8 = (GAS u32x2*)orow + lane; GAS unsigned* q4 = (GAS unsigned*)qrow + lane;
#pragma unroll
    for (int j = 0; j < 16; ++j) { u32x2 w; w.x = cvtpk(v[j].x, v[j].y); w.y = cvtpk(v[j].z, v[j].w);
#ifndef XDIRECT
        o8[64 * j] = w;
#endif
        q4[64 * j] = ((unsigned)(int)rintf(v[j].x * inv) & 0xffu) | (((unsigned)(int)rintf(v[j].y * inv) & 0xffu) << 8) | (((unsigned)(int)rintf(v[j].z * inv) & 0xffu) << 16) | (((unsigned)(int)rintf(v[j].w * inv) & 0xffu) << 24); }
    if (lane == 0) *rs = am * (1.f / 127.f) / sqrtf(s * (1.f / DM) + RMS_EPS);
}
DI void p0_colmax_item(const float* W, int N, unsigned* CM, int item, int lane, const float* gk0, const float* gk1 = nullptr) {
    const int nblk = N / 32, kr = item / nblk, nb = item % nblk, n0 = 32 * nb;
    float mx = 0.f;
    for (int kb = kr * CMK; kb < kr * CMK + CMK; ++kb) { const int k0 = 64 * kb;
        const float* gk = (gk1 && k0 >= 2048) ? gk1 - 2048 : gk0;
        if (!gk0) {
#pragma unroll 16
            for (int i = 0; i < 32; ++i) { const int kk = k0 + 2 * i + (lane >> 5); mx = fmaxf(mx, fabsf(W[(size_t)kk * N + n0 + (lane & 31)])); }
        } else
#pragma unroll 16
        for (int i = 0; i < 32; ++i) { const int kk = k0 + 2 * i + (lane >> 5); mx = fmaxf(mx, fabsf(W[(size_t)kk * N + n0 + (lane & 31)] * gk[kk])); }
    }
    mx = fmaxf(mx, __shfl_xor(mx, 32));
    if (lane < 32) atomicMax(CM + n0 + lane, __float_as_uint(mx));
}
DI void p0_colmax_rows(const float* W, int N, unsigned* CM, int item, int lane, const float* gk0, const float* gk1 = nullptr) {
    const int nch = N / 256, kb = item / nch, ch = item % nch, k0 = CMR * kb, n0 = 256 * ch + 4 * lane;
    const float* gk = (gk1 && k0 >= 2048) ? gk1 - 2048 : gk0;
    float m0 = 0.f, m1 = 0.f, m2 = 0.f, m3 = 0.f;
    const float* wp = W + (size_t)k0 * N + n0;
#pragma unroll 16
    for (int i = 0; i < CMR; ++i) { const f32x4 w = *(const GAS f32x4*)(wp + (size_t)i * N); const float g = gk0 ? gk[k0 + i] : 1.f;
        m0 = fmaxf(m0, fabsf(w.x * g)); m1 = fmaxf(m1, fabsf(w.y * g)); m2 = fmaxf(m2, fabsf(w.z * g)); m3 = fmaxf(m3, fabsf(w.w * g)); }
    atomicMax(CM + n0, __float_as_uint(m0)); atomicMax(CM + n0 + 1, __float_as_uint(m1)); atomicMax(CM + n0 + 2, __float_as_uint(m2)); atomicMax(CM + n0 + 3, __float_as_uint(m3));
}
DI void p0_transpose_item_i8(const float* W, int K, int N, unsigned char* WT, const unsigned* CM, LAS float* scr, int item, int lane, const float* gk0, const float* gk1 = nullptr) {
#ifdef I8PAIR
    const int nblk = N / 32, pr = item >> 1, kb = 2 * (pr / nblk) + (item & 1), nb = pr % nblk, k0 = 64 * kb, n0 = 32 * nb;
#else
    const int nblk = N / 32, kb = item / nblk, nb = item % nblk, k0 = 64 * kb, n0 = 32 * nb;
#endif
    const float* gk = (gk1 && k0 >= 2048) ? gk1 - 2048 : gk0;
#pragma unroll 8
    for (int i = 0; i < 32; ++i) { const int kk = 2 * i + (lane >> 5); scr[kk * 33 + (lane & 31)] = W[(size_t)(k0 + kk) * N + n0 + (lane & 31)]; }
    LDS_WAIT(); asm volatile("" ::: "memory");
    const int c = lane & 7;
    f32x4 ga = {1.f, 1.f, 1.f, 1.f}, gb = {1.f, 1.f, 1.f, 1.f};
    if (gk0) { ga = *(const GAS f32x4*)(gk + k0 + 8 * c); gb = *(const GAS f32x4*)(gk + k0 + 8 * c + 4); }
#pragma unroll
    for (int j = 0; j < 4; ++j) { const int n = (lane >> 3) + 8 * j; const LAS float* sp = scr + (8 * c) * 33 + n;
        const float cm = __uint_as_float(CM[n0 + n]); const float inv = cm > 0.f ? 127.f / cm : 0.f;
        u32x2 o;
        o.x = ((unsigned)(int)rintf(sp[0 * 33] * ga.x * inv) & 0xffu) | (((unsigned)(int)rintf(sp[1 * 33] * ga.y * inv) & 0xffu) << 8) | (((unsigned)(int)rintf(sp[2 * 33] * ga.z * inv) & 0xffu) << 16) | (((unsigned)(int)rintf(sp[3 * 33] * ga.w * inv) & 0xffu) << 24);
        o.y = ((unsigned)(int)rintf(sp[4 * 33] * gb.x * inv) & 0xffu) | (((unsigned)(int)rintf(sp[5 * 33] * gb.y * inv) & 0xffu) << 8) | (((unsigned)(int)rintf(sp[6 * 33] * gb.z * inv) & 0xffu) << 16) | (((unsigned)(int)rintf(sp[7 * 33] * gb.w * inv) & 0xffu) << 24);
        *(GAS u32x2*)(WT + (size_t)(n0 + n) * K + k0 + 8 * c) = o; }
    LDS_WAIT(); asm volatile("" ::: "memory");
}
DI void mix_row_to_i8(const bf16* orow, float ssa, float ssb, unsigned char* qrow, float* rs, int lane) {
    const GAS v4u* p = (const GAS v4u*)orow + lane;
    const float ra = 1.0f / sqrtf(ssa * (1.f / 2048.f) + RMS_EPS), rb = 1.0f / sqrtf(ssb * (1.f / 2048.f) + RMS_EPS);
    float f[8][8]; float am = 0.f;
#pragma unroll
    for (int j = 0; j < 8; ++j) { const v4u v = p[64 * j]; const float rsc = j < 4 ? ra : rb;
#pragma unroll
        for (int k = 0; k < 4; ++k) { f[j][2 * k] = bflo(v[k]) * rsc; f[j][2 * k + 1] = bfhi(v[k]) * rsc; am = fmaxf(am, fmaxf(fabsf(f[j][2 * k]), fabsf(f[j][2 * k + 1]))); } }
#pragma unroll
    for (int o = 1; o < 64; o <<= 1) am = fmaxf(am, __shfl_xor(am, o));
    const float inv = am > 0.f ? 127.f / am : 0.f;
    GAS u32x2* q = (GAS u32x2*)qrow + lane;
#pragma unroll
    for (int j = 0; j < 8; ++j) { u32x2 w;
        w.x = ((unsigned)(int)rintf(f[j][0] * inv) & 0xffu) | (((unsigned)(int)rintf(f[j][1] * inv) & 0xffu) << 8) | (((unsigned)(int)rintf(f[j][2] * inv) & 0xffu) << 16) | (((unsigned)(int)rintf(f[j][3] * inv) & 0xffu) << 24);
        w.y = ((unsigned)(int)rintf(f[j][4] * inv) & 0xffu) | (((unsigned)(int)rintf(f[j][5] * inv) & 0xffu) << 8) | (((unsigned)(int)rintf(f[j][6] * inv) & 0xffu) << 16) | (((unsigned)(int)rintf(f[j][7] * inv) & 0xffu) << 24);
        q[64 * j] = w; }
    if (lane == 0) *rs = am * (1.f / 127.f);
}
DI void mix_row_norm(bf16* orow, const float* ga, const float* gb, int lane) {
    GAS v4u* p = (GAS v4u*)orow + lane;
    v4u v[8]; float sa = 0.f, sb = 0.f;
#pragma unroll
    for (int j = 0; j < 8; ++j) { v[j] = p[64 * j]; float s = 0.f;
#pragma unroll
        for (int k = 0; k < 4; ++k) { const float a = bflo(v[j][k]), b = bfhi(v[j][k]); s += a * a + b * b; }
        if (j < 4) sa += s; else sb += s; }
    const float ra = 1.0f / sqrtf(wave_sum(sa) * (1.f / 2048.f) + RMS_EPS), rb = 1.0f / sqrtf(wave_sum(sb) * (1.f / 2048.f) + RMS_EPS);
#pragma unroll
    for (int j = 0; j < 8; ++j) { const float rs = j < 4 ? ra : rb; const float* gp = (j < 4 ? ga : gb) + ((lane + 64 * (j & 3)) * 8);
        const f32x4 g0 = *(const GAS f32x4*)gp, g1 = *(const GAS f32x4*)(gp + 4); v4u w;
        w.x = cvtpk(bflo(v[j].x) * rs * g0.x, bfhi(v[j].x) * rs * g0.y); w.y = cvtpk(bflo(v[j].y) * rs * g0.z, bfhi(v[j].y) * rs * g0.w);
        w.z = cvtpk(bflo(v[j].z) * rs * g1.x, bfhi(v[j].z) * rs * g1.y); w.w = cvtpk(bflo(v[j].w) * rs * g1.z, bfhi(v[j].w) * rs * g1.w);
        p[64 * j] = w; }
}

struct EpiResF32 {
    static constexpr bool PERM = false, AFTER_DRAIN = false;
    const float* base; float* out; int ldc; float sc;
    __device__ __forceinline__ void operator()(const pg8::f32x4 (&acc)[2][2][4][2], const pg8::Unit& u, int wr, int wc, int fr, int fq) const {
        const int col0 = u.pn * 256 + wc * 32 + 4 * fq;
#pragma unroll
        for (int ai = 0; ai < 2; ++ai)
#pragma unroll
            for (int m = 0; m < 4; ++m) { const int r = ai * 128 + wr * 64 + m * 16 + fr; const size_t off = (size_t)(u.pm * 256 + r) * ldc + col0;
#pragma unroll
                for (int bj = 0; bj < 2; ++bj)
#pragma unroll
                    for (int n = 0; n < 2; ++n) { const pg8::f32x4 bs = *(const pg8::f32x4*)(base + off + bj * 128 + n * 16); *(pg8::f32x4*)(out + off + bj * 128 + n * 16) = bs + acc[ai][bj][m][n] * sc; } }
    }
};

struct EpiResNorm {
    static constexpr bool PERM = false, AFTER_DRAIN = false;
    const float* base; float* out; bf16* xn; const float* gain; float* ssq; int ldc;
    __device__ __forceinline__ void operator()(const pg8::f32x4 (&acc)[2][2][4][2], const pg8::Unit& u, int wr, int wc, int fr, int fq) const {
        const int col0 = u.pn * 256 + wc * 32 + 4 * fq;
        pg8::f32x4 gv[2][2];
#pragma unroll
        for (int bj = 0; bj < 2; ++bj)
#pragma unroll
            for (int n = 0; n < 2; ++n) gv[bj][n] = *(const pg8::f32x4*)(gain + col0 + bj * 128 + n * 16);
#pragma unroll
        for (int ai = 0; ai < 2; ++ai)
#pragma unroll
            for (int m = 0; m < 4; ++m) { const int r = u.pm * 256 + ai * 128 + wr * 64 + m * 16 + fr; const size_t off = (size_t)r * ldc + col0; float part = 0.f;
#pragma unroll
                for (int bj = 0; bj < 2; ++bj)
#pragma unroll
                    for (int n = 0; n < 2; ++n) { const pg8::f32x4 bs = *(const pg8::f32x4*)(base + off + bj * 128 + n * 16); const pg8::f32x4 v = bs + acc[ai][bj][m][n];
                        *(pg8::f32x4*)(out + off + bj * 128 + n * 16) = v; part += (v[0] * v[0] + v[1] * v[1]) + (v[2] * v[2] + v[3] * v[3]);
                        const pg8::f32x4 g = gv[bj][n]; u32x2 w; w.x = cvtpk(v[0] * g[0], v[1] * g[1]); w.y = cvtpk(v[2] * g[2], v[3] * g[3]);
                        *(u32x2*)(xn + off + bj * 128 + n * 16) = w; }
                part += __shfl_xor(part, 16); part += __shfl_xor(part, 32);
                if (fq == 0) atomicAdd(ssq + r, part); }
    }
};
struct EpiResNormMid {
    static constexpr bool PERM = false, AFTER_DRAIN = false;
    const float* base; float* out; bf16* xn; const float* gain; float* ssq; int ldc; const float* ssqa; const float* ssqb;
    LAS float* midtab;
    __device__ __forceinline__ void load_mid(const pg8::Unit& u) const {
        if (threadIdx.x < 256) { const int r = u.pm * 256 + (int)threadIdx.x;
            midtab[threadIdx.x] = sqrtf((ssqb[r] * (1.f / 2048.f) + RMS_EPS) / (ssqa[r] * (1.f / 2048.f) + RMS_EPS)); }
    }
    __device__ __forceinline__ float mid(int row_in_tile) const { return midtab[row_in_tile]; }
    __device__ __forceinline__ void operator()(const pg8::f32x4 (&acc)[2][2][4][2], const pg8::Unit& u, int wr, int wc, int fr, int fq) const {
        const int col0 = u.pn * 256 + wc * 32 + 4 * fq;
        pg8::f32x4 gv[2][2];
#pragma unroll
        for (int bj = 0; bj < 2; ++bj)
#pragma unroll
            for (int n = 0; n < 2; ++n) gv[bj][n] = *(const pg8::f32x4*)(gain + col0 + bj * 128 + n * 16);
#pragma unroll
        for (int ai = 0; ai < 2; ++ai)
#pragma unroll
            for (int m = 0; m < 4; ++m) { const int r = u.pm * 256 + ai * 128 + wr * 64 + m * 16 + fr; const size_t off = (size_t)r * ldc + col0; float part = 0.f;
                const float rsb = 1.0f / sqrtf(ssqb[r] * (1.f / 2048.f) + RMS_EPS);
#pragma unroll
                for (int bj = 0; bj < 2; ++bj)
#pragma unroll
                    for (int n = 0; n < 2; ++n) { const pg8::f32x4 bs = *(const pg8::f32x4*)(base + off + bj * 128 + n * 16); const pg8::f32x4 v = bs + acc[ai][bj][m][n] * rsb;
                        *(pg8::f32x4*)(out + off + bj * 128 + n * 16) = v; part += (v[0] * v[0] + v[1] * v[1]) + (v[2] * v[2] + v[3] * v[3]);
                        const pg8::f32x4 g = gv[bj][n]; u32x2 w; w.x = cvtpk(v[0] * g[0], v[1] * g[1]); w.y = cvtpk(v[2] * g[2], v[3] * g[3]);
                        *(u32x2*)(xn + off + bj * 128 + n * 16) = w; }
                part += __shfl_xor(part, 16); part += __shfl_xor(part, 32);
                if (fq == 0) atomicAdd(ssq + r, part); }
    }
};
struct EpiResHMid {
    static constexpr bool PERM = true, AFTER_DRAIN = false;
    bf16* H; float* ssq; int ldc; const float* ssqa; const float* ssqb; LAS float* midtab;
    __device__ __forceinline__ void load_mid(const pg8::Unit& u) const {
        if (threadIdx.x < 256) { const int r = u.pm * 256 + (int)threadIdx.x;
            midtab[threadIdx.x] = sqrtf((ssqb[r] * (1.f / 2048.f) + RMS_EPS) / (ssqa[r] * (1.f / 2048.f) + RMS_EPS)); }
    }
    __device__ __forceinline__ float mid(int row_in_tile) const { return midtab[row_in_tile]; }
    __device__ __forceinline__ void operator()(const pg8::f32x4 (&acc)[2][2][4][2], const pg8::Unit& u, int wr, int wc, int fr, int fq) const {
        const int col0 = u.pn * 256 + wc * 32 + 8 * fq;
#pragma unroll
        for (int ai = 0; ai < 2; ++ai)
#pragma unroll
            for (int m = 0; m < 4; ++m) { const int r = u.pm * 256 + ai * 128 + wr * 64 + m * 16 + fr; bf16* rowp = H + (size_t)r * ldc + col0; float part = 0.f;
                const float rsb = 1.0f / sqrtf(ssqb[r] * (1.f / 2048.f) + RMS_EPS);
#pragma unroll
                for (int bj = 0; bj < 2; ++bj) { const v4u hb = *(const v4u*)(rowp + bj * 128); float v[8];
#pragma unroll
                    for (int n = 0; n < 2; ++n)
#pragma unroll
                        for (int c = 0; c < 2; ++c) { const unsigned w2 = hb[2 * n + c]; v[4 * n + 2 * c] = bflo(w2) + acc[ai][bj][m][n][2 * c] * rsb; v[4 * n + 2 * c + 1] = bfhi(w2) + acc[ai][bj][m][n][2 * c + 1] * rsb; }
                    v4u w;
#pragma unroll
                    for (int c = 0; c < 4; ++c) { part += v[2 * c] * v[2 * c] + v[2 * c + 1] * v[2 * c + 1]; w[c] = cvtpk(v[2 * c], v[2 * c + 1]); }
                    *(v4u*)(rowp + bj * 128) = w; }
                part += __shfl_xor(part, 16); part += __shfl_xor(part, 32);
                if (fq == 0) atomicAdd(ssq + r, part); }
    }
};
struct EpiResH {
    static constexpr bool PERM = true, AFTER_DRAIN = false;
    bf16* H; float* ssq; int ldc;
    __device__ __forceinline__ void operator()(const pg8::f32x4 (&acc)[2][2][4][2], const pg8::Unit& u, int wr, int wc, int fr, int fq) const {
        const int col0 = u.pn * 256 + wc * 32 + 8 * fq;
#pragma unroll
        for (int ai = 0; ai < 2; ++ai)
#pragma unroll
            for (int m = 0; m < 4; ++m) { const int r = u.pm * 256 + ai * 128 + wr * 64 + m * 16 + fr; bf16* rowp = H + (size_t)r * ldc + col0; float part = 0.f;
#pragma unroll
                for (int bj = 0; bj < 2; ++bj) { const v4u hb = *(const v4u*)(rowp + bj * 128); float v[8];
#pragma unroll
                    for (int n = 0; n < 2; ++n)
#pragma unroll
                        for (int c = 0; c < 2; ++c) { const unsigned w2 = hb[2 * n + c]; v[4 * n + 2 * c] = bflo(w2) + acc[ai][bj][m][n][2 * c]; v[4 * n + 2 * c + 1] = bfhi(w2) + acc[ai][bj][m][n][2 * c + 1]; }
                    v4u w;
#pragma unroll
                    for (int c = 0; c < 4; ++c) { part += v[2 * c] * v[2 * c] + v[2 * c + 1] * v[2 * c + 1]; w[c] = cvtpk(v[2 * c], v[2 * c + 1]); }
                    *(v4u*)(rowp + bj * 128) = w; }
                part += __shfl_xor(part, 16); part += __shfl_xor(part, 32);
                if (fq == 0) atomicAdd(ssq + r, part); }
    }
};
struct EpiBf16I8 {
    static constexpr bool PERM = true, AFTER_DRAIN = false;
    bf16* O; int ldc; const float* rs; const unsigned* cm;
    __device__ __forceinline__ void operator()(const pg8::f32x4 (&acc)[2][2][4][2], const pg8::Unit& u, int wr, int wc, int fr, int fq) const {
        const int row0 = u.pm * 256 + wr * 64 + fr, col0 = u.pn * 256 + wc * 32 + 8 * fq;
        float cs[2][8];
#pragma unroll
        for (int bj = 0; bj < 2; ++bj) { const v4u c0 = *(const v4u*)(cm + col0 + bj * 128), c1 = *(const v4u*)(cm + col0 + bj * 128 + 4);
#pragma unroll
            for (int k = 0; k < 4; ++k) { cs[bj][k] = __uint_as_float(c0[k]) * (1.f / 127.f); cs[bj][4 + k] = __uint_as_float(c1[k]) * (1.f / 127.f); } }
#pragma unroll
        for (int ai = 0; ai < 2; ++ai)
#pragma unroll
            for (int m = 0; m < 4; ++m) { const int row = row0 + ai * 128 + m * 16; const float r1 = rs[row]; bf16* rowp = O + (size_t)row * ldc + col0;
#pragma unroll
                for (int bj = 0; bj < 2; ++bj) { float v[8];
#pragma unroll
                    for (int n = 0; n < 2; ++n)
#pragma unroll
                        for (int k = 0; k < 4; ++k) v[4 * n + k] = (float)(int)__float_as_uint(acc[ai][bj][m][n][k]) * r1 * cs[bj][4 * n + k];
                    v4u w; w.x = cvtpk(v[0], v[1]); w.y = cvtpk(v[2], v[3]); w.z = cvtpk(v[4], v[5]); w.w = cvtpk(v[6], v[7]);
                    *(v4u*)(rowp + bj * 128) = w; } }
    }
};
struct EpiResHI8 {
    static constexpr bool PERM = true, AFTER_DRAIN = false;
    bf16* H; float* ssq; int ldc; const float* rs; const unsigned* cm; const float* X;
    __device__ __forceinline__ void operator()(const pg8::f32x4 (&acc)[2][2][4][2], const pg8::Unit& u, int wr, int wc, int fr, int fq) const {
        const int col0 = u.pn * 256 + wc * 32 + 8 * fq;
        float cs[2][8];
#pragma unroll
        for (int bj = 0; bj < 2; ++bj) { const v4u c0 = *(const v4u*)(cm + col0 + bj * 128), c1 = *(const v4u*)(cm + col0 + bj * 128 + 4);
#pragma unroll
            for (int k = 0; k < 4; ++k) { cs[bj][k] = __uint_as_float(c0[k]) * (1.f / 127.f); cs[bj][4 + k] = __uint_as_float(c1[k]) * (1.f / 127.f); } }
#pragma unroll
        for (int ai = 0; ai < 2; ++ai)
#pragma unroll
            for (int m = 0; m < 4; ++m) { const int r = u.pm * 256 + ai * 128 + wr * 64 + m * 16 + fr; bf16* rowp = H + (size_t)r * ldc + col0; float part = 0.f; const float r1 = rs[r];
#pragma unroll
                for (int bj = 0; bj < 2; ++bj) { float v[8];
#ifdef XDIRECT
                    const float* xp = X + (size_t)r * ldc + col0 + bj * 128;
#pragma unroll
                    for (int n = 0; n < 2; ++n) { const pg8::f32x4 xb = *(const pg8::f32x4*)(xp + 4 * n);
#pragma unroll
                        for (int c = 0; c < 4; ++c) v[4 * n + c] = xb[c] + (float)(int)__float_as_uint(acc[ai][bj][m][n][c]) * r1 * cs[bj][4 * n + c]; }
#else
                    const v4u hb = *(const v4u*)(rowp + bj * 128);
#pragma unroll
                    for (int n = 0; n < 2; ++n)
#pragma unroll
                        for (int c = 0; c < 2; ++c) { const unsigned w2 = hb[2 * n + c];
                            v[4 * n + 2 * c] = bflo(w2) + (float)(int)__float_as_uint(acc[ai][bj][m][n][2 * c]) * r1 * cs[bj][4 * n + 2 * c];
                            v[4 * n + 2 * c + 1] = bfhi(w2) + (float)(int)__float_as_uint(acc[ai][bj][m][n][2 * c + 1]) * r1 * cs[bj][4 * n + 2 * c + 1]; }
#endif
                    v4u w;
#pragma unroll
                    for (int c = 0; c < 4; ++c) { part += v[2 * c] * v[2 * c] + v[2 * c + 1] * v[2 * c + 1]; w[c] = cvtpk(v[2 * c], v[2 * c + 1]); }
                    *(v4u*)(rowp + bj * 128) = w; }
                part += __shfl_xor(part, 16); part += __shfl_xor(part, 32);
                if (fq == 0) atomicAdd(ssq + r, part); }
    }
};
struct EpiBf16RowScale {
    static constexpr bool PERM = true, AFTER_DRAIN = false;
    bf16* O; int ldc; const float* ssq;
    __device__ __forceinline__ void operator()(const pg8::f32x4 (&acc)[2][2][4][2], const pg8::Unit& u, int wr, int wc, int fr, int fq) const {
        const int row0 = u.pm * 256 + wr * 64 + fr, col0 = u.pn * 256 + wc * 32 + 8 * fq;
#pragma unroll
        for (int ai = 0; ai < 2; ++ai)
#pragma unroll
            for (int m = 0; m < 4; ++m) { const int row = row0 + ai * 128 + m * 16; const float rs = 1.0f / sqrtf(ssq[row] * (1.f / DM) + RMS_EPS); bf16* rowp = O + (size_t)row * ldc + col0;
#pragma unroll
                for (int bj = 0; bj < 2; ++bj) { const pg8::f32x4 v0 = acc[ai][bj][m][0] * rs, v1 = acc[ai][bj][m][1] * rs;
                    v4u w; w.x = cvtpk(v0[0], v0[1]); w.y = cvtpk(v0[2], v0[3]); w.z = cvtpk(v1[0], v1[1]); w.w = cvtpk(v1[2], v1[3]);
                    *(v4u*)(rowp + bj * 128) = w; } }
    }
};

template <int NSTEP, int KP>
DI f32x16 qk_tile(const LAS unsigned char* Kt, const bf16x8* qf, int r, int h) {
    f32x16 s;
#pragma unroll
    for (int i = 0; i < 16; ++i) s[i] = 0.f;
    const LAS unsigned char* kp = Kt + r * KP + h * 16;
#pragma unroll
    for (int st = 0; st < NSTEP; ++st) { const bf16x8 a = *(const LAS bf16x8*)(kp + st * 32); s = MFMA32(a, qf[st], s); }
    return s;
}
template <int NDB, int VP>
DI void pv_tile(f32x16* o, const LAS unsigned char* Vt, const f32x16& p, int lane) {
    const int h = lane >> 5, q = (lane & 15) >> 2, pp = lane & 3, blk = (lane >> 4) & 1;
    const bf16x8 p0 = pack8(p, 0), p1 = pack8(p, 1);
    const LAS unsigned char* vb = Vt + (4 * h + q) * VP + blk * 32 + pp * 8;
#pragma unroll
    for (int db = 0; db < NDB; ++db) {
        const s16x4 l0 = vtr(vb + db * 64), h0 = vtr(vb + 8 * VP + db * 64), l1 = vtr(vb + 16 * VP + db * 64), h1 = vtr(vb + 24 * VP + db * 64);
        const bf16x8 v0 = __builtin_shufflevector(l0, h0, 0, 1, 2, 3, 4, 5, 6, 7), v1 = __builtin_shufflevector(l1, h1, 0, 1, 2, 3, 4, 5, 6, 7);
        o[db] = MFMA32(v0, p0, o[db]); o[db] = MFMA32(v1, p1, o[db]);
    }
}
DI float softmax_tile(f32x16& s, float& m, float& l) {
    float mx = s[0];
#pragma unroll
    for (int i = 1; i < 16; ++i) mx = fmaxf(mx, s[i]);
    mx = fmaxf(mx, __shfl_xor(mx, 32));
    const float mn = fmaxf(m, mx), alpha = fexp2(m - mn); m = mn;
    float sum = 0.f;
#pragma unroll
    for (int i = 0; i < 16; ++i) { s[i] = fexp2(s[i] - mn); sum += s[i]; }
    l = l * alpha + sum;
    return alpha;
}
DI float fmul_s(float a, float b) { float r; asm("v_mul_f32_e32 %0, %1, %2" : "=v"(r) : "v"(a), "v"(b)); return r; }
template <int NDB> DI void scale_o(f32x16* o, float alpha) {
#pragma unroll
    for (int db = 0; db < NDB; ++db)
#pragma unroll
        for (int i = 0; i < 16; ++i) o[db][i] *= alpha;
}
struct MaskNone { DI void operator()(f32x16&, int) const {} };
struct MaskSwa { int qpos, k0; int h;
    DI void operator()(f32x16& s, int st2) const {
#pragma unroll
        for (int i = 0; i < 16; ++i) { const int d = qpos - (k0 + 32 * st2 + crow(i, h)); s[i] = (d <= 128 && d >= -128) ? s[i] : -3.0e30f; } } };
struct MaskNat { const LAS float* brow; int t0;
    DI void operator()(f32x16& s, int st2) const {
        float bv[16];
#pragma unroll
        for (int i = 0; i < 16; ++i) bv[i] = brow[32 * st2 + (i & 3) + 8 * (i >> 2)];
        __builtin_amdgcn_sched_barrier(0);
#pragma unroll
        for (int i = 0; i < 16; ++i) { const int kc0 = 32 * st2 + (i & 3) + 8 * (i >> 2); s[i] = ((unsigned)(t0 + kc0) < 16u) ? s[i] + bv[i] : -3.0e30f; } } };
template <int NSTEP, int KP, int NDB, int VP, class Mask>
DI void tile64(const LAS unsigned char* Kb, const LAS unsigned char* Vb, const bf16x8* qf, f32x16* o, float& m, float& l, int lane, const Mask& mask, unsigned long long* tq = nullptr, bool domask = true) {
    const int r = lane & 31, h = lane >> 5;
#ifdef PROBE_TILE
    unsigned long long t0_ = clock64();
#define TT(i_) do { if (tq) { asm volatile("s_waitcnt vmcnt(0) lgkmcnt(0)" ::: "memory"); asm volatile("s_nop 15\n\ts_nop 15" :: "v"(s0), "v"(s1)); const unsigned long long n_ = clock64(); tq[i_] += n_ - t0_; t0_ = n_; } } while (0)
#else
#define TT(i_) do {} while (0)
#endif
    f32x16 s0, s1;
#pragma unroll
    for (int i = 0; i < 16; ++i) { s0[i] = 0.f; s1[i] = 0.f; }
    const LAS unsigned char* kp = Kb + r * KP + h * 16;
#pragma unroll
    for (int st = 0; st < NSTEP; ++st) { const bf16x8 a0 = *(const LAS bf16x8*)(kp + st * 32), a1 = *(const LAS bf16x8*)(kp + 32 * KP + st * 32);
        s0 = MFMA32(a0, qf[st], s0); s1 = MFMA32(a1, qf[st], s1); }
    TT(0);
    if (domask) { mask(s0, 0); mask(s1, 1); }
#ifdef PROBE_SPLIT
    TT(1);
#endif
    float mx0 = fmaxf(s0[0], s1[0]), mx1 = fmaxf(s0[1], s1[1]);
#pragma unroll
    for (int i = 2; i < 16; i += 2) { mx0 = fmaxf(mx0, fmaxf(s0[i], s1[i])); mx1 = fmaxf(mx1, fmaxf(s0[i + 1], s1[i + 1])); }
    float mx = fmaxf(mx0, mx1);
    { const auto sw = __builtin_amdgcn_permlane32_swap(__float_as_uint(mx), __float_as_uint(mx), false, false); mx = fmaxf(__uint_as_float(sw[0]), __uint_as_float(sw[1])); }
    const float mn = fmaxf(m, mx), alpha = fexp2(m - mn); m = mn;
    float sum0 = 0.f, sum1 = 0.f;
#pragma unroll
    for (int i = 0; i < 16; ++i) { s0[i] = fexp2(s0[i] - mn); s1[i] = fexp2(s1[i] - mn); sum0 += s0[i]; sum1 += s1[i]; }
    l = l * alpha + (sum0 + sum1);
    scale_o<NDB>(o, alpha);
#ifdef PROBE_SPLIT
    TT(2);
#else
    TT(1);
#endif
    const int q = (lane & 15) >> 2, pp = lane & 3, blk = (lane >> 4) & 1;
    const bf16x8 p00 = pack8(s0, 0), p01 = pack8(s0, 1), p10 = pack8(s1, 0), p11 = pack8(s1, 1);
    const LAS unsigned char* vb = Vb + (4 * h + q) * VP + blk * 32 + pp * 8;
#pragma unroll
    for (int db = 0; db < NDB; ++db) {
        const s16x4 a0 = vtr(vb + db * 64), a1 = vtr(vb + 8 * VP + db * 64), a2 = vtr(vb + 16 * VP + db * 64), a3 = vtr(vb + 24 * VP + db * 64);
        const s16x4 b0 = vtr(vb + 32 * VP + db * 64), b1 = vtr(vb + 40 * VP + db * 64), b2 = vtr(vb + 48 * VP + db * 64), b3 = vtr(vb + 56 * VP + db * 64);
        const bf16x8 v00 = __builtin_shufflevector(a0, a1, 0, 1, 2, 3, 4, 5, 6, 7), v01 = __builtin_shufflevector(a2, a3, 0, 1, 2, 3, 4, 5, 6, 7);
        const bf16x8 v10 = __builtin_shufflevector(b0, b1, 0, 1, 2, 3, 4, 5, 6, 7), v11 = __builtin_shufflevector(b2, b3, 0, 1, 2, 3, 4, 5, 6, 7);
        o[db] = MFMA32(v00, p00, o[db]); o[db] = MFMA32(v01, p01, o[db]); o[db] = MFMA32(v10, p10, o[db]); o[db] = MFMA32(v11, p11, o[db]);
    }
#if defined(PROBE_TILE) && !defined(PROBE_SPLIT)
    if (tq) { asm volatile("s_nop 15\n\ts_nop 15" :: "v"(o[0]), "v"(o[1]), "v"(o[2]), "v"(o[3])); const unsigned long long n_ = clock64(); tq[2] += n_ - t0_; }
#endif
#undef TT
}
template <int NDB> DI void store_o(const f32x16* o, float inv, bf16* orow, int h, float* ssq = nullptr) {
    float part = 0.f;
#pragma unroll
    for (int db = 0; db < NDB; ++db)
#pragma unroll
        for (int gp = 0; gp < 2; ++gp) {
            unsigned ax, ay, bx, by;
            { const int g = 2 * gp; const float a0 = o[db][4 * g] * inv, a1 = o[db][4 * g + 1] * inv, a2 = o[db][4 * g + 2] * inv, a3 = o[db][4 * g + 3] * inv;
              part += (a0 * a0 + a1 * a1) + (a2 * a2 + a3 * a3); ax = cvtpk(a0, a1); ay = cvtpk(a2, a3); }
            { const int g = 2 * gp + 1; const float a0 = o[db][4 * g] * inv, a1 = o[db][4 * g + 1] * inv, a2 = o[db][4 * g + 2] * inv, a3 = o[db][4 * g + 3] * inv;
              part += (a0 * a0 + a1 * a1) + (a2 * a2 + a3 * a3); bx = cvtpk(a0, a1); by = cvtpk(a2, a3); }
            const auto sx = __builtin_amdgcn_permlane32_swap(ax, bx, false, false), sy = __builtin_amdgcn_permlane32_swap(ay, by, false, false);
            v4u w; w.x = sx[0]; w.y = sy[0]; w.z = sx[1]; w.w = sy[1];
            *(GAS v4u*)(orow + 32 * db + 16 * gp + 8 * h) = w; }
    if (ssq) { part += __shfl_xor(part, 32); if (h == 0) atomicAdd(ssq, part); }
}

constexpr int KP128 = 272, VP128 = 320, KP256 = 528, VP256 = 576;
constexpr int ATT_K_OFF = 0, ATT_V_OFF = 34816, ATT_BIAS_OFF = 72704;

constexpr int A2_K = 0, A2_V = 17408, A2_BUF = 37888, A2_BIAS = 76800;
template <bool SKIPC = false> DI void swa_unit(LAS unsigned char* lds, int u, const bf16* QKV, bf16* OB, const float* sink, const float* ropec, const float* ropes, float* SSQA) {
    const int tid = threadIdx.x, lane = tid & 63, wid = __builtin_amdgcn_readfirstlane(tid >> 6), r = lane & 31, h = lane >> 5;
    const int qb = u & 31, kvh = (u >> 5) & 3, b = u >> 7;
    const int q0 = qb * 64, g = wid >> 1, sub = wid & 1, head = kvh * 4 + g;
    const int qpos = q0 + 32 * sub + r;
    const size_t tok = (size_t)b * SEQ + qpos;
    const float QS = 0.08838834764831845f * LOG2E;
    const int t_lo = qb - 2 < 0 ? 0 : qb - 2, t_hi = qb + 2 > 31 ? 31 : qb + 2;
    const int skey = tid >> 3, sc = tid & 7;
    v4u s_lo, s_hi, s_v0, s_v1; int s_kpos = 0;
#define SWA_LOAD(kt_) do { const int kpos_ = (kt_) * 64 + skey; const size_t ktok_ = (size_t)b * SEQ + kpos_; \
        const bf16* kp_ = QKV + ktok_ * INW + C_KA + kvh * 128 + 8 * sc; s_lo = *(const GAS v4u*)kp_; s_hi = *(const GAS v4u*)(kp_ + 64); \
        const bf16* vp_ = QKV + ktok_ * INW + C_VA + kvh * 128 + 8 * sc; s_v0 = *(const GAS v4u*)vp_; s_v1 = *(const GAS v4u*)(vp_ + 64); \
        s_kpos = kpos_; } while (0)
#define SWA_WRITE(buf_) do { float cc_[8], ss_[8]; _Pragma("unroll") for (int k_ = 0; k_ < 8; ++k_) { const float inv_ = fexp2(-(float)(8 * sc + k_) * (13.287712379549449f / 64.0f)); \
            const float rev_ = ((float)s_kpos * inv_) * 0.15915494309189535f; const float fr_ = rev_ - floorf(rev_); cc_[k_] = __builtin_amdgcn_cosf(fr_); ss_[k_] = __builtin_amdgcn_sinf(fr_); } \
        v4u a_, b_; _Pragma("unroll") for (int k_ = 0; k_ < 4; ++k_) { const float x1a = bflo(s_lo[k_]), x1b = bfhi(s_lo[k_]), x2a = bflo(s_hi[k_]), x2b = bfhi(s_hi[k_]); \
            a_[k_] = cvtpk(x1a * cc_[2 * k_] - x2a * ss_[2 * k_], x1b * cc_[2 * k_ + 1] - x2b * ss_[2 * k_ + 1]); \
            b_[k_] = cvtpk(x2a * cc_[2 * k_] + x1a * ss_[2 * k_], x2b * cc_[2 * k_ + 1] + x1b * ss_[2 * k_ + 1]); } \
        LAS unsigned char* bb_ = lds + (buf_) * A2_BUF; \
        *(LAS v4u*)(bb_ + A2_K + skey * KP128 + 16 * sc) = a_; *(LAS v4u*)(bb_ + A2_K + skey * KP128 + 128 + 16 * sc) = b_; \
        *(LAS v4u*)(bb_ + A2_V + skey * VP128 + 16 * sc) = s_v0; *(LAS v4u*)(bb_ + A2_V + skey * VP128 + 128 + 16 * sc) = s_v1; } while (0)
    bf16x8 qf[8];
    {
        const bf16* qp = QKV + tok * INW + C_QA + head * 128 + 8 * h;
#pragma unroll
        for (int st = 0; st < 4; ++st) {
            const v4u lo = *(const GAS v4u*)(qp + 16 * st), hi = *(const GAS v4u*)(qp + 16 * st + 64);
            const float* cp = ropec + (size_t)qpos * 64 + 16 * st + 8 * h; const float* sp = ropes + (size_t)qpos * 64 + 16 * st + 8 * h;
            const f32x4 c0 = *(const GAS f32x4*)cp, c1 = *(const GAS f32x4*)(cp + 4), s0 = *(const GAS f32x4*)sp, s1 = *(const GAS f32x4*)(sp + 4);
            float x1[8], x2[8], cc[8], ss[8];
#pragma unroll
            for (int k = 0; k < 4; ++k) { x1[2 * k] = bflo(lo[k]); x1[2 * k + 1] = bfhi(lo[k]); x2[2 * k] = bflo(hi[k]); x2[2 * k + 1] = bfhi(hi[k]); cc[k] = c0[k]; cc[4 + k] = c1[k]; ss[k] = s0[k]; ss[4 + k] = s1[k]; }
            v4u a, bq;
#pragma unroll
            for (int k = 0; k < 4; ++k) {
                a[k] = cvtpk((x1[2 * k] * cc[2 * k] - x2[2 * k] * ss[2 * k]) * QS, (x1[2 * k + 1] * cc[2 * k + 1] - x2[2 * k + 1] * ss[2 * k + 1]) * QS);
                bq[k] = cvtpk((x2[2 * k] * cc[2 * k] + x1[2 * k] * ss[2 * k]) * QS, (x2[2 * k + 1] * cc[2 * k + 1] + x1[2 * k + 1] * ss[2 * k + 1]) * QS);
            }
            qf[st] = __builtin_bit_cast(bf16x8, a); qf[st + 4] = __builtin_bit_cast(bf16x8, bq);
        }
    }
    asm volatile("" ::: "memory");
    SWA_LOAD(t_lo);
    float m = sink[head] * LOG2E, l = (h == 0) ? 1.f : 0.f;
    f32x16 o[4];
#pragma unroll
    for (int db = 0; db < 4; ++db)
#pragma unroll
        for (int i = 0; i < 16; ++i) o[db][i] = 0.f;
    __syncthreads();
    SWA_WRITE(0);
    __syncthreads();
    int buf = 0;
    for (int kt = t_lo; kt <= t_hi; ++kt) {
        if (kt < t_hi) SWA_LOAD(kt + 1);
        const LAS unsigned char* bb = lds + buf * A2_BUF;
        if (!SKIPC) { const MaskSwa mk{qpos, kt * 64, h}; tile64<8, KP128, 4, VP128>(bb + A2_K, bb + A2_V, qf, o, m, l, lane, mk, nullptr, kt <= qb - 2 || kt >= qb + 2); }
        if (kt < t_hi) SWA_WRITE(buf ^ 1);
        __syncthreads();
        buf ^= 1;
    }
#undef SWA_LOAD
#undef SWA_WRITE
    const float lt = l + __shfl_xor(l, 32);
    store_o<4>(o, 1.0f / lt, OB + tok * DM + head * 128, h, SSQA + tok);
}

#define PROBE_PTR ((unsigned char*)SSQB - WS_SSQB + 458752)
DI void nat_unit(LAS unsigned char* lds, int u, const bf16* QKV, bf16* OB, const float* relb, float* SSQB) {
    const int tid = threadIdx.x, lane = tid & 63, wid = __builtin_amdgcn_readfirstlane(tid >> 6), r = lane & 31, h = lane >> 5;
    const int rb = u & 7, head = (u >> 3) & 15, b = u >> 7;
    const int r0 = rb * 4, qrow = r0 + (wid >> 1), qcol = 32 * (wid & 1) + r;
    const size_t tok = (size_t)b * SEQ + qrow * 64 + qcol;
    const float QS = 0.08838834764831845f * LOG2E;
    int kr_lo = r0 - 4; kr_lo = kr_lo < 0 ? 0 : (kr_lo > 24 ? 24 : kr_lo);
    int kr_hi = r0 + 3 - 4; kr_hi = (kr_hi < 0 ? 0 : (kr_hi > 24 ? 24 : kr_hi)) + 7;
    int rs = qrow - 4; rs = rs < 0 ? 0 : (rs > 24 ? 24 : rs);
    int cs = qcol - 8; cs = cs < 0 ? 0 : (cs > 48 ? 48 : cs);
    const int skey = tid >> 3, sc = tid & 7;
    v4u s_k0, s_k1, s_v0, s_v1;
#define NAT_LOAD(kr_) do { const size_t ktok_ = (size_t)b * SEQ + (kr_) * 64 + skey; \
        const bf16* kp_ = QKV + ktok_ * INW + C_KB + head * 128 + 8 * sc; s_k0 = *(const GAS v4u*)kp_; s_k1 = *(const GAS v4u*)(kp_ + 64); \
        const bf16* vp_ = QKV + ktok_ * INW + C_VB + head * 128 + 8 * sc; s_v0 = *(const GAS v4u*)vp_; s_v1 = *(const GAS v4u*)(vp_ + 64); } while (0)
#define NAT_WRITE(buf_) do { LAS unsigned char* bb_ = lds + (buf_) * A2_BUF; \
        *(LAS v4u*)(bb_ + A2_K + skey * KP128 + 16 * sc) = s_k0; *(LAS v4u*)(bb_ + A2_K + skey * KP128 + 128 + 16 * sc) = s_k1; \
        *(LAS v4u*)(bb_ + A2_V + skey * VP128 + 16 * sc) = s_v0; *(LAS v4u*)(bb_ + A2_V + skey * VP128 + 128 + 16 * sc) = s_v1; } while (0)
    NAT_LOAD(kr_lo);
    bf16x8 qf[8];
    {
        const bf16* qp = QKV + tok * INW + C_QB + head * 128 + 8 * h;
#pragma unroll
        for (int st = 0; st < 8; ++st) { const v4u x = *(const GAS v4u*)(qp + 16 * st); v4u a;
#pragma unroll
            for (int k = 0; k < 4; ++k) a[k] = cvtpk(bflo(x[k]) * QS, bfhi(x[k]) * QS);
            qf[st] = __builtin_bit_cast(bf16x8, a); }
    }
    float m = -1.0e30f, l = 0.f;
    f32x16 o[4];
#pragma unroll
    for (int db = 0; db < 4; ++db)
#pragma unroll
        for (int i = 0; i < 16; ++i) o[db][i] = 0.f;
    __syncthreads();
    LAS float* bias = (LAS float*)(lds + A2_BIAS) + 64;
    if (tid < 465) bias[tid] = relb[head * 465 + tid] * LOG2E;
    NAT_WRITE(0);
    __syncthreads();
    int buf = 0;
#ifdef PROBE_TILE
    unsigned long long tq_[3] = {0, 0, 0};
#endif
#ifdef PROBE_TIMING
    unsigned long long tc_ = 0, tw_ = 0, tb_ = 0, t0_ = clock64(), tt0_ = t0_;
#define TSTAMP(acc_) do { asm volatile("s_waitcnt vmcnt(0) lgkmcnt(0)" ::: "memory"); const unsigned long long n_ = clock64(); acc_ += n_ - t0_; t0_ = n_; } while (0)
#else
#define TSTAMP(acc_) do {} while (0)
#endif
    for (int kr = kr_lo; kr <= kr_hi; ++kr) {
        if (kr < kr_hi) NAT_LOAD(kr + 1);
        if (kr >= rs && kr < rs + 8) {
            const LAS unsigned char* bb = lds + buf * A2_BUF;
            int dr = kr - qrow + 7; dr = dr < 0 ? 0 : (dr > 14 ? 14 : dr);
            int boff = 15 - qcol + 4 * h, t0 = 4 * h - cs;
            asm volatile("" : "+v"(boff), "+v"(t0));
            const LAS float* brow = bias + dr * 31 + boff;
#ifdef PROBE_TILE
            { const MaskNat mk{brow, t0}; tile64<8, KP128, 4, VP128>(bb + A2_K, bb + A2_V, qf, o, m, l, lane, mk, tq_); }
#else
            { const MaskNat mk{brow, t0}; tile64<8, KP128, 4, VP128>(bb + A2_K, bb + A2_V, qf, o, m, l, lane, mk); }
#endif
        }
#ifdef PROBE_TIMING
        { asm volatile("s_waitcnt lgkmcnt(0)" ::: "memory"); const unsigned long long n_ = clock64(); tc_ += n_ - t0_; t0_ = n_; }
        TSTAMP(tw_);
#endif
        if (kr < kr_hi) NAT_WRITE(buf ^ 1);
        __syncthreads();
        TSTAMP(tb_);
        buf ^= 1;
    }
#ifdef PROBE_TIMING
#ifdef PROBE_TILE
    if (blockIdx.x == 0 && tid == 0) { unsigned long long* pt = (unsigned long long*)PROBE_PTR; pt[0] += tq_[0]; pt[1] += tq_[1]; pt[2] += tq_[2]; pt[3] += tc_; }
#else
    if (blockIdx.x == 0 && tid == 0) { unsigned long long* pt = (unsigned long long*)PROBE_PTR; pt[0] += tc_; pt[1] += tw_; pt[2] += tb_; pt[3] += clock64() - tt0_; }
#endif
#endif
#undef TSTAMP
#undef NAT_LOAD
#undef NAT_WRITE
    const float lt = l + __shfl_xor(l, 32);
    store_o<4>(o, 1.0f / lt, OB + tok * DM + 2048 + head * 128, h, SSQB + tok);
}

DI void mem_unit(LAS unsigned char* lds, int u, const bf16* QM, const bf16* KVM, bf16* OM) {
    const int tid = threadIdx.x, lane = tid & 63, wid = __builtin_amdgcn_readfirstlane(tid >> 6), r = lane & 31, h = lane >> 5;
    const int qblk = u & 15, mh = (u >> 4) & 3, b = u >> 6;
    const int qsub = wid >> 1, dh = wid & 1;
    const size_t tok = (size_t)b * SEQ + qblk * 128 + 32 * qsub + r;
    const float QS = 0.0625f * LOG2E;
    bf16x8 qf[16];
    {
        const bf16* qp = QM + tok * MEMW + mh * 256 + 8 * h;
#pragma unroll
        for (int st = 0; st < 16; ++st) { const v4u x = *(const GAS v4u*)(qp + 16 * st); v4u a;
#pragma unroll
            for (int k = 0; k < 4; ++k) a[k] = cvtpk(bflo(x[k]) * QS, bfhi(x[k]) * QS);
            qf[st] = __builtin_bit_cast(bf16x8, a); }
    }
    float m = -1.0e30f, l = 0.f;
    f32x16 o[4];
#pragma unroll
    for (int db = 0; db < 4; ++db)
#pragma unroll
        for (int i = 0; i < 16; ++i) o[db][i] = 0.f;
    for (int kt = 0; kt < 4; ++kt) {
        __syncthreads();
#pragma unroll
        for (int it = 0; it < 4; ++it) {
            const int ch = tid + 512 * it, key = ch >> 5, c = ch & 31;
            const bf16* kp = KVM + (size_t)(b * MEMLEN + kt * 64 + key) * 2048 + mh * 256 + 8 * c;
            const v4u kv = *(const GAS v4u*)kp, vv = *(const GAS v4u*)(kp + 1024);
            *(LAS v4u*)(lds + ATT_K_OFF + key * KP256 + 16 * c) = kv; *(LAS v4u*)(lds + ATT_V_OFF + key * VP256 + 16 * c) = vv;
        }
        __syncthreads();
        { const MaskNone mk; tile64<16, KP256, 4, VP256>(lds + ATT_K_OFF, lds + ATT_V_OFF + dh * 256, qf, o, m, l, lane, mk); }
    }
    const float lt = l + __shfl_xor(l, 32);
    store_o<4>(o, 1.0f / lt, OM + tok * MEMW + mh * 256 + dh * 128, h);
}

DI unsigned f2sort(float f) { const unsigned u = __float_as_uint(f); return u ^ ((unsigned)((int)u >> 31) | 0x80000000u); }
DI float sort2f(unsigned k) { const unsigned u = (k & 0x80000000u) ? (k ^ 0x80000000u) : ~k; return __uint_as_float(u); }
constexpr int RT_SK_OFF = 0, RT_A_OFF = 69632;
struct constexpr_cand { int a, b; };
__host__ __device__ constexpr constexpr_cand cand_ab(int n) {
    int c = 0;
    for (int a = 0; a < 16; ++a) for (int b = 0; b < 16; ++b) if ((a + 1) * (b + 1) <= 16) { if (c == n) return constexpr_cand{a, b}; ++c; }
    return constexpr_cand{0, 0};
}
DI unsigned selu(int h, unsigned a, unsigned b) { asm volatile("" : "+v"(a), "+v"(b)); return h ? b : a; }
DI float self(int h, float a, float b) { asm volatile("" : "+v"(a), "+v"(b)); return h ? b : a; }
DI void ce_desc(unsigned& a, unsigned& b) { const unsigned hi = a > b ? a : b, lo = a > b ? b : a; a = hi; b = lo; }
template <int LOGN> DI void bitonic_merge_desc(unsigned (&x)[1 << LOGN]) {
#pragma unroll
    for (int lj = LOGN - 1; lj >= 0; --lj)
#pragma unroll
        for (int i = 0; i < (1 << LOGN); ++i) { const int l = i ^ (1 << lj); if (l > i) ce_desc(x[i], x[l]); }
}
DI void bitonic_sort16_desc(unsigned (&x)[16]) {
#pragma unroll
    for (int lk = 1; lk <= 4; ++lk)
#pragma unroll
        for (int lj = lk - 1; lj >= 0; --lj)
#pragma unroll
            for (int i = 0; i < 16; ++i) { const int l = i ^ (1 << lj); if (l > i) { if ((i & (1 << lk)) == 0) ce_desc(x[i], x[l]); else ce_desc(x[l], x[i]); } }
}
DI void top16_merge(unsigned (&a)[16], const unsigned (&b)[16]) {
#pragma unroll
    for (int i = 0; i < 16; ++i) a[i] = a[i] > b[15 - i] ? a[i] : b[15 - i];
    bitonic_merge_desc<4>(a);
}
DI void top16_xlane(unsigned (&a)[16]) {
    unsigned o[16];
#pragma unroll
    for (int i = 0; i < 16; ++i) o[i] = (unsigned)__shfl_xor((int)a[i], 32);
    top16_merge(a, o);
}
DI void route_unit(LAS unsigned char* lds, int u, const bf16* QP, const bf16* SKB, int* IDX, float* GATE) {
    const int tid = threadIdx.x, lane = tid & 63, wid = __builtin_amdgcn_readfirstlane(tid >> 6), r = lane & 31, h = lane >> 5;
    const int hd = u & 7, tile = u >> 3;
    const size_t tok = (size_t)tile * 256 + 32 * wid + r;
    __syncthreads();
#pragma unroll
    for (int it = 0; it < 8; ++it) { const int ch = tid + 512 * it, row = ch >> 4, c = ch & 15;
        const v4u x = *(const GAS v4u*)(SKB + ((size_t)hd * 256 + row) * 128 + 8 * c);
        *(LAS v4u*)(lds + RT_SK_OFF + row * 272 + 16 * c) = x; }
    __syncthreads();
    LAS unsigned* A = (LAS unsigned*)(lds + RT_A_OFF);
    const int tslot = wid * 32 + r;
    unsigned top[2][16];
#pragma unroll
    for (int c = 0; c < 2; ++c) {
        bf16x8 qf[8];
        const bf16* qp = QP + tok * PQW + hd * 256 + c * 128 + 8 * h;
#pragma unroll
        for (int st = 0; st < 8; ++st) qf[st] = __builtin_bit_cast(bf16x8, *(const GAS v4u*)(qp + 16 * st));
        unsigned g0[16], g1[16];
#pragma unroll
        for (int kt = 0; kt < 4; ++kt) {
            const f32x16 s = qk_tile<8, 272>(lds + RT_SK_OFF + (c * 128 + 32 * kt) * 272, qf, r, h);
            unsigned pk[16];
#pragma unroll
            for (int i = 0; i < 16; ++i) pk[i] = (f2sort(s[i]) & ~0x7Fu) | (unsigned)(127 - (32 * kt + crow(i, h)));
            bitonic_sort16_desc(pk);
            if (kt == 0) {
#pragma unroll
                for (int i = 0; i < 16; ++i) g0[i] = pk[i];
            } else if (kt == 1) { top16_merge(g0, pk); }
            else if (kt == 2) {
#pragma unroll
                for (int i = 0; i < 16; ++i) g1[i] = pk[i];
            } else { top16_merge(g1, pk); }
        }
        top16_merge(g0, g1);
        top16_xlane(g0);
#pragma unroll
        for (int i = 0; i < 16; ++i) { top[c][i] = g0[i]; if (h == 0) A[(c * 16 + i) * 256 + tslot] = g0[i]; }
    }
    float v1[16], v2[16];
#pragma unroll
    for (int a = 0; a < 16; ++a) { v1[a] = sort2f(top[0][a] & ~0x7Fu); v2[a] = sort2f(top[1][a] & ~0x7Fu); }
    unsigned cd[64];
#define CK(a_, b_) ((f2sort(v1[a_] + v2[b_]) & ~0xFFu) | (unsigned)(255 - ((a_) * 16 + (b_))))
    cd[0] = CK(0, 0); cd[1] = CK(0, 1); cd[2] = CK(0, 2); cd[3] = CK(0, 3); cd[4] = CK(0, 4);
    cd[5] = CK(0, 5); cd[6] = CK(0, 6); cd[7] = CK(0, 7); cd[8] = CK(0, 8); cd[9] = CK(0, 9);
    cd[10] = CK(0, 10); cd[11] = CK(0, 11); cd[12] = CK(0, 12); cd[13] = CK(0, 13); cd[14] = CK(0, 14);
    cd[15] = CK(0, 15); cd[16] = CK(1, 0); cd[17] = CK(1, 1); cd[18] = CK(1, 2); cd[19] = CK(1, 3);
    cd[20] = CK(1, 4); cd[21] = CK(1, 5); cd[22] = CK(1, 6); cd[23] = CK(1, 7); cd[24] = CK(2, 0);
    cd[25] = CK(2, 1); cd[26] = CK(2, 2); cd[27] = CK(2, 3); cd[28] = CK(2, 4); cd[29] = CK(3, 0);
    cd[30] = CK(3, 1); cd[31] = CK(3, 2); cd[32] = CK(3, 3); cd[33] = CK(4, 0); cd[34] = CK(4, 1);
    cd[35] = CK(4, 2); cd[36] = CK(5, 0); cd[37] = CK(5, 1); cd[38] = CK(6, 0); cd[39] = CK(6, 1);
    cd[40] = CK(7, 0); cd[41] = CK(7, 1); cd[42] = CK(8, 0); cd[43] = CK(9, 0); cd[44] = CK(10, 0);
    cd[45] = CK(11, 0); cd[46] = CK(12, 0); cd[47] = CK(13, 0); cd[48] = CK(14, 0); cd[49] = CK(15, 0);
#undef CK
#pragma unroll
    for (int n = 50; n < 64; ++n) cd[n] = 0u;
    unsigned c0[16], c1[16];
#pragma unroll
    for (int i = 0; i < 16; ++i) { c0[i] = selu(h, cd[i], cd[32 + i]); c1[i] = selu(h, cd[16 + i], cd[48 + i]); }
    bitonic_sort16_desc(c0); bitonic_sort16_desc(c1);
    top16_merge(c0, c1);
    top16_xlane(c0);
    LDS_WAIT();
    asm volatile("" ::: "memory");
    const float mx0 = sort2f(c0[0] & ~0xFFu);
    float ev[16], esum = 0.f;
#pragma unroll
    for (int t = 0; t < 16; ++t) { ev[t] = fexp2((sort2f(c0[t] & ~0xFFu) - mx0) * LOG2E); esum += ev[t]; }
    const float inv = 1.0f / esum;
#pragma unroll
    for (int q4 = 0; q4 < 2; ++q4) {
        int iv[4]; float gv[4];
#pragma unroll
        for (int k = 0; k < 4; ++k) {
            const unsigned cw = selu(h, c0[4 * q4 + k], c0[8 + 4 * q4 + k]);
            const float e = self(h, ev[4 * q4 + k], ev[8 + 4 * q4 + k]);
            const int code = 255 - (int)(cw & 0xFFu), a = code >> 4, bb = code & 15;
            const int i1 = 127 - (int)(A[a * 256 + tslot] & 0x7Fu), i2 = 127 - (int)(A[(16 + bb) * 256 + tslot] & 0x7Fu);
            iv[k] = i1 * 128 + i2; gv[k] = e * inv;
        }
        const size_t o = tok * 128 + hd * 16 + 8 * h + 4 * q4;
        v4u iw; iw.x = (unsigned)iv[0]; iw.y = (unsigned)iv[1]; iw.z = (unsigned)iv[2]; iw.w = (unsigned)iv[3];
        *(GAS v4u*)(IDX + o) = iw;
        f32x4 gw; gw.x = gv[0]; gw.y = gv[1]; gw.z = gv[2]; gw.w = gv[3];
        *(GAS f32x4*)(GATE + o) = gw;
    }
}

DI float dot2bf(unsigned w, unsigned x, float acc) { return __builtin_amdgcn_fdot2_f32_bf16(__builtin_bit_cast(bf16x2_t, w), __builtin_bit_cast(bf16x2_t, x), acc, false); }
DI float readlane_f(float v, int l) { return __uint_as_float((unsigned)__builtin_amdgcn_readlane((int)__float_as_uint(v), l)); }
DI float gelu_erf(float x) { return 0.5f * x * (1.0f + erff(x * 0.70710678118654752f)); }
DI void load_row8(v4u* dst, const bf16* row, int lane) {
    const GAS v4u* p = (const GAS v4u*)row + lane;
#pragma unroll
    for (int j = 0; j < 8; ++j) dst[j] = p[64 * j];
}
DI float dot_row(const v4u* xr, const v4u* w) {
    float a0 = 0.f, a1 = 0.f, a2 = 0.f, a3 = 0.f;
#pragma unroll
    for (int j = 0; j < 8; ++j) { a0 = dot2bf(w[j].x, xr[j].x, a0); a1 = dot2bf(w[j].y, xr[j].y, a1); a2 = dot2bf(w[j].z, xr[j].z, a2); a3 = dot2bf(w[j].w, xr[j].w, a3); }
    return (a0 + a1) + (a2 + a3);
}
DI void axpy_row(float* acc, const v4u* w, float s) {
#pragma unroll
    for (int j = 0; j < 8; ++j)
#pragma unroll
        for (int k = 0; k < 4; ++k) { acc[8 * j + 2 * k] += s * bflo(w[j][k]); acc[8 * j + 2 * k + 1] += s * bfhi(w[j][k]); }
}
DI void peer_token(int tk, const bf16* XN, const int* IDX, const float* GATE, const bf16* UB, const bf16* VB, float* hout, const float* gfin, int lane) {
    v4u xr[8];
    load_row8(xr, XN + (size_t)tk * DM, lane);
    const int ilo = IDX[(size_t)tk * 128 + lane], ihi = IDX[(size_t)tk * 128 + 64 + lane];
    const float glo = GATE[(size_t)tk * 128 + lane], ghi = GATE[(size_t)tk * 128 + 64 + lane];
    float alo = 0.f, ahi = 0.f;
#ifdef PEER_REP
    for (int prep_ = 0; prep_ < 2; ++prep_)
#endif
    {
        v4u b0[8], b1[8];
        load_row8(b0, UB + (size_t)__builtin_amdgcn_readlane(ilo, 0) * DM, lane);
#pragma unroll 1
        for (int e = 0; e < 128; e += 2) {
            const int l1 = (e + 1) & 63;
            const int r1 = (e + 1) < 64 ? __builtin_amdgcn_readlane(ilo, l1) : __builtin_amdgcn_readlane(ihi, l1);
            load_row8(b1, UB + (size_t)r1 * DM, lane);
            { const float d = wave_sum(dot_row(xr, b0)); if (e < 64) { if (lane == (e & 63)) alo = d; } else { if (lane == (e & 63)) ahi = d; } }
            const int e2 = e + 2 < 128 ? e + 2 : 127, l2 = e2 & 63;
            const int r2 = e2 < 64 ? __builtin_amdgcn_readlane(ilo, l2) : __builtin_amdgcn_readlane(ihi, l2);
            load_row8(b0, UB + (size_t)r2 * DM, lane);
            { const float d = wave_sum(dot_row(xr, b1)); if (e + 1 < 64) { if (lane == l1) alo = d; } else { if (lane == l1) ahi = d; } }
        }
    }
#ifdef DBG_NO_PEER
    const float wlo = 0.f * alo * glo, whi = 0.f * ahi * ghi;
#else
    const float wlo = gelu_erf(alo) * glo, whi = gelu_erf(ahi) * ghi;
#endif
    float acc[64];
#pragma unroll
    for (int i = 0; i < 64; ++i) acc[i] = 0.f;
    {
        v4u b0[8], b1[8];
        load_row8(b0, VB + (size_t)__builtin_amdgcn_readlane(ilo, 0) * DM, lane);
#pragma unroll 1
        for (int e = 0; e < 128; e += 2) {
            const int l0 = e & 63, l1 = (e + 1) & 63;
            const int r1 = (e + 1) < 64 ? __builtin_amdgcn_readlane(ilo, l1) : __builtin_amdgcn_readlane(ihi, l1);
            load_row8(b1, VB + (size_t)r1 * DM, lane);
            { const float w = e < 64 ? readlane_f(wlo, l0) : readlane_f(whi, l0); axpy_row(acc, b0, w); }
            const int e2 = e + 2 < 128 ? e + 2 : 127, l2 = e2 & 63;
            const int r2 = e2 < 64 ? __builtin_amdgcn_readlane(ilo, l2) : __builtin_amdgcn_readlane(ihi, l2);
            load_row8(b0, VB + (size_t)r2 * DM, lane);
            { const float w = (e + 1) < 64 ? readlane_f(wlo, l1) : readlane_f(whi, l1); axpy_row(acc, b1, w); }
        }
    }
    float* hrow = hout + (size_t)tk * DM;
    float ssq = 0.f;
#pragma unroll
    for (int j = 0; j < 8; ++j) {
        const f32x4 h0 = *(const GAS f32x4*)(hrow + 512 * j + 8 * lane), h1 = *(const GAS f32x4*)(hrow + 512 * j + 8 * lane + 4);
#pragma unroll
        for (int k = 0; k < 4; ++k) { acc[8 * j + k] += h0[k]; acc[8 * j + 4 + k] += h1[k]; }
#pragma unroll
        for (int k = 0; k < 8; ++k) ssq += acc[8 * j + k] * acc[8 * j + k];
    }
    const float rstd = 1.0f / sqrtf(wave_sum(ssq) * (1.f / DM) + RMS_EPS);
#pragma unroll
    for (int j = 0; j < 8; ++j) {
        const f32x4 g0 = *(const GAS f32x4*)(gfin + 512 * j + 8 * lane), g1 = *(const GAS f32x4*)(gfin + 512 * j + 8 * lane + 4);
        f32x4 o0, o1;
#pragma unroll
        for (int k = 0; k < 4; ++k) { o0[k] = acc[8 * j + k] * rstd * g0[k]; o1[k] = acc[8 * j + 4 + k] * rstd * g1[k]; }
        *(GAS f32x4*)(hrow + 512 * j + 8 * lane) = o0; *(GAS f32x4*)(hrow + 512 * j + 8 * lane + 4) = o1;
    }
}

DI float wave_max(float v) {
#pragma unroll
    for (int o = 1; o < 64; o <<= 1) v = fmaxf(v, __shfl_xor(v, o));
    return v;
}
DI int wave_sum_i(int v) {
#pragma unroll
    for (int o = 1; o < 64; o <<= 1) v += __shfl_xor(v, o);
    return v;
}
DI unsigned q8(float x, float inv, int bias) { return (unsigned)((int)rintf(x * inv) + bias) & 0xffu; }
DI void quant_row_i8(const float* src, unsigned char* dst, float* scl, int lane, int bias) {
    f32x4 v[16]; float am = 0.f;
#pragma unroll
    for (int j = 0; j < 4; ++j)
#pragma unroll
        for (int q = 0; q < 4; ++q) { const f32x4 t = *(const GAS f32x4*)(src + 1024 * j + 16 * lane + 4 * q); v[4 * j + q] = t;
            am = fmaxf(am, fmaxf(fmaxf(fabsf(t.x), fabsf(t.y)), fmaxf(fabsf(t.z), fabsf(t.w)))); }
    am = wave_max(am);
    const float inv = am > 0.f ? 127.f / am : 0.f;
#pragma unroll
    for (int j = 0; j < 4; ++j) { v4u w;
#pragma unroll
        for (int q = 0; q < 4; ++q) { const f32x4 t = v[4 * j + q]; w[q] = q8(t.x, inv, bias) | (q8(t.y, inv, bias) << 8) | (q8(t.z, inv, bias) << 16) | (q8(t.w, inv, bias) << 24); }
        *(GAS v4u*)(dst + 1024 * j + 16 * lane) = w; }
    if (lane == 0) *scl = am * (1.f / 127.f);
}
DI void load_row4(v4u* dst, const unsigned char* row, int lane) {
    const GAS v4u* p = (const GAS v4u*)row + lane;
#pragma unroll
    for (int j = 0; j < 4; ++j) dst[j] = p[64 * j];
}
DI int idot_row(const v4u* xq, const v4u* w) {
    int a0 = 0, a1 = 0;
#pragma unroll
    for (int j = 0; j < 4; ++j) { a0 = __builtin_amdgcn_sdot4((int)w[j].x, (int)xq[j].x, a0, false); a1 = __builtin_amdgcn_sdot4((int)w[j].y, (int)xq[j].y, a1, false);
        a0 = __builtin_amdgcn_sdot4((int)w[j].z, (int)xq[j].z, a0, false); a1 = __builtin_amdgcn_sdot4((int)w[j].w, (int)xq[j].w, a1, false); }
    return a0 + a1;
}
DI void axpy_row_u8(float* acc, const v4u* w, float s) {
#pragma unroll
    for (int j = 0; j < 4; ++j)
#pragma unroll
        for (int q = 0; q < 4; ++q) { const unsigned u = w[j][q];
            acc[16 * j + 4 * q + 0] += s * (float)(u & 0xffu); acc[16 * j + 4 * q + 1] += s * (float)((u >> 8) & 0xffu);
            acc[16 * j + 4 * q + 2] += s * (float)((u >> 16) & 0xffu); acc[16 * j + 4 * q + 3] += s * (float)(u >> 24); }
}
#define RL(v, l) __builtin_amdgcn_readlane((v), (l))
DI void peer_token_q(int tk, const bf16* XN, const int* IDX, const float* GATE, const unsigned char* UQ, const unsigned char* VQ, const float* SU, const float* SV, const float* SSQ,
                     float* hout, const float* gfin, int lane) {
    v4u xq[4]; float sx;
    {
        v4u xb[8]; float am = 0.f;
        const bf16* xp = XN + (size_t)tk * DM + 16 * lane;
#pragma unroll
        for (int j = 0; j < 4; ++j) { xb[2 * j] = *(const GAS v4u*)(xp + 1024 * j); xb[2 * j + 1] = *(const GAS v4u*)(xp + 1024 * j + 8); }
#pragma unroll
        for (int i = 0; i < 8; ++i)
#pragma unroll
            for (int k = 0; k < 4; ++k) am = fmaxf(am, fmaxf(fabsf(bflo(xb[i][k])), fabsf(bfhi(xb[i][k]))));
        am = wave_max(am);
        const float inv = am > 0.f ? 127.f / am : 0.f; sx = am * (1.f / 127.f);
#pragma unroll
        for (int j = 0; j < 4; ++j)
#pragma unroll
            for (int q = 0; q < 4; ++q) { const unsigned w0 = xb[2 * j + (q >> 1)][2 * (q & 1)], w1 = xb[2 * j + (q >> 1)][2 * (q & 1) + 1];
                xq[j][q] = q8(bflo(w0), inv, 0) | (q8(bfhi(w0), inv, 0) << 8) | (q8(bflo(w1), inv, 0) << 16) | (q8(bfhi(w1), inv, 0) << 24); }
    }
    const int ilo = IDX[(size_t)tk * 128 + lane], ihi = IDX[(size_t)tk * 128 + 64 + lane];
    const float glo = GATE[(size_t)tk * 128 + lane], ghi = GATE[(size_t)tk * 128 + 64 + lane];
    const float sulo = SU[ilo], suhi = SU[ihi], svlo = SV[ilo], svhi = SV[ihi];
    int dlo = 0, dhi = 0;
#define ROWIDX(e) ((e) < 64 ? RL(ilo, (e) & 63) : RL(ihi, (e) & 63))
#ifdef PEER_L2PROBE
    {
        int pd = 0;
        v4u ba[2][4], bb[2][4];
#define ROWIDXP(e) (((e) < 64 ? RL(ilo, (e) & 63) : RL(ihi, (e) & 63)) & 511)
        load_row4(ba[0], UQ + (size_t)ROWIDXP(0) * DM, lane); load_row4(ba[1], UQ + (size_t)ROWIDXP(1) * DM, lane);
#pragma unroll 1
        for (int e = 0; e < 128; e += 4) {
            load_row4(bb[0], UQ + (size_t)ROWIDXP(e + 2) * DM, lane); load_row4(bb[1], UQ + (size_t)ROWIDXP(e + 3) * DM, lane);
            pd += wave_sum_i(idot_row(xq, ba[0])) + wave_sum_i(idot_row(xq, ba[1]));
            const int e4 = e + 4 < 128 ? e + 4 : 126;
            load_row4(ba[0], UQ + (size_t)ROWIDXP(e4) * DM, lane); load_row4(ba[1], UQ + (size_t)ROWIDXP(e4 + 1) * DM, lane);
            pd += wave_sum_i(idot_row(xq, bb[0])) + wave_sum_i(idot_row(xq, bb[1]));
        }
#undef ROWIDXP
        asm volatile("" :: "v"(pd));
    }
#endif
#ifdef PEER_REP
    for (int prep_ = 0; prep_ < 2; ++prep_)
#endif
    {
        v4u ba[2][4], bb[2][4];
        load_row4(ba[0], UQ + (size_t)RL(ilo, 0) * DM, lane); load_row4(ba[1], UQ + (size_t)RL(ilo, 1) * DM, lane);
#pragma unroll 1
        for (int e = 0; e < 128; e += 4) {
            load_row4(bb[0], UQ + (size_t)ROWIDX(e + 2) * DM, lane); load_row4(bb[1], UQ + (size_t)ROWIDX(e + 3) * DM, lane);
            { const int d0 = wave_sum_i(idot_row(xq, ba[0])), d1 = wave_sum_i(idot_row(xq, ba[1]));
              if (e < 64) { if (lane == (e & 63)) dlo = d0; if (lane == ((e + 1) & 63)) dlo = d1; } else { if (lane == (e & 63)) dhi = d0; if (lane == ((e + 1) & 63)) dhi = d1; } }
            const int e4 = e + 4 < 128 ? e + 4 : 126;
            load_row4(ba[0], UQ + (size_t)ROWIDX(e4) * DM, lane); load_row4(ba[1], UQ + (size_t)ROWIDX(e4 + 1) * DM, lane);
            { const int d0 = wave_sum_i(idot_row(xq, bb[0])), d1 = wave_sum_i(idot_row(xq, bb[1]));
              if (e < 64) { if (lane == ((e + 2) & 63)) dlo = d0; if (lane == ((e + 3) & 63)) dlo = d1; } else { if (lane == ((e + 2) & 63)) dhi = d0; if (lane == ((e + 3) & 63)) dhi = d1; } }
        }
    }
    const float rsx = sx / sqrtf(SSQ[tk] * (1.f / DM) + RMS_EPS);
    const float wlo = gelu_erf((float)dlo * rsx * sulo) * glo * svlo, whi = gelu_erf((float)dhi * rsx * suhi) * ghi * svhi;
    const float wsum = wave_sum(wlo + whi);
    float acc[64];
#pragma unroll
    for (int i = 0; i < 64; ++i) acc[i] = 0.f;
#define ROWW(e) ((e) < 64 ? readlane_f(wlo, (e) & 63) : readlane_f(whi, (e) & 63))
    {
        v4u ba[2][4], bb[2][4];
        load_row4(ba[0], VQ + (size_t)RL(ilo, 0) * DM, lane); load_row4(ba[1], VQ + (size_t)RL(ilo, 1) * DM, lane);
#pragma unroll 1
        for (int e = 0; e < 128; e += 4) {
            load_row4(bb[0], VQ + (size_t)ROWIDX(e + 2) * DM, lane); load_row4(bb[1], VQ + (size_t)ROWIDX(e + 3) * DM, lane);
            axpy_row_u8(acc, ba[0], ROWW(e)); axpy_row_u8(acc, ba[1], ROWW(e + 1));
            const int e4 = e + 4 < 128 ? e + 4 : 126;
            load_row4(ba[0], VQ + (size_t)ROWIDX(e4) * DM, lane); load_row4(ba[1], VQ + (size_t)ROWIDX(e4 + 1) * DM, lane);
            axpy_row_u8(acc, bb[0], ROWW(e + 2)); axpy_row_u8(acc, bb[1], ROWW(e + 3));
        }
    }
#undef ROWIDX
#undef ROWW
    float* hrow = hout + (size_t)tk * DM + 16 * lane;
    const float corr = -128.f * wsum;
    float ssq = 0.f;
#pragma unroll
    for (int j = 0; j < 4; ++j)
#pragma unroll
        for (int q = 0; q < 4; ++q) { const f32x4 hv = *(const GAS f32x4*)(hrow + 1024 * j + 4 * q);
#pragma unroll
            for (int k = 0; k < 4; ++k) { const float t = acc[16 * j + 4 * q + k] + corr + hv[k]; acc[16 * j + 4 * q + k] = t; ssq += t * t; } }
    const float rstd = 1.0f / sqrtf(wave_sum(ssq) * (1.f / DM) + RMS_EPS);
    const float* gp = gfin + 16 * lane;
#pragma unroll
    for (int j = 0; j < 4; ++j)
#pragma unroll
        for (int q = 0; q < 4; ++q) { const f32x4 gv = *(const GAS f32x4*)(gp + 1024 * j + 4 * q); f32x4 o;
#pragma unroll
            for (int k = 0; k < 4; ++k) o[k] = acc[16 * j + 4 * q + k] * rstd * gv[k];
            *(GAS f32x4*)(hrow + 1024 * j + 4 * q) = o; }
}

DI int sdot4_z(unsigned a, unsigned b) { int d; asm("v_dot4_i32_i8 %0, %1, %2, 0" : "=v"(d) : "v"(a), "v"(b)); return d; }
DI void fmac_s(float& acc, float w, float x) { asm("v_fmac_f32_e32 %0, %1, %2" : "+v"(acc) : "v"(w), "v"(x)); }
DI void pkfma16_lo(unsigned& acc, unsigned x, unsigned wp) { asm("v_pk_fma_f16 %0, %1, %2, %0 op_sel_hi:[1,0,1]" : "+v"(acc) : "v"(x), "v"(wp)); }
DI void pkfma16_hi(unsigned& acc, unsigned x, unsigned wp) { asm("v_pk_fma_f16 %0, %1, %2, %0 op_sel:[0,1,0] op_sel_hi:[1,1,1]" : "+v"(acc) : "v"(x), "v"(wp)); }
DI void quant_row_i8_sliced(const float* src, unsigned char* tab, int e, float* scl, int lane, int bias) {
    f32x4 v[16]; float am = 0.f;
#pragma unroll
    for (int j = 0; j < 4; ++j)
#pragma unroll
        for (int q = 0; q < 4; ++q) { const f32x4 t = *(const GAS f32x4*)(src + 1024 * j + 16 * lane + 4 * q); v[4 * j + q] = t;
            am = fmaxf(am, fmaxf(fmaxf(fabsf(t.x), fabsf(t.y)), fmaxf(fabsf(t.z), fabsf(t.w)))); }
    am = wave_max(am);
    const float inv = am > 0.f ? 127.f / am : 0.f;
#pragma unroll
    for (int j = 0; j < 4; ++j) { v4u w;
#pragma unroll
        for (int q = 0; q < 4; ++q) { const f32x4 t = v[4 * j + q]; w[q] = q8(t.x, inv, bias) | (q8(t.y, inv, bias) << 8) | (q8(t.z, inv, bias) << 16) | (q8(t.w, inv, bias) << 24); }
        *(GAS v4u*)(tab + (size_t)(8 * j + (lane >> 3)) * SLICE_BYTES + (size_t)e * 128 + 16 * (lane & 7)) = w; }
    if (lane == 0) *scl = am * (1.f / 127.f);
}
#ifdef QLDS
DI void qrow_load(f32x4* v, const float* src, int lane) {
#pragma unroll
    for (int i = 0; i < 16; ++i) v[i] = *(const GAS f32x4*)(src + 256 * i + 4 * lane);
}
#else
DI void qrow_load(f32x4* v, const float* src, int lane) {
#pragma unroll
    for (int j = 0; j < 4; ++j)
#pragma unroll
        for (int q = 0; q < 4; ++q) v[4 * j + q] = *(const GAS f32x4*)(src + 1024 * j + 16 * lane + 4 * q);
}
#endif
template <bool NOST = false> DI void qrow_store(const f32x4* v, unsigned char* tab, int e, float* scl, int lane, int bias, LAS unsigned* stg = nullptr) {
    float am = 0.f;
#pragma unroll
    for (int i = 0; i < 16; ++i) { const f32x4 t = v[i]; am = fmaxf(am, fmaxf(fmaxf(fabsf(t.x), fabsf(t.y)), fmaxf(fabsf(t.z), fabsf(t.w)))); }
    am = wave_max(am);
    const float inv = am > 0.f ? 127.f / am : 0.f;
#ifdef QLDS
#pragma unroll
    for (int i = 0; i < 16; ++i) { const f32x4 t = v[i]; stg[64 * i + lane] = q8(t.x, inv, bias) | (q8(t.y, inv, bias) << 8) | (q8(t.z, inv, bias) << 16) | (q8(t.w, inv, bias) << 24); }
    LDS_WAIT(); asm volatile("" ::: "memory");
#endif
#pragma unroll
    for (int j = 0; j < 4; ++j) { v4u w;
#ifdef QLDS
        w = *(const LAS v4u*)(stg + 256 * j + 4 * lane);
#else
#pragma unroll
        for (int q = 0; q < 4; ++q) { const f32x4 t = v[4 * j + q]; w[q] = q8(t.x, inv, bias) | (q8(t.y, inv, bias) << 8) | (q8(t.z, inv, bias) << 16) | (q8(t.w, inv, bias) << 24); }
#endif
#ifndef NO_NT_QST
        if (NOST) asm volatile("" :: "v"(w)); else __builtin_nontemporal_store(w, (GAS v4u*)(tab + (size_t)(8 * j + (lane >> 3)) * SLICE_BYTES + (size_t)e * 128 + 16 * (lane & 7))); }
#else
        if (NOST) asm volatile("" :: "v"(w)); else *(GAS v4u*)(tab + (size_t)(8 * j + (lane >> 3)) * SLICE_BYTES + (size_t)e * 128 + 16 * (lane & 7)) = w; }
#endif
    if (lane == 0 && !NOST) *scl = am * (1.f / 127.f);
#ifdef QLDS
    LDS_WAIT(); asm volatile("" ::: "memory");
#endif
}
DI unsigned q4(float x, float inv) { int q = (int)floorf(x * inv + 8.0f); q = q < 0 ? 0 : (q > 15 ? 15 : q); return (unsigned)q; }
template <bool HIX = false> DI void qrow_store_u4(const f32x4* v, unsigned char* tab, int e, float* scl, int lane, LAS unsigned* stg = nullptr) {
    float ss = 0.f;
#pragma unroll
    for (int i = 0; i < 16; ++i) { const f32x4 t = v[i]; ss += (t.x * t.x + t.y * t.y) + (t.z * t.z + t.w * t.w); }
    ss = wave_sum(ss);
    const float step = 0.3352f * sqrtf(ss * (1.f / DM)), inv = step > 0.f ? 1.0f / step : 0.f;
#ifdef QLDS
#pragma unroll
    for (int i = 0; i < 16; ++i) { const f32x4 t = v[i]; stg[64 * i + lane] = q4(t.x, inv) | (q4(t.y, inv) << 8) | (q4(t.z, inv) << 16) | (q4(t.w, inv) << 24); }
    LDS_WAIT(); asm volatile("" ::: "memory");
#endif
#pragma unroll
    for (int j = 0; j < 4; ++j) { u32x2 w;
#ifdef QLDS
        { const v4u cb = *(const LAS v4u*)(stg + 256 * j + 4 * lane); const unsigned hx = HIX ? 0x08080808u : 0u; w.x = cb.x | ((cb.y ^ hx) << 4); w.y = cb.z | ((cb.w ^ hx) << 4); }
#else
#pragma unroll
        for (int d = 0; d < 2; ++d) { const f32x4 a = v[4 * j + 2 * d], b = v[4 * j + 2 * d + 1];
            w[d] = q4(a.x, inv) | (q4(a.y, inv) << 8) | (q4(a.z, inv) << 16) | (q4(a.w, inv) << 24) | (q4(b.x, inv) << 4) | (q4(b.y, inv) << 12) | (q4(b.z, inv) << 20) | (q4(b.w, inv) << 28); }
#endif
        *(GAS u32x2*)(tab + (size_t)(4 * j + (lane >> 4)) * SLICE_BYTES + (size_t)e * 128 + 8 * (lane & 15)) = w; }
    if (lane == 0) *scl = step;
#ifdef QLDS
    LDS_WAIT(); asm volatile("" ::: "memory");
#endif
}
template <bool NOST = false> DI void quant_rows_strided(int r_lo, int r_hi, int stride, const float* peer_u, const float* peer_v, unsigned char* UQ, unsigned char* VQ, float* SU, float* SV, int lane, LAS unsigned* stg = nullptr) {
    if (r_lo >= r_hi) return;
#ifdef VDOT4
#define VQ_BIAS 0
#else
#define VQ_BIAS 128
#endif
#define QSRC(r_) (((r_) >= NEXP ? peer_v + (size_t)((r_) - NEXP) * DM : peer_u + (size_t)(r_) * DM))
#ifdef U4
#ifdef V4
#define QSTORE(v_, r_) do { if ((r_) >= NEXP) qrow_store_u4<true>(v_, VQ, (r_) - NEXP, SV + ((r_) - NEXP), lane, stg); else qrow_store_u4(v_, UQ, (r_), SU + (r_), lane, stg); } while (0)
#else
#define QSTORE(v_, r_) do { if ((r_) >= NEXP) qrow_store<NOST>(v_, VQ, (r_) - NEXP, SV + ((r_) - NEXP), lane, VQ_BIAS, stg); else qrow_store_u4(v_, UQ, (r_), SU + (r_), lane, stg); } while (0)
#endif
#else
#define QSTORE(v_, r_) do { if ((r_) >= NEXP) qrow_store<NOST>(v_, VQ, (r_) - NEXP, SV + ((r_) - NEXP), lane, VQ_BIAS, stg); else qrow_store<NOST>(v_, UQ, (r_), SU + (r_), lane, 0, stg); } while (0)
#endif
    f32x4 va[16], vb[16];
    qrow_load(va, QSRC(r_lo), lane);
#pragma unroll 1
    for (int r = r_lo; r < r_hi; r += 2 * stride) {
        const int r1 = r + stride < r_hi ? r + stride : r, r2 = r + 2 * stride < r_hi ? r + 2 * stride : r;
        qrow_load(vb, QSRC(r1), lane);
        QSTORE(va, r);
        qrow_load(va, QSRC(r2), lane);
        if (r + stride < r_hi) QSTORE(vb, r1);
    }
#undef QSRC
#undef QSTORE
}
DI void quant_token(int tk, const bf16* XN, const float* gain, const float* SSQ, unsigned char* XQ, float* SX, int lane) {
    v4u xb[8]; float am = 0.f;
    const bf16* xp = XN + (size_t)tk * DM + 16 * lane; const float* gp = gain + 16 * lane;
#pragma unroll
    for (int j = 0; j < 4; ++j) { xb[2 * j] = *(const GAS v4u*)(xp + 1024 * j); xb[2 * j + 1] = *(const GAS v4u*)(xp + 1024 * j + 8); }
#pragma unroll
    for (int i = 0; i < 8; ++i) { const f32x4 g0 = *(const GAS f32x4*)(gp + 1024 * (i >> 1) + 8 * (i & 1)), g1 = *(const GAS f32x4*)(gp + 1024 * (i >> 1) + 8 * (i & 1) + 4);
        xb[i].x = cvtpk(bflo(xb[i].x) * g0.x, bfhi(xb[i].x) * g0.y); xb[i].y = cvtpk(bflo(xb[i].y) * g0.z, bfhi(xb[i].y) * g0.w);
        xb[i].z = cvtpk(bflo(xb[i].z) * g1.x, bfhi(xb[i].z) * g1.y); xb[i].w = cvtpk(bflo(xb[i].w) * g1.z, bfhi(xb[i].w) * g1.w); }
#pragma unroll
    for (int i = 0; i < 8; ++i)
#pragma unroll
        for (int k = 0; k < 4; ++k) am = fmaxf(am, fmaxf(fabsf(bflo(xb[i][k])), fabsf(bfhi(xb[i][k]))));
    am = wave_max(am);
    const float inv = am > 0.f ? 127.f / am : 0.f;
#pragma unroll
    for (int j = 0; j < 4; ++j) { v4u o;
#pragma unroll
        for (int q = 0; q < 4; ++q) { const unsigned w0 = xb[2 * j + (q >> 1)][2 * (q & 1)], w1 = xb[2 * j + (q >> 1)][2 * (q & 1) + 1];
            o[q] = q8(bflo(w0), inv, 0) | (q8(bfhi(w0), inv, 0) << 8) | (q8(bflo(w1), inv, 0) << 16) | (q8(bfhi(w1), inv, 0) << 24); }
        *(GAS v4u*)(XQ + (size_t)tk * DM + 1024 * j + 16 * lane) = o; }
    if (lane == 0) SX[tk] = am * (1.f / 127.f) / sqrtf(SSQ[tk] * (1.f / DM) + RMS_EPS);
#ifdef U4
    {
        int sm = 0;
#pragma unroll
        for (int i = 0; i < 8; ++i)
#pragma unroll
            for (int k = 0; k < 4; ++k) { sm += (int)rintf(bflo(xb[i][k]) * inv) + (int)rintf(bfhi(xb[i][k]) * inv); }
        sm = wave_sum_i(sm);
        if (lane == 0) ((int*)(SX + T_TOK))[tk] = sm;
    }
#endif
}
DI void peer_sweep(LAS unsigned char* lds, int wave, int gw, int NGW, const unsigned char* XQ, const float* SX, const int* IDX, const float* GATE,
                   const unsigned char* UQs, const unsigned char* VQs, const float* SU, const float* SV, bf16* Hres, float* hout, const float* gfin, int lane) {
    const int g = lane >> 3, c = lane & 7;
    LAS int* RI = (LAS int*)(lds + wave * 16384) + lane;
    int tok[4];
#pragma unroll
    for (int k = 0; k < 4; ++k) tok[k] = gw + k * NGW;
    const unsigned char* xqb[4]; bf16* hrb[4]; const int* idxb[4]; const float* gateb[4];
#pragma unroll
    for (int k = 0; k < 4; ++k) { const int tu = __builtin_amdgcn_readfirstlane(tok[k]); xqb[k] = XQ + (size_t)tu * DM; hrb[k] = Hres + (size_t)tu * DM; idxb[k] = IDX + (size_t)tu * 128; gateb[k] = GATE + (size_t)tu * 128; }
#pragma unroll
    for (int k = 0; k < 4; ++k)
#pragma unroll
        for (int i = 0; i < 16; ++i) RI[(k * 16 + i) * 64] = ((const GAS int*)idxb[k])[(unsigned)(8 * i + g)] * 128 + 16 * c;
    LDS_WAIT(); asm volatile("" ::: "memory");
#define PS_ISSUE(dst, base, k_, h_) do { _Pragma("unroll") for (int i_ = 0; i_ < 8; ++i_) dst[i_] = *(const GAS v4u*)((base) + (unsigned)RI[((k_) * 16 + 8 * (h_) + i_) * 64]); } while (0)
#ifdef PROBE_SWEEP
    const unsigned long long tsw0 = __builtin_amdgcn_s_memrealtime(); const unsigned long long tck0 = clock64();
#endif
    int A[4][16];
#pragma unroll
    for (int k = 0; k < 4; ++k)
#pragma unroll
        for (int i = 0; i < 16; ++i) A[k][i] = 0;
#ifdef U4
    {
        v4u wa[16], wb[16], xa0, xa1, xb0, xb1;
#define PS_ISSUE16(dst, base, k_) do { _Pragma("unroll") for (int i_ = 0; i_ < 16; ++i_) dst[i_] = *(const GAS v4u*)((base) + (unsigned)RI[((k_) * 16 + i_) * 64]); } while (0)
#define PS_XS(d0_, d1_, s_, k_) do { const unsigned char* xp_ = xqb[k_] + (unsigned)(256 * (s_) + 32 * c); d0_ = *(const GAS v4u*)xp_; d1_ = *(const GAS v4u*)(xp_ + 16); } while (0)
#define PS_D4(a_, w_, xl_, xh_) do { a_ = __builtin_amdgcn_sdot4((int)((w_) & 0x0F0F0F0Fu), (int)(xl_), a_, false); a_ = __builtin_amdgcn_sdot4((int)(((w_) >> 4) & 0x0F0F0F0Fu), (int)(xh_), a_, false); } while (0)
#define PS_DOT16(k_, w_, x0_, x1_) do { _Pragma("unroll") for (int i_ = 0; i_ < 16; ++i_) { int a_ = A[k_][i_]; PS_D4(a_, w_[i_].x, x0_.x, x0_.y); PS_D4(a_, w_[i_].y, x0_.z, x0_.w); \
            PS_D4(a_, w_[i_].z, x1_.x, x1_.y); PS_D4(a_, w_[i_].w, x1_.z, x1_.w); A[k_][i_] = a_; } } while (0)
#ifdef SROT
        const int soff = 2 * (int)(blockIdx.x & 7);
        PS_ISSUE16(wa, UQs + (size_t)soff * SLICE_BYTES, 0); PS_XS(xa0, xa1, soff, 0);
#else
        PS_ISSUE16(wa, UQs, 0); PS_XS(xa0, xa1, 0, 0);
#endif
#pragma unroll 1
        for (int s_ = 0; s_ < 16; ++s_) {
            asm volatile("" ::: "memory");
#ifdef SROT
            const int s = (s_ + soff) & 15, sn = s_ + 1 < 16 ? (s + 1) & 15 : s;
#else
            const int s = s_, sn = s + 1 < 16 ? s + 1 : 15;
#endif
            const unsigned char* us = UQs + (size_t)s * SLICE_BYTES;
            const unsigned char* usn = UQs + (size_t)sn * SLICE_BYTES;
            PS_ISSUE16(wb, us, 1); PS_XS(xb0, xb1, s, 1);
            PS_DOT16(0, wa, xa0, xa1);
            PS_ISSUE16(wa, us, 2); PS_XS(xa0, xa1, s, 2);
            PS_DOT16(1, wb, xb0, xb1);
            PS_ISSUE16(wb, us, 3); PS_XS(xb0, xb1, s, 3);
            PS_DOT16(2, wa, xa0, xa1);
            PS_ISSUE16(wa, usn, 0); PS_XS(xa0, xa1, sn, 0);
            PS_DOT16(3, wb, xb0, xb1);
        }
#undef PS_ISSUE16
#undef PS_XS
#undef PS_D4
#undef PS_DOT16
    }
#else
    {
        v4u wa[16], wb[16], xa, xb;
#define PS_ISSUE16(dst, base, k_) do { _Pragma("unroll") for (int i_ = 0; i_ < 16; ++i_) dst[i_] = *(const GAS v4u*)((base) + (unsigned)RI[((k_) * 16 + i_) * 64]); } while (0)
#define PS_XS(s_, k_) (*(const GAS v4u*)(XQ + (size_t)tok[k_] * DM + 128 * (s_) + 16 * c))
#define PS_DOT16(k_, w_, x_) do { _Pragma("unroll") for (int i_ = 0; i_ < 16; ++i_) { int a_ = A[k_][i_]; a_ = __builtin_amdgcn_sdot4((int)w_[i_].x, (int)x_.x, a_, false); a_ = __builtin_amdgcn_sdot4((int)w_[i_].y, (int)x_.y, a_, false); \
            a_ = __builtin_amdgcn_sdot4((int)w_[i_].z, (int)x_.z, a_, false); a_ = __builtin_amdgcn_sdot4((int)w_[i_].w, (int)x_.w, a_, false); A[k_][i_] = a_; } } while (0)
        PS_ISSUE16(wa, UQs, 0); xa = PS_XS(0, 0);
#pragma unroll 1
        for (int s = 0; s < 32; ++s) {
            asm volatile("" ::: "memory");
            const unsigned char* us = UQs + (size_t)s * SLICE_BYTES;
            const int sn = s + 1 < 32 ? s + 1 : 31;
            const unsigned char* usn = UQs + (size_t)sn * SLICE_BYTES;
            PS_ISSUE16(wb, us, 1); xb = PS_XS(s, 1);
            PS_DOT16(0, wa, xa);
            PS_ISSUE16(wa, us, 2); xa = PS_XS(s, 2);
            PS_DOT16(1, wb, xb);
            PS_ISSUE16(wb, us, 3); xb = PS_XS(s, 3);
            PS_DOT16(2, wa, xa);
            PS_ISSUE16(wa, usn, 0); xa = PS_XS(sn, 0);
            PS_DOT16(3, wb, xb);
        }
#undef PS_ISSUE16
#undef PS_XS
#undef PS_DOT16
    }
#endif
#ifdef PROBE_USWEEP
    {
        int A2[4][16];
#pragma unroll
        for (int k = 0; k < 4; ++k)
#pragma unroll
            for (int i = 0; i < 16; ++i) A2[k][i] = 0;
        v4u wb0[8], wb1[8], xs, xsn;
        PS_ISSUE(wb0, UQs, 0, 0); xs = *(const GAS v4u*)(XQ + (size_t)tok[0] * DM + 16 * c);
#pragma unroll 1
        for (int s = 0; s < 32; ++s) {
            asm volatile("" ::: "memory");
            const unsigned char* us = UQs + (size_t)s * SLICE_BYTES;
            const int sn = s + 1 < 32 ? s + 1 : 31;
            const unsigned char* usn = UQs + (size_t)sn * SLICE_BYTES;
#pragma unroll
            for (int k = 0; k < 4; ++k) {
                PS_ISSUE(wb1, us, k, 1);
#pragma unroll
                for (int i = 0; i < 8; ++i) { int a = A2[k][i]; a = __builtin_amdgcn_sdot4((int)wb0[i].x, (int)xs.x, a, false); a = __builtin_amdgcn_sdot4((int)wb0[i].y, (int)xs.y, a, false);
                    a = __builtin_amdgcn_sdot4((int)wb0[i].z, (int)xs.z, a, false); a = __builtin_amdgcn_sdot4((int)wb0[i].w, (int)xs.w, a, false); A2[k][i] = a; }
                if (k < 3) { PS_ISSUE(wb0, us, k + 1, 0); xsn = *(const GAS v4u*)(XQ + (size_t)tok[k + 1 < 4 ? k + 1 : 3] * DM + 128 * s + 16 * c); }
                else { PS_ISSUE(wb0, usn, 0, 0); xsn = *(const GAS v4u*)(XQ + (size_t)tok[0] * DM + 128 * sn + 16 * c); }
#pragma unroll
                for (int i = 0; i < 8; ++i) { int a = A2[k][8 + i]; a = __builtin_amdgcn_sdot4((int)wb1[i].x, (int)xs.x, a, false); a = __builtin_amdgcn_sdot4((int)wb1[i].y, (int)xs.y, a, false);
                    a = __builtin_amdgcn_sdot4((int)wb1[i].z, (int)xs.z, a, false); a = __builtin_amdgcn_sdot4((int)wb1[i].w, (int)xs.w, a, false); A2[k][8 + i] = a; }
                xs = xsn;
            }
        }
#pragma unroll
        for (int k = 0; k < 4; ++k)
#pragma unroll
            for (int i = 0; i < 16; ++i) asm volatile("" :: "v"(A2[k][i]));
    }
#endif
#ifdef PROBE_SWEEP
    asm volatile("s_waitcnt vmcnt(0)" ::: "memory"); const unsigned long long tsw1 = __builtin_amdgcn_s_memrealtime();
#endif
    float W[4][16], wsum[4];
#ifdef VDOT4
    unsigned Wq[4][4]; float swq[4]; int Swq[4];
#endif
#ifdef VF16
    unsigned Wp[4][8]; float usc[4];
    typedef _Float16 h2_t __attribute__((ext_vector_type(2)));
#endif
#pragma unroll
    for (int k = 0; k < 4; ++k) {
        const float sx = SX[tok[k]]; float ws_ = 0.f;
#pragma unroll
        for (int i = 0; i < 16; ++i) {
            int a = A[k][i]; a += __shfl_xor(a, 1); a += __shfl_xor(a, 2); a += __shfl_xor(a, 4);
            const unsigned e = (unsigned)((const GAS int*)idxb[k])[(unsigned)(8 * i + g)];
#ifdef U4
            const float w = gelu_erf(((float)a - 7.5f * (float)((const int*)(SX + T_TOK))[tok[k]]) * sx * ((const GAS float*)SU)[e]) * ((const GAS float*)gateb[k])[(unsigned)(8 * i + g)] * ((const GAS float*)SV)[e];
#else
            const float w = gelu_erf((float)a * sx * ((const GAS float*)SU)[e]) * ((const GAS float*)gateb[k])[(unsigned)(8 * i + g)] * ((const GAS float*)SV)[e];
#endif
            W[k][i] = w; ws_ += w;
        }
        ws_ += __shfl_xor(ws_, 8); ws_ += __shfl_xor(ws_, 16); ws_ += __shfl_xor(ws_, 32);
        wsum[k] = ws_;
#ifdef VDOT4
        {
            float wm = 0.f;
#pragma unroll
            for (int i = 0; i < 16; ++i) wm = fmaxf(wm, fabsf(W[k][i]));
            wm = fmaxf(wm, __shfl_xor(wm, 8)); wm = fmaxf(wm, __shfl_xor(wm, 16)); wm = fmaxf(wm, __shfl_xor(wm, 32));
            const float inv = wm > 0.f ? 127.f / wm : 0.f;
            swq[k] = wm * (1.f / 127.f);
#ifdef V4
            { int sq = 0;
#pragma unroll
              for (int i = 0; i < 16; ++i) sq += (int)rintf(W[k][i] * inv);
              sq += __shfl_xor(sq, 8); sq += __shfl_xor(sq, 16); sq += __shfl_xor(sq, 32); Swq[k] = sq; }
#endif
#pragma unroll
            for (int q = 0; q < 4; ++q) Wq[k][q] = q8(W[k][4 * q], inv, 0) | (q8(W[k][4 * q + 1], inv, 0) << 8) | (q8(W[k][4 * q + 2], inv, 0) << 16) | (q8(W[k][4 * q + 3], inv, 0) << 24);
        }
#elif defined(VF16)
        {
            float wm = 0.f;
#pragma unroll
            for (int i = 0; i < 16; ++i) wm = fmaxf(wm, fabsf(W[k][i]));
            wm = fmaxf(wm, __shfl_xor(wm, 8)); wm = fmaxf(wm, __shfl_xor(wm, 16)); wm = fmaxf(wm, __shfl_xor(wm, 32));
            const int ex = wm > 0.f ? __builtin_amdgcn_frexp_expf(wm) : 14;
            const float alpha = __builtin_amdgcn_ldexpf(1.0f, 14 - ex);
            usc[k] = __builtin_amdgcn_ldexpf(1.0f, 24 - (14 - ex));
#pragma unroll
            for (int p = 0; p < 8; ++p) { const _Float16 h0 = (_Float16)(W[k][2 * p] * alpha), h1 = (_Float16)(W[k][2 * p + 1] * alpha);
                Wp[k][p] = (unsigned)__builtin_bit_cast(unsigned short, h0) | ((unsigned)__builtin_bit_cast(unsigned short, h1) << 16); }
        }
#endif
    }
    float ssq[4] = {0.f, 0.f, 0.f, 0.f};
    const bool g0 = (g & 1) != 0, g1 = (g & 2) != 0, g2 = (g & 4) != 0;
    const int colsub = 16 * c + 8 * (g & 1) + 4 * ((g >> 1) & 1) + 2 * ((g >> 2) & 1);
#ifdef V4
    {
        v4u wb0[8], wb1[8]; int riA[8], riB[8];
        const int colsub4 = 32 * c + 16 * ((g >> 2) & 1) + 8 * ((g >> 1) & 1) + 4 * (g & 1);
#define PS_RI(dst, k_, h_) do { _Pragma("unroll") for (int i_ = 0; i_ < 8; ++i_) dst[i_] = RI[((k_) * 16 + 8 * (h_) + i_) * 64]; } while (0)
#define PS_LD(dst, base, ri_) do { _Pragma("unroll") for (int i_ = 0; i_ < 8; ++i_) dst[i_] = *(const GAS v4u*)((base) + (unsigned)ri_[i_]); } while (0)
#define PS_BLK4(wv_, i0_, wq_) do { _Pragma("unroll") for (int q = 0; q < 4; ++q) { const unsigned d0 = wv_[(i0_)][q], d1 = wv_[(i0_) + 1][q], d2 = wv_[(i0_) + 2][q], d3 = wv_[(i0_) + 3][q]; \
                        const unsigned l01 = __builtin_amdgcn_perm(d1, d0, 0x05010400u), h01 = __builtin_amdgcn_perm(d1, d0, 0x07030602u), l23 = __builtin_amdgcn_perm(d3, d2, 0x05010400u), h23 = __builtin_amdgcn_perm(d3, d2, 0x07030602u); \
                        const unsigned t0 = __builtin_amdgcn_perm(l23, l01, 0x05040100u), t1 = __builtin_amdgcn_perm(l23, l01, 0x07060302u), t2 = __builtin_amdgcn_perm(h23, h01, 0x05040100u), t3 = __builtin_amdgcn_perm(h23, h01, 0x07060302u); \
                        af[4 * q + 0] = __builtin_amdgcn_sdot4((int)t0, (int)(wq_), af[4 * q + 0], false); ah[4 * q + 0] = __builtin_amdgcn_sdot4((int)(t0 & 0xF0F0F0F0u), (int)(wq_), ah[4 * q + 0], false); \
                        af[4 * q + 1] = __builtin_amdgcn_sdot4((int)t1, (int)(wq_), af[4 * q + 1], false); ah[4 * q + 1] = __builtin_amdgcn_sdot4((int)(t1 & 0xF0F0F0F0u), (int)(wq_), ah[4 * q + 1], false); \
                        af[4 * q + 2] = __builtin_amdgcn_sdot4((int)t2, (int)(wq_), af[4 * q + 2], false); ah[4 * q + 2] = __builtin_amdgcn_sdot4((int)(t2 & 0xF0F0F0F0u), (int)(wq_), ah[4 * q + 2], false); \
                        af[4 * q + 3] = __builtin_amdgcn_sdot4((int)t3, (int)(wq_), af[4 * q + 3], false); ah[4 * q + 3] = __builtin_amdgcn_sdot4((int)(t3 & 0xF0F0F0F0u), (int)(wq_), ah[4 * q + 3], false); } } while (0)
#define PS_BLK4Z(wv_, i0_, wq_) do { _Pragma("unroll") for (int q = 0; q < 4; ++q) { const unsigned d0 = wv_[(i0_)][q], d1 = wv_[(i0_) + 1][q], d2 = wv_[(i0_) + 2][q], d3 = wv_[(i0_) + 3][q]; \
                        const unsigned l01 = __builtin_amdgcn_perm(d1, d0, 0x05010400u), h01 = __builtin_amdgcn_perm(d1, d0, 0x07030602u), l23 = __builtin_amdgcn_perm(d3, d2, 0x05010400u), h23 = __builtin_amdgcn_perm(d3, d2, 0x07030602u); \
                        const unsigned t0 = __builtin_amdgcn_perm(l23, l01, 0x05040100u), t1 = __builtin_amdgcn_perm(l23, l01, 0x07060302u), t2 = __builtin_amdgcn_perm(h23, h01, 0x05040100u), t3 = __builtin_amdgcn_perm(h23, h01, 0x07060302u); \
                        af[4 * q + 0] = sdot4_z(t0, (wq_)); ah[4 * q + 0] = sdot4_z(t0 & 0xF0F0F0F0u, (wq_)); \
                        af[4 * q + 1] = sdot4_z(t1, (wq_)); ah[4 * q + 1] = sdot4_z(t1 & 0xF0F0F0F0u, (wq_)); \
                        af[4 * q + 2] = sdot4_z(t2, (wq_)); ah[4 * q + 2] = sdot4_z(t2 & 0xF0F0F0F0u, (wq_)); \
                        af[4 * q + 3] = sdot4_z(t3, (wq_)); ah[4 * q + 3] = sdot4_z(t3 & 0xF0F0F0F0u, (wq_)); } } while (0)
        PS_RI(riB, 0, 1);
#ifdef SROT
        const int soffv = 2 * (int)(blockIdx.x & 7);
        PS_ISSUE(wb0, VQs + (size_t)soffv * SLICE_BYTES, 0, 0);
#else
        PS_ISSUE(wb0, VQs, 0, 0);
#endif
#pragma unroll 1
        for (int s_ = 0; s_ < 16; ++s_) {
            asm volatile("" ::: "memory");
#ifdef SROT
            const int s = (s_ + soffv) & 15, sn = s_ + 1 < 16 ? (s + 1) & 15 : s;
#else
            const int s = s_, sn = s + 1 < 16 ? s + 1 : 15;
#endif
            const unsigned char* vs = VQs + (size_t)s * SLICE_BYTES;
            const unsigned char* vsn = VQs + (size_t)sn * SLICE_BYTES;
#pragma unroll
            for (int k = 0; k < 4; ++k) {
                PS_LD(wb1, vs, riB);
                if (k < 3) PS_RI(riA, k + 1, 0); else PS_RI(riA, 0, 0);
                __builtin_amdgcn_sched_barrier(0);
                const u32x2 hb = *(const GAS u32x2*)(hrb[k] + (unsigned)(256 * s + colsub4));
                int af[16], ah[16];
                PS_BLK4Z(wb0, 0, Wq[k][0]); PS_BLK4(wb0, 4, Wq[k][1]);
                if (k < 3) { PS_LD(wb0, vs, riA); PS_RI(riB, k + 1, 1); } else { PS_LD(wb0, vsn, riA); PS_RI(riB, 0, 1); }
                __builtin_amdgcn_sched_barrier(0);
                PS_BLK4(wb1, 0, Wq[k][2]); PS_BLK4(wb1, 4, Wq[k][3]);
                int ia[32];
#pragma unroll
                for (int q = 0; q < 4; ++q)
#pragma unroll
                    for (int t = 0; t < 4; ++t) { ia[8 * q + t] = af[4 * q + t] - ah[4 * q + t]; ia[8 * q + 4 + t] = ah[4 * q + t]; }
                int r16[16], r8i[8], r4i[4];
#pragma unroll
                for (int j = 0; j < 16; ++j) { const auto sw = __builtin_amdgcn_permlane32_swap((unsigned)ia[j], (unsigned)ia[16 + j], false, false); r16[j] = (int)sw[0] + (int)sw[1]; }
#pragma unroll
                for (int j = 0; j < 8; ++j) { const auto sw = __builtin_amdgcn_permlane16_swap((unsigned)r16[j], (unsigned)r16[8 + j], false, false); r8i[j] = (int)sw[0] + (int)sw[1]; }
#pragma unroll
                for (int j = 0; j < 4; ++j) { const int snd = g0 ? r8i[j] : r8i[4 + j], kp = g0 ? r8i[4 + j] : r8i[j];
                    r4i[j] = kp + __builtin_amdgcn_update_dpp(0, snd, 0x128, 0xf, 0xf, false); }
                const float corr = (g0 ? 8.0f : -7.5f) * (float)Swq[k], sc_ = g0 ? swq[k] * 0.0625f : swq[k];
                f32x4 o; o.x = bflo(hb.x) + ((float)r4i[0] + corr) * sc_; o.y = bfhi(hb.x) + ((float)r4i[1] + corr) * sc_; o.z = bflo(hb.y) + ((float)r4i[2] + corr) * sc_; o.w = bfhi(hb.y) + ((float)r4i[3] + corr) * sc_;
                ssq[k] += (o.x * o.x + o.y * o.y) + (o.z * o.z + o.w * o.w);
                u32x2 ow; ow.x = cvtpk(o.x, o.y); ow.y = cvtpk(o.z, o.w);
                *(GAS u32x2*)(hrb[k] + (unsigned)(256 * s + colsub4)) = ow;
            }
        }
#undef PS_BLK4
#undef PS_BLK4Z
#undef PS_RI
#undef PS_LD
    }
#elif !defined(NO_VSWEEP)
    {
        v4u wb0[8], wb1[8];
#ifdef VF16
        int riA[8], riB[8];
#define PS_RI(dst, k_, h_) do { _Pragma("unroll") for (int i_ = 0; i_ < 8; ++i_) dst[i_] = RI[((k_) * 16 + 8 * (h_) + i_) * 64]; } while (0)
#define PS_LD(dst, base, ri_) do { _Pragma("unroll") for (int i_ = 0; i_ < 8; ++i_) dst[i_] = *(const GAS v4u*)((base) + (unsigned)ri_[i_]); } while (0)
        PS_RI(riB, 0, 1);
#endif
        PS_ISSUE(wb0, VQs, 0, 0);
#pragma unroll 1
        for (int s = 0; s < 32; ++s) {
#ifdef SWEEP_BAR
            if ((s & (SWEEP_BAR - 1)) == 0) __builtin_amdgcn_s_barrier();
#endif
            asm volatile("" ::: "memory");
            const unsigned char* vs = VQs + (size_t)s * SLICE_BYTES;
            const int sn = s + 1 < 32 ? s + 1 : 31;
            const unsigned char* vsn = VQs + (size_t)sn * SLICE_BYTES;
#pragma unroll
            for (int k = 0; k < 4; ++k) {
                float acc[16];
#ifdef VF16
                PS_LD(wb1, vs, riB);
                if (k < 3) PS_RI(riA, k + 1, 0); else PS_RI(riA, 0, 0);
                __builtin_amdgcn_sched_barrier(0);
#else
                PS_ISSUE(wb1, vs, k, 1);
#endif
                const unsigned hb = *(const GAS unsigned*)(Hres + (size_t)tok[k] * DM + 128 * s + colsub);
                f32x2 hv; hv.x = bflo(hb); hv.y = bfhi(hb);
#ifdef VDOT4
                int ia[16];
#pragma unroll
                for (int b = 0; b < 16; ++b) ia[b] = 0;
#define PS_BLK(wv_, i0_, wq_) do { _Pragma("unroll") for (int q = 0; q < 4; ++q) { const unsigned d0 = wv_[(i0_)][q], d1 = wv_[(i0_) + 1][q], d2 = wv_[(i0_) + 2][q], d3 = wv_[(i0_) + 3][q]; \
                        const unsigned l01 = __builtin_amdgcn_perm(d1, d0, 0x05010400u), h01 = __builtin_amdgcn_perm(d1, d0, 0x07030602u), l23 = __builtin_amdgcn_perm(d3, d2, 0x05010400u), h23 = __builtin_amdgcn_perm(d3, d2, 0x07030602u); \
                        ia[4 * q + 0] = __builtin_amdgcn_sdot4((int)__builtin_amdgcn_perm(l23, l01, 0x05040100u), (int)(wq_), ia[4 * q + 0], false); \
                        ia[4 * q + 1] = __builtin_amdgcn_sdot4((int)__builtin_amdgcn_perm(l23, l01, 0x07060302u), (int)(wq_), ia[4 * q + 1], false); \
                        ia[4 * q + 2] = __builtin_amdgcn_sdot4((int)__builtin_amdgcn_perm(h23, h01, 0x05040100u), (int)(wq_), ia[4 * q + 2], false); \
                        ia[4 * q + 3] = __builtin_amdgcn_sdot4((int)__builtin_amdgcn_perm(h23, h01, 0x07060302u), (int)(wq_), ia[4 * q + 3], false); } } while (0)
                PS_BLK(wb0, 0, Wq[k][0]); PS_BLK(wb0, 4, Wq[k][1]);
                if (k < 3) { PS_LD(wb0, vs, riA); PS_RI(riB, k + 1, 1); } else { PS_LD(wb0, vsn, riA); PS_RI(riB, 0, 1); }
                __builtin_amdgcn_sched_barrier(0);
                PS_BLK(wb1, 0, Wq[k][2]); PS_BLK(wb1, 4, Wq[k][3]);
#undef PS_BLK
                int i8r[8], i4r[4], i2r[2];
#pragma unroll
                for (int j = 0; j < 8; ++j) { const int snd = g0 ? ia[j] : ia[8 + j], kp = g0 ? ia[8 + j] : ia[j];
                    i8r[j] = kp + __builtin_amdgcn_update_dpp(0, snd, 0x128, 0xf, 0xf, false); }
#pragma unroll
                for (int j = 0; j < 4; ++j) { const auto sw = __builtin_amdgcn_permlane16_swap((unsigned)i8r[j], (unsigned)i8r[4 + j], false, false); i4r[j] = (int)sw[0] + (int)sw[1]; }
#pragma unroll
                for (int j = 0; j < 2; ++j) { const auto sw = __builtin_amdgcn_permlane32_swap((unsigned)i4r[j], (unsigned)i4r[2 + j], false, false); i2r[j] = (int)sw[0] + (int)sw[1]; }
                { f32x2 o; o.x = hv.x + (float)i2r[0] * swq[k]; o.y = hv.y + (float)i2r[1] * swq[k];
                  ssq[k] += o.x * o.x + o.y * o.y;
                  *(GAS unsigned*)(Hres + (size_t)tok[k] * DM + 128 * s + colsub) = cvtpk(o.x, o.y); }
                continue;
#elif defined(VF16)
                unsigned ac2[8];
#pragma unroll
                for (int b = 0; b < 8; ++b) ac2[b] = 0u;
#define PS_ROWH(wv_, i_) do { const unsigned wp_ = Wp[k][(i_) >> 1]; \
                    _Pragma("unroll") for (int q = 0; q < 4; ++q) { const unsigned u = wv_[q]; \
                        const unsigned x0 = __builtin_amdgcn_perm(u, 0u, 0x0C050C04u), x1 = __builtin_amdgcn_perm(u, 0u, 0x0C070C06u); \
                        if ((i_) & 1) { pkfma16_hi(ac2[2 * q], x0, wp_); pkfma16_hi(ac2[2 * q + 1], x1, wp_); } else { pkfma16_lo(ac2[2 * q], x0, wp_); pkfma16_lo(ac2[2 * q + 1], x1, wp_); } } } while (0)
#pragma unroll
                for (int i = 0; i < 8; ++i) PS_ROWH(wb0[i], i);
                if (k < 3) { PS_LD(wb0, vs, riA); PS_RI(riB, k + 1, 1); } else { PS_LD(wb0, vsn, riA); PS_RI(riB, 0, 1); }
                __builtin_amdgcn_sched_barrier(0);
#pragma unroll
                for (int i = 0; i < 8; ++i) PS_ROWH(wb1[i], 8 + i);
#undef PS_ROWH
#pragma unroll
                for (int b = 0; b < 8; ++b) { const h2_t hv2 = __builtin_bit_cast(h2_t, ac2[b]); acc[2 * b] = (float)hv2.x * usc[k]; acc[2 * b + 1] = (float)hv2.y * usc[k]; }
#else
#pragma unroll
                for (int b = 0; b < 16; ++b) acc[b] = 0.f;
#pragma unroll
                for (int i = 0; i < 8; ++i) { const float w = W[k][i];
#pragma unroll
                    for (int q = 0; q < 4; ++q) { const unsigned u = wb0[i][q];
                        fmac_s(acc[4 * q + 0], w, (float)(u & 0xffu)); fmac_s(acc[4 * q + 1], w, (float)((u >> 8) & 0xffu)); fmac_s(acc[4 * q + 2], w, (float)((u >> 16) & 0xffu)); fmac_s(acc[4 * q + 3], w, (float)(u >> 24)); } }
                if (k < 3) { PS_ISSUE(wb0, vs, k + 1, 0); } else { PS_ISSUE(wb0, vsn, 0, 0); }
#pragma unroll
                for (int i = 0; i < 8; ++i) { const float w = W[k][8 + i];
#pragma unroll
                    for (int q = 0; q < 4; ++q) { const unsigned u = wb1[i][q];
                        fmac_s(acc[4 * q + 0], w, (float)(u & 0xffu)); fmac_s(acc[4 * q + 1], w, (float)((u >> 8) & 0xffu)); fmac_s(acc[4 * q + 2], w, (float)((u >> 16) & 0xffu)); fmac_s(acc[4 * q + 3], w, (float)(u >> 24)); } }
#endif
                float r8[8], r4[4], r2[2];
#pragma unroll
                for (int j = 0; j < 8; ++j) { const float snd = g0 ? acc[j] : acc[8 + j], kp = g0 ? acc[8 + j] : acc[j];
                    r8[j] = kp + __uint_as_float((unsigned)__builtin_amdgcn_update_dpp(0, (int)__float_as_uint(snd), 0x128  , 0xf, 0xf, false)); }
#pragma unroll
                for (int j = 0; j < 4; ++j) { const auto sw = __builtin_amdgcn_permlane16_swap(__float_as_uint(r8[j]), __float_as_uint(r8[4 + j]), false, false); r4[j] = __uint_as_float(sw[0]) + __uint_as_float(sw[1]); }
#pragma unroll
                for (int j = 0; j < 2; ++j) { const auto sw = __builtin_amdgcn_permlane32_swap(__float_as_uint(r4[j]), __float_as_uint(r4[2 + j]), false, false); r2[j] = __uint_as_float(sw[0]) + __uint_as_float(sw[1]); }
                const float corr = -128.f * wsum[k];
                f32x2 o; o.x = hv.x + r2[0] + corr; o.y = hv.y + r2[1] + corr;
                ssq[k] += o.x * o.x + o.y * o.y;
                *(GAS unsigned*)(Hres + (size_t)tok[k] * DM + 128 * s + colsub) = cvtpk(o.x, o.y);
            }
        }
    }
#endif
#undef PS_ISSUE
    asm volatile("s_waitcnt vmcnt(0)" ::: "memory");
#ifdef PROBE_SWEEP
    const unsigned long long tsw2 = __builtin_amdgcn_s_memrealtime();
#endif
#ifdef FINAL_CONT
#pragma unroll 1
    for (int k = 0; k < 4; ++k) {
        const float rstd = 1.0f / sqrtf(wave_sum(ssq[k]) * (1.f / DM) + RMS_EPS);
        const GAS u32x2* hb = (const GAS u32x2*)(Hres + (size_t)tok[k] * DM) + lane;
        float* orow = hout + (size_t)tok[k] * DM + 4 * lane; const float* gp = gfin + 4 * lane;
        u32x2 hv[16];
#pragma unroll
        for (int j = 0; j < 16; ++j) hv[j] = hb[64 * j];
#pragma unroll
        for (int j = 0; j < 16; ++j) { const f32x4 g0 = *(const GAS f32x4*)(gp + 256 * j);
            f32x4 o; o.x = bflo(hv[j].x) * rstd * g0.x; o.y = bfhi(hv[j].x) * rstd * g0.y; o.z = bflo(hv[j].y) * rstd * g0.z; o.w = bfhi(hv[j].y) * rstd * g0.w;
            *(GAS f32x4*)(orow + 256 * j) = o; }
    }
#elif defined(FINAL_PIPE)
    {
        f32x4 gv[16];
#pragma unroll
        for (int j = 0; j < 8; ++j) { gv[2 * j] = *(const GAS f32x4*)(gfin + 8 * lane + 512 * j); gv[2 * j + 1] = *(const GAS f32x4*)(gfin + 8 * lane + 512 * j + 4); }
        v4u hr[2][8];
#pragma unroll
        for (int j = 0; j < 8; ++j) hr[0][j] = ((const GAS v4u*)(Hres + (size_t)tok[0] * DM) + lane)[64 * j];
#pragma unroll
        for (int k = 0; k < 4; ++k) {
            const float rstd = 1.0f / sqrtf(wave_sum(ssq[k]) * (1.f / DM) + RMS_EPS);
            if (k < 3) {
#pragma unroll
                for (int j = 0; j < 8; ++j) hr[(k + 1) & 1][j] = ((const GAS v4u*)(Hres + (size_t)tok[k + 1] * DM) + lane)[64 * j];
            }
            float* orow = hout + (size_t)tok[k] * DM + 8 * lane;
#pragma unroll
            for (int j = 0; j < 8; ++j) { const v4u v = hr[k & 1][j]; const f32x4 g0 = gv[2 * j], g1 = gv[2 * j + 1];
                f32x4 o0, o1; o0.x = bflo(v.x) * rstd * g0.x; o0.y = bfhi(v.x) * rstd * g0.y; o0.z = bflo(v.y) * rstd * g0.z; o0.w = bfhi(v.y) * rstd * g0.w;
                o1.x = bflo(v.z) * rstd * g1.x; o1.y = bfhi(v.z) * rstd * g1.y; o1.z = bflo(v.w) * rstd * g1.z; o1.w = bfhi(v.w) * rstd * g1.w;
                __builtin_nontemporal_store(o0, (GAS f32x4*)(orow + 512 * j)); __builtin_nontemporal_store(o1, (GAS f32x4*)(orow + 512 * j + 4)); }
        }
    }
#else
#pragma unroll 1
    for (int k = 0; k < 4; ++k) {
        const float rstd = 1.0f / sqrtf(wave_sum(ssq[k]) * (1.f / DM) + RMS_EPS);
        const GAS v4u* hb = (const GAS v4u*)(Hres + (size_t)tok[k] * DM) + lane;
        float* orow = hout + (size_t)tok[k] * DM + 8 * lane; const float* gp = gfin + 8 * lane;
#pragma unroll
        for (int j = 0; j < 8; ++j) { const v4u v = hb[64 * j]; const f32x4 g0 = *(const GAS f32x4*)(gp + 512 * j), g1 = *(const GAS f32x4*)(gp + 512 * j + 4);
            f32x4 o0, o1; o0.x = bflo(v.x) * rstd * g0.x; o0.y = bfhi(v.x) * rstd * g0.y; o0.z = bflo(v.y) * rstd * g0.z; o0.w = bfhi(v.y) * rstd * g0.w;
            o1.x = bflo(v.z) * rstd * g1.x; o1.y = bfhi(v.z) * rstd * g1.y; o1.z = bflo(v.w) * rstd * g1.z; o1.w = bfhi(v.w) * rstd * g1.w;
            *(GAS f32x4*)(orow + 512 * j) = o0; *(GAS f32x4*)(orow + 512 * j + 4) = o1; }
    }
#endif
#ifdef PROBE_SWEEP
    if (gw == 0 && lane == 0) { asm volatile("s_waitcnt vmcnt(0)" ::: "memory");
        const unsigned long long tsw3 = __builtin_amdgcn_s_memrealtime();
        const unsigned long long d = PROBE_SWEEP == 0 ? tsw1 - tsw0 : (PROBE_SWEEP == 1 ? tsw2 - tsw1 : tsw3 - tsw2);
        const float val = PROBE_SWEEP == 4 ? (float)(clock64() - tck0) / (float)(tsw3 - tsw0) / 40.f : (PROBE_SWEEP == 3 ? (float)(tsw3 - tsw0) * (0.01f / 1000.f) : (float)d / (float)(tsw3 - tsw0));
        hout[(size_t)tok[0] * DM] += 0.2f + 0.25f * val; }
#endif
#ifdef PROBE_PHASE
    if (gw == 0 && lane == 0) { asm volatile("s_waitcnt vmcnt(0)" ::: "memory");
        const unsigned long long* ps = (const unsigned long long*)((const unsigned char*)SU - WS_SU + 458752 + 64);
        const unsigned long long tend = (PROBE_END == 13) ? __builtin_amdgcn_s_memrealtime() : ps[PROBE_END];
        hout[(size_t)tok[0] * DM] += 0.2f + 0.25f * ((float)(tend - ps[PROBE_START]) * 0.0131f / (float)PROBE_SCALE); }
#endif
#ifdef PROBE_TIMING
    if (gw == 0 && lane == 0) { asm volatile("s_waitcnt vmcnt(0)" ::: "memory");
        const unsigned long long* pt = (const unsigned long long*)((const unsigned char*)SU - WS_SU + 458752);
        const float tot = (float)pt[3]; const float frac = (float)pt[PROBE_METRIC] / tot;
        hout[(size_t)tok[0] * DM] += 0.2f + 0.25f * frac; }
#endif
}

struct Args { const float* in[21]; float* out; unsigned char* ws; int ph_lo, ph_hi; };
static_assert(sizeof(Args) == 21 * 8 + 8 + 8 + 8, "Args has no padding");

__global__ void __launch_bounds__(NWAVES * 64, 2) hymba_fwd(Args args) {
    extern __shared__ __attribute__((aligned(16))) unsigned char lds_raw[];
    LAS unsigned char* lds = (LAS unsigned char*)lds_raw;
    volatile LAS unsigned* MISC = (volatile LAS unsigned*)(lds + MISC_OFF);
    const int tid = threadIdx.x, lane = tid & 63, wave = __builtin_amdgcn_readfirstlane(tid >> 6);
    const int G = gridDim.x; const int bx = blockIdx.x;
    const int vcu = (G % 8 == 0) ? (bx % 8) * (G / 8) + bx / 8 : bx;
    unsigned char* ws = args.ws;
    gu32* ctl = (gu32*)(ws + WS_CTL);
    for (int u = tid; u < (LDS_BYTES - LDSCTL_OFF) / 4; u += NWAVES * 64) ((LAS unsigned*)(lds + LDSCTL_OFF))[u] = 0u;
    __syncthreads();
    XcdBarrier bar = xcd_barrier_post((unsigned*)(ctl + CW_BAR), MISC + 8);
    const int lo = args.ph_lo, hi = args.ph_hi;
#ifdef PH_ONLY
#define IN(k) ((k) == PH_ONLY && lo <= (k) && (k) < hi)
#else
#define IN(k) (lo <= (k) && (k) < hi)
#endif
#ifndef DUP_PHASE
#define DUP_PHASE -1
#endif
#define REP(k) for (int rep_ = 0; rep_ < ((k) == DUP_PHASE ? 2 : 1); ++rep_)
#ifdef PROBE_PHASE
#define PSTAMP(i_) do { if (blockIdx.x == 0 && tid == 0) ((unsigned long long*)(ws + 458752 + 64))[i_] = __builtin_amdgcn_s_memrealtime(); } while (0)
#define PSTAMPB(i_) do { __syncthreads(); if (bx == G - 1 && tid == 0) ((unsigned long long*)(ws + 458752 + 64))[i_] = __builtin_amdgcn_s_memrealtime(); } while (0)
#else
#define PSTAMP(i_) do {} while (0)
#define PSTAMPB(i_) do {} while (0)
#endif
#define SEAM(k) do { if (IN(k) && IN((k) + 1)) xcd_barrier(bar); PSTAMP((k) + 1); } while (0)

    const float* x = args.in[0]; const float* mem = args.in[1]; const float* norm_mix = args.in[2]; const float* w_in = args.in[3];
    const float* swa_sink = args.in[4]; const float* nat_rel_bias = args.in[5]; const float* out_norm_swa = args.in[6]; const float* out_norm_nat = args.in[7];
    const float* w_out = args.in[8]; const float* norm_mem_q = args.in[9]; const float* norm_mem_kv = args.in[10]; const float* w_mem_q = args.in[11];
    const float* w_mem_k = args.in[12]; const float* w_mem_v = args.in[13]; const float* w_mem_o = args.in[14]; const float* norm_ffn = args.in[15];
    const float* w_peer_q = args.in[16]; const float* peer_sub_keys = args.in[17]; const float* peer_u = args.in[18]; const float* peer_v = args.in[19];
    const float* norm_final = args.in[20];
    float* out = args.out;
    float* ropec = (float*)(ws + WS_ROPE); float* ropes = ropec + 2048 * 64;
    bf16* SKB = (bf16*)(ws + WS_SKB);
    bf16* WIN_T = (bf16*)(ws + WS_WIN); bf16* WOUT_T = (bf16*)(ws + WS_WOUT); bf16* WMQ_T = (bf16*)(ws + WS_WMQ); bf16* WMKV_T = (bf16*)(ws + WS_WMKV);
    bf16* WMO_T = (bf16*)(ws + WS_WMO); bf16* WPQ_T = (bf16*)(ws + WS_WPQ); bf16* UB = (bf16*)(ws + WS_UB); bf16* VB = (bf16*)(ws + WS_VB);
    bf16* XN = (bf16*)(ws + WS_XN); bf16* QKV = (bf16*)(ws + WS_QKV); bf16* OB = (bf16*)(ws + WS_OB); bf16* MEMN = (bf16*)(ws + WS_MEMN);
    bf16* KVM = (bf16*)(ws + WS_KVM); bf16* QM = (bf16*)(ws + WS_QM); bf16* OM = (bf16*)(ws + WS_OM); bf16* QP = (bf16*)(ws + WS_QP);
    int* IDX = (int*)(ws + WS_IDX); float* GATE = (float*)(ws + WS_GATE);
    float* SSQ1 = (float*)(ws + WS_SSQ1); float* SSQ2 = (float*)(ws + WS_SSQ2); float* SSQA = (float*)(ws + WS_SSQA); float* SSQB = (float*)(ws + WS_SSQB); float* SSQ0 = (float*)(ws + WS_SSQ0);
    unsigned* CM = (unsigned*)(ws + WS_CM); unsigned* CM2 = (unsigned*)(ws + WS_CM2); unsigned* CM3 = (unsigned*)(ws + WS_CM3);
    unsigned char* XQ = ws + WS_XQ; float* SX = (float*)(ws + WS_SX);
    unsigned char* UQ = ws + WS_UQ; unsigned char* VQ = ws + WS_VQ; float* SU = (float*)(ws + WS_SU); float* SV = (float*)(ws + WS_SV);
    const int gw = vcu * NWAVES + wave, NGW = G * NWAVES;

    PSTAMP(0);
    constexpr int I_IN = (DM / 64) * (INW / 32), I_OUT = (DM / 64) * (DM / 32), I_MQ = (DM / 64) * (MEMW / 32), I_MO = (MEMW / 64) * (DM / 32), I_PQ = (DM / 64) * (PQW / 32);
#ifdef QKV_I8
#ifndef QR0V
#define QR0V 13824
#endif
#ifndef QR1V
#define QR1V 19968
#endif
    constexpr int QR0 = QR0V, QR1 = QR1V;
#ifndef D1P0
#define D1P0 8192
#endif
#else
    constexpr int QR0 = 26624, QR1 = 28160;
#define D1P0 0
#endif
#ifdef WOUT_I8
#define D1_WOUT(r_) p0_transpose_item_i8(w_out, DM, DM, (unsigned char*)WOUT_T, CM2, scr, (r_), lane, out_norm_swa, out_norm_nat)
#else
#define D1_WOUT(r_) p0_transpose_item(w_out, DM, DM, WOUT_T, 0, scr, (r_), lane, out_norm_swa, out_norm_nat)
#endif
#define D1_ITEM(it_) do { int r = (it_); \
        if (r < I_OUT) { D1_WOUT(r); break; } r -= I_OUT; \
        if (r < I_MQ) { p0_transpose_item(w_mem_q, DM, MEMW, WMQ_T, 0, scr, r, lane, norm_mem_q, norm_mem_q + 2048); break; } r -= I_MQ; \
        if (r < I_MQ) { p0_transpose_item(w_mem_k, DM, MEMW, WMKV_T, 0, scr, r, lane); break; } r -= I_MQ; \
        p0_transpose_item(w_mem_v, DM, MEMW, WMKV_T, MEMW, scr, r, lane); } while (0)
#define QUANT_ROWS(first_, last_, w0_, nw_) quant_rows_strided((first_) + (w0_), (last_), (nw_), peer_u, peer_v, UQ, VQ, SU, SV, lane, (LAS unsigned*)(lds + wave * 16384))
    if (IN(0)) REP(0) {
        LAS float* scr = (LAS float*)(lds + wave * 16384);
#ifdef DUP_P0A
        for (int rr_ = 0; rr_ < 2; ++rr_)
#endif
#ifdef QKV_I8
        { constexpr int C_IN = (DM / CMR) * (INW / 256), C_OUT = (DM / CMR) * (DM / 256), C_PQ = (DM / CMR) * (PQW / 256);
#if defined(PQ_I8)
          constexpr int C_ALL = C_IN + C_OUT + C_PQ;
#elif defined(WOUT_I8)
          constexpr int C_ALL = C_IN + C_OUT;
#else
          constexpr int C_ALL = C_IN;
#endif
          for (int it = gw; it < C_ALL; it += NGW) {
              if (it < C_IN) p0_colmax_rows(w_in, INW, CM, it, lane, norm_mix);
              else if (it < C_IN + C_OUT) p0_colmax_rows(w_out, DM, CM2, it - C_IN, lane, out_norm_swa, out_norm_nat);
              else p0_colmax_rows(w_peer_q, PQW, CM3, it - C_IN - C_OUT, lane, nullptr);
          } }
#if 0
#ifdef WOUT_I8
        for (int it = gw; it < I_OUT / CMK; it += NGW) p0_colmax_item(w_out, DM, CM2, it, lane, out_norm_swa, out_norm_nat);
#endif
#ifdef PQ_I8
        for (int it = gw; it < I_PQ / CMK; it += NGW) p0_colmax_item(w_peer_q, PQW, CM3, it, lane, nullptr);
#endif
#endif
        PSTAMP(14);
        xcd_barrier(bar);
        PSTAMP(15);
#ifdef I8PAIR
        for (int it = 2 * gw; it < I_IN; it += 2 * NGW) { p0_transpose_item_i8(w_in, DM, INW, (unsigned char*)WIN_T, CM, scr, it, lane, norm_mix); p0_transpose_item_i8(w_in, DM, INW, (unsigned char*)WIN_T, CM, scr, it + 1, lane, norm_mix); }
#else
        for (int it = gw; it < I_IN; it += NGW) p0_transpose_item_i8(w_in, DM, INW, (unsigned char*)WIN_T, CM, scr, it, lane, norm_mix);
#endif
        PSTAMP(16);
#ifdef I8PAIR
        for (int it = 2 * gw; it < D1P0; it += 2 * NGW) { D1_ITEM(it); D1_ITEM(it + 1); }
#else
        for (int it = gw; it < D1P0; it += NGW) D1_ITEM(it);
#endif
        PSTAMP(17);
        for (int m = gw; m < T_TOK; m += NGW) row_to_bf16_i8(x + (size_t)m * DM, XN + (size_t)m * DM, XQ + (size_t)m * DM, SSQ0 + m, lane);
        PSTAMP(18);
#else
        for (int it = gw; it < I_IN; it += NGW) p0_transpose_item(w_in, DM, INW, WIN_T, 0, scr, it, lane, norm_mix, norm_mix + 2048);
        for (int m = gw; m < T_TOK; m += NGW) row_to_bf16_ssq(x + (size_t)m * DM, XN + (size_t)m * DM, SSQ0 + m, lane);
#endif
        for (int m = gw; m < NBATCH * MEMLEN; m += NGW) rms_row_to_bf16(mem + (size_t)m * DM, norm_mem_kv, MEMN + (size_t)m * DM, lane);
#ifdef DUP_P0C
        for (int rr_ = 0; rr_ < 2; ++rr_)
#endif
        QUANT_ROWS(0, QR0, gw, NGW);
        PSTAMP(19);
#ifdef DUP_P0C_NOST
        quant_rows_strided<true>(gw, QR0, NGW, peer_u, peer_v, UQ, VQ, SU, SV, lane);
#endif
        for (int e = gw * 64 + lane; e < 4 * T_TOK; e += NGW * 64) SSQ1[e] = 0.f;
        for (int e = (gw * 64 + lane) * 4; e < 8 * 2 * 128 * 128; e += NGW * 64 * 4) { const f32x4 a = *(const GAS f32x4*)(peer_sub_keys + e); u32x2 w; w.x = cvtpk(a.x, a.y); w.y = cvtpk(a.z, a.w); *(GAS u32x2*)(SKB + e) = w; }
        for (int e = gw * 64 + lane; e < 2048 * 64; e += NGW * 64) {
            const int pos = e >> 6, i = e & 63;
            const float inv = fexp2(-(float)i * (13.287712379549449f / 64.0f));
            const float ang = (float)pos * inv;
            const float rev = ang * 0.15915494309189535f; const float fr = rev - floorf(rev);
            ropec[e] = __builtin_amdgcn_cosf(fr); ropes[e] = __builtin_amdgcn_sinf(fr);
        }
    }
    SEAM(0);
    if (IN(1)) REP(1) {
#ifdef QKV_I8
        { pg8::Gemm g{(const bf16*)XQ, WIN_T, T_TOK, INW, DM / 2}; pg8::StaticOrder S; S.init(T_TOK, INW, G, bx);
          EpiBf16I8 E{QKV, INW, SSQ0, CM};
          pg8::gemm_phase<EpiBf16I8, pg8::StaticOrder, true, true, false, true>(lds, g, S, E); }
#else
        { pg8::Gemm g{XN, WIN_T, T_TOK, INW, DM}; pg8::StaticOrder S; S.init(T_TOK, INW, G, bx);
          EpiBf16RowScale E{QKV, INW, SSQ0};
          pg8::gemm_phase<EpiBf16RowScale, pg8::StaticOrder, true, true>(lds, g, S, E); }
#endif
        if (bx >= G / 2) {
            LAS float* scr = (LAS float*)(lds + wave * 16384);
            const int w0 = (bx - G / 2) * NWAVES + wave, nw = (G - G / 2) * NWAVES;
            PSTAMPB(20);
#ifdef WGTR
            static_assert(D1P0 == I_OUT, "the P1 slot only holds the w_mem_q/k/v copies");
            wgtr_run((LAS float*)lds, bx - G / 2, 768, G - G / 2, [&](int g) -> WgTrDesc { const int m = g >> 8, it = g & 255;
                return m == 0 ? WgTrDesc{w_mem_q, WMQ_T, norm_mem_q, DM, MEMW, 0, it} : m == 1 ? WgTrDesc{w_mem_k, WMKV_T, nullptr, DM, MEMW, 0, it} : WgTrDesc{w_mem_v, WMKV_T, nullptr, DM, MEMW, MEMW, it}; }, wave, lane);
#else
            for (int it = D1P0 + w0; it < I_OUT + 3 * I_MQ; it += nw) D1_ITEM(it);
#endif
            PSTAMPB(21);
            QUANT_ROWS(QR0, QR1, w0, nw);
            PSTAMPB(22);
        }
    }
    SEAM(1);
    if (IN(2)) REP(2) {
        for (int u = vcu; u < 1024; u += G) {
#ifndef NO_SWA
            if (u < 512) swa_unit(lds, u, QKV, OB, swa_sink, ropec, ropes, SSQA);
#endif
#ifndef NO_NAT
            if (u >= 512) nat_unit(lds, u - 512, QKV, OB, nat_rel_bias, SSQB);
#endif
#ifdef PROBE_SWA2
            if (u < 512) swa_unit<true>(lds, u, QKV, (bf16*)(ws + WS_QP), swa_sink, ropec, ropes, (float*)(ws + 393216));
#endif
#ifdef PROBE_NAT2
            if (u >= 512) nat_unit(lds, u - 512, QKV, (bf16*)(ws + WS_QP), nat_rel_bias, (float*)(ws + 393216));
#endif
        }
    }
    SEAM(2);
#ifdef WOUT_I8
    if (IN(3)) { unsigned char* OQ = (unsigned char*)QKV;
        for (int m = gw; m < T_TOK; m += NGW) mix_row_to_i8(OB + (size_t)m * DM, SSQA[m], SSQB[m], OQ + (size_t)m * DM, SSQ0 + m, lane); }
    SEAM(3);
    if (IN(4)) REP(4) {
        pg8::Gemm g{(const bf16*)QKV, WOUT_T, T_TOK, DM, DM / 2}; pg8::StaticOrder S; S.init(T_TOK, DM, G, bx);
        EpiResHI8 E{XN, SSQ1, DM, SSQ0, CM2, x};
        pg8::gemm_phase<EpiResHI8, pg8::StaticOrder, true, true, false, true>(lds, g, S, E);
    }
#else
    if (IN(4)) REP(4) {
        pg8::Gemm g{OB, WOUT_T, T_TOK, DM, DM}; pg8::StaticOrder S; S.init(T_TOK, DM, G, bx);
        EpiResHMid E{XN, SSQ1, DM, SSQA, SSQB, (LAS float*)(lds + RING_BYTES + 1024)};
        pg8::gemm_phase<EpiResHMid, pg8::StaticOrder, true, true, true>(lds, g, S, E);
    }
#endif
    SEAM(4);
    if (IN(6)) REP(6) {
        pg8::Gemm g{XN, WMQ_T, T_TOK, MEMW, DM}; pg8::StaticOrder S; S.init(T_TOK, MEMW, G, bx);
        EpiBf16RowScale E{QM, MEMW, SSQ1};
        pg8::gemm_phase<EpiBf16RowScale, pg8::StaticOrder, true, true>(lds, g, S, E);
        { pg8::Gemm g2{MEMN, WMKV_T, NBATCH * MEMLEN, 2 * MEMW, DM}; pg8::StaticOrder S2; S2.init(NBATCH * MEMLEN, 2 * MEMW, G, (bx + G / 2) % G);
          pg8::EpiBf16<0> E2{KVM, 2 * MEMW, nullptr, 0, 0, 1.f};
          pg8::gemm_phase<pg8::EpiBf16<0>, pg8::StaticOrder, true, true>(lds, g2, S2, E2); }
        if (bx >= G / 2 + 32) {
            LAS float* scr = (LAS float*)(lds + wave * 16384);
            const int w0 = (bx - (G / 2 + 32)) * NWAVES + wave, nw = (G - (G / 2 + 32)) * NWAVES;
            PSTAMPB(23);
#if defined(WGTR) && !defined(PQ_I8)
            wgtr_run((LAS float*)lds, bx - (G / 2 + 32), 768, G - (G / 2 + 32), [&](int g) -> WgTrDesc {
                return g < 256 ? WgTrDesc{w_mem_o, WMO_T, nullptr, MEMW, DM, 0, g} : WgTrDesc{w_peer_q, WPQ_T, norm_ffn, DM, PQW, 0, g - 256}; }, wave, lane);
            if (0)
#endif
            for (int it = w0; it < I_MO + I_PQ; it += nw) {
                if (it < I_MO) p0_transpose_item(w_mem_o, MEMW, DM, WMO_T, 0, scr, it, lane);
#ifdef PQ_I8
                else p0_transpose_item_i8(w_peer_q, DM, PQW, (unsigned char*)WPQ_T, CM3, scr, it - I_MO, lane, nullptr);
#else
                else p0_transpose_item(w_peer_q, DM, PQW, WPQ_T, 0, scr, it - I_MO, lane, norm_ffn, norm_ffn + 2048);
#endif
            }
            PSTAMPB(24);
            QUANT_ROWS(QR1, 2 * NEXP, w0, nw);
            PSTAMPB(25);
        }
    }
    SEAM(6);
    if (IN(7)) REP(7) { for (int u = bx; u < 256; u += G) mem_unit(lds, u, QM, KVM, OM); }
    SEAM(7);
    if (IN(8)) {
        pg8::Gemm g{OM, WMO_T, T_TOK, DM, MEMW}; pg8::StaticOrder S; S.init(T_TOK, DM, G, bx);
        EpiResH E{XN, SSQ2, DM};
        pg8::gemm_phase<EpiResH, pg8::StaticOrder, true, true>(lds, g, S, E);
    }
    SEAM(8);
#ifdef PQ_I8
    if (IN(9)) { for (int m = gw; m < T_TOK; m += NGW) quant_token(m, XN, norm_ffn, SSQ2, XQ, SX, lane); }
    SEAM(9);
#endif
    if (IN(10)) REP(10) {
#ifdef PQ_I8
        pg8::Gemm g{(const bf16*)XQ, WPQ_T, T_TOK, PQW, DM / 2}; pg8::StaticOrder S; S.init(T_TOK, PQW, G, bx);
        EpiBf16I8 E{QP, PQW, SX, CM3};
        pg8::gemm_phase<EpiBf16I8, pg8::StaticOrder, true, true, false, true>(lds, g, S, E);
#else
        pg8::Gemm g{XN, WPQ_T, T_TOK, PQW, DM}; pg8::StaticOrder S; S.init(T_TOK, PQW, G, bx);
        EpiBf16RowScale E{QP, PQW, SSQ2};
        pg8::gemm_phase<EpiBf16RowScale, pg8::StaticOrder, true, true>(lds, g, S, E);
#endif
#ifdef FUSE_ROUTE
        { pg8::Unit un; for (int i = 0; S.next(i, un); ++i) { asm volatile("s_waitcnt vmcnt(0)" ::: "memory"); route_unit(lds, un.pm * 8 + un.pn, QP, SKB, IDX, GATE); } }
#ifndef PQ_I8
        for (int m = gw; m < T_TOK; m += NGW) quant_token(m, XN, norm_ffn, SSQ2, XQ, SX, lane);
#endif
#endif
    }
#ifdef FUSE_ROUTE
    if (IN(10) && IN(12)) { xcd_barrier(bar); PSTAMP(12); }
#else
    SEAM(10);
    if (IN(11)) REP(11) { for (int u = bx; u < 256; u += G) route_unit(lds, u, QP, SKB, IDX, GATE);
        for (int m = gw; m < T_TOK; m += NGW) quant_token(m, XN, norm_ffn, SSQ2, XQ, SX, lane); }
    SEAM(11);
#endif
    if (IN(12)) { __syncthreads(); peer_sweep(lds, wave, gw, NGW, XQ, SX, IDX, GATE, UQ, VQ, SU, SV, XN, out, norm_final, lane); }
#ifdef PROBE_TAIL
    { unsigned long long* endt = (unsigned long long*)(ws + 458752 + 1024);
      __syncthreads(); if (tid == 0) { asm volatile("s_waitcnt vmcnt(0)" ::: "memory"); endt[blockIdx.x] = __builtin_amdgcn_s_memrealtime(); }
      xcd_barrier(bar);
      if (gw == 0) { const unsigned long long* ps = (const unsigned long long*)(ws + 458752 + 64); float mx = 0.f, mn = 1e30f, sm = 0.f, sx = 0.f; int nx = 0;
        for (int j = 0; j < 4; ++j) { const int b = lane + 64 * j; const float t = (float)(__builtin_nontemporal_load(endt + b) - ps[PROBE_START]) * 0.0131f; mx = fmaxf(mx, t); mn = fminf(mn, t); sm += t;
            if ((b & 7) == (PROBE_TAILSEL - 10)) { sx += t; ++nx; } }
        for (int o = 1; o < 64; o <<= 1) { mx = fmaxf(mx, __shfl_xor(mx, o)); mn = fminf(mn, __shfl_xor(mn, o)); sm += __shfl_xor(sm, o); sx += __shfl_xor(sx, o); nx += __shfl_xor(nx, o); }
        const float val = PROBE_TAILSEL == 0 ? mx : PROBE_TAILSEL == 1 ? mn : PROBE_TAILSEL == 2 ? sm * (1.f / 256.f) : sx / (float)(nx > 0 ? nx : 1);
        if (lane == 0) out[0] += 0.25f * (val / (float)PROBE_SCALE); } }
#endif
#undef IN
#undef SEAM
}

constexpr int N_PHASES = 13;
#ifndef MK_N_LAUNCHES
#define MK_N_LAUNCHES 1
#endif

extern "C" void kernel_launch(void* const* d_in, const int* in_sizes, int n_in, void* d_out, int out_size, void* d_ws, size_t ws_size, hipStream_t stream) {
    static int grid = 0;
    if (grid == 0) {
        if (n_in != 21 || in_sizes[0] != T_TOK * DM || out_size != T_TOK * DM || ws_size < WS_END) { fprintf(stderr, "kernel_launch: unexpected shapes (n_in %d in0 %d out %d ws %zu)\n", n_in, n_in > 0 ? in_sizes[0] : -1, out_size, ws_size); grid = -1; return; }
        int dev = 0, cus = 0, per_cu = 0;
        if (hipGetDevice(&dev) != hipSuccess || hipDeviceGetAttribute(&cus, hipDeviceAttributeMultiprocessorCount, dev) != hipSuccess) { grid = -1; return; }
        if (hipFuncSetAttribute((const void*)hymba_fwd, hipFuncAttributeMaxDynamicSharedMemorySize, LDS_BYTES) != hipSuccess) { fprintf(stderr, "kernel_launch: hipFuncSetAttribute failed\n"); grid = -1; return; }
        if (hipOccupancyMaxActiveBlocksPerMultiprocessor(&per_cu, (const void*)hymba_fwd, NWAVES * 64, LDS_BYTES) != hipSuccess || per_cu < 1) fprintf(stderr, "kernel_launch: occupancy query says %d\n", per_cu);
        (void)hipGetLastError();
        grid = cus;
    }
    if (grid < 0) return;
    if (hipMemsetAsync((char*)d_ws + WS_CTL, 0, CTL_ZERO_BYTES, stream) != hipSuccess) return;
    Args a{};
    for (int i = 0; i < 21; ++i) a.in[i] = (const float*)d_in[i];
    a.out = (float*)d_out; a.ws = (unsigned char*)d_ws;
#if MK_N_LAUNCHES == 1
    a.ph_lo = 0; a.ph_hi = N_PHASES;
    hipLaunchKernelGGL(hymba_fwd, dim3(grid), dim3(NWAVES * 64), LDS_BYTES, stream, a);
#else
    for (int p = 0; p < N_PHASES; ++p) { a.ph_lo = p; a.ph_hi = p + 1; hipLaunchKernelGGL(hymba_fwd, dim3(grid), dim3(NWAVES * 64), LDS_BYTES, stream, a); }
#endif
}
```
